# Optimizing an MI355X kernel written in HIP

```python
import jax, jax.numpy as jnp
from jax import lax
import numpy as np

D_MODEL = 1024
BATCH = 8
SEQ = 2048
DEPTH = 4

HEAD_DIM = 64
N_HEADS = D_MODEL // HEAD_DIM
N_SB_HEADS = N_HEADS // 2
N_DIL_HEADS = N_HEADS - N_SB_HEADS
N_FOX_HEADS = N_HEADS
D_ATTN = N_HEADS * HEAD_DIM
D_FF = -(-8 * D_MODEL // (3 * 256)) * 256
ROPE_THETA = 500000.0
ROT_DIM = HEAD_DIM // 4
Q_BLOCK = 128
DIL_PATTERNS = ((128, 1), (512, 4), (2048, 16))
RMS_EPS = 1e-5
N_EVEN = (DEPTH + 1) // 2
N_ODD = DEPTH // 2

kernel_name = "hybrid_stickbreak_dilated_fox_trunk"


def rms_norm(x, g):
    xf = x.astype(jnp.float32)
    y = xf * lax.rsqrt(jnp.mean(xf * xf, axis=-1, keepdims=True) + RMS_EPS)
    return (y * g.astype(jnp.float32)).astype(x.dtype)


def partial_rotary(x, pos):
    half = ROT_DIM // 2
    inv_freq = ROPE_THETA ** (-jnp.arange(half, dtype=jnp.float32) * 2.0 / ROT_DIM)
    ang = pos[:, None] * inv_freq[None, :]
    cos = jnp.cos(ang)[:, None, :].astype(x.dtype)
    sin = jnp.sin(ang)[:, None, :].astype(x.dtype)
    x1, x2, x_pass = x[..., :half], x[..., half:ROT_DIM], x[..., ROT_DIM:]
    return jnp.concatenate([x1 * cos - x2 * sin, x2 * cos + x1 * sin, x_pass], axis=-1)


def stick_breaking_attention(q, k, v):
    B, H, S, Dh = q.shape
    nb = S // Q_BLOCK
    qb = q.reshape(B, H, nb, Q_BLOCK, Dh).transpose(2, 0, 1, 3, 4)
    kpos = jnp.arange(S)

    def block(args):
        qblk, n = args
        z = jnp.einsum('bhqd,bhkd->bhqk', qblk, k).astype(jnp.float32)
        qpos = n * Q_BLOCK + jnp.arange(Q_BLOCK)
        strict = kpos[None, :] < qpos[:, None]
        log_1m_beta = jnp.where(strict, jax.nn.log_sigmoid(-z), 0.0)
        between = lax.cumsum(log_1m_beta, axis=3, reverse=True) - log_1m_beta
        a = jnp.where(strict, jnp.exp(jax.nn.log_sigmoid(z) + between), 0.0)
        return jnp.einsum('bhqk,bhkd->bhqd', a.astype(v.dtype), v)

    out = lax.map(block, (qb, jnp.arange(nb)))
    return out.transpose(1, 2, 0, 3, 4).reshape(B, H, S, Dh)


def dilated_window_attention(q, k, v, window, dilation):
    B, S, H, Dh = q.shape
    span = window // dilation
    L = S // dilation
    nb = -(-L // span)
    Lp = nb * span

    def to_blocks(t):
        t = t.reshape(B, L, dilation, H, Dh)
        t = jnp.pad(t, ((0, 0), (0, Lp - L), (0, 0), (0, 0), (0, 0)))
        return t.reshape(B, nb, span, dilation, H, Dh)

    def with_prev(t):
        prev = jnp.pad(t[:, :-1], ((0, 0), (1, 0), (0, 0), (0, 0), (0, 0), (0, 0)))
        return jnp.concatenate([prev, t], axis=2)

    qb = to_blocks(q)
    kw = with_prev(to_blocks(k))
    vw = with_prev(to_blocks(v))
    s = jnp.einsum('bnqrhd,bnkrhd->bnrhqk', qb, kw).astype(jnp.float32)
    a = jnp.arange(span)[None, :, None]
    kk = jnp.arange(2 * span)[None, None, :]
    blk = jnp.arange(nb)[:, None, None]
    valid = (kk >= a) & (kk <= a + span) & (blk * span - span + kk >= 0)
    s = jnp.where(valid[None, :, None, None], s, -jnp.inf)
    m = jnp.max(s, axis=-1, keepdims=True)
    p = jnp.exp(s - m)
    l = jnp.sum(p, axis=-1, keepdims=True)
    o = jnp.einsum('bnrhqk,bnkrhd->bnqrhd', (p / l).astype(v.dtype), vw)
    lse = (m + jnp.log(l))[..., 0]
    o = o.reshape(B, Lp, dilation, H, Dh)[:, :L].reshape(B, S, H, Dh)
    lse = lse.transpose(0, 1, 4, 2, 3).reshape(B, Lp, dilation, H)[:, :L].reshape(B, S, H)
    return o, lse


def forgetting_attention(q, k, v, log_f):
    B, H, S, Dh = q.shape
    F = lax.cumsum(log_f, axis=2)
    nb = S // Q_BLOCK
    qb = q.reshape(B, H, nb, Q_BLOCK, Dh).transpose(2, 0, 1, 3, 4)
    Fb = F.reshape(B, H, nb, Q_BLOCK).transpose(2, 0, 1, 3)
    kpos = jnp.arange(S)

    def block(args):
        qblk, Fq, n = args
        z = jnp.einsum('bhqd,bhkd->bhqk', qblk, k).astype(jnp.float32)
        z = z + Fq[..., None] - F[:, :, None, :]
        qpos = n * Q_BLOCK + jnp.arange(Q_BLOCK)
        z = jnp.where(kpos[None, :] <= qpos[:, None], z, -jnp.inf)
        p = jax.nn.softmax(z, axis=-1)
        return jnp.einsum('bhqk,bhkd->bhqd', p.astype(v.dtype), v)

    out = lax.map(block, (qb, Fb, jnp.arange(nb)))
    return out.transpose(1, 2, 0, 3, 4).reshape(B, H, S, Dh)


def even_mixer(h, w_qkv, w_o):
    B, S, _ = h.shape
    scale = HEAD_DIM ** -0.5
    qkv = (h @ w_qkv).reshape(B, S, 3, N_HEADS, HEAD_DIM)
    q, k, v = qkv[:, :, 0], qkv[:, :, 1], qkv[:, :, 2]
    qa = (q[:, :, :N_SB_HEADS] * scale).transpose(0, 2, 1, 3)
    ka = k[:, :, :N_SB_HEADS].transpose(0, 2, 1, 3)
    va = v[:, :, :N_SB_HEADS].transpose(0, 2, 1, 3)
    out_a = stick_breaking_attention(qa, ka, va).transpose(0, 2, 1, 3)
    pos = jnp.arange(S, dtype=jnp.float32)
    qd = partial_rotary(q[:, :, N_SB_HEADS:], pos) * scale
    kd = partial_rotary(k[:, :, N_SB_HEADS:], pos)
    vd = v[:, :, N_SB_HEADS:]
    outs, lses = [], []
    for window, dilation in DIL_PATTERNS:
        o_p, lse_p = dilated_window_attention(qd, kd, vd, window, dilation)
        outs.append(o_p)
        lses.append(lse_p)
    mix = jax.nn.softmax(jnp.stack(lses), axis=0)
    out_b = jnp.einsum('pbsh,pbshd->bshd', mix.astype(vd.dtype), jnp.stack(outs))
    o = jnp.concatenate([out_a, out_b], axis=2).reshape(B, S, D_ATTN)
    return o @ w_o


def odd_mixer(h, w_qkvf, b_forget, w_o):
    B, S, _ = h.shape
    scale = HEAD_DIM ** -0.5
    proj = h @ w_qkvf
    qkv = proj[..., :3 * D_ATTN].reshape(B, S, 3, N_FOX_HEADS, HEAD_DIM)
    f_logit = proj[..., 3 * D_ATTN:] + b_forget
    log_f = jax.nn.log_sigmoid(f_logit.astype(jnp.float32)).transpose(0, 2, 1)
    q = (qkv[:, :, 0] * scale).transpose(0, 2, 1, 3)
    k = qkv[:, :, 1].transpose(0, 2, 1, 3)
    v = qkv[:, :, 2].transpose(0, 2, 1, 3)
    o = forgetting_attention(q, k, v, log_f).transpose(0, 2, 1, 3).reshape(B, S, D_ATTN)
    return o @ w_o


def swiglu(h, w_in, w_out):
    g, u = jnp.split(h @ w_in, 2, axis=-1)
    return (jax.nn.silu(g) * u) @ w_out


def setup_inputs(seed: int = 0) -> dict:
    key = jax.random.key(seed)
    ks = jax.random.split(key, 12)
    f32 = jnp.float32
    res_scale = (2.0 * DEPTH) ** -0.5
    x = jax.random.normal(ks[0], (BATCH, SEQ, D_MODEL), f32)
    norm_mix = 1.0 + 0.02 * jax.random.normal(ks[1], (DEPTH, D_MODEL), f32)
    w_qkv_even = jax.random.normal(ks[2], (N_EVEN, D_MODEL, 3 * D_ATTN), f32) * D_MODEL ** -0.5
    w_o_even = jax.random.normal(ks[3], (N_EVEN, D_ATTN, D_MODEL), f32) * (D_ATTN ** -0.5 * res_scale)
    w_qkvf_odd = jax.random.normal(ks[4], (N_ODD, D_MODEL, 3 * D_ATTN + N_FOX_HEADS), f32) * D_MODEL ** -0.5
    b_forget = jax.random.uniform(ks[5], (N_ODD, N_FOX_HEADS), f32, minval=1.0, maxval=4.0)
    w_o_odd = jax.random.normal(ks[6], (N_ODD, D_ATTN, D_MODEL), f32) * (D_ATTN ** -0.5 * res_scale)
    norm_ffn = 1.0 + 0.02 * jax.random.normal(ks[7], (DEPTH, D_MODEL), f32)
    w_ffn_in = jax.random.normal(ks[8], (DEPTH, D_MODEL, 2 * D_FF), f32) * D_MODEL ** -0.5
    w_ffn_out = jax.random.normal(ks[9], (DEPTH, D_FF, D_MODEL), f32) * (D_FF ** -0.5 * res_scale)
    norm_final = 1.0 + 0.02 * jax.random.normal(ks[10], (D_MODEL,), f32)
    return {"x": x, "norm_mix": norm_mix, "w_qkv_even": w_qkv_even, "w_o_even": w_o_even,
            "w_qkvf_odd": w_qkvf_odd, "b_forget": b_forget, "w_o_odd": w_o_odd,
            "norm_ffn": norm_ffn, "w_ffn_in": w_ffn_in, "w_ffn_out": w_ffn_out,
            "norm_final": norm_final}


def reference(x, norm_mix, w_qkv_even, w_o_even, w_qkvf_odd, b_forget, w_o_odd,
              norm_ffn, w_ffn_in, w_ffn_out, norm_final):
    for layer in range(DEPTH):
        h = rms_norm(x, norm_mix[layer])
        if layer % 2 == 0:
            x = x + even_mixer(h, w_qkv_even[layer // 2], w_o_even[layer // 2])
        else:
            x = x + odd_mixer(h, w_qkvf_odd[layer // 2], b_forget[layer // 2], w_o_odd[layer // 2])
        h = rms_norm(x, norm_ffn[layer])
        x = x + swiglu(h, w_ffn_in[layer], w_ffn_out[layer])
    return rms_norm(x, norm_final)
```

```cpp
#include <hip/hip_runtime.h>
#include <hip/hip_cooperative_groups.h>
#include <cstdio>
#include <cstdint>
namespace cg = cooperative_groups;
namespace pg8 {
#define PG8_LAS __attribute__((address_space(3)))
typedef unsigned short bf16_t;
typedef short bf16x8 __attribute__((ext_vector_type(8)));
typedef float f32x4 __attribute__((ext_vector_type(4)));
typedef unsigned u32x4 __attribute__((ext_vector_type(4)));
constexpr int BM = 256, BK = 64, HALF = 128, HTB = HALF * BK * 2  , STAGE_BYTES = 8 * HTB, NXCD = 8, WGM = 8;

__host__ __device__ __forceinline__ int lds_byte(int r, int c) { const int st = (r >> 4) * 2 + (c >> 5), rr = r & 15, cc = c & 31, ob = rr * 64 + cc * 2; return st * 1024 + (ob ^ (((ob >> 9) & 1) << 5)); }
__host__ __device__ __forceinline__ void stage_rc(int b, int& R, int& C) { const int st = b / 1024, sb = b % 1024, swz = sb ^ (((sb >> 9) & 1) << 5); R = (st >> 1) * 16 + swz / 64; C = (st & 1) * 32 + (swz % 64) / 2; }
__host__ __device__ __forceinline__ int perm32(int rho) { const int n = rho >> 4, i = rho & 15; return 8 * (i >> 2) + 4 * n + (i & 3); }

struct Unit { int pm, pn; };
struct Gemm { const bf16_t* A; const bf16_t* Bt; int M, N, K; };

struct StaticOrder {
    int nM, nN, nwg, G, c;
    __host__ __device__ void init(int M, int N, int G_, int c_) { nM = M / BM; nN = N / BM; nwg = nM * nN; G = G_; c = c_; }
    __host__ __device__ bool next(int i, Unit& u) const {
        const long L = (long)i * G + c; if (L >= nwg) return false;
        int wgid = (int)L; { const int q = nwg / NXCD, r = nwg % NXCD, xcd = wgid % NXCD, off = wgid / NXCD; wgid = (xcd < r ? xcd * (q + 1) : r * (q + 1) + (xcd - r) * q) + off; }
        const int nig = WGM * nN, gid = wgid / nig, fm = gid * WGM, gsz = (nM - fm) < WGM ? (nM - fm) : WGM;
        u.pm = fm + ((wgid % nig) % gsz); u.pn = (wgid % nig) / gsz; return true;
    }
    __device__ __forceinline__ void a_ready(const Unit&) const {}
    __device__ __forceinline__ void done(const Unit&) const {}
};

__device__ __forceinline__ unsigned cvt_pk_bf16(float lo, float hi) { unsigned r; asm volatile("v_cvt_pk_bf16_f32 %0, %1, %2" : "=v"(r) : "v"(lo), "v"(hi)); return r; }
constexpr float RMS_EPS_F = 1e-5f;
__device__ __forceinline__ float rstd_of(const float* rowss, int row) { return 1.0f / sqrtf(rowss[row] * (1.0f / 1024.0f) + RMS_EPS_F); }

struct EpiQKV {
    static constexpr bool PERM = true, AFTER_DRAIN = false;
    bf16_t* O; const float* rowss; const float* rot; int rope;
    __device__ __forceinline__ void operator()(const f32x4 (&acc)[2][2][4][2], const Unit& u, int wr, int wc, int fr, int fq) const {
        const int row0 = u.pm * BM + wr * 64 + fr;
        const int col0 = u.pn * BM + wc * 32 + 8 * fq;
        const bool rt = rope && ((u.pn & 2) != 0) && (u.pn < 8) && ((wc & 1) == 0);
#pragma unroll
        for (int ai = 0; ai < 2; ++ai)
#pragma unroll
            for (int m = 0; m < 4; ++m) {
                const int row = row0 + ai * HALF + m * 16;
                const float rs = rstd_of(rowss, row);
                bf16_t* rowp = O + (size_t)row * 3072 + col0;
                f32x4 c0 = {1.f, 1.f, 1.f, 1.f}, c1 = c0, s0 = {0.f, 0.f, 0.f, 0.f}, s1 = s0;
                if (rt) { const f32x4* rp = (const f32x4*)(rot + (size_t)(row & 2047) * 16); c0 = rp[0]; c1 = rp[1]; s0 = rp[2]; s1 = rp[3]; }
#pragma unroll
                for (int bj = 0; bj < 2; ++bj) {
                    f32x4 v0 = acc[ai][bj][m][0] * rs, v1 = acc[ai][bj][m][1] * rs;
                    if (rt) {
                        f32x4 p0, p1;
#pragma unroll
                        for (int e = 0; e < 4; ++e) { p0[e] = __shfl_xor(v0[e], 16); p1[e] = __shfl_xor(v1[e], 16); }
                        if (fq == 0) { v0 = v0 * c0 - p0 * s0; v1 = v1 * c1 - p1 * s1; }
                        else if (fq == 1) { v0 = v0 * c0 + p0 * s0; v1 = v1 * c1 + p1 * s1; }
                    }
                    u32x4 w; w.x = cvt_pk_bf16(v0[0], v0[1]); w.y = cvt_pk_bf16(v0[2], v0[3]); w.z = cvt_pk_bf16(v1[0], v1[1]); w.w = cvt_pk_bf16(v1[2], v1[3]);
                    *(u32x4*)(rowp + bj * HALF) = w;
                }
            }
    }
};

struct EpiResid {
    static constexpr bool PERM = true, AFTER_DRAIN = false;
    const float* xin; float* xout; bf16_t* xb; float* rowss_next;
    __device__ __forceinline__ void operator()(const f32x4 (&acc)[2][2][4][2], const Unit& u, int wr, int wc, int fr, int fq) const {
        const int row0 = u.pm * BM + wr * 64 + fr;
        const int col0 = u.pn * BM + wc * 32 + 8 * fq;
#pragma unroll
        for (int ai = 0; ai < 2; ++ai)
#pragma unroll
            for (int m = 0; m < 4; ++m) {
                const int row = row0 + ai * HALF + m * 16;
                float ss = 0.f;
#pragma unroll
                for (int bj = 0; bj < 2; ++bj) {
                    const size_t off = (size_t)row * 1024 + col0 + bj * HALF;
                    const f32x4* xi = (const f32x4*)(xin + off);
                    const f32x4 a0 = xi[0] + acc[ai][bj][m][0], a1 = xi[1] + acc[ai][bj][m][1];
                    f32x4* xo = (f32x4*)(xout + off); xo[0] = a0; xo[1] = a1;
                    ss += (a0[0] * a0[0] + a0[1] * a0[1]) + (a0[2] * a0[2] + a0[3] * a0[3]) + (a1[0] * a1[0] + a1[1] * a1[1]) + (a1[2] * a1[2] + a1[3] * a1[3]);
                    u32x4 w; w.x = cvt_pk_bf16(a0[0], a0[1]); w.y = cvt_pk_bf16(a0[2], a0[3]); w.z = cvt_pk_bf16(a1[0], a1[1]); w.w = cvt_pk_bf16(a1[2], a1[3]);
                    *(u32x4*)(xb + off) = w;
                }
                ss += __shfl_xor(ss, 16); ss += __shfl_xor(ss, 32);
                if (fq == 0) atomicAdd(rowss_next + row, ss);
            }
    }
};

struct EpiSwiGLU {
    static constexpr bool PERM = true, AFTER_DRAIN = false;
    bf16_t* H; const float* rowss;
    __device__ __forceinline__ void operator()(const f32x4 (&acc)[2][2][4][2], const Unit& u, int wr, int wc, int fr, int fq) const {
        const int row0 = u.pm * BM + wr * 64 + fr;
        const int col0 = u.pn * HALF + wc * 32 + 8 * fq;
#pragma unroll
        for (int ai = 0; ai < 2; ++ai)
#pragma unroll
            for (int m = 0; m < 4; ++m) {
                const int row = row0 + ai * HALF + m * 16;
                const float rs = rstd_of(rowss, row);
                float h[8];
#pragma unroll
                for (int n = 0; n < 2; ++n)
#pragma unroll
                    for (int e = 0; e < 4; ++e) {
                        const float g = acc[ai][0][m][n][e] * rs, up = acc[ai][1][m][n][e] * rs;
                        const float sg = g * __builtin_amdgcn_rcpf(1.0f + __builtin_amdgcn_exp2f(-1.4426950408889634f * g));
                        h[n * 4 + e] = sg * up;
                    }
                u32x4 w; w.x = cvt_pk_bf16(h[0], h[1]); w.y = cvt_pk_bf16(h[2], h[3]); w.z = cvt_pk_bf16(h[4], h[5]); w.w = cvt_pk_bf16(h[6], h[7]);
                *(u32x4*)(H + (size_t)row * 2816 + col0) = w;
            }
    }
};

template <class Epi, class Sched, bool ALIGN_EPI = false, bool SP2 = false>
__device__ __forceinline__ void gemm_phase(PG8_LAS unsigned char* lds, const Gemm g, const Sched& S, const Epi& E) {
    int tid_ = threadIdx.x; asm volatile("" : "+v"(tid_));
    const int tid = tid_, wid = __builtin_amdgcn_readfirstlane(tid >> 6), lane = tid & 63, wr = wid >> 2, wc = wid & 3, fr = lane & 15, fq = lane >> 4;
    const int K = g.K, nt = K / BK;
    unsigned voffA[2], voffB[2];
#pragma unroll
    for (int i = 0; i < 2; ++i) { int R, C; stage_rc(tid * 16 + i * 8192, R, C); const int Rb = Epi::PERM ? ((R & ~31) + perm32(R & 31)) : R;
        voffA[i] = (unsigned)(R * K + C) * 2u; voffB[i] = (unsigned)(Rb * K + C) * 2u; }
    const size_t kstep = (size_t)(BK * 2);
    const size_t hstep = (size_t)HALF * K * 2;
    const size_t tstep = 2 * hstep;
    const unsigned ldsw = (unsigned)wid * 1024u;
    const int aoff = lds_byte(wr * 64 + fr, fq * 8), boff = lds_byte(wc * 32 + fr, fq * 8);
#define PG8_SA(b, h) (((b) * 2 + (h)) * HTB)
#define PG8_SB(b, h) ((4 + (b) * 2 + (h)) * HTB)
#define PG8_STAGE(bufoff, gbase, voff) do { _Pragma("unroll") for (int _i = 0; _i < 2; ++_i) \
        __builtin_amdgcn_global_load_lds((const unsigned*)((const char*)(gbase) + (voff)[_i]), (PG8_LAS unsigned*)(lds + (bufoff) + ldsw + _i * 8192), 16, 0, 0); } while (0)
#define PG8_LDA(dst, b, h) do { _Pragma("unroll") for (int m = 0; m < 4; ++m) _Pragma("unroll") for (int k = 0; k < 2; ++k) dst[m][k] = *(const PG8_LAS bf16x8*)(lds + PG8_SA(b, h) + aoff + m * 2048 + k * 1024); } while (0)
#define PG8_LDB(dst, b, h) do { _Pragma("unroll") for (int n = 0; n < 2; ++n) _Pragma("unroll") for (int k = 0; k < 2; ++k) dst[n][k] = *(const PG8_LAS bf16x8*)(lds + PG8_SB(b, h) + boff + n * 2048 + k * 1024); } while (0)
#define PG8_MMA(ai, bj, At, Bt) do { __builtin_amdgcn_s_setprio(1); _Pragma("unroll") for (int m = 0; m < 4; ++m) _Pragma("unroll") for (int n = 0; n < 2; ++n) _Pragma("unroll") for (int k = 0; k < 2; ++k) \
        acc[ai][bj][m][n] = __builtin_amdgcn_mfma_f32_16x16x32_bf16(Bt[n][k], At[m][k], acc[ai][bj][m][n], 0, 0, 0); __builtin_amdgcn_s_setprio(0); } while (0)
#define PG8_WAIT_V(n) asm volatile("s_waitcnt vmcnt(" #n ")" ::: "memory")
#define PG8_WAIT_L(n) asm volatile("s_waitcnt lgkmcnt(" #n ")" ::: "memory")
#define PG8_BAR __builtin_amdgcn_s_barrier()
#define PG8_SCHED __builtin_amdgcn_sched_barrier(0)
    Unit cur, nxt; int ui = 0;
    if (!S.next(0, cur)) return;
    f32x4 acc[2][2][4][2];
#pragma unroll
    for (int a = 0; a < 2; ++a)
#pragma unroll
        for (int b = 0; b < 2; ++b)
#pragma unroll
            for (int m = 0; m < 4; ++m)
#pragma unroll
                for (int n = 0; n < 2; ++n) acc[a][b][m][n] = (f32x4){0.f, 0.f, 0.f, 0.f};
    bf16x8 At[4][2], B0[2][2], B1[2][2];
    const char* cA = (const char*)g.A + (size_t)cur.pm * tstep; const char* cB = (const char*)g.Bt + (size_t)cur.pn * tstep;
    S.a_ready(cur);
    if constexpr (SP2) {
        PG8_STAGE(PG8_SB(0, 0), cB, voffB); PG8_STAGE(PG8_SB(0, 1), cB + hstep, voffB); PG8_STAGE(PG8_SA(0, 0), cA, voffA); PG8_STAGE(PG8_SA(0, 1), cA + hstep, voffA);
        if (wr == 1) PG8_BAR;
        PG8_WAIT_V(2); PG8_BAR;
        PG8_STAGE(PG8_SB(1, 0), cB + kstep, voffB); PG8_STAGE(PG8_SA(1, 0), cA + kstep, voffA); PG8_STAGE(PG8_SB(1, 1), cB + hstep + kstep, voffB);
        PG8_WAIT_V(6); PG8_BAR;
    } else {
        PG8_STAGE(PG8_SB(0, 0), cB, voffB); PG8_STAGE(PG8_SA(0, 0), cA, voffA); PG8_STAGE(PG8_SB(0, 1), cB + hstep, voffB); PG8_STAGE(PG8_SA(0, 1), cA + hstep, voffA);
        if (wr == 1) PG8_BAR;
        PG8_WAIT_V(4); PG8_BAR;
        PG8_STAGE(PG8_SB(1, 0), cB + kstep, voffB); PG8_STAGE(PG8_SA(1, 0), cA + kstep, voffA); PG8_STAGE(PG8_SB(1, 1), cB + hstep + kstep, voffB);
        PG8_WAIT_V(6); PG8_BAR;
    }
    for (;;) {
        const bool has_next = S.next(ui + 1, nxt);
        const char* nA = has_next ? (const char*)g.A + (size_t)nxt.pm * tstep : cA; const char* nB = has_next ? (const char*)g.Bt + (size_t)nxt.pn * tstep : cB;
        for (int t = 0; t < nt; t += 2) {
            const bool last = (t == nt - 2);
            const char* a1 = cA + (size_t)(t + 1) * kstep;
            const char* a2 = last ? nA : cA + (size_t)(t + 2) * kstep; const char* b2 = last ? nB : cB + (size_t)(t + 2) * kstep;
            const char* a3 = a2 + kstep; const char* b3 = b2 + kstep;
            if (last && has_next) S.a_ready(nxt);
            if constexpr (SP2) {
            PG8_LDB(B0, 0, 0); PG8_LDB(B1, 0, 1); PG8_SCHED; PG8_LDA(At, 0, 0); PG8_STAGE(PG8_SA(1, 1), a1 + hstep, voffA);
            PG8_WAIT_V(8); PG8_WAIT_L(0); PG8_BAR; PG8_MMA(0, 0, At, B0); PG8_MMA(0, 1, At, B1); PG8_BAR; PG8_SCHED;
            PG8_LDA(At, 0, 1); PG8_STAGE(PG8_SB(0, 0), b2, voffB); PG8_STAGE(PG8_SB(0, 1), b2 + hstep, voffB); PG8_STAGE(PG8_SA(0, 0), a2, voffA);
            PG8_WAIT_V(8); PG8_WAIT_L(0); PG8_BAR; PG8_MMA(1, 0, At, B0); PG8_MMA(1, 1, At, B1); PG8_BAR; PG8_SCHED;
            PG8_LDB(B0, 1, 0); PG8_LDB(B1, 1, 1); PG8_SCHED; PG8_LDA(At, 1, 0); PG8_STAGE(PG8_SA(0, 1), a2 + hstep, voffA);
            PG8_WAIT_V(8); PG8_WAIT_L(0); PG8_BAR; PG8_MMA(0, 0, At, B0); PG8_MMA(0, 1, At, B1); PG8_BAR; PG8_SCHED;
            PG8_LDA(At, 1, 1); PG8_STAGE(PG8_SB(1, 0), b3, voffB); PG8_STAGE(PG8_SB(1, 1), b3 + hstep, voffB); PG8_STAGE(PG8_SA(1, 0), a3, voffA);
            PG8_WAIT_V(8); PG8_WAIT_L(0); PG8_BAR; PG8_MMA(1, 0, At, B0); PG8_MMA(1, 1, At, B1); PG8_BAR; PG8_SCHED;
            } else {
            PG8_LDB(B0, 0, 0); PG8_SCHED; PG8_LDA(At, 0, 0); PG8_STAGE(PG8_SA(1, 1), a1 + hstep, voffA);
            PG8_WAIT_L(8); PG8_BAR; PG8_WAIT_L(0); PG8_MMA(0, 0, At, B0); PG8_BAR; PG8_SCHED;
            PG8_LDB(B1, 0, 1); PG8_STAGE(PG8_SB(0, 0), b2, voffB);
            PG8_BAR; PG8_WAIT_L(0); PG8_MMA(0, 1, At, B1); PG8_BAR;
            PG8_LDA(At, 0, 1); PG8_STAGE(PG8_SA(0, 0), a2, voffA);
            PG8_BAR; PG8_WAIT_L(0); PG8_MMA(1, 0, At, B0); PG8_BAR; PG8_SCHED;
            PG8_STAGE(PG8_SB(0, 1), b2 + hstep, voffB);
            PG8_WAIT_V(6); PG8_BAR; PG8_MMA(1, 1, At, B1); PG8_BAR;
            PG8_LDB(B0, 1, 0); PG8_SCHED; PG8_LDA(At, 1, 0); PG8_STAGE(PG8_SA(0, 1), a2 + hstep, voffA);
            PG8_WAIT_L(8); PG8_BAR; PG8_WAIT_L(0); PG8_MMA(0, 0, At, B0); PG8_BAR; PG8_SCHED;
            PG8_LDB(B1, 1, 1); PG8_STAGE(PG8_SB(1, 0), b3, voffB);
            PG8_BAR; PG8_WAIT_L(0); PG8_MMA(0, 1, At, B1); PG8_BAR;
            PG8_LDA(At, 1, 1); PG8_STAGE(PG8_SA(1, 0), a3, voffA);
            PG8_BAR; PG8_WAIT_L(0); PG8_MMA(1, 0, At, B0); PG8_BAR; PG8_SCHED;
            PG8_STAGE(PG8_SB(1, 1), b3 + hstep, voffB);
            PG8_WAIT_V(6); PG8_BAR; PG8_MMA(1, 1, At, B1); PG8_BAR;
            }
        }
        if constexpr (ALIGN_EPI) { if (wr == 0) PG8_BAR; }
        if constexpr (!Epi::AFTER_DRAIN) { E(acc, cur, wr, wc, fr, fq); S.done(cur); }
        if (!has_next) break;
#pragma unroll
        for (int a = 0; a < 2; ++a)
#pragma unroll
            for (int b = 0; b < 2; ++b)
#pragma unroll
                for (int m = 0; m < 4; ++m)
#pragma unroll
                    for (int n = 0; n < 2; ++n) acc[a][b][m][n] = (f32x4){0.f, 0.f, 0.f, 0.f};
        cur = nxt; cA = nA; cB = nB; ++ui;
        if constexpr (ALIGN_EPI) { if (wr == 1) PG8_BAR; }
    }
    PG8_WAIT_V(0);
    if constexpr (!ALIGN_EPI) { if (wr == 0) PG8_BAR; }
    PG8_BAR;
    if constexpr (Epi::AFTER_DRAIN) { E.fused(acc, cur, wr, wc, fr, fq, lds, wid, lane); S.done(cur); }
#undef PG8_SA
#undef PG8_SB
#undef PG8_STAGE
#undef PG8_LDA
#undef PG8_LDB
#undef PG8_MMA
#undef PG8_WAIT_V
#undef PG8_WAIT_L
#undef PG8_BAR
#undef PG8_SCHED
}
}

#define LAS __attribute__((address_space(3)))
typedef unsigned short bf16_t;
typedef short bf16x8 __attribute__((ext_vector_type(8)));
typedef short s16x4 __attribute__((ext_vector_type(4)));
typedef float f32x4 __attribute__((ext_vector_type(4)));
typedef float f32x16 __attribute__((ext_vector_type(16)));
typedef unsigned u32x4 __attribute__((ext_vector_type(4)));
typedef unsigned u32x2 __attribute__((ext_vector_type(2)));

constexpr int NB = 8, SEQ = 2048, DM = 1024, MTOK = NB * SEQ, DFF = 2816, NLAYER = 4, QKV_LD = 3072;
constexpr int NWAVES = 8, NTHR = 512;
constexpr float LOG2E = 1.4426950408889634f;
constexpr int LDS_BYTES = 147456;
constexpr int VROW = 192;
constexpr int VTILE = 32 * VROW;
constexpr int LDS_F = 49152;
constexpr int NPHASE = 2 + 5 * NLAYER;

constexpr size_t MiB = 1u << 20;
constexpr size_t SZ_WQKV = (size_t)3072 * 1024 * 2, SZ_WO = (size_t)1024 * 1024 * 2, SZ_WI = (size_t)5632 * 1024 * 2, SZ_WOUT = (size_t)1024 * 2816 * 2;
constexpr size_t SZ_WLAYER = SZ_WQKV + SZ_WO + SZ_WI + SZ_WOUT;
constexpr size_t WS_W = 0;
constexpr size_t WS_XB = 104 * MiB;
constexpr size_t WS_XRES = WS_XB + 32 * MiB;
constexpr size_t WS_QKV = WS_XRES + 64 * MiB;
constexpr size_t WS_ATT = WS_QKV + 96 * MiB;
constexpr size_t WS_SMALL = WS_ATT + 32 * MiB;
constexpr size_t WS_ROWSS = WS_SMALL;
constexpr size_t WS_ROT = WS_ROWSS + (size_t)9 * MTOK * 4;
constexpr size_t WS_WF = WS_ROT + (size_t)2048 * 16 * 4;
constexpr size_t WS_LOCF = WS_WF + (size_t)2 * 16 * 1024 * 4;
constexpr size_t WS_TOTF = WS_LOCF + (size_t)128 * 2048 * 4;
constexpr size_t WS_LSE = WS_TOTF + (size_t)128 * 32 * 4;
constexpr size_t WS_END = WS_LSE + (size_t)2 * MTOK * 8 * 4;
static_assert(SZ_WLAYER * 4 <= 104 * MiB, "weights fit");

struct Args {
    const float* x; const float* norm_mix; const float* w_qkv_even; const float* w_o_even; const float* w_qkvf_odd; const float* b_forget; const float* w_o_odd;
    const float* norm_ffn; const float* w_ffn_in; const float* w_ffn_out; const float* norm_final;
    float* out; unsigned char* ws; int ph_lo, ph_hi;
};

__device__ __forceinline__ unsigned f2bf(float f) { unsigned u = __builtin_bit_cast(unsigned, f); return (u + 0x7fffu + ((u >> 16) & 1u)) >> 16; }
__device__ __forceinline__ unsigned pk2(float lo, float hi) { return f2bf(lo) | (f2bf(hi) << 16); }
__device__ __forceinline__ unsigned cvtpk(float lo, float hi) { unsigned r; asm volatile("v_cvt_pk_bf16_f32 %0, %1, %2" : "=v"(r) : "v"(lo), "v"(hi)); return r; }
__device__ __forceinline__ float wave_sum(float v) {
#pragma unroll
    for (int o = 1; o < 64; o <<= 1) v += __shfl_xor(v, o);
    return v;
}
#define LDS_WAIT() asm volatile("s_waitcnt lgkmcnt(0)" ::: "memory")
__device__ __forceinline__ int otid() { int t = threadIdx.x; asm volatile("" : "+v"(t)); return t; }

__device__ __forceinline__ void transpose_item(const float* W, int ldw, int K, int k0, int src_col, bf16_t* WT, int dst_row, const float* gain, float cscale, LAS float* scr, int lane) {
#pragma unroll 8
    for (int i = 0; i < 32; ++i) { const int kk = 2 * i + (lane >> 5); const float g = gain ? gain[k0 + kk] * cscale : cscale;
        scr[kk * 33 + (lane & 31)] = W[(size_t)(k0 + kk) * ldw + src_col + (lane & 31)] * g; }
    LDS_WAIT(); asm volatile("" ::: "memory");
    const int c = lane & 7;
#pragma unroll
    for (int j = 0; j < 4; ++j) { const int n = (lane >> 3) + 8 * j; const LAS float* s = scr + (8 * c) * 33 + n;
        u32x4 o; o.x = pk2(s[0 * 33], s[1 * 33]); o.y = pk2(s[2 * 33], s[3 * 33]); o.z = pk2(s[4 * 33], s[5 * 33]); o.w = pk2(s[6 * 33], s[7 * 33]);
        *(u32x4*)(WT + (size_t)(dst_row + n) * K + k0 + 8 * c) = o; }
    LDS_WAIT(); asm volatile("" ::: "memory");
}

__device__ __forceinline__ void prologue(const Args& a, LAS unsigned char* lds, int vwg, int G) {
    const int tid = otid(), lane = tid & 63, wave = __builtin_amdgcn_readfirstlane(tid >> 6);
    LAS float* scr = (LAS float*)(lds + wave * 16384);
    const int gw = vwg * NWAVES + wave, NGW = G * NWAVES;
    constexpr int I_QKV = 16 * 96, I_O = 16 * 32, I_IN = 16 * 176, I_OUT = 44 * 32, I_LAYER = I_QKV + I_O + I_IN + I_OUT;
    for (int it = gw; it < NLAYER * I_LAYER; it += NGW) {
        const int l = it / I_LAYER; int r = it % I_LAYER;
        bf16_t* wl = (bf16_t*)(a.ws + WS_W + (size_t)l * SZ_WLAYER);
        if (r < I_QKV) {
            const int kb = r / 96, nb = r % 96, n0 = 32 * nb;
            const float* W = (l & 1) ? a.w_qkvf_odd + (size_t)(l >> 1) * 1024 * 3088 : a.w_qkv_even + (size_t)(l >> 1) * 1024 * 3072;
            transpose_item(W, (l & 1) ? 3088 : 3072, 1024, 64 * kb, n0, wl, n0, a.norm_mix + l * 1024, n0 < 1024 ? 0.125f * LOG2E : 1.0f, scr, lane);
            continue; }
        r -= I_QKV;
        if (r < I_O) {
            const int kb = r / 32, nb = r % 32, n0 = 32 * nb;
            const float* W = (l & 1) ? a.w_o_odd + (size_t)(l >> 1) * 1024 * 1024 : a.w_o_even + (size_t)(l >> 1) * 1024 * 1024;
            transpose_item(W, 1024, 1024, 64 * kb, n0, (bf16_t*)((unsigned char*)wl + SZ_WQKV), n0, nullptr, 1.0f, scr, lane);
            continue; }
        r -= I_O;
        if (r < I_IN) {
            const int kb = r / 176, nb = r % 176, n0 = 32 * nb;
            const int pn = n0 >> 8, bj = (n0 >> 7) & 1, c0 = n0 & 127;
            transpose_item(a.w_ffn_in + (size_t)l * 1024 * 5632, 5632, 1024, 64 * kb, bj * 2816 + 128 * pn + c0, (bf16_t*)((unsigned char*)wl + SZ_WQKV + SZ_WO), n0, a.norm_ffn + l * 1024, 1.0f, scr, lane);
            continue; }
        r -= I_IN;
        {
            const int kb = r / 32, nb = r % 32, n0 = 32 * nb;
            transpose_item(a.w_ffn_out + (size_t)l * 2816 * 1024, 1024, 2816, 64 * kb, n0, (bf16_t*)((unsigned char*)wl + SZ_WQKV + SZ_WO + SZ_WI), n0, nullptr, 1.0f, scr, lane);
        }
    }
    bf16_t* xb = (bf16_t*)(a.ws + WS_XB); float* rowss = (float*)(a.ws + WS_ROWSS);
    for (int m = gw; m < MTOK; m += NGW) {
        const f32x4* xr = (const f32x4*)(a.x + (size_t)m * DM) + lane; float s = 0.f; f32x4 v[4];
#pragma unroll
        for (int j = 0; j < 4; ++j) { v[j] = xr[64 * j]; s += (v[j].x * v[j].x + v[j].y * v[j].y) + (v[j].z * v[j].z + v[j].w * v[j].w); }
        s = wave_sum(s);
        unsigned long long* o8 = (unsigned long long*)(xb + (size_t)m * DM) + lane;
#pragma unroll
        for (int j = 0; j < 4; ++j) o8[64 * j] = (unsigned long long)pk2(v[j].x, v[j].y) | ((unsigned long long)pk2(v[j].z, v[j].w) << 32);
        if (lane == 0) rowss[m] = s;
    }
    const int gt = vwg * NTHR + tid, NGT = G * NTHR;
    for (int i = gt; i < 8 * MTOK; i += NGT) rowss[MTOK + i] = 0.f;
    float* rot = (float*)(a.ws + WS_ROT);
    for (int i = gt; i < 2048 * 8; i += NGT) {
        const int pos = i >> 3, j = i & 7;
        const float invf[8] = {1.0f, 0.19392274474868576f, 0.03760603093086393f, 0.007292664737217109f, 0.001414213562373095f, 0.0002742481756762073f, 5.318295896944988e-05f, 1.031338537721246e-05f};
        float fq = invf[0];
#pragma unroll
        for (int t = 1; t < 8; ++t) fq = (j == t) ? invf[t] : fq;
        const float ang = (float)pos * fq;
        const double rev = (double)ang * 0.15915494309189535; const float fr = (float)(rev - floor(rev));
        rot[pos * 16 + j] = __builtin_amdgcn_cosf(fr); rot[pos * 16 + 8 + j] = __builtin_amdgcn_sinf(fr);
    }
    float* wf = (float*)(a.ws + WS_WF);
    for (int i = gt; i < 2 * 16 * 1024; i += NGT) {
        const int lo = i >> 14, hd = (i >> 10) & 15, k = i & 1023;
        wf[i] = a.w_qkvf_odd[(size_t)lo * 1024 * 3088 + (size_t)k * 3088 + 3072 + hd] * a.norm_mix[(2 * lo + 1) * 1024 + k];
    }
}

__device__ __forceinline__ void fgate_phase(const Args& a, int lo, LAS unsigned char* lds, int vwg, int G) {
    const int tid = otid(), lane = tid & 63, wave = __builtin_amdgcn_readfirstlane(tid >> 6);
    const float* xres = (const float*)(a.ws + WS_XRES); const float* rowss = (const float*)(a.ws + WS_ROWSS) + (size_t)(2 * (2 * lo + 1)) * MTOK;
    const float* wf = (const float*)(a.ws + WS_WF) + (size_t)lo * 16 * 1024;
    float* locF = (float*)(a.ws + WS_LOCF); float* totF = (float*)(a.ws + WS_TOTF);
    LAS float* lf = (LAS float*)lds;
    const int hd = lane & 15, kq = lane >> 4;
    const float bias = a.b_forget[lo * 16 + hd];
    for (int j = vwg; j < 256; j += G) {
        for (int tt = 0; tt < 8; ++tt) {
            const int tok = 64 * j + 8 * wave + tt;
            const f32x4* xr = (const f32x4*)(xres + (size_t)tok * DM + kq * 256); const f32x4* wr = (const f32x4*)(wf + hd * 1024 + kq * 256);
            float acc = 0.f;
#pragma unroll 8
            for (int i = 0; i < 64; ++i) { const f32x4 xv = xr[i], wv = wr[i]; acc += (xv.x * wv.x + xv.y * wv.y) + (xv.z * wv.z + xv.w * wv.w); }
            acc += __shfl_xor(acc, 16); acc += __shfl_xor(acc, 32);
            const float fl = acc * pg8::rstd_of(rowss, tok) + bias;
            const float z2 = fl * LOG2E; const float l2 = -(fmaxf(-z2, 0.f) + __builtin_amdgcn_logf(1.0f + __builtin_amdgcn_exp2f(-fabsf(z2))));
            if (kq == 0) lf[(8 * wave + tt) * 16 + hd] = l2;
        }
        __syncthreads();
        if (tid < 16) {
            const int b = j >> 5, sl = j & 31; float run = 0.f; float* dst = locF + (size_t)(b * 16 + tid) * 2048 + sl * 64;
            for (int t = 0; t < 64; ++t) { run += lf[t * 16 + tid]; dst[t] = run; }
            totF[(b * 16 + tid) * 32 + sl] = run;
        }
        __syncthreads();
    }
}

__device__ __forceinline__ int phi32(int r) { return ((r >> 4) & 1) * 16 + ((r >> 2) & 1) * 8 + ((r >> 3) & 1) * 4 + (r & 3); }
__device__ __forceinline__ s16x4 vtr(const LAS unsigned char* p) { return __builtin_bit_cast(s16x4, __builtin_amdgcn_ds_read_tr16_b64_v4i16((LAS s16x4*)p)); }

template <int MODE>
__device__ __forceinline__ void attn_task(const bf16_t* qp, const bf16_t* kp, const bf16_t* vp, size_t rstride, int q0, int kb_lo, int kb_hi,
                                          LAS unsigned char* vlds, const LAS float* Fs, f32x16 (&O)[2], float& lse2) {
    const int lane = otid() & 63, n = lane & 31, hh = lane >> 5;
    bf16x8 qf[4];
    { const bf16_t* p = qp + (size_t)(q0 + n) * rstride + 8 * hh;
#pragma unroll
      for (int ks = 0; ks < 4; ++ks) qf[ks] = *(const bf16x8*)(p + 16 * ks); }
    const int qi = q0 + n;
    float Fq = 0.f; if (MODE == 0) Fq = Fs[qi];
#pragma unroll
    for (int r = 0; r < 16; ++r) { O[0][r] = 0.f; O[1][r] = 0.f; }
    float m = -1e30f, l = 0.f, R = 0.f;
    const bf16_t* kl = kp + (size_t)phi32(n) * rstride + 8 * hh;
    const bf16_t* vl = vp + (size_t)(lane >> 3) * rstride + 8 * (lane & 7);
    LAS unsigned char* vw = vlds + (lane >> 3) * VROW + (lane & 7) * 16;
    const LAS unsigned char* vr = vlds + (8 * hh + ((lane & 15) >> 2)) * VROW + (16 * ((lane >> 4) & 1) + 4 * (lane & 3)) * 2;
    bf16x8 kn[4]; u32x4 vn[4];
#define AT_ISSUE(kb) do { const bf16_t* kk_ = kl + (size_t)(kb) * 32 * rstride; const bf16_t* vv_ = vl + (size_t)(kb) * 32 * rstride; \
        _Pragma("unroll") for (int ks = 0; ks < 4; ++ks) kn[ks] = *(const bf16x8*)(kk_ + 16 * ks); \
        _Pragma("unroll") for (int ii = 0; ii < 4; ++ii) vn[ii] = *(const u32x4*)(vv_ + (size_t)(8 * ii) * rstride); } while (0)
    const int nblk = kb_hi - kb_lo + 1;
    int kb = (MODE == 2) ? kb_hi : kb_lo;
    AT_ISSUE(kb);
    for (int it = 0; it < nblk; ++it) {
        bf16x8 kc[4];
#pragma unroll
        for (int ks = 0; ks < 4; ++ks) kc[ks] = kn[ks];
        asm volatile("" ::: "memory");
#pragma unroll
        for (int ii = 0; ii < 4; ++ii) *(LAS u32x4*)(vw + ii * 8 * VROW) = vn[ii];
        asm volatile("" ::: "memory");
        const int kbn = (MODE == 2) ? kb - 1 : kb + 1;
        if (it + 1 < nblk) AT_ISSUE(kbn);
        const int key0 = kb * 32 + 8 * hh;
        f32x16 s;
        if (MODE == 0) {
            const LAS f32x4* fk = (const LAS f32x4*)(Fs + key0);
            const f32x4 f0 = fk[0], f1 = fk[1], f2 = fk[4], f3 = fk[5];
#pragma unroll
            for (int e = 0; e < 4; ++e) { s[e] = Fq - f0[e]; s[4 + e] = Fq - f1[e]; s[8 + e] = Fq - f2[e]; s[12 + e] = Fq - f3[e]; }
        } else {
#pragma unroll
            for (int r = 0; r < 16; ++r) s[r] = 0.f;
        }
#pragma unroll
        for (int ks = 0; ks < 4; ++ks) s = __builtin_amdgcn_mfma_f32_32x32x16_bf16(kc[ks], qf[ks], s, 0, 0, 0);
        bf16x8 pb[2];
        if (MODE != 2) {
            const bool diag = (kb * 32 + 31 > q0);
            if (MODE == 1) {
#pragma unroll
                for (int r = 0; r < 16; ++r) { const int ki = key0 + 16 * (r >> 3) + (r & 7); if (ki > qi || ki < qi - 128) s[r] = -1e30f; }
            } else if (diag) {
#pragma unroll
                for (int r = 0; r < 16; ++r) { const int ki = key0 + 16 * (r >> 3) + (r & 7); if (ki > qi) s[r] = -1e30f; }
            }
            float bm = fmaxf(fmaxf(s[0], s[1]), fmaxf(s[2], s[3]));
#pragma unroll
            for (int r = 4; r < 16; r += 4) bm = fmaxf(bm, fmaxf(fmaxf(s[r], s[r + 1]), fmaxf(s[r + 2], s[r + 3])));
            bm = fmaxf(bm, __shfl_xor(bm, 32));
            const float mn = fmaxf(m, bm), alpha = __builtin_amdgcn_exp2f(m - mn); m = mn;
            float ps = 0.f;
#pragma unroll
            for (int r = 0; r < 16; ++r) { s[r] = __builtin_amdgcn_exp2f(s[r] - mn); ps += s[r]; }
            l = l * alpha + ps;
#pragma unroll
            for (int r = 0; r < 16; ++r) { O[0][r] *= alpha; O[1][r] *= alpha; }
        } else {
            const bool diag = (kb * 32 + 31 >= q0);
            float L[16];
#pragma unroll
            for (int r = 0; r < 16; ++r) {
                const float z = s[r], t = __builtin_amdgcn_exp2f(-fabsf(z)), sp = fmaxf(z, 0.f) + __builtin_amdgcn_logf(1.0f + t);
                L[r] = -sp; s[r] = z - sp;
            }
            if (diag) {
#pragma unroll
                for (int r = 0; r < 16; ++r) { const int ki = key0 + 16 * (r >> 3) + (r & 7); if (ki >= qi) { L[r] = 0.f; s[r] = -1e30f; } }
            }
            float sA = ((L[0] + L[1]) + (L[2] + L[3])) + ((L[4] + L[5]) + (L[6] + L[7]));
            float sB = ((L[8] + L[9]) + (L[10] + L[11])) + ((L[12] + L[13]) + (L[14] + L[15]));
            const float pA = __shfl_xor(sA, 32), pB = __shfl_xor(sB, 32);
            const float offA = sB + pB + (hh == 0 ? pA : 0.f), offB = (hh == 0 ? pB : 0.f);
            float run = R + offA;
#pragma unroll
            for (int e = 7; e >= 0; --e) { const float lr = L[e]; s[e] = __builtin_amdgcn_exp2f(s[e] + run); run += lr; }
            run = R + offB;
#pragma unroll
            for (int e = 15; e >= 8; --e) { const float lr = L[e]; s[e] = __builtin_amdgcn_exp2f(s[e] + run); run += lr; }
            R += (sA + sB) + (pA + pB);
        }
        { u32x4 w0, w1;
          w0.x = cvtpk(s[0], s[1]); w0.y = cvtpk(s[2], s[3]); w0.z = cvtpk(s[4], s[5]); w0.w = cvtpk(s[6], s[7]);
          w1.x = cvtpk(s[8], s[9]); w1.y = cvtpk(s[10], s[11]); w1.z = cvtpk(s[12], s[13]); w1.w = cvtpk(s[14], s[15]);
          pb[0] = __builtin_bit_cast(bf16x8, w0); pb[1] = __builtin_bit_cast(bf16x8, w1); }
        asm volatile("" ::: "memory");
#pragma unroll
        for (int db = 0; db < 2; ++db)
#pragma unroll
            for (int kk = 0; kk < 2; ++kk) {
                const s16x4 lo4 = vtr(vr + (16 * kk) * VROW + 64 * db), hi4 = vtr(vr + (16 * kk + 4) * VROW + 64 * db);
                const bf16x8 av = {lo4[0], lo4[1], lo4[2], lo4[3], hi4[0], hi4[1], hi4[2], hi4[3]};
                O[db] = __builtin_amdgcn_mfma_f32_32x32x16_bf16(av, pb[kk], O[db], 0, 0, 0);
            }
        asm volatile("s_waitcnt lgkmcnt(0)" ::: "memory");
        if (MODE == 2) { if (__builtin_amdgcn_ballot_w64(R >= -160.f) == 0ull) break; }
        kb = kbn;
    }
#undef AT_ISSUE
    asm volatile("s_waitcnt vmcnt(0)" ::: "memory");
    if (MODE != 2) {
        l += __shfl_xor(l, 32);
        const float inv = 1.0f / l;
#pragma unroll
        for (int r = 0; r < 16; ++r) { O[0][r] *= inv; O[1][r] *= inv; }
        lse2 = m + __builtin_amdgcn_logf(l);
    }
}

__device__ __forceinline__ void store_o_bf16(const f32x16 (&O)[2], bf16_t* att_row  , int hh) {
#pragma unroll
    for (int db = 0; db < 2; ++db)
#pragma unroll
        for (int i = 0; i < 4; ++i) {
            u32x2 w; w.x = cvtpk(O[db][4 * i], O[db][4 * i + 1]); w.y = cvtpk(O[db][4 * i + 2], O[db][4 * i + 3]);
            *(u32x2*)(att_row + 32 * db + 8 * i + 4 * hh) = w;
        }
}

__device__ __forceinline__ void fox_phase(const Args& a, LAS unsigned char* lds, int vwg, int G) {
    const int tid = otid(), lane = tid & 63, wave = __builtin_amdgcn_readfirstlane(tid >> 6), n = lane & 31, hh = lane >> 5;
    const bf16_t* qkv = (const bf16_t*)(a.ws + WS_QKV); bf16_t* att = (bf16_t*)(a.ws + WS_ATT);
    const float* locF = (const float*)(a.ws + WS_LOCF); const float* totF = (const float*)(a.ws + WS_TOTF);
    LAS float* Fs = (LAS float*)(lds + LDS_F); LAS float* pre = Fs + 2048;
    LAS unsigned char* vlds = lds + wave * VTILE;
    for (int j = vwg; j < 256; j += G) {
        const int bh = j >> 1, b = bh >> 4, h = bh & 15;
        __syncthreads();
        if (tid < 32) { float p = 0.f; for (int s = 0; s < tid; ++s) p += totF[bh * 32 + s]; pre[tid] = p; }
        __syncthreads();
        for (int t = tid; t < 2048; t += NTHR) Fs[t] = locF[(size_t)bh * 2048 + t] + pre[t >> 6];
        __syncthreads();
        const bf16_t* base = qkv + (size_t)(b * SEQ) * QKV_LD + h * 64;
        for (int ui = 0; ui < 4; ++ui) {
            const int u = (j & 1) ? ((ui < 2) ? 2 + ui : 7 - ui) : ((ui < 2) ? ui : 9 - ui);
            const int qt = 8 * u + wave;
            f32x16 O[2]; float lse;
            attn_task<0>(base, base + 1024, base + 2048, (size_t)QKV_LD, 32 * qt, 0, qt, vlds, Fs, O, lse);
            store_o_bf16(O, att + (size_t)(b * SEQ + 32 * qt + n) * DM + h * 64, hh);
        }
    }
}

__device__ __forceinline__ void even_attn_phase(const Args& a, LAS unsigned char* lds, int vwg, int G) {
    const int tid = otid(), lane = tid & 63, wave = __builtin_amdgcn_readfirstlane(tid >> 6), n = lane & 31, hh = lane >> 5;
    const bf16_t* qkv = (const bf16_t*)(a.ws + WS_QKV); bf16_t* att = (bf16_t*)(a.ws + WS_ATT);
    float* part = a.out;
    float* plse = (float*)(a.ws + WS_LSE);
    LAS unsigned char* vlds = lds + wave * VTILE;
    const LAS float* nof = (const LAS float*)lds;
    for (int j = vwg; j < 256; j += G) {
        const int bh = j >> 2, b = bh >> 3, hl = bh & 7, c = j & 3;
        { const bf16_t* base = qkv + (size_t)(b * SEQ) * QKV_LD + hl * 64;
          for (int ui = 0; ui < 2; ++ui) {
              const int u = ui ? 7 - c : c, qt = 8 * u + wave;
              f32x16 O[2]; float lse;
              attn_task<2>(base, base + 1024, base + 2048, (size_t)QKV_LD, 32 * qt, 0, qt, vlds, nof, O, lse);
              store_o_bf16(O, att + (size_t)(b * SEQ + 32 * qt + n) * DM + hl * 64, hh);
          } }
        const bf16_t* base = qkv + (size_t)(b * SEQ) * QKV_LD + (8 + hl) * 64;
        for (int p = 0; p < 2; ++p) {
            const int dil = p ? 4 : 1;
            for (int ti = 0; ti < 2; ++ti) {
                const int task = wave + 8 * ti;
                const int res = p ? (task & 3) : 0, tile = p ? (task >> 2) : task;
                const int q0 = (p ? 128 * c : 512 * c) + 32 * tile;
                const int kbh = q0 >> 5, kbl = kbh - 4 < 0 ? 0 : kbh - 4;
                const bf16_t* bp = base + (size_t)res * QKV_LD;
                f32x16 O[2]; float lse;
                attn_task<1>(bp, bp + 1024, bp + 2048, (size_t)dil * QKV_LD, q0, kbl, kbh, vlds, nof, O, lse);
                const int tok = res + dil * (q0 + n);
                float* pr = part + ((size_t)p * MTOK + (size_t)(b * SEQ + tok)) * 512 + hl * 64;
#pragma unroll
                for (int db = 0; db < 2; ++db)
#pragma unroll
                    for (int i = 0; i < 4; ++i) *(f32x4*)(pr + 32 * db + 8 * i + 4 * hh) = (f32x4){O[db][4 * i], O[db][4 * i + 1], O[db][4 * i + 2], O[db][4 * i + 3]};
                if (hh == 0) plse[((size_t)p * MTOK + (size_t)(b * SEQ + tok)) * 8 + hl] = lse;
            }
        }
        __threadfence(); __syncthreads(); __threadfence();
        for (int ti = 0; ti < 2; ++ti) {
            const int res = wave + 8 * ti, q0 = 32 * c;
            const bf16_t* bp = base + (size_t)res * QKV_LD;
            f32x16 O[2]; float lse3;
            attn_task<1>(bp, bp + 1024, bp + 2048, (size_t)16 * QKV_LD, q0, 0, c, vlds, nof, O, lse3);
            const int tok = res + 16 * (q0 + n); const size_t grow = (size_t)(b * SEQ + tok);
            const float l1 = plse[grow * 8 + hl], l2 = plse[((size_t)MTOK + grow) * 8 + hl];
            const float mx = fmaxf(lse3, fmaxf(l1, l2));
            float w1 = __builtin_amdgcn_exp2f(l1 - mx), w2 = __builtin_amdgcn_exp2f(l2 - mx), w3 = __builtin_amdgcn_exp2f(lse3 - mx);
            const float inv = 1.0f / (w1 + w2 + w3); w1 *= inv; w2 *= inv; w3 *= inv;
            const float* p1 = part + grow * 512 + hl * 64; const float* p2 = part + ((size_t)MTOK + grow) * 512 + hl * 64;
#pragma unroll
            for (int db = 0; db < 2; ++db)
#pragma unroll
                for (int i = 0; i < 4; ++i) {
                    const f32x4 a1 = *(const f32x4*)(p1 + 32 * db + 8 * i + 4 * hh), a2 = *(const f32x4*)(p2 + 32 * db + 8 * i + 4 * hh);
#pragma unroll
                    for (int e = 0; e < 4; ++e) O[db][4 * i + e] = O[db][4 * i + e] * w3 + a1[e] * w1 + a2[e] * w2;
                }
            store_o_bf16(O, att + grow * DM + (8 + hl) * 64, hh);
        }
        __syncthreads();
    }
}

__device__ __forceinline__ void final_phase(const Args& a, int vwg, int G) {
    const int tid = otid(), lane = tid & 63, wave = tid >> 6;
    const float* xres = (const float*)(a.ws + WS_XRES); const float* rowss = (const float*)(a.ws + WS_ROWSS) + (size_t)8 * MTOK;
    const int gw = vwg * NWAVES + wave, NGW = G * NWAVES;
    f32x4 g[4];
#pragma unroll
    for (int j = 0; j < 4; ++j) g[j] = ((const f32x4*)a.norm_final)[lane + 64 * j];
    for (int m = gw; m < MTOK; m += NGW) {
        const float rs = pg8::rstd_of(rowss, m);
        const f32x4* xr = (const f32x4*)(xres + (size_t)m * DM) + lane; f32x4* o = (f32x4*)(a.out + (size_t)m * DM) + lane;
#pragma unroll
        for (int j = 0; j < 4; ++j) o[64 * j] = xr[64 * j] * rs * g[j];
    }
}

__global__ void __launch_bounds__(NTHR, 2) fwd_kernel(Args a) {
    extern __shared__ __attribute__((aligned(16))) unsigned char lds_raw[];
    LAS unsigned char* lds = (LAS unsigned char*)lds_raw;
    cg::grid_group grid = cg::this_grid();
    const int G = gridDim.x, vwg = blockIdx.x;
    unsigned char* ws = a.ws;
    bf16_t* xb = (bf16_t*)(ws + WS_XB); float* xres = (float*)(ws + WS_XRES); bf16_t* qkv = (bf16_t*)(ws + WS_QKV); bf16_t* hid = (bf16_t*)(ws + WS_QKV);
    bf16_t* att = (bf16_t*)(ws + WS_ATT); float* rowss = (float*)(ws + WS_ROWSS); const float* rot = (const float*)(ws + WS_ROT);
    for (int ph = a.ph_lo; ph < a.ph_hi; ++ph) {
        if (ph == 0) prologue(a, lds, vwg, G);
        else if (ph == NPHASE - 1) final_phase(a, vwg, G);
        else {
            const int l = (ph - 1) / 5, sp = (ph - 1) % 5;
            const bf16_t* wl = (const bf16_t*)(ws + WS_W + (size_t)l * SZ_WLAYER);
            const bf16_t* w_qkv = wl; const bf16_t* w_o = (const bf16_t*)((const unsigned char*)wl + SZ_WQKV);
            const bf16_t* w_in = (const bf16_t*)((const unsigned char*)wl + SZ_WQKV + SZ_WO); const bf16_t* w_out = (const bf16_t*)((const unsigned char*)wl + SZ_WQKV + SZ_WO + SZ_WI);
            if (sp == 0) {
                pg8::Gemm g{xb, w_qkv, MTOK, 3072, 1024}; pg8::StaticOrder S; S.init(MTOK, 3072, G, vwg);
                pg8::EpiQKV E{qkv, rowss + (size_t)(2 * l) * MTOK, rot, (l & 1) ? 0 : 1};
                pg8::gemm_phase<pg8::EpiQKV, pg8::StaticOrder, true, true>(lds, g, S, E);
                if (l & 1) { __syncthreads(); fgate_phase(a, l >> 1, lds, vwg, G); }
            } else if (sp == 1) {
                if (l & 1) fox_phase(a, lds, vwg, G); else even_attn_phase(a, lds, vwg, G);
            } else if (sp == 2) {
                pg8::Gemm g{att, w_o, MTOK, 1024, 1024}; pg8::StaticOrder S; S.init(MTOK, 1024, G, vwg);
                pg8::EpiResid E{l == 0 ? a.x : xres, xres, xb, rowss + (size_t)(2 * l + 1) * MTOK};
                pg8::gemm_phase<pg8::EpiResid, pg8::StaticOrder, true, true>(lds, g, S, E);
            } else if (sp == 3) {
                pg8::Gemm g{xb, w_in, MTOK, 5632, 1024}; pg8::StaticOrder S; S.init(MTOK, 5632, G, vwg);
                pg8::EpiSwiGLU E{hid, rowss + (size_t)(2 * l + 1) * MTOK};
                pg8::gemm_phase<pg8::EpiSwiGLU, pg8::StaticOrder, true, true>(lds, g, S, E);
            } else {
                pg8::Gemm g{hid, w_out, MTOK, 1024, 2816}; pg8::StaticOrder S; S.init(MTOK, 1024, G, vwg);
                pg8::EpiResid E{xres, xres, xb, rowss + (size_t)(2 * l + 2) * MTOK};
                pg8::gemm_phase<pg8::EpiResid, pg8::StaticOrder, true, true>(lds, g, S, E);
            }
        }
        if (ph + 1 < a.ph_hi) grid.sync();
    }
}

#ifndef N_LAUNCH_MODE
#define N_LAUNCH_MODE 1
#endif

extern "C" void kernel_launch(void* const* d_in, const int* in_sizes, int n_in, void* d_out, int out_size, void* d_ws, size_t ws_size, hipStream_t stream) {
    static int grid = 0;
    if (grid == 0) {
        if (n_in != 11 || out_size != MTOK * DM || ws_size < WS_END) { fprintf(stderr, "kernel_launch: unexpected sizes n_in %d out %d ws %zu (need %zu)\n", n_in, out_size, ws_size, (size_t)WS_END); grid = -1; return; }
        int dev = 0, cus = 0, per_cu = 0;
        hipGetDevice(&dev); hipDeviceGetAttribute(&cus, hipDeviceAttributeMultiprocessorCount, dev);
        if (hipFuncSetAttribute((const void*)fwd_kernel, hipFuncAttributeMaxDynamicSharedMemorySize, LDS_BYTES) != hipSuccess) { fprintf(stderr, "kernel_launch: hipFuncSetAttribute failed\n"); grid = -1; return; }
        if (hipOccupancyMaxActiveBlocksPerMultiprocessor(&per_cu, (const void*)fwd_kernel, NTHR, LDS_BYTES) != hipSuccess || per_cu < 1) { fprintf(stderr, "kernel_launch: occupancy query says %d\n", per_cu); per_cu = 1; }
        (void)hipGetLastError();
        grid = cus * 1;
        fprintf(stderr, "kernel_launch: grid %d (cus %d, per_cu %d)\n", grid, cus, per_cu);
    }
    if (grid < 0) return;
    Args a{};
    a.x = (const float*)d_in[0]; a.norm_mix = (const float*)d_in[1]; a.w_qkv_even = (const float*)d_in[2]; a.w_o_even = (const float*)d_in[3];
    a.w_qkvf_odd = (const float*)d_in[4]; a.b_forget = (const float*)d_in[5]; a.w_o_odd = (const float*)d_in[6]; a.norm_ffn = (const float*)d_in[7];
    a.w_ffn_in = (const float*)d_in[8]; a.w_ffn_out = (const float*)d_in[9]; a.norm_final = (const float*)d_in[10];
    a.out = (float*)d_out; a.ws = (unsigned char*)d_ws;
#if N_LAUNCH_MODE == 1
    a.ph_lo = 0; a.ph_hi = NPHASE;
    void* args[] = {&a};
    hipError_t e = hipLaunchCooperativeKernel((const void*)fwd_kernel, dim3(grid), dim3(NTHR), args, LDS_BYTES, stream);
    if (e != hipSuccess) fprintf(stderr, "cooperative launch failed: %s (grid %d)\n", hipGetErrorString(e), grid);
#else
    for (int ph = 0; ph < NPHASE; ++ph) {
        a.ph_lo = ph; a.ph_hi = ph + 1;
        hipLaunchKernelGGL(fwd_kernel, dim3(grid), dim3(NTHR), LDS_BYTES, stream, a);
    }
#endif
}
```

```cpp
#include <hip/hip_runtime.h>
#include <hip/hip_cooperative_groups.h>
#include <cstdio>
#include <cstdint>
namespace cg = cooperative_groups;
namespace pg8 {
#define PG8_LAS __attribute__((address_space(3)))
typedef unsigned short bf16_t;
typedef short bf16x8 __attribute__((ext_vector_type(8)));
typedef float f32x4 __attribute__((ext_vector_type(4)));
typedef unsigned u32x4 __attribute__((ext_vector_type(4)));
constexpr int BM = 256, BK = 64, HALF = 128, HTB = HALF * BK * 2  , STAGE_BYTES = 8 * HTB, NXCD = 8, WGM = 8;

__host__ __device__ __forceinline__ int lds_byte(int r, int c) { const int st = (r >> 4) * 2 + (c >> 5), rr = r & 15, cc = c & 31, ob = rr * 64 + cc * 2; return st * 1024 + (ob ^ (((ob >> 9) & 1) << 5)); }
__host__ __device__ __forceinline__ void stage_rc(int b, int& R, int& C) { const int st = b / 1024, sb = b % 1024, swz = sb ^ (((sb >> 9) & 1) << 5); R = (st >> 1) * 16 + swz / 64; C = (st & 1) * 32 + (swz % 64) / 2; }
__host__ __device__ __forceinline__ int perm32(int rho) { const int n = rho >> 4, i = rho & 15; return 8 * (i >> 2) + 4 * n + (i & 3); }

struct Unit { int pm, pn; };
struct Gemm { const bf16_t* A; const bf16_t* Bt; int M, N, K; };

struct StaticOrder {
    int nM, nN, nwg, G, c;
    __host__ __device__ void init(int M, int N, int G_, int c_) { nM = M / BM; nN = N / BM; nwg = nM * nN; G = G_; c = c_; }
    __host__ __device__ bool next(int i, Unit& u) const {
        const long L = (long)i * G + c; if (L >= nwg) return false;
        int wgid = (int)L; { const int q = nwg / NXCD, r = nwg % NXCD, xcd = wgid % NXCD, off = wgid / NXCD; wgid = (xcd < r ? xcd * (q + 1) : r * (q + 1) + (xcd - r) * q) + off; }
        const int nig = WGM * nN, gid = wgid / nig, fm = gid * WGM, gsz = (nM - fm) < WGM ? (nM - fm) : WGM;
        u.pm = fm + ((wgid % nig) % gsz); u.pn = (wgid % nig) / gsz; return true;
    }
    __device__ __forceinline__ void a_ready(const Unit&) const {}
    __device__ __forceinline__ void done(const Unit&) const {}
};

__device__ __forceinline__ unsigned cvt_pk_bf16(float lo, float hi) { unsigned r; asm volatile("v_cvt_pk_bf16_f32 %0, %1, %2" : "=v"(r) : "v"(lo), "v"(hi)); return r; }
constexpr float RMS_EPS_F = 1e-5f;
__device__ __forceinline__ float rstd_of(const float* rowss, int row) { return 1.0f / sqrtf(rowss[row] * (1.0f / 1024.0f) + RMS_EPS_F); }

struct EpiQKV {
    static constexpr bool PERM = true, AFTER_DRAIN = false;
    bf16_t* O; const float* rowss; const float* rot; int rope;
    __device__ __forceinline__ void operator()(const f32x4 (&acc)[2][2][4][2], const Unit& u, int wr, int wc, int fr, int fq) const {
        const int row0 = u.pm * BM + wr * 64 + fr;
        const int col0 = u.pn * BM + wc * 32 + 8 * fq;
        const bool rt = rope && ((u.pn & 2) != 0) && (u.pn < 8) && ((wc & 1) == 0);
#pragma unroll
        for (int ai = 0; ai < 2; ++ai)
#pragma unroll
            for (int m = 0; m < 4; ++m) {
                const int row = row0 + ai * HALF + m * 16;
                const float rs = rstd_of(rowss, row);
                bf16_t* rowp = O + (size_t)row * 3072 + col0;
                f32x4 c0 = {1.f, 1.f, 1.f, 1.f}, c1 = c0, s0 = {0.f, 0.f, 0.f, 0.f}, s1 = s0;
                if (rt) { const f32x4* rp = (const f32x4*)(rot + (size_t)(row & 2047) * 16); c0 = rp[0]; c1 = rp[1]; s0 = rp[2]; s1 = rp[3]; }
#pragma unroll
                for (int bj = 0; bj < 2; ++bj) {
                    f32x4 v0 = acc[ai][bj][m][0] * rs, v1 = acc[ai][bj][m][1] * rs;
                    if (rt) {
                        f32x4 p0, p1;
#pragma unroll
                        for (int e = 0; e < 4; ++e) { p0[e] = __shfl_xor(v0[e], 16); p1[e] = __shfl_xor(v1[e], 16); }
                        if (fq == 0) { v0 = v0 * c0 - p0 * s0; v1 = v1 * c1 - p1 * s1; }
                        else if (fq == 1) { v0 = v0 * c0 + p0 * s0; v1 = v1 * c1 + p1 * s1; }
                    }
                    u32x4 w; w.x = cvt_pk_bf16(v0[0], v0[1]); w.y = cvt_pk_bf16(v0[2], v0[3]); w.z = cvt_pk_bf16(v1[0], v1[1]); w.w = cvt_pk_bf16(v1[2], v1[3]);
                    *(u32x4*)(rowp + bj * HALF) = w;
                }
            }
    }
};

struct EpiResid {
    static constexpr bool PERM = true, AFTER_DRAIN = false;
    const float* xin; float* xout; bf16_t* xb; float* rowss_next;
    __device__ __forceinline__ void operator()(const f32x4 (&acc)[2][2][4][2], const Unit& u, int wr, int wc, int fr, int fq) const {
        const int row0 = u.pm * BM + wr * 64 + fr;
        const int col0 = u.pn * BM + wc * 32 + 8 * fq;
#pragma unroll
        for (int ai = 0; ai < 2; ++ai)
#pragma unroll
            for (int m = 0; m < 4; ++m) {
                const int row = row0 + ai * HALF + m * 16;
                float ss = 0.f;
#pragma unroll
                for (int bj = 0; bj < 2; ++bj) {
                    const size_t off = (size_t)row * 1024 + col0 + bj * HALF;
                    const f32x4* xi = (const f32x4*)(xin + off);
                    const f32x4 a0 = xi[0] + acc[ai][bj][m][0], a1 = xi[1] + acc[ai][bj][m][1];
                    f32x4* xo = (f32x4*)(xout + off); xo[0] = a0; xo[1] = a1;
                    ss += (a0[0] * a0[0] + a0[1] * a0[1]) + (a0[2] * a0[2] + a0[3] * a0[3]) + (a1[0] * a1[0] + a1[1] * a1[1]) + (a1[2] * a1[2] + a1[3] * a1[3]);
                    u32x4 w; w.x = cvt_pk_bf16(a0[0], a0[1]); w.y = cvt_pk_bf16(a0[2], a0[3]); w.z = cvt_pk_bf16(a1[0], a1[1]); w.w = cvt_pk_bf16(a1[2], a1[3]);
                    *(u32x4*)(xb + off) = w;
                }
                ss += __shfl_xor(ss, 16); ss += __shfl_xor(ss, 32);
                if (fq == 0) atomicAdd(rowss_next + row, ss);
            }
    }
};

struct EpiSwiGLU {
    static constexpr bool PERM = true, AFTER_DRAIN = false;
    bf16_t* H; const float* rowss;
    __device__ __forceinline__ void operator()(const f32x4 (&acc)[2][2][4][2], const Unit& u, int wr, int wc, int fr, int fq) const {
        const int row0 = u.pm * BM + wr * 64 + fr;
        const int col0 = u.pn * HALF + wc * 32 + 8 * fq;
#pragma unroll
        for (int ai = 0; ai < 2; ++ai)
#pragma unroll
            for (int m = 0; m < 4; ++m) {
                const int row = row0 + ai * HALF + m * 16;
                const float rs = rstd_of(rowss, row);
                float h[8];
#pragma unroll
                for (int n = 0; n < 2; ++n)
#pragma unroll
                    for (int e = 0; e < 4; ++e) {
                        const float g = acc[ai][0][m][n][e] * rs, up = acc[ai][1][m][n][e] * rs;
                        const float sg = g * __builtin_amdgcn_rcpf(1.0f + __builtin_amdgcn_exp2f(-1.4426950408889634f * g));
                        h[n * 4 + e] = sg * up;
                    }
                u32x4 w; w.x = cvt_pk_bf16(h[0], h[1]); w.y = cvt_pk_bf16(h[2], h[3]); w.z = cvt_pk_bf16(h[4], h[5]); w.w = cvt_pk_bf16(h[6], h[7]);
                *(u32x4*)(H + (size_t)row * 2816 + col0) = w;
            }
    }
};

template <class Epi, class Sched, bool ALIGN_EPI = false, bool SP2 = false>
__device__ __forceinline__ void gemm_phase(PG8_LAS unsigned char* lds, const Gemm g, const Sched& S, const Epi& E) {
    int tid_ = threadIdx.x; asm volatile("" : "+v"(tid_));
    const int tid = tid_, wid = __builtin_amdgcn_readfirstlane(tid >> 6), lane = tid & 63, wr = wid >> 2, wc = wid & 3, fr = lane & 15, fq = lane >> 4;
    const int K = g.K, nt = K / BK;
    unsigned voffA[2], voffB[2];
#pragma unroll
    for (int i = 0; i < 2; ++i) { int R, C; stage_rc(tid * 16 + i * 8192, R, C); const int Rb = Epi::PERM ? ((R & ~31) + perm32(R & 31)) : R;
        voffA[i] = (unsigned)(R * K + C) * 2u; voffB[i] = (unsigned)(Rb * K + C) * 2u; }
    const size_t kstep = (size_t)(BK * 2);
    const size_t hstep = (size_t)HALF * K * 2;
    const size_t tstep = 2 * hstep;
    const unsigned ldsw = (unsigned)wid * 1024u;
    const int aoff = lds_byte(wr * 64 + fr, fq * 8), boff = lds_byte(wc * 32 + fr, fq * 8);
#define PG8_SA(b, h) (((b) * 2 + (h)) * HTB)
#define PG8_SB(b, h) ((4 + (b) * 2 + (h)) * HTB)
#define PG8_STAGE(bufoff, gbase, voff) do { _Pragma("unroll") for (int _i = 0; _i < 2; ++_i) \
        __builtin_amdgcn_global_load_lds((const unsigned*)((const char*)(gbase) + (voff)[_i]), (PG8_LAS unsigned*)(lds + (bufoff) + ldsw + _i * 8192), 16, 0, 0); } while (0)
#define PG8_LDA(dst, b, h) do { _Pragma("unroll") for (int m = 0; m < 4; ++m) _Pragma("unroll") for (int k = 0; k < 2; ++k) dst[m][k] = *(const PG8_LAS bf16x8*)(lds + PG8_SA(b, h) + aoff + m * 2048 + k * 1024); } while (0)
#define PG8_LDB(dst, b, h) do { _Pragma("unroll") for (int n = 0; n < 2; ++n) _Pragma("unroll") for (int k = 0; k < 2; ++k) dst[n][k] = *(const PG8_LAS bf16x8*)(lds + PG8_SB(b, h) + boff + n * 2048 + k * 1024); } while (0)
#define PG8_MMA(ai, bj, At, Bt) do { __builtin_amdgcn_s_setprio(1); _Pragma("unroll") for (int m = 0; m < 4; ++m) _Pragma("unroll") for (int n = 0; n < 2; ++n) _Pragma("unroll") for (int k = 0; k < 2; ++k) \
        acc[ai][bj][m][n] = __builtin_amdgcn_mfma_f32_16x16x32_bf16(Bt[n][k], At[m][k], acc[ai][bj][m][n], 0, 0, 0); __builtin_amdgcn_s_setprio(0); } while (0)
#define PG8_WAIT_V(n) asm volatile("s_waitcnt vmcnt(" #n ")" ::: "memory")
#define PG8_WAIT_L(n) asm volatile("s_waitcnt lgkmcnt(" #n ")" ::: "memory")
#define PG8_BAR __builtin_amdgcn_s_barrier()
#define PG8_SCHED __builtin_amdgcn_sched_barrier(0)
    Unit cur, nxt; int ui = 0;
    if (!S.next(0, cur)) return;
    f32x4 acc[2][2][4][2];
#pragma unroll
    for (int a = 0; a < 2; ++a)
#pragma unroll
        for (int b = 0; b < 2; ++b)
#pragma unroll
            for (int m = 0; m < 4; ++m)
#pragma unroll
                for (int n = 0; n < 2; ++n) acc[a][b][m][n] = (f32x4){0.f, 0.f, 0.f, 0.f};
    bf16x8 At[4][2], B0[2][2], B1[2][2];
    const char* cA = (const char*)g.A + (size_t)cur.pm * tstep; const char* cB = (const char*)g.Bt + (size_t)cur.pn * tstep;
    S.a_ready(cur);
    if constexpr (SP2) {
        PG8_STAGE(PG8_SB(0, 0), cB, voffB); PG8_STAGE(PG8_SB(0, 1), cB + hstep, voffB); PG8_STAGE(PG8_SA(0, 0), cA, voffA); PG8_STAGE(PG8_SA(0, 1), cA + hstep, voffA);
        if (wr == 1) PG8_BAR;
        PG8_WAIT_V(2); PG8_BAR;
        PG8_STAGE(PG8_SB(1, 0), cB + kstep, voffB); PG8_STAGE(PG8_SA(1, 0), cA + kstep, voffA); PG8_STAGE(PG8_SB(1, 1), cB + hstep + kstep, voffB);
        PG8_WAIT_V(6); PG8_BAR;
    } else {
        PG8_STAGE(PG8_SB(0, 0), cB, voffB); PG8_STAGE(PG8_SA(0, 0), cA, voffA); PG8_STAGE(PG8_SB(0, 1), cB + hstep, voffB); PG8_STAGE(PG8_SA(0, 1), cA + hstep, voffA);
        if (wr == 1) PG8_BAR;
        PG8_WAIT_V(4); PG8_BAR;
        PG8_STAGE(PG8_SB(1, 0), cB + kstep, voffB); PG8_STAGE(PG8_SA(1, 0), cA + kstep, voffA); PG8_STAGE(PG8_SB(1, 1), cB + hstep + kstep, voffB);
        PG8_WAIT_V(6); PG8_BAR;
    }
    for (;;) {
        const bool has_next = S.next(ui + 1, nxt);
        const char* nA = has_next ? (const char*)g.A + (size_t)nxt.pm * tstep : cA; const char* nB = has_next ? (const char*)g.Bt + (size_t)nxt.pn * tstep : cB;
        for (int t = 0; t < nt; t += 2) {
            const bool last = (t == nt - 2);
            const char* a1 = cA + (size_t)(t + 1) * kstep;
            const char* a2 = last ? nA : cA + (size_t)(t + 2) * kstep; const char* b2 = last ? nB : cB + (size_t)(t + 2) * kstep;
            const char* a3 = a2 + kstep; const char* b3 = b2 + kstep;
            if (last && has_next) S.a_ready(nxt);
            if constexpr (SP2) {
            PG8_LDB(B0, 0, 0); PG8_LDB(B1, 0, 1); PG8_SCHED; PG8_LDA(At, 0, 0); PG8_STAGE(PG8_SA(1, 1), a1 + hstep, voffA);
            PG8_WAIT_V(8); PG8_WAIT_L(0); PG8_BAR; PG8_MMA(0, 0, At, B0); PG8_MMA(0, 1, At, B1); PG8_BAR; PG8_SCHED;
            PG8_LDA(At, 0, 1); PG8_STAGE(PG8_SB(0, 0), b2, voffB); PG8_STAGE(PG8_SB(0, 1), b2 + hstep, voffB); PG8_STAGE(PG8_SA(0, 0), a2, voffA);
            PG8_WAIT_V(8); PG8_WAIT_L(0); PG8_BAR; PG8_MMA(1, 0, At, B0); PG8_MMA(1, 1, At, B1); PG8_BAR; PG8_SCHED;
            PG8_LDB(B0, 1, 0); PG8_LDB(B1, 1, 1); PG8_SCHED; PG8_LDA(At, 1, 0); PG8_STAGE(PG8_SA(0, 1), a2 + hstep, voffA);
            PG8_WAIT_V(8); PG8_WAIT_L(0); PG8_BAR; PG8_MMA(0, 0, At, B0); PG8_MMA(0, 1, At, B1); PG8_BAR; PG8_SCHED;
            PG8_LDA(At, 1, 1); PG8_STAGE(PG8_SB(1, 0), b3, voffB); PG8_STAGE(PG8_SB(1, 1), b3 + hstep, voffB); PG8_STAGE(PG8_SA(1, 0), a3, voffA);
            PG8_WAIT_V(8); PG8_WAIT_L(0); PG8_BAR; PG8_MMA(1, 0, At, B0); PG8_MMA(1, 1, At, B1); PG8_BAR; PG8_SCHED;
            } else {
            PG8_LDB(B0, 0, 0); PG8_SCHED; PG8_LDA(At, 0, 0); PG8_STAGE(PG8_SA(1, 1), a1 + hstep, voffA);
            PG8_WAIT_L(8); PG8_BAR; PG8_WAIT_L(0); PG8_MMA(0, 0, At, B0); PG8_BAR; PG8_SCHED;
            PG8_LDB(B1, 0, 1); PG8_STAGE(PG8_SB(0, 0), b2, voffB);
            PG8_BAR; PG8_WAIT_L(0); PG8_MMA(0, 1, At, B1); PG8_BAR;
            PG8_LDA(At, 0, 1); PG8_STAGE(PG8_SA(0, 0), a2, voffA);
            PG8_BAR; PG8_WAIT_L(0); PG8_MMA(1, 0, At, B0); PG8_BAR; PG8_SCHED;
            PG8_STAGE(PG8_SB(0, 1), b2 + hstep, voffB);
            PG8_WAIT_V(6); PG8_BAR; PG8_MMA(1, 1, At, B1); PG8_BAR;
            PG8_LDB(B0, 1, 0); PG8_SCHED; PG8_LDA(At, 1, 0); PG8_STAGE(PG8_SA(0, 1), a2 + hstep, voffA);
            PG8_WAIT_L(8); PG8_BAR; PG8_WAIT_L(0); PG8_MMA(0, 0, At, B0); PG8_BAR; PG8_SCHED;
            PG8_LDB(B1, 1, 1); PG8_STAGE(PG8_SB(1, 0), b3, voffB);
            PG8_BAR; PG8_WAIT_L(0); PG8_MMA(0, 1, At, B1); PG8_BAR;
            PG8_LDA(At, 1, 1); PG8_STAGE(PG8_SA(1, 0), a3, voffA);
            PG8_BAR; PG8_WAIT_L(0); PG8_MMA(1, 0, At, B0); PG8_BAR; PG8_SCHED;
            PG8_STAGE(PG8_SB(1, 1), b3 + hstep, voffB);
            PG8_WAIT_V(6); PG8_BAR; PG8_MMA(1, 1, At, B1); PG8_BAR;
            }
        }
        if constexpr (ALIGN_EPI) { if (wr == 0) PG8_BAR; }
        if constexpr (!Epi::AFTER_DRAIN) { E(acc, cur, wr, wc, fr, fq); S.done(cur); }
        if (!has_next) break;
#pragma unroll
        for (int a = 0; a < 2; ++a)
#pragma unroll
            for (int b = 0; b < 2; ++b)
#pragma unroll
                for (int m = 0; m < 4; ++m)
#pragma unroll
                    for (int n = 0; n < 2; ++n) acc[a][b][m][n] = (f32x4){0.f, 0.f, 0.f, 0.f};
        cur = nxt; cA = nA; cB = nB; ++ui;
        if constexpr (ALIGN_EPI) { if (wr == 1) PG8_BAR; }
    }
    PG8_WAIT_V(0);
    if constexpr (!ALIGN_EPI) { if (wr == 0) PG8_BAR; }
    PG8_BAR;
    if constexpr (Epi::AFTER_DRAIN) { E.fused(acc, cur, wr, wc, fr, fq, lds, wid, lane); S.done(cur); }
#undef PG8_SA
#undef PG8_SB
#undef PG8_STAGE
#undef PG8_LDA
#undef PG8_LDB
#undef PG8_MMA
#undef PG8_WAIT_V
#undef PG8_WAIT_L
#undef PG8_BAR
#undef PG8_SCHED
}
}

#define LAS __attribute__((address_space(3)))
typedef unsigned short bf16_t;
typedef short bf16x8 __attribute__((ext_vector_type(8)));
typedef short s16x4 __attribute__((ext_vector_type(4)));
typedef float f32x4 __attribute__((ext_vector_type(4)));
typedef float f32x16 __attribute__((ext_vector_type(16)));
typedef unsigned u32x4 __attribute__((ext_vector_type(4)));
typedef unsigned u32x2 __attribute__((ext_vector_type(2)));

constexpr int NB = 8, SEQ = 2048, DM = 1024, MTOK = NB * SEQ, DFF = 2816, NLAYER = 4, QKV_LD = 3072;
constexpr int NWAVES = 8, NTHR = 512;
constexpr float LOG2E = 1.4426950408889634f;
constexpr int LDS_BYTES = 147456;
constexpr int VROW = 192;
constexpr int VTILE = 32 * VROW;
constexpr int LDS_F = 49152;
constexpr int NPHASE = 2 + 5 * NLAYER;
constexpr int LDS_MISC = 131072;

constexpr size_t MiB = 1u << 20;
constexpr size_t SZ_WQKV = (size_t)3072 * 1024 * 2, SZ_WO = (size_t)1024 * 1024 * 2, SZ_WI = (size_t)5632 * 1024 * 2, SZ_WOUT = (size_t)1024 * 2816 * 2;
constexpr size_t SZ_WLAYER = SZ_WQKV + SZ_WO + SZ_WI + SZ_WOUT;
constexpr size_t WS_W = 0;
constexpr size_t WS_XB = 104 * MiB;
constexpr size_t WS_XRES = WS_XB + 32 * MiB;
constexpr size_t WS_QKV = WS_XRES + 64 * MiB;
constexpr size_t WS_ATT = WS_QKV + 96 * MiB;
constexpr size_t WS_SMALL = WS_ATT + 32 * MiB;
constexpr size_t WS_ROWSS = WS_SMALL;
constexpr size_t WS_ROT = WS_ROWSS + (size_t)9 * MTOK * 4;
constexpr size_t WS_WF = WS_ROT + (size_t)2048 * 16 * 4;
constexpr size_t WS_LOCF = WS_WF + (size_t)2 * 16 * 1024 * 4;
constexpr size_t WS_TOTF = WS_LOCF + (size_t)128 * 2048 * 4;
constexpr size_t WS_LSE = WS_TOTF + (size_t)128 * 32 * 4;
constexpr size_t WS_BAR = WS_LSE + (size_t)2 * MTOK * 8 * 4;
constexpr size_t WS_END = WS_BAR + 16384;
static_assert(SZ_WLAYER * 4 <= 104 * MiB, "weights fit");

struct Args {
    const float* x; const float* norm_mix; const float* w_qkv_even; const float* w_o_even; const float* w_qkvf_odd; const float* b_forget; const float* w_o_odd;
    const float* norm_ffn; const float* w_ffn_in; const float* w_ffn_out; const float* norm_final;
    float* out; unsigned char* ws; int ph_lo, ph_hi;
};

__device__ __forceinline__ unsigned f2bf(float f) { unsigned u = __builtin_bit_cast(unsigned, f); return (u + 0x7fffu + ((u >> 16) & 1u)) >> 16; }
__device__ __forceinline__ unsigned pk2(float lo, float hi) { return f2bf(lo) | (f2bf(hi) << 16); }
__device__ __forceinline__ unsigned cvtpk(float lo, float hi) { unsigned r; asm volatile("v_cvt_pk_bf16_f32 %0, %1, %2" : "=v"(r) : "v"(lo), "v"(hi)); return r; }
__device__ __forceinline__ float wave_sum(float v) {
#pragma unroll
    for (int o = 1; o < 64; o <<= 1) v += __shfl_xor(v, o);
    return v;
}
#define LDS_WAIT() asm volatile("s_waitcnt lgkmcnt(0)" ::: "memory")
__device__ __forceinline__ int otid() { int t = threadIdx.x; asm volatile("" : "+v"(t)); return t; }

__device__ __forceinline__ void transpose_item(const float* W, int ldw, int K, int k0, int src_col, bf16_t* WT, int dst_row, const float* gain, float cscale, LAS float* scr, int lane) {
    const int kr = lane >> 3, c4 = lane & 7;
    f32x4 v[8]; float g[8];
#pragma unroll
    for (int i = 0; i < 8; ++i) { const int kk = 8 * i + kr; v[i] = *(const f32x4*)(W + (size_t)(k0 + kk) * ldw + src_col + 4 * c4); g[i] = gain ? gain[k0 + kk] * cscale : cscale; }
#pragma unroll
    for (int i = 0; i < 8; ++i) { const int kk = 8 * i + kr; LAS float* d = scr + kk * 33 + 4 * c4; d[0] = v[i].x * g[i]; d[1] = v[i].y * g[i]; d[2] = v[i].z * g[i]; d[3] = v[i].w * g[i]; }
    LDS_WAIT(); asm volatile("" ::: "memory");
    const int c = lane & 7;
#pragma unroll
    for (int j = 0; j < 4; ++j) { const int n = (lane >> 3) + 8 * j; const LAS float* s = scr + (8 * c) * 33 + n;
        u32x4 o; o.x = pk2(s[0 * 33], s[1 * 33]); o.y = pk2(s[2 * 33], s[3 * 33]); o.z = pk2(s[4 * 33], s[5 * 33]); o.w = pk2(s[6 * 33], s[7 * 33]);
        *(u32x4*)(WT + (size_t)(dst_row + n) * K + k0 + 8 * c) = o; }
    LDS_WAIT(); asm volatile("" ::: "memory");
}

__device__ __forceinline__ void prologue(const Args& a, LAS unsigned char* lds, int vwg, int G) {
    const int tid = otid(), lane = tid & 63, wave = __builtin_amdgcn_readfirstlane(tid >> 6);
    LAS float* scr = (LAS float*)(lds + wave * 16384);
    const int gw = vwg * NWAVES + wave, NGW = G * NWAVES;
    constexpr int I_QKV = 16 * 96, I_O = 16 * 32, I_IN = 16 * 176, I_OUT = 44 * 32, I_LAYER = I_QKV + I_O + I_IN + I_OUT;
    for (int it = gw; it < NLAYER * I_LAYER; it += NGW) {
        const int l = it / I_LAYER; int r = it % I_LAYER;
        bf16_t* wl = (bf16_t*)(a.ws + WS_W + (size_t)l * SZ_WLAYER);
        if (r < I_QKV) {
            const int kb = r / 96, nb = r % 96, n0 = 32 * nb;
            const float* W = (l & 1) ? a.w_qkvf_odd + (size_t)(l >> 1) * 1024 * 3088 : a.w_qkv_even + (size_t)(l >> 1) * 1024 * 3072;
            transpose_item(W, (l & 1) ? 3088 : 3072, 1024, 64 * kb, n0, wl, n0, a.norm_mix + l * 1024, n0 < 1024 ? 0.125f * LOG2E : 1.0f, scr, lane);
            continue; }
        r -= I_QKV;
        if (r < I_O) {
            const int kb = r / 32, nb = r % 32, n0 = 32 * nb;
            const float* W = (l & 1) ? a.w_o_odd + (size_t)(l >> 1) * 1024 * 1024 : a.w_o_even + (size_t)(l >> 1) * 1024 * 1024;
            transpose_item(W, 1024, 1024, 64 * kb, n0, (bf16_t*)((unsigned char*)wl + SZ_WQKV), n0, nullptr, 1.0f, scr, lane);
            continue; }
        r -= I_O;
        if (r < I_IN) {
            const int kb = r / 176, nb = r % 176, n0 = 32 * nb;
            const int pn = n0 >> 8, bj = (n0 >> 7) & 1, c0 = n0 & 127;
            transpose_item(a.w_ffn_in + (size_t)l * 1024 * 5632, 5632, 1024, 64 * kb, bj * 2816 + 128 * pn + c0, (bf16_t*)((unsigned char*)wl + SZ_WQKV + SZ_WO), n0, a.norm_ffn + l * 1024, 1.0f, scr, lane);
            continue; }
        r -= I_IN;
        {
            const int kb = r / 32, nb = r % 32, n0 = 32 * nb;
            transpose_item(a.w_ffn_out + (size_t)l * 2816 * 1024, 1024, 2816, 64 * kb, n0, (bf16_t*)((unsigned char*)wl + SZ_WQKV + SZ_WO + SZ_WI), n0, nullptr, 1.0f, scr, lane);
        }
    }
    bf16_t* xb = (bf16_t*)(a.ws + WS_XB); float* rowss = (float*)(a.ws + WS_ROWSS);
    for (int m = gw; m < MTOK; m += NGW) {
        const f32x4* xr = (const f32x4*)(a.x + (size_t)m * DM) + lane; float s = 0.f; f32x4 v[4];
#pragma unroll
        for (int j = 0; j < 4; ++j) { v[j] = xr[64 * j]; s += (v[j].x * v[j].x + v[j].y * v[j].y) + (v[j].z * v[j].z + v[j].w * v[j].w); }
        s = wave_sum(s);
        unsigned long long* o8 = (unsigned long long*)(xb + (size_t)m * DM) + lane;
#pragma unroll
        for (int j = 0; j < 4; ++j) o8[64 * j] = (unsigned long long)pk2(v[j].x, v[j].y) | ((unsigned long long)pk2(v[j].z, v[j].w) << 32);
        if (lane == 0) rowss[m] = s;
    }
    const int gt = vwg * NTHR + tid, NGT = G * NTHR;
    for (int i = gt; i < 8 * MTOK; i += NGT) rowss[MTOK + i] = 0.f;
    float* rot = (float*)(a.ws + WS_ROT);
    for (int i = gt; i < 2048 * 8; i += NGT) {
        const int pos = i >> 3, j = i & 7;
        const float invf[8] = {1.0f, 0.19392274474868576f, 0.03760603093086393f, 0.007292664737217109f, 0.001414213562373095f, 0.0002742481756762073f, 5.318295896944988e-05f, 1.031338537721246e-05f};
        float fq = invf[0];
#pragma unroll
        for (int t = 1; t < 8; ++t) fq = (j == t) ? invf[t] : fq;
        const float ang = (float)pos * fq;
        const double rev = (double)ang * 0.15915494309189535; const float fr = (float)(rev - floor(rev));
        rot[pos * 16 + j] = __builtin_amdgcn_cosf(fr); rot[pos * 16 + 8 + j] = __builtin_amdgcn_sinf(fr);
    }
    float* wf = (float*)(a.ws + WS_WF);
    for (int i = gt; i < 2 * 16 * 1024; i += NGT) {
        const int lo = i >> 14, hd = (i >> 10) & 15, k = i & 1023;
        wf[i] = a.w_qkvf_odd[(size_t)lo * 1024 * 3088 + (size_t)k * 3088 + 3072 + hd] * a.norm_mix[(2 * lo + 1) * 1024 + k];
    }
}

__device__ __forceinline__ void fgate_phase(const Args& a, int lo, LAS unsigned char* lds, int vwg, int G) {
    const int tid = otid(), lane = tid & 63, wave = __builtin_amdgcn_readfirstlane(tid >> 6);
    const float* xres = (const float*)(a.ws + WS_XRES); const float* rowss = (const float*)(a.ws + WS_ROWSS) + (size_t)(2 * (2 * lo + 1)) * MTOK;
    const float* wf = (const float*)(a.ws + WS_WF) + (size_t)lo * 16 * 1024;
    float* locF = (float*)(a.ws + WS_LOCF); float* totF = (float*)(a.ws + WS_TOTF);
    LAS float* lf = (LAS float*)lds;
    const int r16 = lane & 15, g4 = lane >> 4, tile = wave & 3, kh = wave >> 2;
    for (int j = vwg; j < 256; j += G) {
        const f32x4* xr = (const f32x4*)(xres + (size_t)(64 * j + 16 * tile + r16) * DM + 512 * kh + 4 * g4);
        const f32x4* wr = (const f32x4*)(wf + (size_t)r16 * 1024 + 512 * kh + 4 * g4);
        f32x4 acc = {0.f, 0.f, 0.f, 0.f};
#pragma unroll 8
        for (int s = 0; s < 32; ++s) {
            const f32x4 xv = xr[4 * s], wv = wr[4 * s];
            acc = __builtin_amdgcn_mfma_f32_16x16x4f32(xv.x, wv.x, acc, 0, 0, 0);
            acc = __builtin_amdgcn_mfma_f32_16x16x4f32(xv.y, wv.y, acc, 0, 0, 0);
            acc = __builtin_amdgcn_mfma_f32_16x16x4f32(xv.z, wv.z, acc, 0, 0, 0);
            acc = __builtin_amdgcn_mfma_f32_16x16x4f32(xv.w, wv.w, acc, 0, 0, 0);
        }
#pragma unroll
        for (int jj = 0; jj < 4; ++jj) lf[(kh * 64 + 16 * tile + 4 * g4 + jj) * 16 + r16] = acc[jj];
        __syncthreads();
        if (tid < 16) {
            const int b = j >> 5, sl = j & 31; float run = 0.f; float* dst = locF + (size_t)(b * 16 + tid) * 2048 + sl * 64;
            const float bias = a.b_forget[lo * 16 + tid];
            for (int t = 0; t < 64; ++t) {
                const float fl = (lf[t * 16 + tid] + lf[(64 + t) * 16 + tid]) * pg8::rstd_of(rowss, 64 * j + t) + bias;
                const float z2 = fl * LOG2E; const float l2 = -(fmaxf(-z2, 0.f) + __builtin_amdgcn_logf(1.0f + __builtin_amdgcn_exp2f(-fabsf(z2))));
                run += l2; dst[t] = run;
            }
            totF[(b * 16 + tid) * 32 + sl] = run;
        }
        __syncthreads();
    }
}

__device__ __forceinline__ int phi32(int r) { return ((r >> 4) & 1) * 16 + ((r >> 2) & 1) * 8 + ((r >> 3) & 1) * 4 + (r & 3); }
__device__ __forceinline__ s16x4 vtr(const LAS unsigned char* p) { return __builtin_bit_cast(s16x4, __builtin_amdgcn_ds_read_tr16_b64_v4i16((LAS s16x4*)p)); }

template <int MODE>
__device__ __forceinline__ void attn_task(const bf16_t* qp, const bf16_t* kp, const bf16_t* vp, size_t rstride, int q0, int kb_lo, int kb_hi,
                                          LAS unsigned char* vlds, const LAS float* Fs, f32x16 (&O)[2], float& lse2) {
    const int lane = otid() & 63, n = lane & 31, hh = lane >> 5;
    bf16x8 qf[4];
    { const bf16_t* p = qp + (size_t)(q0 + n) * rstride + 8 * hh;
#pragma unroll
      for (int ks = 0; ks < 4; ++ks) qf[ks] = *(const bf16x8*)(p + 16 * ks); }
    const int qi = q0 + n;
    float Fq = 0.f; if (MODE == 0) Fq = Fs[qi];
#pragma unroll
    for (int r = 0; r < 16; ++r) { O[0][r] = 0.f; O[1][r] = 0.f; }
    float m = -1e30f, l = 0.f, R = 0.f;
    const bf16_t* kl = kp + (size_t)phi32(n) * rstride + 8 * hh;
    const bf16_t* vl = vp + (size_t)(lane >> 3) * rstride + 8 * (lane & 7);
    LAS unsigned char* vw = vlds + (lane >> 3) * VROW + (lane & 7) * 16;
    const LAS unsigned char* vr = vlds + (8 * hh + ((lane & 15) >> 2)) * VROW + (16 * ((lane >> 4) & 1) + 4 * (lane & 3)) * 2;
    bf16x8 kn[4]; u32x4 vn[4];
#define AT_ISSUE(kb) do { const bf16_t* kk_ = kl + (size_t)(kb) * 32 * rstride; const bf16_t* vv_ = vl + (size_t)(kb) * 32 * rstride; \
        _Pragma("unroll") for (int ks = 0; ks < 4; ++ks) kn[ks] = *(const bf16x8*)(kk_ + 16 * ks); \
        _Pragma("unroll") for (int ii = 0; ii < 4; ++ii) vn[ii] = *(const u32x4*)(vv_ + (size_t)(8 * ii) * rstride); } while (0)
    const int nblk = kb_hi - kb_lo + 1;
    int kb = (MODE == 2) ? kb_hi : kb_lo;
    AT_ISSUE(kb);
    for (int it = 0; it < nblk; ++it) {
        bf16x8 kc[4];
#pragma unroll
        for (int ks = 0; ks < 4; ++ks) kc[ks] = kn[ks];
        asm volatile("" ::: "memory");
#pragma unroll
        for (int ii = 0; ii < 4; ++ii) *(LAS u32x4*)(vw + ii * 8 * VROW) = vn[ii];
        asm volatile("" ::: "memory");
        const int kbn = (MODE == 2) ? kb - 1 : kb + 1;
        if (it + 1 < nblk) AT_ISSUE(kbn);
        const int key0 = kb * 32 + 8 * hh;
        f32x16 s;
        if (MODE == 0) {
            const LAS f32x4* fk = (const LAS f32x4*)(Fs + key0);
            const f32x4 f0 = fk[0], f1 = fk[1], f2 = fk[4], f3 = fk[5];
#pragma unroll
            for (int e = 0; e < 4; ++e) { s[e] = Fq - f0[e]; s[4 + e] = Fq - f1[e]; s[8 + e] = Fq - f2[e]; s[12 + e] = Fq - f3[e]; }
        } else {
#pragma unroll
            for (int r = 0; r < 16; ++r) s[r] = 0.f;
        }
#pragma unroll
        for (int ks = 0; ks < 4; ++ks) s = __builtin_amdgcn_mfma_f32_32x32x16_bf16(kc[ks], qf[ks], s, 0, 0, 0);
        bf16x8 pb[2];
        if (MODE != 2) {
            const bool diag = (kb * 32 + 31 > q0);
            if (MODE == 1) {
#pragma unroll
                for (int r = 0; r < 16; ++r) { const int ki = key0 + 16 * (r >> 3) + (r & 7); if (ki > qi || ki < qi - 128) s[r] = -1e30f; }
            } else if (diag) {
#pragma unroll
                for (int r = 0; r < 16; ++r) { const int ki = key0 + 16 * (r >> 3) + (r & 7); if (ki > qi) s[r] = -1e30f; }
            }
            float bm = fmaxf(fmaxf(s[0], s[1]), fmaxf(s[2], s[3]));
#pragma unroll
            for (int r = 4; r < 16; r += 4) bm = fmaxf(bm, fmaxf(fmaxf(s[r], s[r + 1]), fmaxf(s[r + 2], s[r + 3])));
            bm = fmaxf(bm, __shfl_xor(bm, 32));
            const float mn = fmaxf(m, bm), alpha = __builtin_amdgcn_exp2f(m - mn); m = mn;
            float ps = 0.f;
#pragma unroll
            for (int r = 0; r < 16; ++r) { s[r] = __builtin_amdgcn_exp2f(s[r] - mn); ps += s[r]; }
            l = l * alpha + ps;
#pragma unroll
            for (int r = 0; r < 16; ++r) { O[0][r] *= alpha; O[1][r] *= alpha; }
        } else {
            const bool diag = (kb * 32 + 31 >= q0);
            float L[16];
#pragma unroll
            for (int r = 0; r < 16; ++r) {
                const float z = s[r], t = __builtin_amdgcn_exp2f(-fabsf(z)), sp = fmaxf(z, 0.f) + __builtin_amdgcn_logf(1.0f + t);
                L[r] = -sp; s[r] = z - sp;
            }
            if (diag) {
#pragma unroll
                for (int r = 0; r < 16; ++r) { const int ki = key0 + 16 * (r >> 3) + (r & 7); if (ki >= qi) { L[r] = 0.f; s[r] = -1e30f; } }
            }
            float sA = ((L[0] + L[1]) + (L[2] + L[3])) + ((L[4] + L[5]) + (L[6] + L[7]));
            float sB = ((L[8] + L[9]) + (L[10] + L[11])) + ((L[12] + L[13]) + (L[14] + L[15]));
            const float pA = __shfl_xor(sA, 32), pB = __shfl_xor(sB, 32);
            const float offA = sB + pB + (hh == 0 ? pA : 0.f), offB = (hh == 0 ? pB : 0.f);
            float run = R + offA;
#pragma unroll
            for (int e = 7; e >= 0; --e) { const float lr = L[e]; s[e] = __builtin_amdgcn_exp2f(s[e] + run); run += lr; }
            run = R + offB;
#pragma unroll
            for (int e = 15; e >= 8; --e) { const float lr = L[e]; s[e] = __builtin_amdgcn_exp2f(s[e] + run); run += lr; }
            R += (sA + sB) + (pA + pB);
        }
        { u32x4 w0, w1;
          w0.x = cvtpk(s[0], s[1]); w0.y = cvtpk(s[2], s[3]); w0.z = cvtpk(s[4], s[5]); w0.w = cvtpk(s[6], s[7]);
          w1.x = cvtpk(s[8], s[9]); w1.y = cvtpk(s[10], s[11]); w1.z = cvtpk(s[12], s[13]); w1.w = cvtpk(s[14], s[15]);
          pb[0] = __builtin_bit_cast(bf16x8, w0); pb[1] = __builtin_bit_cast(bf16x8, w1); }
        asm volatile("" ::: "memory");
#pragma unroll
        for (int db = 0; db < 2; ++db)
#pragma unroll
            for (int kk = 0; kk < 2; ++kk) {
                const s16x4 lo4 = vtr(vr + (16 * kk) * VROW + 64 * db), hi4 = vtr(vr + (16 * kk + 4) * VROW + 64 * db);
                const bf16x8 av = {lo4[0], lo4[1], lo4[2], lo4[3], hi4[0], hi4[1], hi4[2], hi4[3]};
                O[db] = __builtin_amdgcn_mfma_f32_32x32x16_bf16(av, pb[kk], O[db], 0, 0, 0);
            }
        asm volatile("s_waitcnt lgkmcnt(0)" ::: "memory");
        if (MODE == 2) { if (__builtin_amdgcn_ballot_w64(R >= -160.f) == 0ull) break; }
        kb = kbn;
    }
#undef AT_ISSUE
    asm volatile("s_waitcnt vmcnt(0)" ::: "memory");
    if (MODE != 2) {
        l += __shfl_xor(l, 32);
        const float inv = 1.0f / l;
#pragma unroll
        for (int r = 0; r < 16; ++r) { O[0][r] *= inv; O[1][r] *= inv; }
        lse2 = m + __builtin_amdgcn_logf(l);
    }
}

__device__ __forceinline__ void store_o_bf16(const f32x16 (&O)[2], bf16_t* att_row  , int hh) {
#pragma unroll
    for (int db = 0; db < 2; ++db)
#pragma unroll
        for (int i = 0; i < 4; ++i) {
            u32x2 w; w.x = cvtpk(O[db][4 * i], O[db][4 * i + 1]); w.y = cvtpk(O[db][4 * i + 2], O[db][4 * i + 3]);
            *(u32x2*)(att_row + 32 * db + 8 * i + 4 * hh) = w;
        }
}

__device__ __forceinline__ void fox_phase(const Args& a, LAS unsigned char* lds, int vwg, int G) {
    const int tid = otid(), lane = tid & 63, wave = __builtin_amdgcn_readfirstlane(tid >> 6), n = lane & 31, hh = lane >> 5;
    const bf16_t* qkv = (const bf16_t*)(a.ws + WS_QKV); bf16_t* att = (bf16_t*)(a.ws + WS_ATT);
    const float* locF = (const float*)(a.ws + WS_LOCF); const float* totF = (const float*)(a.ws + WS_TOTF);
    LAS float* Fs = (LAS float*)(lds + LDS_F); LAS float* pre = Fs + 2048;
    LAS unsigned char* vlds = lds + wave * VTILE;
    for (int j = vwg; j < 256; j += G) {
        const int bh = j >> 1, b = bh >> 4, h = bh & 15;
        __syncthreads();
        if (tid < 32) { float p = 0.f; for (int s = 0; s < tid; ++s) p += totF[bh * 32 + s]; pre[tid] = p; }
        __syncthreads();
        for (int t = tid; t < 2048; t += NTHR) Fs[t] = locF[(size_t)bh * 2048 + t] + pre[t >> 6];
        __syncthreads();
        const bf16_t* base = qkv + (size_t)(b * SEQ) * QKV_LD + h * 64;
        for (int ui = 0; ui < 4; ++ui) {
            const int u = (j & 1) ? ((ui < 2) ? 2 + ui : 7 - ui) : ((ui < 2) ? ui : 9 - ui);
            const int qt = 8 * u + wave;
            f32x16 O[2]; float lse;
            attn_task<0>(base, base + 1024, base + 2048, (size_t)QKV_LD, 32 * qt, 0, qt, vlds, Fs, O, lse);
            store_o_bf16(O, att + (size_t)(b * SEQ + 32 * qt + n) * DM + h * 64, hh);
        }
    }
}

__device__ __forceinline__ void even_attn_phase(const Args& a, LAS unsigned char* lds, int vwg, int G) {
    const int tid = otid(), lane = tid & 63, wave = __builtin_amdgcn_readfirstlane(tid >> 6), n = lane & 31, hh = lane >> 5;
    const bf16_t* qkv = (const bf16_t*)(a.ws + WS_QKV); bf16_t* att = (bf16_t*)(a.ws + WS_ATT);
    float* part = a.out;
    float* plse = (float*)(a.ws + WS_LSE);
    LAS unsigned char* vlds = lds + wave * VTILE;
    const LAS float* nof = (const LAS float*)lds;
    for (int j = vwg; j < 256; j += G) {
        const int bh = j >> 2, b = bh >> 3, hl = bh & 7, c = j & 3;
        { const bf16_t* base = qkv + (size_t)(b * SEQ) * QKV_LD + hl * 64;
          for (int ui = 0; ui < 2; ++ui) {
              const int u = ui ? 7 - c : c, qt = 8 * u + wave;
              f32x16 O[2]; float lse;
              attn_task<2>(base, base + 1024, base + 2048, (size_t)QKV_LD, 32 * qt, 0, qt, vlds, nof, O, lse);
              store_o_bf16(O, att + (size_t)(b * SEQ + 32 * qt + n) * DM + hl * 64, hh);
          } }
        const bf16_t* base = qkv + (size_t)(b * SEQ) * QKV_LD + (8 + hl) * 64;
        for (int p = 0; p < 2; ++p) {
            const int dil = p ? 4 : 1;
            for (int ti = 0; ti < 2; ++ti) {
                const int task = wave + 8 * ti;
                const int res = p ? (task & 3) : 0, tile = p ? (task >> 2) : task;
                const int q0 = (p ? 128 * c : 512 * c) + 32 * tile;
                const int kbh = q0 >> 5, kbl = kbh - 4 < 0 ? 0 : kbh - 4;
                const bf16_t* bp = base + (size_t)res * QKV_LD;
                f32x16 O[2]; float lse;
                attn_task<1>(bp, bp + 1024, bp + 2048, (size_t)dil * QKV_LD, q0, kbl, kbh, vlds, nof, O, lse);
                const int tok = res + dil * (q0 + n);
                float* pr = part + ((size_t)p * MTOK + (size_t)(b * SEQ + tok)) * 512 + hl * 64;
#pragma unroll
                for (int db = 0; db < 2; ++db)
#pragma unroll
                    for (int i = 0; i < 4; ++i) *(f32x4*)(pr + 32 * db + 8 * i + 4 * hh) = (f32x4){O[db][4 * i], O[db][4 * i + 1], O[db][4 * i + 2], O[db][4 * i + 3]};
                if (hh == 0) plse[((size_t)p * MTOK + (size_t)(b * SEQ + tok)) * 8 + hl] = lse;
            }
        }
        __threadfence(); __syncthreads(); __threadfence();
        for (int ti = 0; ti < 2; ++ti) {
            const int res = wave + 8 * ti, q0 = 32 * c;
            const bf16_t* bp = base + (size_t)res * QKV_LD;
            f32x16 O[2]; float lse3;
            attn_task<1>(bp, bp + 1024, bp + 2048, (size_t)16 * QKV_LD, q0, 0, c, vlds, nof, O, lse3);
            const int tok = res + 16 * (q0 + n); const size_t grow = (size_t)(b * SEQ + tok);
            const float l1 = plse[grow * 8 + hl], l2 = plse[((size_t)MTOK + grow) * 8 + hl];
            const float mx = fmaxf(lse3, fmaxf(l1, l2));
            float w1 = __builtin_amdgcn_exp2f(l1 - mx), w2 = __builtin_amdgcn_exp2f(l2 - mx), w3 = __builtin_amdgcn_exp2f(lse3 - mx);
            const float inv = 1.0f / (w1 + w2 + w3); w1 *= inv; w2 *= inv; w3 *= inv;
            const float* p1 = part + grow * 512 + hl * 64; const float* p2 = part + ((size_t)MTOK + grow) * 512 + hl * 64;
#pragma unroll
            for (int db = 0; db < 2; ++db)
#pragma unroll
                for (int i = 0; i < 4; ++i) {
                    const f32x4 a1 = *(const f32x4*)(p1 + 32 * db + 8 * i + 4 * hh), a2 = *(const f32x4*)(p2 + 32 * db + 8 * i + 4 * hh);
#pragma unroll
                    for (int e = 0; e < 4; ++e) O[db][4 * i + e] = O[db][4 * i + e] * w3 + a1[e] * w1 + a2[e] * w2;
                }
            store_o_bf16(O, att + grow * DM + (8 + hl) * 64, hh);
        }
        __syncthreads();
    }
}

__device__ __forceinline__ void final_phase(const Args& a, int vwg, int G) {
    const int tid = otid(), lane = tid & 63, wave = tid >> 6;
    const float* xres = (const float*)(a.ws + WS_XRES); const float* rowss = (const float*)(a.ws + WS_ROWSS) + (size_t)8 * MTOK;
    const int gw = vwg * NWAVES + wave, NGW = G * NWAVES;
    f32x4 g[4];
#pragma unroll
    for (int j = 0; j < 4; ++j) g[j] = ((const f32x4*)a.norm_final)[lane + 64 * j];
    for (int m = gw; m < MTOK; m += NGW) {
        const float rs = pg8::rstd_of(rowss, m);
        const f32x4* xr = (const f32x4*)(xres + (size_t)m * DM) + lane; f32x4* o = (f32x4*)(a.out + (size_t)m * DM) + lane;
#pragma unroll
        for (int j = 0; j < 4; ++j) o[64 * j] = xr[64 * j] * rs * g[j];
    }
}

#define XB_TMO      128
#define XB_XCNT(j)  (256  + 64 * (j))
#define XB_XSUB(j)  (1280 + 64 * (j))
#define XB_XGEN(j)  (2304 + 64 * (j))
#define XB_TOP      3328
#define XB_TOPGEN   3392
#define XCD_BAR_WORDS 3456
#define XB_SPIN_CAP (1u << 18)

__device__ __forceinline__ unsigned xb_ld(unsigned* p)              { return __hip_atomic_load(p, __ATOMIC_RELAXED, __HIP_MEMORY_SCOPE_AGENT); }
__device__ __forceinline__ unsigned xb_add(unsigned* p, unsigned v) { return __hip_atomic_fetch_add(p, v, __ATOMIC_RELAXED, __HIP_MEMORY_SCOPE_AGENT); }
__device__ __forceinline__ unsigned xb_xcc_id() { return (unsigned)__builtin_amdgcn_s_getreg((3 << 11) | 20) & 0xFu; }
#define XB_SPIN(cond, bar) do { unsigned _sp = 0; while (cond) { __builtin_amdgcn_s_sleep(1); \
    if ((++_sp & 255u) == 0u) { if (xb_ld(&(bar)[XB_TMO])) break; if (_sp > XB_SPIN_CAP) { atomicAdd(&(bar)[XB_TMO], 1u); break; } } } } while (0)

struct XcdBarrier {
    unsigned* bar; unsigned x;
    volatile LAS unsigned* st;
};

__device__ __forceinline__ XcdBarrier xcd_barrier_post(unsigned* bar, volatile LAS unsigned* st) {
    XcdBarrier b; b.bar = bar; b.x = xb_xcc_id(); b.st = st;
    if (threadIdx.x == 0) (void)xb_add(&bar[XB_XCNT(b.x)], 1u);
    return b;
}
__device__ __forceinline__ void xcd_barrier_complete(unsigned* bar, unsigned x, unsigned& nloc, unsigned& nx) {
    const unsigned G = gridDim.x * gridDim.y * gridDim.z;
    unsigned sum, cnt, mine, sp = 0u;
    for (;;) {
        sum = 0u; cnt = 0u; mine = 0u;
#pragma unroll
        for (unsigned j = 0; j < 16; ++j) { const unsigned c = xb_ld(&bar[XB_XCNT(j)]); sum += c; cnt += (c > 0u) ? 1u : 0u; mine = (j == x) ? c : mine; }
        if (sum == G) break;
        __builtin_amdgcn_s_sleep(1);
        if ((++sp & 255u) == 0u) { if (xb_ld(&bar[XB_TMO])) break; if (sp > XB_SPIN_CAP) { atomicAdd(&bar[XB_TMO], 1u); break; } }
    }
    nloc = mine > 0u ? mine : 1u; nx = cnt > 0u ? cnt : 1u;
}

__device__ __forceinline__ void xcd_barrier(const XcdBarrier& b) {
    asm volatile("s_waitcnt vmcnt(0)" ::: "memory");
    __syncthreads();
    if (threadIdx.x == 0) {
        unsigned* bar = b.bar;
        __builtin_amdgcn_s_waitcnt(0);
        unsigned nloc = b.st[0], nx = b.st[1];
        if (nloc == 0u) { xcd_barrier_complete(bar, b.x, nloc, nx); b.st[0] = nloc; b.st[1] = nx; }
        const unsigned old = xb_add(&bar[XB_XSUB(b.x)], 1u);
        const unsigned gen = old / nloc;
        if (old + 1u == (gen + 1u) * nloc) {
            __builtin_amdgcn_fence(__ATOMIC_RELEASE, "agent");
            asm volatile("s_waitcnt vmcnt(0)" ::: "memory");
            const unsigned og = xb_add(&bar[XB_TOP], 1u);
            const unsigned tg = og / nx;
            if (og + 1u == (tg + 1u) * nx) xb_add(&bar[XB_TOPGEN], 1u);
            else XB_SPIN(xb_ld(&bar[XB_TOPGEN]) == tg, bar);
            __builtin_amdgcn_fence(__ATOMIC_ACQUIRE, "agent");
            xb_add(&bar[XB_XGEN(b.x)], 1u);
            asm volatile("s_waitcnt vmcnt(0)" ::: "memory");
        } else {
            XB_SPIN(xb_ld(&bar[XB_XGEN(b.x)]) == gen, bar);
            __builtin_amdgcn_fence(__ATOMIC_ACQUIRE, "agent");
            asm volatile("s_waitcnt vmcnt(0)" ::: "memory");
        }
    }
    __syncthreads();
}

#ifndef REP_QKV
#define REP_QKV 1
#endif
#ifndef REP_FG
#define REP_FG 1
#endif
#ifndef REP_FFI
#define REP_FFI 1
#endif
#ifndef REP_PRO
#define REP_PRO 1
#endif
#ifndef REP_SYNC
#define REP_SYNC 1
#endif
#ifndef REP_FOX
#define REP_FOX 1
#endif
#ifndef REP_EVEN
#define REP_EVEN 1
#endif
__global__ void __launch_bounds__(NTHR, 2) fwd_kernel(Args a) {
    extern __shared__ __attribute__((aligned(16))) unsigned char lds_raw[];
    LAS unsigned char* lds = (LAS unsigned char*)lds_raw;
    cg::grid_group grid = cg::this_grid();
    const int G = gridDim.x, vwg = blockIdx.x;
    unsigned char* ws = a.ws;
    bf16_t* xb = (bf16_t*)(ws + WS_XB); float* xres = (float*)(ws + WS_XRES); bf16_t* qkv = (bf16_t*)(ws + WS_QKV); bf16_t* hid = (bf16_t*)(ws + WS_QKV);
    bf16_t* att = (bf16_t*)(ws + WS_ATT); float* rowss = (float*)(ws + WS_ROWSS); const float* rot = (const float*)(ws + WS_ROT);
    unsigned* barw = (unsigned*)(ws + WS_BAR);
    volatile LAS unsigned* bst = (volatile LAS unsigned*)(lds + LDS_MISC);
    if (threadIdx.x == 0) { bst[0] = 0u; bst[1] = 0u; }
    if (blockIdx.x == 0) { for (int i = threadIdx.x; i < XCD_BAR_WORDS; i += NTHR) barw[i] = 0u; }
    __syncthreads();
    XcdBarrier bar; bar.bar = barw; bar.x = 0; bar.st = bst;
    bool posted = false;
    for (int ph = a.ph_lo; ph < a.ph_hi; ++ph) {
        if (ph == 0) { for (int rep = 0; rep < REP_PRO; ++rep) { prologue(a, lds, vwg, G); __syncthreads(); } }
        else if (ph == NPHASE - 1) final_phase(a, vwg, G);
        else {
            const int l = (ph - 1) / 5, sp = (ph - 1) % 5;
            const bf16_t* wl = (const bf16_t*)(ws + WS_W + (size_t)l * SZ_WLAYER);
            const bf16_t* w_qkv = wl; const bf16_t* w_o = (const bf16_t*)((const unsigned char*)wl + SZ_WQKV);
            const bf16_t* w_in = (const bf16_t*)((const unsigned char*)wl + SZ_WQKV + SZ_WO); const bf16_t* w_out = (const bf16_t*)((const unsigned char*)wl + SZ_WQKV + SZ_WO + SZ_WI);
            if (sp == 0) {
                pg8::Gemm g{xb, w_qkv, MTOK, 3072, 1024}; pg8::StaticOrder S; S.init(MTOK, 3072, G, vwg);
                pg8::EpiQKV E{qkv, rowss + (size_t)(2 * l) * MTOK, rot, (l & 1) ? 0 : 1};
                for (int rep = 0; rep < REP_QKV; ++rep) { pg8::gemm_phase<pg8::EpiQKV, pg8::StaticOrder, true, true>(lds, g, S, E); __syncthreads(); }
                if (l & 1) { for (int rep = 0; rep < REP_FG; ++rep) { __syncthreads(); fgate_phase(a, l >> 1, lds, vwg, G); } }
            } else if (sp == 1) {
                if (l & 1) { for (int rep = 0; rep < REP_FOX; ++rep) { fox_phase(a, lds, vwg, G); __syncthreads(); } } else { for (int rep = 0; rep < REP_EVEN; ++rep) { even_attn_phase(a, lds, vwg, G); __syncthreads(); } }
            } else if (sp == 2) {
                pg8::Gemm g{att, w_o, MTOK, 1024, 1024}; pg8::StaticOrder S; S.init(MTOK, 1024, G, vwg);
                pg8::EpiResid E{l == 0 ? a.x : xres, xres, xb, rowss + (size_t)(2 * l + 1) * MTOK};
                pg8::gemm_phase<pg8::EpiResid, pg8::StaticOrder, true, true>(lds, g, S, E);
            } else if (sp == 3) {
                pg8::Gemm g{xb, w_in, MTOK, 5632, 1024}; pg8::StaticOrder S; S.init(MTOK, 5632, G, vwg);
                pg8::EpiSwiGLU E{hid, rowss + (size_t)(2 * l + 1) * MTOK};
                for (int rep = 0; rep < REP_FFI; ++rep) { pg8::gemm_phase<pg8::EpiSwiGLU, pg8::StaticOrder, true, true>(lds, g, S, E); __syncthreads(); }
            } else {
                pg8::Gemm g{hid, w_out, MTOK, 1024, 2816}; pg8::StaticOrder S; S.init(MTOK, 1024, G, vwg);
                pg8::EpiResid E{xres, xres, xb, rowss + (size_t)(2 * l + 2) * MTOK};
                pg8::gemm_phase<pg8::EpiResid, pg8::StaticOrder, true, true>(lds, g, S, E);
            }
        }
        if (ph + 1 < a.ph_hi) {
            if (!posted) { grid.sync(); bar = xcd_barrier_post(barw, bst); posted = true; }
            else { for (int rep = 0; rep < REP_SYNC; ++rep) xcd_barrier(bar); }
        }
    }
}

#ifndef N_LAUNCH_MODE
#define N_LAUNCH_MODE 1
#endif

extern "C" void kernel_launch(void* const* d_in, const int* in_sizes, int n_in, void* d_out, int out_size, void* d_ws, size_t ws_size, hipStream_t stream) {
    static int grid = 0;
    if (grid == 0) {
        if (n_in != 11 || out_size != MTOK * DM || ws_size < WS_END) { fprintf(stderr, "kernel_launch: unexpected sizes n_in %d out %d ws %zu (need %zu)\n", n_in, out_size, ws_size, (size_t)WS_END); grid = -1; return; }
        int dev = 0, cus = 0, per_cu = 0;
        hipGetDevice(&dev); hipDeviceGetAttribute(&cus, hipDeviceAttributeMultiprocessorCount, dev);
        if (hipFuncSetAttribute((const void*)fwd_kernel, hipFuncAttributeMaxDynamicSharedMemorySize, LDS_BYTES) != hipSuccess) { fprintf(stderr, "kernel_launch: hipFuncSetAttribute failed\n"); grid = -1; return; }
        if (hipOccupancyMaxActiveBlocksPerMultiprocessor(&per_cu, (const void*)fwd_kernel, NTHR, LDS_BYTES) != hipSuccess || per_cu < 1) { fprintf(stderr, "kernel_launch: occupancy query says %d\n", per_cu); per_cu = 1; }
        (void)hipGetLastError();
        grid = cus * 1;
        fprintf(stderr, "kernel_launch: grid %d (cus %d, per_cu %d)\n", grid, cus, per_cu);
    }
    if (grid < 0) return;
    Args a{};
    a.x = (const float*)d_in[0]; a.norm_mix = (const float*)d_in[1]; a.w_qkv_even = (const float*)d_in[2]; a.w_o_even = (const float*)d_in[3];
    a.w_qkvf_odd = (const float*)d_in[4]; a.b_forget = (const float*)d_in[5]; a.w_o_odd = (const float*)d_in[6]; a.norm_ffn = (const float*)d_in[7];
    a.w_ffn_in = (const float*)d_in[8]; a.w_ffn_out = (const float*)d_in[9]; a.norm_final = (const float*)d_in[10];
    a.out = (float*)d_out; a.ws = (unsigned char*)d_ws;
#if N_LAUNCH_MODE == 1
    a.ph_lo = 0; a.ph_hi = NPHASE;
    void* args[] = {&a};
    hipError_t e = hipLaunchCooperativeKernel((const void*)fwd_kernel, dim3(grid), dim3(NTHR), args, LDS_BYTES, stream);
    if (e != hipSuccess) fprintf(stderr, "cooperative launch failed: %s (grid %d)\n", hipGetErrorString(e), grid);
#else
    for (int ph = 0; ph < NPHASE; ++ph) {
        a.ph_lo = ph; a.ph_hi = ph + 1;
        hipLaunchKernelGGL(fwd_kernel, dim3(grid), dim3(NTHR), LDS_BYTES, stream, a);
    }
#endif
}
```

```cpp
#include <hip/hip_runtime.h>
#include <hip/hip_cooperative_groups.h>
#include <cstdio>
#include <cstdint>
namespace cg = cooperative_groups;
namespace pg8 {
#define PG8_LAS __attribute__((address_space(3)))
typedef unsigned short bf16_t;
typedef short bf16x8 __attribute__((ext_vector_type(8)));
typedef float f32x4 __attribute__((ext_vector_type(4)));
typedef unsigned u32x4 __attribute__((ext_vector_type(4)));
constexpr int BM = 256, BK = 64, HALF = 128, HTB = HALF * BK * 2  , STAGE_BYTES = 8 * HTB, NXCD = 8, WGM = 8;

__host__ __device__ __forceinline__ int lds_byte(int r, int c) { const int st = (r >> 4) * 2 + (c >> 5), rr = r & 15, cc = c & 31, ob = rr * 64 + cc * 2; return st * 1024 + (ob ^ (((ob >> 9) & 1) << 5)); }
__host__ __device__ __forceinline__ void stage_rc(int b, int& R, int& C) { const int st = b / 1024, sb = b % 1024, swz = sb ^ (((sb >> 9) & 1) << 5); R = (st >> 1) * 16 + swz / 64; C = (st & 1) * 32 + (swz % 64) / 2; }
__host__ __device__ __forceinline__ int perm32(int rho) { const int n = rho >> 4, i = rho & 15; return 8 * (i >> 2) + 4 * n + (i & 3); }

struct Unit { int pm, pn; };
struct Gemm { const bf16_t* A; const bf16_t* Bt; int M, N, K; };

struct StaticOrder {
    int nM, nN, nwg, G, c;
    __host__ __device__ void init(int M, int N, int G_, int c_) { nM = M / BM; nN = N / BM; nwg = nM * nN; G = G_; c = c_; }
    __host__ __device__ bool next(int i, Unit& u) const {
        const long L = (long)i * G + c; if (L >= nwg) return false;
        int wgid = (int)L; { const int q = nwg / NXCD, r = nwg % NXCD, xcd = wgid % NXCD, off = wgid / NXCD; wgid = (xcd < r ? xcd * (q + 1) : r * (q + 1) + (xcd - r) * q) + off; }
        const int nig = WGM * nN, gid = wgid / nig, fm = gid * WGM, gsz = (nM - fm) < WGM ? (nM - fm) : WGM;
        u.pm = fm + ((wgid % nig) % gsz); u.pn = (wgid % nig) / gsz; return true;
    }
    __device__ __forceinline__ void a_ready(const Unit&) const {}
    __device__ __forceinline__ void done(const Unit&) const {}
};

__device__ __forceinline__ unsigned cvt_pk_bf16(float lo, float hi) { unsigned r; asm volatile("v_cvt_pk_bf16_f32 %0, %1, %2" : "=v"(r) : "v"(lo), "v"(hi)); return r; }
constexpr float RMS_EPS_F = 1e-5f;
__device__ __forceinline__ float rstd_of(const float* rowss, int row) { return 1.0f / sqrtf(rowss[row] * (1.0f / 1024.0f) + RMS_EPS_F); }

struct EpiQKV {
    static constexpr bool PERM = true, AFTER_DRAIN = false;
    bf16_t* O; const float* rowss; const float* rot; int rope;
    __device__ __forceinline__ void operator()(const f32x4 (&acc)[2][2][4][2], const Unit& u, int wr, int wc, int fr, int fq) const {
        const int row0 = u.pm * BM + wr * 64 + fr;
        const int col0 = u.pn * BM + wc * 32 + 8 * fq;
        const bool rt = rope && ((u.pn & 2) != 0) && (u.pn < 8) && ((wc & 1) == 0);
#pragma unroll
        for (int ai = 0; ai < 2; ++ai)
#pragma unroll
            for (int m = 0; m < 4; ++m) {
                const int row = row0 + ai * HALF + m * 16;
                const float rs = rstd_of(rowss, row);
                bf16_t* rowp = O + (size_t)row * 3072 + col0;
                f32x4 c0 = {1.f, 1.f, 1.f, 1.f}, c1 = c0, s0 = {0.f, 0.f, 0.f, 0.f}, s1 = s0;
                if (rt) { const f32x4* rp = (const f32x4*)(rot + (size_t)(row & 2047) * 16); c0 = rp[0]; c1 = rp[1]; s0 = rp[2]; s1 = rp[3]; }
#pragma unroll
                for (int bj = 0; bj < 2; ++bj) {
                    f32x4 v0 = acc[ai][bj][m][0] * rs, v1 = acc[ai][bj][m][1] * rs;
                    if (rt) {
                        f32x4 p0, p1;
#pragma unroll
                        for (int e = 0; e < 4; ++e) { p0[e] = __shfl_xor(v0[e], 16); p1[e] = __shfl_xor(v1[e], 16); }
                        if (fq == 0) { v0 = v0 * c0 - p0 * s0; v1 = v1 * c1 - p1 * s1; }
                        else if (fq == 1) { v0 = v0 * c0 + p0 * s0; v1 = v1 * c1 + p1 * s1; }
                    }
                    u32x4 w; w.x = cvt_pk_bf16(v0[0], v0[1]); w.y = cvt_pk_bf16(v0[2], v0[3]); w.z = cvt_pk_bf16(v1[0], v1[1]); w.w = cvt_pk_bf16(v1[2], v1[3]);
                    *(u32x4*)(rowp + bj * HALF) = w;
                }
            }
    }
};

struct EpiResid {
    static constexpr bool PERM = true, AFTER_DRAIN = false;
    const float* xin; float* xout; bf16_t* xb; float* rowss_next;
    __device__ __forceinline__ void operator()(const f32x4 (&acc)[2][2][4][2], const Unit& u, int wr, int wc, int fr, int fq) const {
        const int row0 = u.pm * BM + wr * 64 + fr;
        const int col0 = u.pn * BM + wc * 32 + 8 * fq;
#pragma unroll
        for (int ai = 0; ai < 2; ++ai)
#pragma unroll
            for (int m = 0; m < 4; ++m) {
                const int row = row0 + ai * HALF + m * 16;
                float ss = 0.f;
#pragma unroll
                for (int bj = 0; bj < 2; ++bj) {
                    const size_t off = (size_t)row * 1024 + col0 + bj * HALF;
                    const f32x4* xi = (const f32x4*)(xin + off);
                    const f32x4 a0 = xi[0] + acc[ai][bj][m][0], a1 = xi[1] + acc[ai][bj][m][1];
                    f32x4* xo = (f32x4*)(xout + off); xo[0] = a0; xo[1] = a1;
                    ss += (a0[0] * a0[0] + a0[1] * a0[1]) + (a0[2] * a0[2] + a0[3] * a0[3]) + (a1[0] * a1[0] + a1[1] * a1[1]) + (a1[2] * a1[2] + a1[3] * a1[3]);
                    u32x4 w; w.x = cvt_pk_bf16(a0[0], a0[1]); w.y = cvt_pk_bf16(a0[2], a0[3]); w.z = cvt_pk_bf16(a1[0], a1[1]); w.w = cvt_pk_bf16(a1[2], a1[3]);
                    *(u32x4*)(xb + off) = w;
                }
                ss += __shfl_xor(ss, 16); ss += __shfl_xor(ss, 32);
                if (fq == 0) atomicAdd(rowss_next + row, ss);
            }
    }
};

struct EpiSwiGLU {
    static constexpr bool PERM = true, AFTER_DRAIN = false;
    bf16_t* H; const float* rowss;
    __device__ __forceinline__ void operator()(const f32x4 (&acc)[2][2][4][2], const Unit& u, int wr, int wc, int fr, int fq) const {
        const int row0 = u.pm * BM + wr * 64 + fr;
        const int col0 = u.pn * HALF + wc * 32 + 8 * fq;
#pragma unroll
        for (int ai = 0; ai < 2; ++ai)
#pragma unroll
            for (int m = 0; m < 4; ++m) {
                const int row = row0 + ai * HALF + m * 16;
                const float rs = rstd_of(rowss, row);
                float h[8];
#pragma unroll
                for (int n = 0; n < 2; ++n)
#pragma unroll
                    for (int e = 0; e < 4; ++e) {
                        const float g = acc[ai][0][m][n][e] * rs, up = acc[ai][1][m][n][e] * rs;
                        const float sg = g * __builtin_amdgcn_rcpf(1.0f + __builtin_amdgcn_exp2f(-1.4426950408889634f * g));
                        h[n * 4 + e] = sg * up;
                    }
                u32x4 w; w.x = cvt_pk_bf16(h[0], h[1]); w.y = cvt_pk_bf16(h[2], h[3]); w.z = cvt_pk_bf16(h[4], h[5]); w.w = cvt_pk_bf16(h[6], h[7]);
                *(u32x4*)(H + (size_t)row * 2816 + col0) = w;
            }
    }
};

template <class Epi, class Sched, bool ALIGN_EPI = false, bool SP2 = false>
__device__ __forceinline__ void gemm_phase(PG8_LAS unsigned char* lds, const Gemm g, const Sched& S, const Epi& E) {
    int tid_ = threadIdx.x; asm volatile("" : "+v"(tid_));
    const int tid = tid_, wid = __builtin_amdgcn_readfirstlane(tid >> 6), lane = tid & 63, wr = wid >> 2, wc = wid & 3, fr = lane & 15, fq = lane >> 4;
    const int K = g.K, nt = K / BK;
    unsigned voffA[2], voffB[2];
#pragma unroll
    for (int i = 0; i < 2; ++i) { int R, C; stage_rc(tid * 16 + i * 8192, R, C); const int Rb = Epi::PERM ? ((R & ~31) + perm32(R & 31)) : R;
        voffA[i] = (unsigned)(R * K + C) * 2u; voffB[i] = (unsigned)(Rb * K + C) * 2u; }
    const size_t kstep = (size_t)(BK * 2);
    const size_t hstep = (size_t)HALF * K * 2;
    const size_t tstep = 2 * hstep;
    const unsigned ldsw = (unsigned)wid * 1024u;
    const int aoff = lds_byte(wr * 64 + fr, fq * 8), boff = lds_byte(wc * 32 + fr, fq * 8);
#define PG8_SA(b, h) (((b) * 2 + (h)) * HTB)
#define PG8_SB(b, h) ((4 + (b) * 2 + (h)) * HTB)
#define PG8_STAGE(bufoff, gbase, voff) do { _Pragma("unroll") for (int _i = 0; _i < 2; ++_i) \
        __builtin_amdgcn_global_load_lds((const unsigned*)((const char*)(gbase) + (voff)[_i]), (PG8_LAS unsigned*)(lds + (bufoff) + ldsw + _i * 8192), 16, 0, 0); } while (0)
#define PG8_LDA(dst, b, h) do { _Pragma("unroll") for (int m = 0; m < 4; ++m) _Pragma("unroll") for (int k = 0; k < 2; ++k) dst[m][k] = *(const PG8_LAS bf16x8*)(lds + PG8_SA(b, h) + aoff + m * 2048 + k * 1024); } while (0)
#define PG8_LDB(dst, b, h) do { _Pragma("unroll") for (int n = 0; n < 2; ++n) _Pragma("unroll") for (int k = 0; k < 2; ++k) dst[n][k] = *(const PG8_LAS bf16x8*)(lds + PG8_SB(b, h) + boff + n * 2048 + k * 1024); } while (0)
#define PG8_MMA(ai, bj, At, Bt) do { __builtin_amdgcn_s_setprio(1); _Pragma("unroll") for (int m = 0; m < 4; ++m) _Pragma("unroll") for (int n = 0; n < 2; ++n) _Pragma("unroll") for (int k = 0; k < 2; ++k) \
        acc[ai][bj][m][n] = __builtin_amdgcn_mfma_f32_16x16x32_bf16(Bt[n][k], At[m][k], acc[ai][bj][m][n], 0, 0, 0); __builtin_amdgcn_s_setprio(0); } while (0)
#define PG8_WAIT_V(n) asm volatile("s_waitcnt vmcnt(" #n ")" ::: "memory")
#define PG8_WAIT_L(n) asm volatile("s_waitcnt lgkmcnt(" #n ")" ::: "memory")
#define PG8_BAR __builtin_amdgcn_s_barrier()
#define PG8_SCHED __builtin_amdgcn_sched_barrier(0)
    Unit cur, nxt; int ui = 0;
    if (!S.next(0, cur)) return;
    f32x4 acc[2][2][4][2];
#pragma unroll
    for (int a = 0; a < 2; ++a)
#pragma unroll
        for (int b = 0; b < 2; ++b)
#pragma unroll
            for (int m = 0; m < 4; ++m)
#pragma unroll
                for (int n = 0; n < 2; ++n) acc[a][b][m][n] = (f32x4){0.f, 0.f, 0.f, 0.f};
    bf16x8 At[4][2], B0[2][2], B1[2][2];
    const char* cA = (const char*)g.A + (size_t)cur.pm * tstep; const char* cB = (const char*)g.Bt + (size_t)cur.pn * tstep;
    S.a_ready(cur);
    if constexpr (SP2) {
        PG8_STAGE(PG8_SB(0, 0), cB, voffB); PG8_STAGE(PG8_SB(0, 1), cB + hstep, voffB); PG8_STAGE(PG8_SA(0, 0), cA, voffA); PG8_STAGE(PG8_SA(0, 1), cA + hstep, voffA);
        if (wr == 1) PG8_BAR;
        PG8_WAIT_V(2); PG8_BAR;
        PG8_STAGE(PG8_SB(1, 0), cB + kstep, voffB); PG8_STAGE(PG8_SA(1, 0), cA + kstep, voffA); PG8_STAGE(PG8_SB(1, 1), cB + hstep + kstep, voffB);
        PG8_WAIT_V(6); PG8_BAR;
    } else {
        PG8_STAGE(PG8_SB(0, 0), cB, voffB); PG8_STAGE(PG8_SA(0, 0), cA, voffA); PG8_STAGE(PG8_SB(0, 1), cB + hstep, voffB); PG8_STAGE(PG8_SA(0, 1), cA + hstep, voffA);
        if (wr == 1) PG8_BAR;
        PG8_WAIT_V(4); PG8_BAR;
        PG8_STAGE(PG8_SB(1, 0), cB + kstep, voffB); PG8_STAGE(PG8_SA(1, 0), cA + kstep, voffA); PG8_STAGE(PG8_SB(1, 1), cB + hstep + kstep, voffB);
        PG8_WAIT_V(6); PG8_BAR;
    }
    for (;;) {
        const bool has_next = S.next(ui + 1, nxt);
        const char* nA = has_next ? (const char*)g.A + (size_t)nxt.pm * tstep : cA; const char* nB = has_next ? (const char*)g.Bt + (size_t)nxt.pn * tstep : cB;
        for (int t = 0; t < nt; t += 2) {
            const bool last = (t == nt - 2);
            const char* a1 = cA + (size_t)(t + 1) * kstep;
            const char* a2 = last ? nA : cA + (size_t)(t + 2) * kstep; const char* b2 = last ? nB : cB + (size_t)(t + 2) * kstep;
            const char* a3 = a2 + kstep; const char* b3 = b2 + kstep;
            if (last && has_next) S.a_ready(nxt);
            if constexpr (SP2) {
            PG8_LDB(B0, 0, 0); PG8_LDB(B1, 0, 1); PG8_SCHED; PG8_LDA(At, 0, 0); PG8_STAGE(PG8_SA(1, 1), a1 + hstep, voffA);
            PG8_WAIT_V(8); PG8_WAIT_L(0); PG8_BAR; PG8_MMA(0, 0, At, B0); PG8_MMA(0, 1, At, B1); PG8_BAR; PG8_SCHED;
            PG8_LDA(At, 0, 1); PG8_STAGE(PG8_SB(0, 0), b2, voffB); PG8_STAGE(PG8_SB(0, 1), b2 + hstep, voffB); PG8_STAGE(PG8_SA(0, 0), a2, voffA);
            PG8_WAIT_V(8); PG8_WAIT_L(0); PG8_BAR; PG8_MMA(1, 0, At, B0); PG8_MMA(1, 1, At, B1); PG8_BAR; PG8_SCHED;
            PG8_LDB(B0, 1, 0); PG8_LDB(B1, 1, 1); PG8_SCHED; PG8_LDA(At, 1, 0); PG8_STAGE(PG8_SA(0, 1), a2 + hstep, voffA);
            PG8_WAIT_V(8); PG8_WAIT_L(0); PG8_BAR; PG8_MMA(0, 0, At, B0); PG8_MMA(0, 1, At, B1); PG8_BAR; PG8_SCHED;
            PG8_LDA(At, 1, 1); PG8_STAGE(PG8_SB(1, 0), b3, voffB); PG8_STAGE(PG8_SB(1, 1), b3 + hstep, voffB); PG8_STAGE(PG8_SA(1, 0), a3, voffA);
            PG8_WAIT_V(8); PG8_WAIT_L(0); PG8_BAR; PG8_MMA(1, 0, At, B0); PG8_MMA(1, 1, At, B1); PG8_BAR; PG8_SCHED;
            } else {
            PG8_LDB(B0, 0, 0); PG8_SCHED; PG8_LDA(At, 0, 0); PG8_STAGE(PG8_SA(1, 1), a1 + hstep, voffA);
            PG8_WAIT_L(8); PG8_BAR; PG8_WAIT_L(0); PG8_MMA(0, 0, At, B0); PG8_BAR; PG8_SCHED;
            PG8_LDB(B1, 0, 1); PG8_STAGE(PG8_SB(0, 0), b2, voffB);
            PG8_BAR; PG8_WAIT_L(0); PG8_MMA(0, 1, At, B1); PG8_BAR;
            PG8_LDA(At, 0, 1); PG8_STAGE(PG8_SA(0, 0), a2, voffA);
            PG8_BAR; PG8_WAIT_L(0); PG8_MMA(1, 0, At, B0); PG8_BAR; PG8_SCHED;
            PG8_STAGE(PG8_SB(0, 1), b2 + hstep, voffB);
            PG8_WAIT_V(6); PG8_BAR; PG8_MMA(1, 1, At, B1); PG8_BAR;
            PG8_LDB(B0, 1, 0); PG8_SCHED; PG8_LDA(At, 1, 0); PG8_STAGE(PG8_SA(0, 1), a2 + hstep, voffA);
            PG8_WAIT_L(8); PG8_BAR; PG8_WAIT_L(0); PG8_MMA(0, 0, At, B0); PG8_BAR; PG8_SCHED;
            PG8_LDB(B1, 1, 1); PG8_STAGE(PG8_SB(1, 0), b3, voffB);
            PG8_BAR; PG8_WAIT_L(0); PG8_MMA(0, 1, At, B1); PG8_BAR;
            PG8_LDA(At, 1, 1); PG8_STAGE(PG8_SA(1, 0), a3, voffA);
            PG8_BAR; PG8_WAIT_L(0); PG8_MMA(1, 0, At, B0); PG8_BAR; PG8_SCHED;
            PG8_STAGE(PG8_SB(1, 1), b3 + hstep, voffB);
            PG8_WAIT_V(6); PG8_BAR; PG8_MMA(1, 1, At, B1); PG8_BAR;
            }
        }
        if constexpr (ALIGN_EPI) { if (wr == 0) PG8_BAR; }
        if constexpr (!Epi::AFTER_DRAIN) { E(acc, cur, wr, wc, fr, fq); S.done(cur); }
        if (!has_next) break;
#pragma unroll
        for (int a = 0; a < 2; ++a)
#pragma unroll
            for (int b = 0; b < 2; ++b)
#pragma unroll
                for (int m = 0; m < 4; ++m)
#pragma unroll
                    for (int n = 0; n < 2; ++n) acc[a][b][m][n] = (f32x4){0.f, 0.f, 0.f, 0.f};
        cur = nxt; cA = nA; cB = nB; ++ui;
        if constexpr (ALIGN_EPI) { if (wr == 1) PG8_BAR; }
    }
    PG8_WAIT_V(0);
    if constexpr (!ALIGN_EPI) { if (wr == 0) PG8_BAR; }
    PG8_BAR;
    if constexpr (Epi::AFTER_DRAIN) { E.fused(acc, cur, wr, wc, fr, fq, lds, wid, lane); S.done(cur); }
#undef PG8_SA
#undef PG8_SB
#undef PG8_STAGE
#undef PG8_LDA
#undef PG8_LDB
#undef PG8_MMA
#undef PG8_WAIT_V
#undef PG8_WAIT_L
#undef PG8_BAR
#undef PG8_SCHED
}
}

#define LAS __attribute__((address_space(3)))
typedef unsigned short bf16_t;
typedef short bf16x8 __attribute__((ext_vector_type(8)));
typedef short s16x4 __attribute__((ext_vector_type(4)));
typedef float f32x4 __attribute__((ext_vector_type(4)));
typedef float f32x16 __attribute__((ext_vector_type(16)));
typedef unsigned u32x4 __attribute__((ext_vector_type(4)));
typedef unsigned u32x2 __attribute__((ext_vector_type(2)));

constexpr int NB = 8, SEQ = 2048, DM = 1024, MTOK = NB * SEQ, DFF = 2816, NLAYER = 4, QKV_LD = 3072;
constexpr int NWAVES = 8, NTHR = 512;
constexpr float LOG2E = 1.4426950408889634f;
constexpr int LDS_BYTES = 147456;
constexpr int VROW = 192;
constexpr int VTILE = 32 * VROW;
constexpr int LDS_F = 49152;
constexpr int NPHASE = 2 + 5 * NLAYER;
constexpr int LDS_MISC = 131072;

constexpr size_t MiB = 1u << 20;
constexpr size_t SZ_WQKV = (size_t)3072 * 1024 * 2, SZ_WO = (size_t)1024 * 1024 * 2, SZ_WI = (size_t)5632 * 1024 * 2, SZ_WOUT = (size_t)1024 * 2816 * 2;
constexpr size_t SZ_WLAYER = SZ_WQKV + SZ_WO + SZ_WI + SZ_WOUT;
constexpr size_t WS_W = 0;
constexpr size_t WS_XB = 104 * MiB;
constexpr size_t WS_XRES = WS_XB + 32 * MiB;
constexpr size_t WS_QKV = WS_XRES + 64 * MiB;
constexpr size_t WS_ATT = WS_QKV + 96 * MiB;
constexpr size_t WS_SMALL = WS_ATT + 32 * MiB;
constexpr size_t WS_ROWSS = WS_SMALL;
constexpr size_t WS_ROT = WS_ROWSS + (size_t)9 * MTOK * 4;
constexpr size_t WS_WF = WS_ROT + (size_t)2048 * 16 * 4;
constexpr size_t WS_LOCF = WS_WF + (size_t)2 * 16 * 1024 * 4;
constexpr size_t WS_TOTF = WS_LOCF + (size_t)128 * 2048 * 4;
constexpr size_t WS_LSE = WS_TOTF + (size_t)128 * 32 * 4;
constexpr size_t WS_BAR = WS_LSE + (size_t)2 * MTOK * 8 * 4;
constexpr size_t WS_END = WS_BAR + 16384;
static_assert(SZ_WLAYER * 4 <= 104 * MiB, "weights fit");

struct Args {
    const float* x; const float* norm_mix; const float* w_qkv_even; const float* w_o_even; const float* w_qkvf_odd; const float* b_forget; const float* w_o_odd;
    const float* norm_ffn; const float* w_ffn_in; const float* w_ffn_out; const float* norm_final;
    float* out; unsigned char* ws; int ph_lo, ph_hi;
};

__device__ __forceinline__ unsigned f2bf(float f) { unsigned u = __builtin_bit_cast(unsigned, f); return (u + 0x7fffu + ((u >> 16) & 1u)) >> 16; }
__device__ __forceinline__ unsigned pk2(float lo, float hi) { return f2bf(lo) | (f2bf(hi) << 16); }
__device__ __forceinline__ unsigned cvtpk(float lo, float hi) { unsigned r; asm volatile("v_cvt_pk_bf16_f32 %0, %1, %2" : "=v"(r) : "v"(lo), "v"(hi)); return r; }
__device__ __forceinline__ float wave_sum(float v) {
#pragma unroll
    for (int o = 1; o < 64; o <<= 1) v += __shfl_xor(v, o);
    return v;
}
#define LDS_WAIT() asm volatile("s_waitcnt lgkmcnt(0)" ::: "memory")
__device__ __forceinline__ int otid() { int t = threadIdx.x; asm volatile("" : "+v"(t)); return t; }

__device__ __forceinline__ void transpose_item(const float* W, int ldw, int K, int k0, int src_col, bf16_t* WT, int dst_row, const float* gain, float cscale, LAS float* scr, int lane) {
    const int kr = lane >> 3, c4 = lane & 7;
    f32x4 v[8]; float g[8];
#pragma unroll
    for (int i = 0; i < 8; ++i) { const int kk = 8 * i + kr; v[i] = *(const f32x4*)(W + (size_t)(k0 + kk) * ldw + src_col + 4 * c4); g[i] = gain ? gain[k0 + kk] * cscale : cscale; }
#pragma unroll
    for (int i = 0; i < 8; ++i) { const int kk = 8 * i + kr; LAS float* d = scr + kk * 33 + 4 * c4; d[0] = v[i].x * g[i]; d[1] = v[i].y * g[i]; d[2] = v[i].z * g[i]; d[3] = v[i].w * g[i]; }
    LDS_WAIT(); asm volatile("" ::: "memory");
    const int c = lane & 7;
#pragma unroll
    for (int j = 0; j < 4; ++j) { const int n = (lane >> 3) + 8 * j; const LAS float* s = scr + (8 * c) * 33 + n;
        u32x4 o; o.x = pk2(s[0 * 33], s[1 * 33]); o.y = pk2(s[2 * 33], s[3 * 33]); o.z = pk2(s[4 * 33], s[5 * 33]); o.w = pk2(s[6 * 33], s[7 * 33]);
        *(u32x4*)(WT + (size_t)(dst_row + n) * K + k0 + 8 * c) = o; }
    LDS_WAIT(); asm volatile("" ::: "memory");
}

__device__ __forceinline__ void prologue(const Args& a, LAS unsigned char* lds, int vwg, int G) {
    const int tid = otid(), lane = tid & 63, wave = __builtin_amdgcn_readfirstlane(tid >> 6);
    LAS float* scr = (LAS float*)(lds + wave * 16384);
    const int gw = vwg * NWAVES + wave, NGW = G * NWAVES;
    constexpr int I_QKV = 16 * 96, I_O = 16 * 32, I_IN = 16 * 176, I_OUT = 44 * 32, I_LAYER = I_QKV + I_O + I_IN + I_OUT;
    for (int it = gw; it < NLAYER * I_LAYER; it += NGW) {
        const int l = it / I_LAYER; int r = it % I_LAYER;
        bf16_t* wl = (bf16_t*)(a.ws + WS_W + (size_t)l * SZ_WLAYER);
        if (r < I_QKV) {
            const int kb = r / 96, nb = r % 96, n0 = 32 * nb;
            const float* W = (l & 1) ? a.w_qkvf_odd + (size_t)(l >> 1) * 1024 * 3088 : a.w_qkv_even + (size_t)(l >> 1) * 1024 * 3072;
            transpose_item(W, (l & 1) ? 3088 : 3072, 1024, 64 * kb, n0, wl, n0, a.norm_mix + l * 1024, n0 < 1024 ? 0.125f * LOG2E : 1.0f, scr, lane);
            continue; }
        r -= I_QKV;
        if (r < I_O) {
            const int kb = r / 32, nb = r % 32, n0 = 32 * nb;
            const float* W = (l & 1) ? a.w_o_odd + (size_t)(l >> 1) * 1024 * 1024 : a.w_o_even + (size_t)(l >> 1) * 1024 * 1024;
            transpose_item(W, 1024, 1024, 64 * kb, n0, (bf16_t*)((unsigned char*)wl + SZ_WQKV), n0, nullptr, 1.0f, scr, lane);
            continue; }
        r -= I_O;
        if (r < I_IN) {
            const int kb = r / 176, nb = r % 176, n0 = 32 * nb;
            const int pn = n0 >> 8, bj = (n0 >> 7) & 1, c0 = n0 & 127;
            transpose_item(a.w_ffn_in + (size_t)l * 1024 * 5632, 5632, 1024, 64 * kb, bj * 2816 + 128 * pn + c0, (bf16_t*)((unsigned char*)wl + SZ_WQKV + SZ_WO), n0, a.norm_ffn + l * 1024, 1.0f, scr, lane);
            continue; }
        r -= I_IN;
        {
            const int kb = r / 32, nb = r % 32, n0 = 32 * nb;
            transpose_item(a.w_ffn_out + (size_t)l * 2816 * 1024, 1024, 2816, 64 * kb, n0, (bf16_t*)((unsigned char*)wl + SZ_WQKV + SZ_WO + SZ_WI), n0, nullptr, 1.0f, scr, lane);
        }
    }
    bf16_t* xb = (bf16_t*)(a.ws + WS_XB); float* rowss = (float*)(a.ws + WS_ROWSS);
    for (int m = gw; m < MTOK; m += NGW) {
        const f32x4* xr = (const f32x4*)(a.x + (size_t)m * DM) + lane; float s = 0.f; f32x4 v[4];
#pragma unroll
        for (int j = 0; j < 4; ++j) { v[j] = xr[64 * j]; s += (v[j].x * v[j].x + v[j].y * v[j].y) + (v[j].z * v[j].z + v[j].w * v[j].w); }
        s = wave_sum(s);
        unsigned long long* o8 = (unsigned long long*)(xb + (size_t)m * DM) + lane;
#pragma unroll
        for (int j = 0; j < 4; ++j) o8[64 * j] = (unsigned long long)pk2(v[j].x, v[j].y) | ((unsigned long long)pk2(v[j].z, v[j].w) << 32);
        if (lane == 0) rowss[m] = s;
    }
    const int gt = vwg * NTHR + tid, NGT = G * NTHR;
    for (int i = gt; i < 8 * MTOK; i += NGT) rowss[MTOK + i] = 0.f;
    float* rot = (float*)(a.ws + WS_ROT);
    for (int i = gt; i < 2048 * 8; i += NGT) {
        const int pos = i >> 3, j = i & 7;
        const float invf[8] = {1.0f, 0.19392274474868576f, 0.03760603093086393f, 0.007292664737217109f, 0.001414213562373095f, 0.0002742481756762073f, 5.318295896944988e-05f, 1.031338537721246e-05f};
        float fq = invf[0];
#pragma unroll
        for (int t = 1; t < 8; ++t) fq = (j == t) ? invf[t] : fq;
        const float ang = (float)pos * fq;
        const double rev = (double)ang * 0.15915494309189535; const float fr = (float)(rev - floor(rev));
        rot[pos * 16 + j] = __builtin_amdgcn_cosf(fr); rot[pos * 16 + 8 + j] = __builtin_amdgcn_sinf(fr);
    }
    float* wf = (float*)(a.ws + WS_WF);
    for (int i = gt; i < 2 * 16 * 1024; i += NGT) {
        const int lo = i >> 14, hd = (i >> 10) & 15, k = i & 1023;
        wf[i] = a.w_qkvf_odd[(size_t)lo * 1024 * 3088 + (size_t)k * 3088 + 3072 + hd] * a.norm_mix[(2 * lo + 1) * 1024 + k];
    }
}

__device__ __forceinline__ void fgate_phase(const Args& a, int lo, LAS unsigned char* lds, int vwg, int G) {
    const int tid = otid(), lane = tid & 63, wave = __builtin_amdgcn_readfirstlane(tid >> 6);
    const float* xres = (const float*)(a.ws + WS_XRES); const float* rowss = (const float*)(a.ws + WS_ROWSS) + (size_t)(2 * (2 * lo + 1)) * MTOK;
    const float* wf = (const float*)(a.ws + WS_WF) + (size_t)lo * 16 * 1024;
    float* locF = (float*)(a.ws + WS_LOCF); float* totF = (float*)(a.ws + WS_TOTF);
    LAS float* lf = (LAS float*)lds;
    const int r16 = lane & 15, g4 = lane >> 4, tile = wave & 3, kh = wave >> 2;
    for (int j = vwg; j < 256; j += G) {
        const f32x4* xr = (const f32x4*)(xres + (size_t)(64 * j + 16 * tile + r16) * DM + 512 * kh + 4 * g4);
        const f32x4* wr = (const f32x4*)(wf + (size_t)r16 * 1024 + 512 * kh + 4 * g4);
        f32x4 acc = {0.f, 0.f, 0.f, 0.f};
#pragma unroll 8
        for (int s = 0; s < 32; ++s) {
            const f32x4 xv = xr[4 * s], wv = wr[4 * s];
            acc = __builtin_amdgcn_mfma_f32_16x16x4f32(xv.x, wv.x, acc, 0, 0, 0);
            acc = __builtin_amdgcn_mfma_f32_16x16x4f32(xv.y, wv.y, acc, 0, 0, 0);
            acc = __builtin_amdgcn_mfma_f32_16x16x4f32(xv.z, wv.z, acc, 0, 0, 0);
            acc = __builtin_amdgcn_mfma_f32_16x16x4f32(xv.w, wv.w, acc, 0, 0, 0);
        }
#pragma unroll
        for (int jj = 0; jj < 4; ++jj) lf[(kh * 64 + 16 * tile + 4 * g4 + jj) * 16 + r16] = acc[jj];
        __syncthreads();
        if (tid < 16) {
            const int b = j >> 5, sl = j & 31; float run = 0.f; float* dst = locF + (size_t)(b * 16 + tid) * 2048 + sl * 64;
            const float bias = a.b_forget[lo * 16 + tid];
            for (int t = 0; t < 64; ++t) {
                const float fl = (lf[t * 16 + tid] + lf[(64 + t) * 16 + tid]) * pg8::rstd_of(rowss, 64 * j + t) + bias;
                const float z2 = fl * LOG2E; const float l2 = -(fmaxf(-z2, 0.f) + __builtin_amdgcn_logf(1.0f + __builtin_amdgcn_exp2f(-fabsf(z2))));
                run += l2; dst[t] = run;
            }
            totF[(b * 16 + tid) * 32 + sl] = run;
        }
        __syncthreads();
    }
}

__device__ __forceinline__ int phi32(int r) { return ((r >> 4) & 1) * 16 + ((r >> 2) & 1) * 8 + ((r >> 3) & 1) * 4 + (r & 3); }
__device__ __forceinline__ s16x4 vtr(const LAS unsigned char* p) { return __builtin_bit_cast(s16x4, __builtin_amdgcn_ds_read_tr16_b64_v4i16((LAS s16x4*)p)); }

template <int MODE, int DBG = 0>
__device__ __forceinline__ void attn_task(const bf16_t* qp, const bf16_t* kp, const bf16_t* vp, size_t rstride, int q0, int kb_lo, int kb_hi,
                                          LAS unsigned char* vlds, const LAS float* Fs, f32x16 (&O)[2], float& lse2) {
    const int lane = otid() & 63, n = lane & 31, hh = lane >> 5;
    bf16x8 qf[4];
    { const bf16_t* p = qp + (size_t)(q0 + n) * rstride + 8 * hh;
#pragma unroll
      for (int ks = 0; ks < 4; ++ks) qf[ks] = *(const bf16x8*)(p + 16 * ks); }
    const int qi = q0 + n;
    float Fq = 0.f; if (MODE == 0) Fq = Fs[qi];
#pragma unroll
    for (int r = 0; r < 16; ++r) { O[0][r] = 0.f; O[1][r] = 0.f; }
    float m = -1e30f, l = 0.f, R = 0.f;
    const bf16_t* kl = kp + (size_t)phi32(n) * rstride + 8 * hh;
    const bf16_t* vl = vp + (size_t)(lane >> 3) * rstride + 8 * (lane & 7);
    LAS unsigned char* vw = vlds + (lane >> 3) * VROW + (lane & 7) * 16;
    const LAS unsigned char* vr = vlds + (8 * hh + ((lane & 15) >> 2)) * VROW + (16 * ((lane >> 4) & 1) + 4 * (lane & 3)) * 2;
    bf16x8 kn[4]; u32x4 vn[4];
#define AT_ISSUE(kb) do { const bf16_t* kk_ = kl + (size_t)(kb) * 32 * rstride; const bf16_t* vv_ = vl + (size_t)(kb) * 32 * rstride; \
        _Pragma("unroll") for (int ks = 0; ks < 4; ++ks) kn[ks] = *(const bf16x8*)(kk_ + 16 * ks); \
        _Pragma("unroll") for (int ii = 0; ii < 4; ++ii) vn[ii] = *(const u32x4*)(vv_ + (size_t)(8 * ii) * rstride); } while (0)
    const int nblk = kb_hi - kb_lo + 1;
    int kb = (MODE == 2) ? kb_hi : kb_lo;
    AT_ISSUE(kb);
    for (int it = 0; it < nblk; ++it) {
        bf16x8 kc[4];
#pragma unroll
        for (int ks = 0; ks < 4; ++ks) kc[ks] = kn[ks];
        asm volatile("" ::: "memory");
#pragma unroll
        for (int ii = 0; ii < 4; ++ii) *(LAS u32x4*)(vw + ii * 8 * VROW) = vn[ii];
        asm volatile("" ::: "memory");
        const int kbn = (MODE == 2) ? kb - 1 : kb + 1;
        if (it + 1 < nblk && DBG != 1) AT_ISSUE(kbn);
        if (DBG != 2) {
        const int key0 = kb * 32 + 8 * hh;
        f32x16 s;
        if (MODE == 0) {
            const LAS f32x4* fk = (const LAS f32x4*)(Fs + key0);
            const f32x4 f0 = fk[0], f1 = fk[1], f2 = fk[4], f3 = fk[5];
#pragma unroll
            for (int e = 0; e < 4; ++e) { s[e] = Fq - f0[e]; s[4 + e] = Fq - f1[e]; s[8 + e] = Fq - f2[e]; s[12 + e] = Fq - f3[e]; }
        } else {
#pragma unroll
            for (int r = 0; r < 16; ++r) s[r] = 0.f;
        }
#pragma unroll
        for (int ks = 0; ks < 4; ++ks) s = __builtin_amdgcn_mfma_f32_32x32x16_bf16(kc[ks], qf[ks], s, 0, 0, 0);
        bf16x8 pb[2];
        if (MODE != 2) {
            const bool diag = (kb * 32 + 31 > q0);
            if (MODE == 1) {
#pragma unroll
                for (int r = 0; r < 16; ++r) { const int ki = key0 + 16 * (r >> 3) + (r & 7); if (ki > qi || ki < qi - 128) s[r] = -1e30f; }
            } else if (diag) {
#pragma unroll
                for (int r = 0; r < 16; ++r) { const int ki = key0 + 16 * (r >> 3) + (r & 7); if (ki > qi) s[r] = -1e30f; }
            }
            float bm = fmaxf(fmaxf(s[0], s[1]), fmaxf(s[2], s[3]));
#pragma unroll
            for (int r = 4; r < 16; r += 4) bm = fmaxf(bm, fmaxf(fmaxf(s[r], s[r + 1]), fmaxf(s[r + 2], s[r + 3])));
            bm = fmaxf(bm, __shfl_xor(bm, 32));
            const float mn = fmaxf(m, bm), alpha = __builtin_amdgcn_exp2f(m - mn); m = mn;
            float ps = 0.f;
#pragma unroll
            for (int r = 0; r < 16; ++r) { s[r] = __builtin_amdgcn_exp2f(s[r] - mn); ps += s[r]; }
            l = l * alpha + ps;
#pragma unroll
            for (int r = 0; r < 16; ++r) { O[0][r] *= alpha; O[1][r] *= alpha; }
        } else {
            const bool diag = (kb * 32 + 31 >= q0);
            float L[16];
#pragma unroll
            for (int r = 0; r < 16; ++r) {
                const float z = s[r], t = __builtin_amdgcn_exp2f(-fabsf(z)), sp = fmaxf(z, 0.f) + __builtin_amdgcn_logf(1.0f + t);
                L[r] = -sp; s[r] = z - sp;
            }
            if (diag) {
#pragma unroll
                for (int r = 0; r < 16; ++r) { const int ki = key0 + 16 * (r >> 3) + (r & 7); if (ki >= qi) { L[r] = 0.f; s[r] = -1e30f; } }
            }
            float sA = ((L[0] + L[1]) + (L[2] + L[3])) + ((L[4] + L[5]) + (L[6] + L[7]));
            float sB = ((L[8] + L[9]) + (L[10] + L[11])) + ((L[12] + L[13]) + (L[14] + L[15]));
            const float pA = __shfl_xor(sA, 32), pB = __shfl_xor(sB, 32);
            const float offA = sB + pB + (hh == 0 ? pA : 0.f), offB = (hh == 0 ? pB : 0.f);
            float run = R + offA;
#pragma unroll
            for (int e = 7; e >= 0; --e) { const float lr = L[e]; s[e] = __builtin_amdgcn_exp2f(s[e] + run); run += lr; }
            run = R + offB;
#pragma unroll
            for (int e = 15; e >= 8; --e) { const float lr = L[e]; s[e] = __builtin_amdgcn_exp2f(s[e] + run); run += lr; }
            R += (sA + sB) + (pA + pB);
        }
        { u32x4 w0, w1;
          w0.x = cvtpk(s[0], s[1]); w0.y = cvtpk(s[2], s[3]); w0.z = cvtpk(s[4], s[5]); w0.w = cvtpk(s[6], s[7]);
          w1.x = cvtpk(s[8], s[9]); w1.y = cvtpk(s[10], s[11]); w1.z = cvtpk(s[12], s[13]); w1.w = cvtpk(s[14], s[15]);
          pb[0] = __builtin_bit_cast(bf16x8, w0); pb[1] = __builtin_bit_cast(bf16x8, w1); }
        asm volatile("" ::: "memory");
#pragma unroll
        for (int db = 0; db < 2; ++db)
#pragma unroll
            for (int kk = 0; kk < 2; ++kk) {
                const s16x4 lo4 = vtr(vr + (16 * kk) * VROW + 64 * db), hi4 = vtr(vr + (16 * kk + 4) * VROW + 64 * db);
                const bf16x8 av = {lo4[0], lo4[1], lo4[2], lo4[3], hi4[0], hi4[1], hi4[2], hi4[3]};
                O[db] = __builtin_amdgcn_mfma_f32_32x32x16_bf16(av, pb[kk], O[db], 0, 0, 0);
            }
        asm volatile("s_waitcnt lgkmcnt(0)" ::: "memory");
        } else { asm volatile("s_waitcnt lgkmcnt(0)" ::: "memory"); O[0][0] += __builtin_bit_cast(float, (int)kc[0][0]) ; }
        if (MODE == 2) { if (__builtin_amdgcn_ballot_w64(R >= -160.f) == 0ull) break; }
        kb = kbn;
    }
#undef AT_ISSUE
    asm volatile("s_waitcnt vmcnt(0)" ::: "memory");
    if (MODE != 2) {
        l += __shfl_xor(l, 32);
        const float inv = 1.0f / l;
#pragma unroll
        for (int r = 0; r < 16; ++r) { O[0][r] *= inv; O[1][r] *= inv; }
        lse2 = m + __builtin_amdgcn_logf(l);
    }
}

__device__ __forceinline__ void store_o_bf16(const f32x16 (&O)[2], bf16_t* att_row  , int hh) {
#pragma unroll
    for (int db = 0; db < 2; ++db)
#pragma unroll
        for (int i = 0; i < 4; ++i) {
            u32x2 w; w.x = cvtpk(O[db][4 * i], O[db][4 * i + 1]); w.y = cvtpk(O[db][4 * i + 2], O[db][4 * i + 3]);
            *(u32x2*)(att_row + 32 * db + 8 * i + 4 * hh) = w;
        }
}

template <int DBG>
__device__ __forceinline__ void fox_phase(const Args& a, LAS unsigned char* lds, int vwg, int G) {
    const int tid = otid(), lane = tid & 63, wave = __builtin_amdgcn_readfirstlane(tid >> 6), n = lane & 31, hh = lane >> 5;
    const bf16_t* qkv = (const bf16_t*)(a.ws + WS_QKV); bf16_t* att = (bf16_t*)(a.ws + WS_ATT);
    const float* locF = (const float*)(a.ws + WS_LOCF); const float* totF = (const float*)(a.ws + WS_TOTF);
    LAS float* Fs = (LAS float*)(lds + LDS_F); LAS float* pre = Fs + 2048;
    LAS unsigned char* vlds = lds + wave * VTILE;
    for (int j = vwg; j < 256; j += G) {
        const int bh = j >> 1, b = bh >> 4, h = bh & 15;
        __syncthreads();
        if (tid < 32) { float p = 0.f; for (int s = 0; s < tid; ++s) p += totF[bh * 32 + s]; pre[tid] = p; }
        __syncthreads();
        for (int t = tid; t < 2048; t += NTHR) Fs[t] = locF[(size_t)bh * 2048 + t] + pre[t >> 6];
        __syncthreads();
        const bf16_t* base = qkv + (size_t)(b * SEQ) * QKV_LD + h * 64;
        for (int ui = 0; ui < 4; ++ui) {
            const int u = (j & 1) ? ((ui < 2) ? 2 + ui : 7 - ui) : ((ui < 2) ? ui : 9 - ui);
            const int qt = 8 * u + wave;
            f32x16 O[2]; float lse;
            attn_task<0, DBG>(base, base + 1024, base + 2048, (size_t)QKV_LD, 32 * qt, 0, qt, vlds, Fs, O, lse);
            store_o_bf16(O, att + (size_t)(b * SEQ + 32 * qt + n) * DM + h * 64, hh);
        }
    }
}

template <int PART>
__device__ __forceinline__ void even_attn_phase(const Args& a, LAS unsigned char* lds, int vwg, int G) {
    const int tid = otid(), lane = tid & 63, wave = __builtin_amdgcn_readfirstlane(tid >> 6), n = lane & 31, hh = lane >> 5;
    const bf16_t* qkv = (const bf16_t*)(a.ws + WS_QKV); bf16_t* att = (bf16_t*)(a.ws + WS_ATT);
    float* part = a.out;
    float* plse = (float*)(a.ws + WS_LSE);
    LAS unsigned char* vlds = lds + wave * VTILE;
    const LAS float* nof = (const LAS float*)lds;
    for (int j = vwg; j < 256; j += G) {
        const int bh = j >> 2, b = bh >> 3, hl = bh & 7, c = j & 3;
        if (PART & 1) { const bf16_t* base = qkv + (size_t)(b * SEQ) * QKV_LD + hl * 64;
          for (int ui = 0; ui < 2; ++ui) {
              const int u = ui ? 7 - c : c, qt = 8 * u + wave;
              f32x16 O[2]; float lse;
              attn_task<2>(base, base + 1024, base + 2048, (size_t)QKV_LD, 32 * qt, 0, qt, vlds, nof, O, lse);
              store_o_bf16(O, att + (size_t)(b * SEQ + 32 * qt + n) * DM + hl * 64, hh);
          } }
        if (!(PART & 2)) continue;
        const bf16_t* base = qkv + (size_t)(b * SEQ) * QKV_LD + (8 + hl) * 64;
        for (int p = 0; p < 2; ++p) {
            const int dil = p ? 4 : 1;
            for (int ti = 0; ti < 2; ++ti) {
                const int task = wave + 8 * ti;
                const int res = p ? (task & 3) : 0, tile = p ? (task >> 2) : task;
                const int q0 = (p ? 128 * c : 512 * c) + 32 * tile;
                const int kbh = q0 >> 5, kbl = kbh - 4 < 0 ? 0 : kbh - 4;
                const bf16_t* bp = base + (size_t)res * QKV_LD;
                f32x16 O[2]; float lse;
                attn_task<1>(bp, bp + 1024, bp + 2048, (size_t)dil * QKV_LD, q0, kbl, kbh, vlds, nof, O, lse);
                const int tok = res + dil * (q0 + n);
                float* pr = part + ((size_t)p * MTOK + (size_t)(b * SEQ + tok)) * 512 + hl * 64;
#pragma unroll
                for (int db = 0; db < 2; ++db)
#pragma unroll
                    for (int i = 0; i < 4; ++i) *(f32x4*)(pr + 32 * db + 8 * i + 4 * hh) = (f32x4){O[db][4 * i], O[db][4 * i + 1], O[db][4 * i + 2], O[db][4 * i + 3]};
                if (hh == 0) plse[((size_t)p * MTOK + (size_t)(b * SEQ + tok)) * 8 + hl] = lse;
            }
        }
        __syncthreads();
        for (int ti = 0; ti < 2; ++ti) {
            const int res = wave + 8 * ti, q0 = 32 * c;
            const bf16_t* bp = base + (size_t)res * QKV_LD;
            f32x16 O[2]; float lse3;
            attn_task<1>(bp, bp + 1024, bp + 2048, (size_t)16 * QKV_LD, q0, 0, c, vlds, nof, O, lse3);
            const int tok = res + 16 * (q0 + n); const size_t grow = (size_t)(b * SEQ + tok);
            const float l1 = plse[grow * 8 + hl], l2 = plse[((size_t)MTOK + grow) * 8 + hl];
            const float mx = fmaxf(lse3, fmaxf(l1, l2));
            float w1 = __builtin_amdgcn_exp2f(l1 - mx), w2 = __builtin_amdgcn_exp2f(l2 - mx), w3 = __builtin_amdgcn_exp2f(lse3 - mx);
            const float inv = 1.0f / (w1 + w2 + w3); w1 *= inv; w2 *= inv; w3 *= inv;
            const float* p1 = part + grow * 512 + hl * 64; const float* p2 = part + ((size_t)MTOK + grow) * 512 + hl * 64;
#pragma unroll
            for (int db = 0; db < 2; ++db)
#pragma unroll
                for (int i = 0; i < 4; ++i) {
                    const f32x4 a1 = *(const f32x4*)(p1 + 32 * db + 8 * i + 4 * hh), a2 = *(const f32x4*)(p2 + 32 * db + 8 * i + 4 * hh);
#pragma unroll
                    for (int e = 0; e < 4; ++e) O[db][4 * i + e] = O[db][4 * i + e] * w3 + a1[e] * w1 + a2[e] * w2;
                }
            store_o_bf16(O, att + grow * DM + (8 + hl) * 64, hh);
        }
        __syncthreads();
    }
}

__device__ __forceinline__ void final_phase(const Args& a, int vwg, int G) {
    const int tid = otid(), lane = tid & 63, wave = tid >> 6;
    const float* xres = (const float*)(a.ws + WS_XRES); const float* rowss = (const float*)(a.ws + WS_ROWSS) + (size_t)8 * MTOK;
    const int gw = vwg * NWAVES + wave, NGW = G * NWAVES;
    f32x4 g[4];
#pragma unroll
    for (int j = 0; j < 4; ++j) g[j] = ((const f32x4*)a.norm_final)[lane + 64 * j];
    for (int m = gw; m < MTOK; m += NGW) {
        const float rs = pg8::rstd_of(rowss, m);
        const f32x4* xr = (const f32x4*)(xres + (size_t)m * DM) + lane; f32x4* o = (f32x4*)(a.out + (size_t)m * DM) + lane;
#pragma unroll
        for (int j = 0; j < 4; ++j) o[64 * j] = xr[64 * j] * rs * g[j];
    }
}

#define XB_TMO      128
#define XB_XCNT(j)  (256  + 64 * (j))
#define XB_XSUB(j)  (1280 + 64 * (j))
#define XB_XGEN(j)  (2304 + 64 * (j))
#define XB_TOP      3328
#define XB_TOPGEN   3392
#define XCD_BAR_WORDS 3456
#define XB_SPIN_CAP (1u << 18)

__device__ __forceinline__ unsigned xb_ld(unsigned* p)              { return __hip_atomic_load(p, __ATOMIC_RELAXED, __HIP_MEMORY_SCOPE_AGENT); }
__device__ __forceinline__ unsigned xb_add(unsigned* p, unsigned v) { return __hip_atomic_fetch_add(p, v, __ATOMIC_RELAXED, __HIP_MEMORY_SCOPE_AGENT); }
__device__ __forceinline__ unsigned xb_xcc_id() { return (unsigned)__builtin_amdgcn_s_getreg((3 << 11) | 20) & 0xFu; }
#define XB_SPIN(cond, bar) do { unsigned _sp = 0; while (cond) { __builtin_amdgcn_s_sleep(1); \
    if ((++_sp & 255u) == 0u) { if (xb_ld(&(bar)[XB_TMO])) break; if (_sp > XB_SPIN_CAP) { atomicAdd(&(bar)[XB_TMO], 1u); break; } } } } while (0)

struct XcdBarrier {
    unsigned* bar; unsigned x;
    volatile LAS unsigned* st;
};

__device__ __forceinline__ XcdBarrier xcd_barrier_post(unsigned* bar, volatile LAS unsigned* st) {
    XcdBarrier b; b.bar = bar; b.x = xb_xcc_id(); b.st = st;
    if (threadIdx.x == 0) (void)xb_add(&bar[XB_XCNT(b.x)], 1u);
    return b;
}
__device__ __forceinline__ void xcd_barrier_complete(unsigned* bar, unsigned x, unsigned& nloc, unsigned& nx) {
    const unsigned G = gridDim.x * gridDim.y * gridDim.z;
    unsigned sum, cnt, mine, sp = 0u;
    for (;;) {
        sum = 0u; cnt = 0u; mine = 0u;
#pragma unroll
        for (unsigned j = 0; j < 16; ++j) { const unsigned c = xb_ld(&bar[XB_XCNT(j)]); sum += c; cnt += (c > 0u) ? 1u : 0u; mine = (j == x) ? c : mine; }
        if (sum == G) break;
        __builtin_amdgcn_s_sleep(1);
        if ((++sp & 255u) == 0u) { if (xb_ld(&bar[XB_TMO])) break; if (sp > XB_SPIN_CAP) { atomicAdd(&bar[XB_TMO], 1u); break; } }
    }
    nloc = mine > 0u ? mine : 1u; nx = cnt > 0u ? cnt : 1u;
}

__device__ __forceinline__ void xcd_barrier(const XcdBarrier& b) {
    asm volatile("s_waitcnt vmcnt(0)" ::: "memory");
    __syncthreads();
    if (threadIdx.x == 0) {
        unsigned* bar = b.bar;
        __builtin_amdgcn_s_waitcnt(0);
        unsigned nloc = b.st[0], nx = b.st[1];
        if (nloc == 0u) { xcd_barrier_complete(bar, b.x, nloc, nx); b.st[0] = nloc; b.st[1] = nx; }
        const unsigned old = xb_add(&bar[XB_XSUB(b.x)], 1u);
        const unsigned gen = old / nloc;
        if (old + 1u == (gen + 1u) * nloc) {
            __builtin_amdgcn_fence(__ATOMIC_RELEASE, "agent");
            asm volatile("s_waitcnt vmcnt(0)" ::: "memory");
            const unsigned og = xb_add(&bar[XB_TOP], 1u);
            const unsigned tg = og / nx;
            if (og + 1u == (tg + 1u) * nx) xb_add(&bar[XB_TOPGEN], 1u);
            else XB_SPIN(xb_ld(&bar[XB_TOPGEN]) == tg, bar);
            __builtin_amdgcn_fence(__ATOMIC_ACQUIRE, "agent");
            xb_add(&bar[XB_XGEN(b.x)], 1u);
            asm volatile("s_waitcnt vmcnt(0)" ::: "memory");
        } else {
            XB_SPIN(xb_ld(&bar[XB_XGEN(b.x)]) == gen, bar);
            __builtin_amdgcn_fence(__ATOMIC_ACQUIRE, "agent");
            asm volatile("s_waitcnt vmcnt(0)" ::: "memory");
        }
    }
    __syncthreads();
}

#ifndef DBG_EVEN
#define DBG_EVEN 0
#endif
#ifndef DBG_FOX
#define DBG_FOX 0
#endif
#ifndef REP_QKV
#define REP_QKV 1
#endif
#ifndef REP_FG
#define REP_FG 1
#endif
#ifndef REP_FFI
#define REP_FFI 1
#endif
#ifndef REP_PRO
#define REP_PRO 1
#endif
#ifndef REP_SYNC
#define REP_SYNC 1
#endif
#ifndef REP_FOX
#define REP_FOX 1
#endif
#ifndef REP_EVEN
#define REP_EVEN 1
#endif
__global__ void __launch_bounds__(NTHR, 2) fwd_kernel(Args a) {
    extern __shared__ __attribute__((aligned(16))) unsigned char lds_raw[];
    LAS unsigned char* lds = (LAS unsigned char*)lds_raw;
    cg::grid_group grid = cg::this_grid();
    const int G = gridDim.x, vwg = blockIdx.x;
    unsigned char* ws = a.ws;
    bf16_t* xb = (bf16_t*)(ws + WS_XB); float* xres = (float*)(ws + WS_XRES); bf16_t* qkv = (bf16_t*)(ws + WS_QKV); bf16_t* hid = (bf16_t*)(ws + WS_QKV);
    bf16_t* att = (bf16_t*)(ws + WS_ATT); float* rowss = (float*)(ws + WS_ROWSS); const float* rot = (const float*)(ws + WS_ROT);
    unsigned* barw = (unsigned*)(ws + WS_BAR);
    volatile LAS unsigned* bst = (volatile LAS unsigned*)(lds + LDS_MISC);
    if (threadIdx.x == 0) { bst[0] = 0u; bst[1] = 0u; }
    if (blockIdx.x == 0) { for (int i = threadIdx.x; i < XCD_BAR_WORDS; i += NTHR) barw[i] = 0u; }
    __syncthreads();
    XcdBarrier bar; bar.bar = barw; bar.x = 0; bar.st = bst;
    bool posted = false;
    for (int ph = a.ph_lo; ph < a.ph_hi; ++ph) {
        if (ph == 0) { for (int rep = 0; rep < REP_PRO; ++rep) { prologue(a, lds, vwg, G); __syncthreads(); } }
        else if (ph == NPHASE - 1) final_phase(a, vwg, G);
        else {
            const int l = (ph - 1) / 5, sp = (ph - 1) % 5;
            const bf16_t* wl = (const bf16_t*)(ws + WS_W + (size_t)l * SZ_WLAYER);
            const bf16_t* w_qkv = wl; const bf16_t* w_o = (const bf16_t*)((const unsigned char*)wl + SZ_WQKV);
            const bf16_t* w_in = (const bf16_t*)((const unsigned char*)wl + SZ_WQKV + SZ_WO); const bf16_t* w_out = (const bf16_t*)((const unsigned char*)wl + SZ_WQKV + SZ_WO + SZ_WI);
            if (sp == 0) {
                pg8::Gemm g{xb, w_qkv, MTOK, 3072, 1024}; pg8::StaticOrder S; S.init(MTOK, 3072, G, vwg);
                pg8::EpiQKV E{qkv, rowss + (size_t)(2 * l) * MTOK, rot, (l & 1) ? 0 : 1};
                for (int rep = 0; rep < REP_QKV; ++rep) { pg8::gemm_phase<pg8::EpiQKV, pg8::StaticOrder, true, true>(lds, g, S, E); __syncthreads(); }
                if (l & 1) { for (int rep = 0; rep < REP_FG; ++rep) { __syncthreads(); fgate_phase(a, l >> 1, lds, vwg, G); } }
            } else if (sp == 1) {
                if (l & 1) { if (DBG_FOX) { fox_phase<DBG_FOX>(a, lds, vwg, G); __syncthreads(); } fox_phase<0>(a, lds, vwg, G); } else { if (DBG_EVEN) { even_attn_phase<DBG_EVEN>(a, lds, vwg, G); __syncthreads(); } even_attn_phase<3>(a, lds, vwg, G); }
            } else if (sp == 2) {
                pg8::Gemm g{att, w_o, MTOK, 1024, 1024}; pg8::StaticOrder S; S.init(MTOK, 1024, G, vwg);
                pg8::EpiResid E{l == 0 ? a.x : xres, xres, xb, rowss + (size_t)(2 * l + 1) * MTOK};
                pg8::gemm_phase<pg8::EpiResid, pg8::StaticOrder, true, true>(lds, g, S, E);
            } else if (sp == 3) {
                pg8::Gemm g{xb, w_in, MTOK, 5632, 1024}; pg8::StaticOrder S; S.init(MTOK, 5632, G, vwg);
                pg8::EpiSwiGLU E{hid, rowss + (size_t)(2 * l + 1) * MTOK};
                for (int rep = 0; rep < REP_FFI; ++rep) { pg8::gemm_phase<pg8::EpiSwiGLU, pg8::StaticOrder, true, true>(lds, g, S, E); __syncthreads(); }
            } else {
                pg8::Gemm g{hid, w_out, MTOK, 1024, 2816}; pg8::StaticOrder S; S.init(MTOK, 1024, G, vwg);
                pg8::EpiResid E{xres, xres, xb, rowss + (size_t)(2 * l + 2) * MTOK};
                pg8::gemm_phase<pg8::EpiResid, pg8::StaticOrder, true, true>(lds, g, S, E);
            }
        }
        if (ph + 1 < a.ph_hi) {
            if (!posted) { grid.sync(); bar = xcd_barrier_post(barw, bst); posted = true; }
            else { for (int rep = 0; rep < REP_SYNC; ++rep) xcd_barrier(bar); }
        }
    }
}

#ifndef N_LAUNCH_MODE
#define N_LAUNCH_MODE 1
#endif

extern "C" void kernel_launch(void* const* d_in, const int* in_sizes, int n_in, void* d_out, int out_size, void* d_ws, size_t ws_size, hipStream_t stream) {
    static int grid = 0;
    if (grid == 0) {
        if (n_in != 11 || out_size != MTOK * DM || ws_size < WS_END) { fprintf(stderr, "kernel_launch: unexpected sizes n_in %d out %d ws %zu (need %zu)\n", n_in, out_size, ws_size, (size_t)WS_END); grid = -1; return; }
        int dev = 0, cus = 0, per_cu = 0;
        hipGetDevice(&dev); hipDeviceGetAttribute(&cus, hipDeviceAttributeMultiprocessorCount, dev);
        if (hipFuncSetAttribute((const void*)fwd_kernel, hipFuncAttributeMaxDynamicSharedMemorySize, LDS_BYTES) != hipSuccess) { fprintf(stderr, "kernel_launch: hipFuncSetAttribute failed\n"); grid = -1; return; }
        if (hipOccupancyMaxActiveBlocksPerMultiprocessor(&per_cu, (const void*)fwd_kernel, NTHR, LDS_BYTES) != hipSuccess || per_cu < 1) { fprintf(stderr, "kernel_launch: occupancy query says %d\n", per_cu); per_cu = 1; }
        (void)hipGetLastError();
        grid = cus * 1;
        fprintf(stderr, "kernel_launch: grid %d (cus %d, per_cu %d)\n", grid, cus, per_cu);
    }
    if (grid < 0) return;
    Args a{};
    a.x = (const float*)d_in[0]; a.norm_mix = (const float*)d_in[1]; a.w_qkv_even = (const float*)d_in[2]; a.w_o_even = (const float*)d_in[3];
    a.w_qkvf_odd = (const float*)d_in[4]; a.b_forget = (const float*)d_in[5]; a.w_o_odd = (const float*)d_in[6]; a.norm_ffn = (const float*)d_in[7];
    a.w_ffn_in = (const float*)d_in[8]; a.w_ffn_out = (const float*)d_in[9]; a.norm_final = (const float*)d_in[10];
    a.out = (float*)d_out; a.ws = (unsigned char*)d_ws;
#if N_LAUNCH_MODE == 1
    a.ph_lo = 0; a.ph_hi = NPHASE;
    void* args[] = {&a};
    hipError_t e = hipLaunchCooperativeKernel((const void*)fwd_kernel, dim3(grid), dim3(NTHR), args, LDS_BYTES, stream);
    if (e != hipSuccess) fprintf(stderr, "cooperative launch failed: %s (grid %d)\n", hipGetErrorString(e), grid);
#else
    for (int ph = 0; ph < NPHASE; ++ph) {
        a.ph_lo = ph; a.ph_hi = ph + 1;
        hipLaunchKernelGGL(fwd_kernel, dim3(grid), dim3(NTHR), LDS_BYTES, stream, a);
    }
#endif
}
```

```cpp
#include <hip/hip_runtime.h>
#include <hip/hip_cooperative_groups.h>
#include <cstdio>
#include <cstdint>
namespace cg = cooperative_groups;
namespace pg8 {
#define PG8_LAS __attribute__((address_space(3)))
typedef unsigned short bf16_t;
typedef short bf16x8 __attribute__((ext_vector_type(8)));
typedef float f32x4 __attribute__((ext_vector_type(4)));
typedef unsigned u32x4 __attribute__((ext_vector_type(4)));
constexpr int BM = 256, BK = 64, HALF = 128, HTB = HALF * BK * 2  , STAGE_BYTES = 8 * HTB, NXCD = 8, WGM = 8;

__host__ __device__ __forceinline__ int lds_byte(int r, int c) { const int st = (r >> 4) * 2 + (c >> 5), rr = r & 15, cc = c & 31, ob = rr * 64 + cc * 2; return st * 1024 + (ob ^ (((ob >> 9) & 1) << 5)); }
__host__ __device__ __forceinline__ void stage_rc(int b, int& R, int& C) { const int st = b / 1024, sb = b % 1024, swz = sb ^ (((sb >> 9) & 1) << 5); R = (st >> 1) * 16 + swz / 64; C = (st & 1) * 32 + (swz % 64) / 2; }
__host__ __device__ __forceinline__ int perm32(int rho) { const int n = rho >> 4, i = rho & 15; return 8 * (i >> 2) + 4 * n + (i & 3); }

struct Unit { int pm, pn; };
struct Gemm { const bf16_t* A; const bf16_t* Bt; int M, N, K; };

struct StaticOrder {
    int nM, nN, nwg, G, c;
    __host__ __device__ void init(int M, int N, int G_, int c_) { nM = M / BM; nN = N / BM; nwg = nM * nN; G = G_; c = c_; }
    __host__ __device__ bool next(int i, Unit& u) const {
        const long L = (long)i * G + c; if (L >= nwg) return false;
        int wgid = (int)L; { const int q = nwg / NXCD, r = nwg % NXCD, xcd = wgid % NXCD, off = wgid / NXCD; wgid = (xcd < r ? xcd * (q + 1) : r * (q + 1) + (xcd - r) * q) + off; }
        const int nig = WGM * nN, gid = wgid / nig, fm = gid * WGM, gsz = (nM - fm) < WGM ? (nM - fm) : WGM;
        u.pm = fm + ((wgid % nig) % gsz); u.pn = (wgid % nig) / gsz; return true;
    }
    __device__ __forceinline__ void a_ready(const Unit&) const {}
    __device__ __forceinline__ void done(const Unit&) const {}
};

__device__ __forceinline__ unsigned cvt_pk_bf16(float lo, float hi) { unsigned r; asm volatile("v_cvt_pk_bf16_f32 %0, %1, %2" : "=v"(r) : "v"(lo), "v"(hi)); return r; }
constexpr float RMS_EPS_F = 1e-5f;
__device__ __forceinline__ float rstd_of(const float* rowss, int row) { return 1.0f / sqrtf(rowss[row] * (1.0f / 1024.0f) + RMS_EPS_F); }

struct EpiQKV {
    static constexpr bool PERM = true, AFTER_DRAIN = false;
    bf16_t* O; const float* rowss; const float* rot; int rope;
    __device__ __forceinline__ void operator()(const f32x4 (&acc)[2][2][4][2], const Unit& u, int wr, int wc, int fr, int fq) const {
        const int row0 = u.pm * BM + wr * 64 + fr;
        const int col0 = u.pn * BM + wc * 32 + 8 * fq;
        const bool rt = rope && ((u.pn & 2) != 0) && (u.pn < 8) && ((wc & 1) == 0);
#pragma unroll
        for (int ai = 0; ai < 2; ++ai)
#pragma unroll
            for (int m = 0; m < 4; ++m) {
                const int row = row0 + ai * HALF + m * 16;
                const float rs = rstd_of(rowss, row);
                bf16_t* rowp = O + (size_t)row * 3072 + col0;
                f32x4 c0 = {1.f, 1.f, 1.f, 1.f}, c1 = c0, s0 = {0.f, 0.f, 0.f, 0.f}, s1 = s0;
                if (rt) { const f32x4* rp = (const f32x4*)(rot + (size_t)(row & 2047) * 16); c0 = rp[0]; c1 = rp[1]; s0 = rp[2]; s1 = rp[3]; }
#pragma unroll
                for (int bj = 0; bj < 2; ++bj) {
                    f32x4 v0 = acc[ai][bj][m][0] * rs, v1 = acc[ai][bj][m][1] * rs;
                    if (rt) {
                        f32x4 p0, p1;
#pragma unroll
                        for (int e = 0; e < 4; ++e) { p0[e] = __shfl_xor(v0[e], 16); p1[e] = __shfl_xor(v1[e], 16); }
                        if (fq == 0) { v0 = v0 * c0 - p0 * s0; v1 = v1 * c1 - p1 * s1; }
                        else if (fq == 1) { v0 = v0 * c0 + p0 * s0; v1 = v1 * c1 + p1 * s1; }
                    }
                    u32x4 w; w.x = cvt_pk_bf16(v0[0], v0[1]); w.y = cvt_pk_bf16(v0[2], v0[3]); w.z = cvt_pk_bf16(v1[0], v1[1]); w.w = cvt_pk_bf16(v1[2], v1[3]);
                    *(u32x4*)(rowp + bj * HALF) = w;
                }
            }
    }
};

struct EpiResid {
    static constexpr bool PERM = true, AFTER_DRAIN = false;
    const float* xin; float* xout; bf16_t* xb; float* rowss_next;
    __device__ __forceinline__ void operator()(const f32x4 (&acc)[2][2][4][2], const Unit& u, int wr, int wc, int fr, int fq) const {
        const int row0 = u.pm * BM + wr * 64 + fr;
        const int col0 = u.pn * BM + wc * 32 + 8 * fq;
#pragma unroll
        for (int ai = 0; ai < 2; ++ai)
#pragma unroll
            for (int m = 0; m < 4; ++m) {
                const int row = row0 + ai * HALF + m * 16;
                float ss = 0.f;
#pragma unroll
                for (int bj = 0; bj < 2; ++bj) {
                    const size_t off = (size_t)row * 1024 + col0 + bj * HALF;
                    const f32x4* xi = (const f32x4*)(xin + off);
                    const f32x4 a0 = xi[0] + acc[ai][bj][m][0], a1 = xi[1] + acc[ai][bj][m][1];
                    f32x4* xo = (f32x4*)(xout + off); xo[0] = a0; xo[1] = a1;
                    ss += (a0[0] * a0[0] + a0[1] * a0[1]) + (a0[2] * a0[2] + a0[3] * a0[3]) + (a1[0] * a1[0] + a1[1] * a1[1]) + (a1[2] * a1[2] + a1[3] * a1[3]);
                    u32x4 w; w.x = cvt_pk_bf16(a0[0], a0[1]); w.y = cvt_pk_bf16(a0[2], a0[3]); w.z = cvt_pk_bf16(a1[0], a1[1]); w.w = cvt_pk_bf16(a1[2], a1[3]);
                    *(u32x4*)(xb + off) = w;
                }
                ss += __shfl_xor(ss, 16); ss += __shfl_xor(ss, 32);
                if (fq == 0) atomicAdd(rowss_next + row, ss);
            }
    }
};

struct EpiSwiGLU {
    static constexpr bool PERM = true, AFTER_DRAIN = false;
    bf16_t* H; const float* rowss;
    __device__ __forceinline__ void operator()(const f32x4 (&acc)[2][2][4][2], const Unit& u, int wr, int wc, int fr, int fq) const {
        const int row0 = u.pm * BM + wr * 64 + fr;
        const int col0 = u.pn * HALF + wc * 32 + 8 * fq;
#pragma unroll
        for (int ai = 0; ai < 2; ++ai)
#pragma unroll
            for (int m = 0; m < 4; ++m) {
                const int row = row0 + ai * HALF + m * 16;
                const float rs = rstd_of(rowss, row);
                float h[8];
#pragma unroll
                for (int n = 0; n < 2; ++n)
#pragma unroll
                    for (int e = 0; e < 4; ++e) {
                        const float g = acc[ai][0][m][n][e] * rs, up = acc[ai][1][m][n][e] * rs;
                        const float sg = g * __builtin_amdgcn_rcpf(1.0f + __builtin_amdgcn_exp2f(-1.4426950408889634f * g));
                        h[n * 4 + e] = sg * up;
                    }
                u32x4 w; w.x = cvt_pk_bf16(h[0], h[1]); w.y = cvt_pk_bf16(h[2], h[3]); w.z = cvt_pk_bf16(h[4], h[5]); w.w = cvt_pk_bf16(h[6], h[7]);
                *(u32x4*)(H + (size_t)row * 2816 + col0) = w;
            }
    }
};

template <class Epi, class Sched, bool ALIGN_EPI = false, bool SP2 = false>
__device__ __forceinline__ void gemm_phase(PG8_LAS unsigned char* lds, const Gemm g, const Sched& S, const Epi& E) {
    int tid_ = threadIdx.x; asm volatile("" : "+v"(tid_));
    const int tid = tid_, wid = __builtin_amdgcn_readfirstlane(tid >> 6), lane = tid & 63, wr = wid >> 2, wc = wid & 3, fr = lane & 15, fq = lane >> 4;
    const int K = g.K, nt = K / BK;
    unsigned voffA[2], voffB[2];
#pragma unroll
    for (int i = 0; i < 2; ++i) { int R, C; stage_rc(tid * 16 + i * 8192, R, C); const int Rb = Epi::PERM ? ((R & ~31) + perm32(R & 31)) : R;
        voffA[i] = (unsigned)(R * K + C) * 2u; voffB[i] = (unsigned)(Rb * K + C) * 2u; }
    const size_t kstep = (size_t)(BK * 2);
    const size_t hstep = (size_t)HALF * K * 2;
    const size_t tstep = 2 * hstep;
    const unsigned ldsw = (unsigned)wid * 1024u;
    const int aoff = lds_byte(wr * 64 + fr, fq * 8), boff = lds_byte(wc * 32 + fr, fq * 8);
#define PG8_SA(b, h) (((b) * 2 + (h)) * HTB)
#define PG8_SB(b, h) ((4 + (b) * 2 + (h)) * HTB)
#define PG8_STAGE(bufoff, gbase, voff) do { _Pragma("unroll") for (int _i = 0; _i < 2; ++_i) \
        __builtin_amdgcn_global_load_lds((const unsigned*)((const char*)(gbase) + (voff)[_i]), (PG8_LAS unsigned*)(lds + (bufoff) + ldsw + _i * 8192), 16, 0, 0); } while (0)
#define PG8_LDA(dst, b, h) do { _Pragma("unroll") for (int m = 0; m < 4; ++m) _Pragma("unroll") for (int k = 0; k < 2; ++k) dst[m][k] = *(const PG8_LAS bf16x8*)(lds + PG8_SA(b, h) + aoff + m * 2048 + k * 1024); } while (0)
#define PG8_LDB(dst, b, h) do { _Pragma("unroll") for (int n = 0; n < 2; ++n) _Pragma("unroll") for (int k = 0; k < 2; ++k) dst[n][k] = *(const PG8_LAS bf16x8*)(lds + PG8_SB(b, h) + boff + n * 2048 + k * 1024); } while (0)
#define PG8_MMA(ai, bj, At, Bt) do { __builtin_amdgcn_s_setprio(1); _Pragma("unroll") for (int m = 0; m < 4; ++m) _Pragma("unroll") for (int n = 0; n < 2; ++n) _Pragma("unroll") for (int k = 0; k < 2; ++k) \
        acc[ai][bj][m][n] = __builtin_amdgcn_mfma_f32_16x16x32_bf16(Bt[n][k], At[m][k], acc[ai][bj][m][n], 0, 0, 0); __builtin_amdgcn_s_setprio(0); } while (0)
#define PG8_WAIT_V(n) asm volatile("s_waitcnt vmcnt(" #n ")" ::: "memory")
#define PG8_WAIT_L(n) asm volatile("s_waitcnt lgkmcnt(" #n ")" ::: "memory")
#define PG8_BAR __builtin_amdgcn_s_barrier()
#define PG8_SCHED __builtin_amdgcn_sched_barrier(0)
    Unit cur, nxt; int ui = 0;
    if (!S.next(0, cur)) return;
    f32x4 acc[2][2][4][2];
#pragma unroll
    for (int a = 0; a < 2; ++a)
#pragma unroll
        for (int b = 0; b < 2; ++b)
#pragma unroll
            for (int m = 0; m < 4; ++m)
#pragma unroll
                for (int n = 0; n < 2; ++n) acc[a][b][m][n] = (f32x4){0.f, 0.f, 0.f, 0.f};
    bf16x8 At[4][2], B0[2][2], B1[2][2];
    const char* cA = (const char*)g.A + (size_t)cur.pm * tstep; const char* cB = (const char*)g.Bt + (size_t)cur.pn * tstep;
    S.a_ready(cur);
    if constexpr (SP2) {
        PG8_STAGE(PG8_SB(0, 0), cB, voffB); PG8_STAGE(PG8_SB(0, 1), cB + hstep, voffB); PG8_STAGE(PG8_SA(0, 0), cA, voffA); PG8_STAGE(PG8_SA(0, 1), cA + hstep, voffA);
        if (wr == 1) PG8_BAR;
        PG8_WAIT_V(2); PG8_BAR;
        PG8_STAGE(PG8_SB(1, 0), cB + kstep, voffB); PG8_STAGE(PG8_SA(1, 0), cA + kstep, voffA); PG8_STAGE(PG8_SB(1, 1), cB + hstep + kstep, voffB);
        PG8_WAIT_V(6); PG8_BAR;
    } else {
        PG8_STAGE(PG8_SB(0, 0), cB, voffB); PG8_STAGE(PG8_SA(0, 0), cA, voffA); PG8_STAGE(PG8_SB(0, 1), cB + hstep, voffB); PG8_STAGE(PG8_SA(0, 1), cA + hstep, voffA);
        if (wr == 1) PG8_BAR;
        PG8_WAIT_V(4); PG8_BAR;
        PG8_STAGE(PG8_SB(1, 0), cB + kstep, voffB); PG8_STAGE(PG8_SA(1, 0), cA + kstep, voffA); PG8_STAGE(PG8_SB(1, 1), cB + hstep + kstep, voffB);
        PG8_WAIT_V(6); PG8_BAR;
    }
    for (;;) {
        const bool has_next = S.next(ui + 1, nxt);
        const char* nA = has_next ? (const char*)g.A + (size_t)nxt.pm * tstep : cA; const char* nB = has_next ? (const char*)g.Bt + (size_t)nxt.pn * tstep : cB;
        for (int t = 0; t < nt; t += 2) {
            const bool last = (t == nt - 2);
            const char* a1 = cA + (size_t)(t + 1) * kstep;
            const char* a2 = last ? nA : cA + (size_t)(t + 2) * kstep; const char* b2 = last ? nB : cB + (size_t)(t + 2) * kstep;
            const char* a3 = a2 + kstep; const char* b3 = b2 + kstep;
            if (last && has_next) S.a_ready(nxt);
            if constexpr (SP2) {
            PG8_LDB(B0, 0, 0); PG8_LDB(B1, 0, 1); PG8_SCHED; PG8_LDA(At, 0, 0); PG8_STAGE(PG8_SA(1, 1), a1 + hstep, voffA);
            PG8_WAIT_V(8); PG8_WAIT_L(0); PG8_BAR; PG8_MMA(0, 0, At, B0); PG8_MMA(0, 1, At, B1); PG8_BAR; PG8_SCHED;
            PG8_LDA(At, 0, 1); PG8_STAGE(PG8_SB(0, 0), b2, voffB); PG8_STAGE(PG8_SB(0, 1), b2 + hstep, voffB); PG8_STAGE(PG8_SA(0, 0), a2, voffA);
            PG8_WAIT_V(8); PG8_WAIT_L(0); PG8_BAR; PG8_MMA(1, 0, At, B0); PG8_MMA(1, 1, At, B1); PG8_BAR; PG8_SCHED;
            PG8_LDB(B0, 1, 0); PG8_LDB(B1, 1, 1); PG8_SCHED; PG8_LDA(At, 1, 0); PG8_STAGE(PG8_SA(0, 1), a2 + hstep, voffA);
            PG8_WAIT_V(8); PG8_WAIT_L(0); PG8_BAR; PG8_MMA(0, 0, At, B0); PG8_MMA(0, 1, At, B1); PG8_BAR; PG8_SCHED;
            PG8_LDA(At, 1, 1); PG8_STAGE(PG8_SB(1, 0), b3, voffB); PG8_STAGE(PG8_SB(1, 1), b3 + hstep, voffB); PG8_STAGE(PG8_SA(1, 0), a3, voffA);
            PG8_WAIT_V(8); PG8_WAIT_L(0); PG8_BAR; PG8_MMA(1, 0, At, B0); PG8_MMA(1, 1, At, B1); PG8_BAR; PG8_SCHED;
            } else {
            PG8_LDB(B0, 0, 0); PG8_SCHED; PG8_LDA(At, 0, 0); PG8_STAGE(PG8_SA(1, 1), a1 + hstep, voffA);
            PG8_WAIT_L(8); PG8_BAR; PG8_WAIT_L(0); PG8_MMA(0, 0, At, B0); PG8_BAR; PG8_SCHED;
            PG8_LDB(B1, 0, 1); PG8_STAGE(PG8_SB(0, 0), b2, voffB);
            PG8_BAR; PG8_WAIT_L(0); PG8_MMA(0, 1, At, B1); PG8_BAR;
            PG8_LDA(At, 0, 1); PG8_STAGE(PG8_SA(0, 0), a2, voffA);
            PG8_BAR; PG8_WAIT_L(0); PG8_MMA(1, 0, At, B0); PG8_BAR; PG8_SCHED;
            PG8_STAGE(PG8_SB(0, 1), b2 + hstep, voffB);
            PG8_WAIT_V(6); PG8_BAR; PG8_MMA(1, 1, At, B1); PG8_BAR;
            PG8_LDB(B0, 1, 0); PG8_SCHED; PG8_LDA(At, 1, 0); PG8_STAGE(PG8_SA(0, 1), a2 + hstep, voffA);
            PG8_WAIT_L(8); PG8_BAR; PG8_WAIT_L(0); PG8_MMA(0, 0, At, B0); PG8_BAR; PG8_SCHED;
            PG8_LDB(B1, 1, 1); PG8_STAGE(PG8_SB(1, 0), b3, voffB);
            PG8_BAR; PG8_WAIT_L(0); PG8_MMA(0, 1, At, B1); PG8_BAR;
            PG8_LDA(At, 1, 1); PG8_STAGE(PG8_SA(1, 0), a3, voffA);
            PG8_BAR; PG8_WAIT_L(0); PG8_MMA(1, 0, At, B0); PG8_BAR; PG8_SCHED;
            PG8_STAGE(PG8_SB(1, 1), b3 + hstep, voffB);
            PG8_WAIT_V(6); PG8_BAR; PG8_MMA(1, 1, At, B1); PG8_BAR;
            }
        }
        if constexpr (ALIGN_EPI) { if (wr == 0) PG8_BAR; }
        if constexpr (!Epi::AFTER_DRAIN) { E(acc, cur, wr, wc, fr, fq); S.done(cur); }
        if (!has_next) break;
#pragma unroll
        for (int a = 0; a < 2; ++a)
#pragma unroll
            for (int b = 0; b < 2; ++b)
#pragma unroll
                for (int m = 0; m < 4; ++m)
#pragma unroll
                    for (int n = 0; n < 2; ++n) acc[a][b][m][n] = (f32x4){0.f, 0.f, 0.f, 0.f};
        cur = nxt; cA = nA; cB = nB; ++ui;
        if constexpr (ALIGN_EPI) { if (wr == 1) PG8_BAR; }
    }
    PG8_WAIT_V(0);
    if constexpr (!ALIGN_EPI) { if (wr == 0) PG8_BAR; }
    PG8_BAR;
    if constexpr (Epi::AFTER_DRAIN) { E.fused(acc, cur, wr, wc, fr, fq, lds, wid, lane); S.done(cur); }
#undef PG8_SA
#undef PG8_SB
#undef PG8_STAGE
#undef PG8_LDA
#undef PG8_LDB
#undef PG8_MMA
#undef PG8_WAIT_V
#undef PG8_WAIT_L
#undef PG8_BAR
#undef PG8_SCHED
}
}
#include <hip/hip_bf16.h>
#include <cmath>
namespace attn_body {
using bf16=__hip_bfloat16;
using bf16x8=__attribute__((ext_vector_type(8)))short;
using s16x4=__attribute__((ext_vector_type(4)))short;
using f32x16=__attribute__((ext_vector_type(16)))float;
using u32x4=__attribute__((ext_vector_type(4)))unsigned;
using f32x4_t=__attribute__((ext_vector_type(4)))float;
constexpr int BATCH=8,NHEAD=16,SEQ=2048,D=64,DM=3072,DMO=1024;
constexpr int NW=8,QBLK=32,QB=QBLK*NW,KVBLK=64,NQB=SEQ/QB;
constexpr int ATTN_PITCH=DM, ATTN_UNIT_ROWS=QB;
__device__ __forceinline__ int crow(int r,int hi){return (r&3)+8*(r>>2)+4*hi;}
#define SBAR() __builtin_amdgcn_sched_barrier(0)
__device__ __forceinline__ void cmask(f32x16&p0,f32x16&p1,int jb,int qrel,int hi){
  const float NEG=-INFINITY; int kb=64*jb+4*hi;
  #pragma unroll
  for(int r=0;r<16;++r){int kv=kb+(r&3)+8*(r>>2); if(kv>qrel)p0[r]=NEG; if(kv+32>qrel)p1[r]=NEG;}
}

constexpr int NSLOT=3, SLOTB=8192;
constexpr int LDS_K=0, LDS_V=NSLOT*SLOTB, LDS_WS=2*NSLOT*SLOTB, LDS_OST=LDS_WS+NW*64*4, LDS_BYTES=LDS_OST+NW*4096;
constexpr float C2=0.125f*1.4426950408889634f;
__device__ __forceinline__ void glds16(const void*gsrc,unsigned lds_dst){unsigned keep;
  asm volatile("s_mov_b32 %0, m0\n\ts_mov_b32 m0, %2\n\ts_nop 0\n\tglobal_load_lds_dwordx4 %1, off\n\ts_mov_b32 m0, %0":"=&s"(keep):"v"(gsrc),"s"(lds_dst):"memory");}
__device__ __forceinline__ float max3f(float a,float b,float c){float r;asm("v_max3_f32 %0, %1, %2, %3":"=v"(r):"v"(a),"v"(b),"v"(c));return r;}
__device__ __forceinline__ float max2f(float a,float b){float r;asm("v_max_f32_e32 %0, %1, %2":"=v"(r):"v"(a),"v"(b));return r;}
__device__ __forceinline__ float fadd_s(float a,float b){float r;asm("v_add_f32_e32 %0, %1, %2":"=v"(r):"v"(a),"v"(b));return r;}
__device__ __forceinline__ float fsub_s(float a,float b){float r;asm("v_sub_f32_e32 %0, %1, %2":"=v"(r):"v"(a),"v"(b));return r;}
typedef float f32x2_t __attribute__((ext_vector_type(2))); typedef __bf16 bf16x2_t __attribute__((ext_vector_type(2)));
__device__ __forceinline__ unsigned cvtpk_s(float lo,float hi){f32x2_t v={lo,hi};bf16x2_t b=__builtin_convertvector(v,bf16x2_t);return __builtin_bit_cast(unsigned,b);}
#define WAIT_BAR(N) asm volatile("s_waitcnt vmcnt(" #N ") lgkmcnt(0)\n\ts_barrier":::"memory")

__device__ __forceinline__ void qkt(f32x16&p0,f32x16&p1,const char*Kslot,const bf16x8*qr,int r32,int hi){
  const char*kb=Kslot+hi*1024+r32*16;
  #pragma unroll
  for(int d0=0;d0<4;++d0){
    const bf16x8 b0=*reinterpret_cast<const bf16x8*>(kb+d0*2048);
    const bf16x8 b1=*reinterpret_cast<const bf16x8*>(kb+d0*2048+512);
    p0=__builtin_amdgcn_mfma_f32_32x32x16_bf16(b0,qr[d0],p0,0,0,0);p1=__builtin_amdgcn_mfma_f32_32x32x16_bf16(b1,qr[d0],p1,0,0,0);}
}
typedef __attribute__((address_space(3))) const char* lds_cptr;
typedef short v4i16_t __attribute__((ext_vector_type(4)));
__device__ __forceinline__ void kload8(bf16x8*kf,lds_cptr kp){
  kf[0]=*(const __attribute__((address_space(3))) bf16x8*)(kp);      kf[1]=*(const __attribute__((address_space(3))) bf16x8*)(kp+512);
  kf[2]=*(const __attribute__((address_space(3))) bf16x8*)(kp+2048); kf[3]=*(const __attribute__((address_space(3))) bf16x8*)(kp+2560);
  kf[4]=*(const __attribute__((address_space(3))) bf16x8*)(kp+4096); kf[5]=*(const __attribute__((address_space(3))) bf16x8*)(kp+4608);
  kf[6]=*(const __attribute__((address_space(3))) bf16x8*)(kp+6144); kf[7]=*(const __attribute__((address_space(3))) bf16x8*)(kp+6656);
}
__device__ __forceinline__ void kload2(bf16x8*kf,lds_cptr kp,int j){ kf[2*j]=*(const __attribute__((address_space(3))) bf16x8*)(kp+j*2048); kf[2*j+1]=*(const __attribute__((address_space(3))) bf16x8*)(kp+j*2048+512); }
__device__ __forceinline__ s16x4 vtr(lds_cptr p){ return __builtin_bit_cast(s16x4,__builtin_amdgcn_ds_read_tr16_b64_v4i16((__attribute__((address_space(3))) v4i16_t*)p)); }
__device__ __forceinline__ float rowmax(const f32x16&p0,const f32x16&p1){
  float a=max3f(p0[0],p0[1],p1[0]),b=max3f(p0[2],p0[3],p1[1]);a=max3f(a,p1[2],p1[3]);
  #pragma unroll
  for(int r=4;r<16;r+=4){a=max3f(a,p0[r],p0[r+1]);b=max3f(b,p0[r+2],p0[r+3]);a=max3f(a,p1[r],p1[r+1]);b=max3f(b,p1[r+2],p1[r+3]);}
  const float m=max2f(a,b);
  auto rr=__builtin_amdgcn_permlane32_swap(__float_as_uint(m),__float_as_uint(m),false,false);
  return max2f(__uint_as_float(rr[0]),__uint_as_float(rr[1]));
}
__device__ __forceinline__ void pv(f32x16*o,int vb,bf16x8 pa0,bf16x8 pa1,bf16x8 pa2,bf16x8 pa3){
  #pragma unroll
  for(int d0=0;d0<2;++d0){s16x4 lo[4],hi[4];
    #pragma unroll
    for(int ks=0;ks<4;++ks){
      asm volatile("ds_read_b64_tr_b16 %0,%1 offset:%c2":"=&v"(lo[ks]):"v"(vb),"i"(d0*4096+ks*1024):"memory");
      asm volatile("ds_read_b64_tr_b16 %0,%1 offset:%c2":"=&v"(hi[ks]):"v"(vb),"i"(d0*4096+ks*1024+512):"memory");}
    asm volatile("s_waitcnt lgkmcnt(0)":::"memory");SBAR();
    #define PK(k) (bf16x8){lo[k][0],lo[k][1],lo[k][2],lo[k][3],hi[k][0],hi[k][1],hi[k][2],hi[k][3]}
    o[d0]=__builtin_amdgcn_mfma_f32_32x32x16_bf16(pa0,PK(0),o[d0],0,0,0);
    o[d0]=__builtin_amdgcn_mfma_f32_32x32x16_bf16(pa1,PK(1),o[d0],0,0,0);
    o[d0]=__builtin_amdgcn_mfma_f32_32x32x16_bf16(pa2,PK(2),o[d0],0,0,0);
    o[d0]=__builtin_amdgcn_mfma_f32_32x32x16_bf16(pa3,PK(3),o[d0],0,0,0);
    #undef PK
  }
}

#ifndef ATTN_STORE16
#define ATTN_STORE16(p,v) (*(u32x4*)(p)=(v))
#endif
template<int THRL> __device__ __forceinline__ void attn_unit(int b,int h,int qb,const bf16*Q,const bf16*__restrict__ K,const bf16*__restrict__ V,bf16*O,char*shm,const __attribute__((address_space(3))) float*Fs){
  int tid_=threadIdx.x; asm volatile("":"+v"(tid_)); const int tid=tid_,lane=tid&63,r32=lane&31,hi=lane>>5;   const int wid=__builtin_amdgcn_readfirstlane(tid>>6);
  const long rowbase=(long)b*SEQ; const int q0=qb*QB;
  const bf16*Qw=Q+(rowbase+q0+wid*QBLK)*DM+h*D;
  const bf16*Kh=K+rowbase*DM+h*D,*Vh=V+rowbase*DM+h*D;
  const unsigned lds0=(unsigned)(uintptr_t)shm;
  float*wsf=(float*)(shm+LDS_WS)+wid*64;
  const bf16*ksrc=Kh+(long)lane*DM+wid*8;
  const bf16*vsrc=Vh+(long)(16*(wid&3)+(lane>>2))*DM+(wid>>2)*32+(lane&3)*8;
  const unsigned kdst=lds0+LDS_K+wid*1024, vdst=lds0+LDS_V+wid*1024;
  #define DMA_K(t,slot) glds16(ksrc+(long)(t)*KVBLK*DM,(unsigned)__builtin_amdgcn_readfirstlane(kdst+(slot)))
  #define DMA_V(t,slot) glds16(vsrc+(long)(t)*KVBLK*DM,(unsigned)__builtin_amdgcn_readfirstlane(vdst+(slot)))
  const int vb0=(int)(lds0+LDS_V)+((lane>>4)&1)*32+(lane&3)*8+(4*hi+((lane&15)>>2))*64;
  const char*Kbase=shm+LDS_K; bf16x8 kf[8];
  const lds_cptr shm3=(lds_cptr)shm; const lds_cptr kp0=shm3+LDS_K+hi*1024+r32*16; const lds_cptr vp0=shm3+LDS_V+((lane>>4)&1)*32+(lane&3)*8+(4*hi+((lane&15)>>2))*64;
  const int NT=(q0+QB)/KVBLK;
  DMA_K(0,0);DMA_V(0,0);DMA_K(1,SLOTB);
  bf16x8 qr[4];
  #pragma unroll
  for(int d0=0;d0<4;++d0)qr[d0]=*reinterpret_cast<const bf16x8*>(&Qw[(long)r32*DM+d0*16+hi*8]);
  float mhat=0.f,l_reg=0.f;f32x16 o[2];o[0]=f32x16{};o[1]=f32x16{};
  const int qrel=wid*QBLK+r32;
  const float Fq=Fs[q0+qrel];
  #define BIAS(C0,C1,t) do{ const __attribute__((address_space(3))) f32x4_t*fk_=(const __attribute__((address_space(3))) f32x4_t*)(Fs+64*(t)+4*hi); const float fb_=Fq-mhat; \
    _Pragma("unroll") for(int g_=0;g_<4;++g_){ const f32x4_t a_=fk_[2*g_], b_=fk_[8+2*g_]; \
      _Pragma("unroll") for(int e_=0;e_<4;++e_){ C0[4*g_+e_]=fb_-a_[e_]; C1[4*g_+e_]=fb_-b_[e_]; } } }while(0)
  #define CMASK(P0,P1,t) do{int jb_=(t)-(NT-4); if(jb_>=0)cmask(P0,P1,jb_,qrel,hi);}while(0)
  bool resc=false;
  #define START(P0,P1) do{ const float rm=rowmax(P0,P1); resc=false; \
    { const float dl=rm; mhat=fadd_s(mhat,dl); \
      _Pragma("unroll") for(int r=0;r<16;++r){P0[r]=fsub_s(P0[r],dl);P1[r]=fsub_s(P1[r],dl);} \
      } \
    _Pragma("unroll") for(int r=0;r<16;++r)P0[r]=__builtin_amdgcn_exp2f(P0[r]); }while(0)
  #define RESC() do{ if(resc){ asm volatile("s_waitcnt lgkmcnt(0)":::"memory"); \
      _Pragma("unroll") for(int d_=0;d_<2;++d_) _Pragma("unroll") for(int r=0;r<16;++r)o[d_][r]*=wsf[crow(r,hi)]; } }while(0)
  f32x16 pA0,pA1,pB0,pB1;
  int sl_prev=0,sl_cur=0,sl_next=SLOTB;
  #define ROT() do{sl_prev=sl_cur;sl_cur=sl_next;sl_next=(sl_next==(NSLOT-1)*SLOTB)?0:sl_next+SLOTB;}while(0)
  DMA_K(2,2*SLOTB);
  WAIT_BAR(3);
  BIAS(pA0,pA1,0); qkt(pA0,pA1,Kbase,qr,r32,hi);asm volatile("s_nop 15\n\ts_nop 7":"+v"(pA0),"+v"(pA1));CMASK(pA0,pA1,0);
  START(pA0,pA1);
  _Pragma("unroll") for(int r=0;r<16;++r)pA1[r]=__builtin_amdgcn_exp2f(pA1[r]);
  WAIT_BAR(0);
  DMA_K(3,0);DMA_V(1,SLOTB);
  ROT();
  kload8(kf,kp0+sl_cur);
  WAIT_BAR(2);
  s16x4 vlo[8],vhi[8]; u32x4 pw0,pw1,pw2,pw3;
  #define PKW(P,B) cvtpk_s(P[B],P[B+1])
  #define PAF(k) __builtin_bit_cast(bf16x8,pw##k)
  #define VFR(i) (bf16x8){vlo[i][0],vlo[i][1],vlo[i][2],vlo[i][3],vhi[i][0],vhi[i][1],vhi[i][2],vhi[i][3]}
  #define PIN(x) asm volatile("":"+v"(x))
  #define MX3(a,b,c) __builtin_fmaxf(__builtin_fmaxf((a),(b)),(c))
  #define GAPA(MF,A0,A1,A2,A3,W0,W1,PW) do{ MF; sacc+=A0; sacc+=A1; sacc+=A2; sacc+=A3; PIN(sacc); W0; W1; PIN(PW); SBAR(); }while(0)
  #define EX(v) __builtin_amdgcn_exp2f(v)
  #define GAPB(MF,X,B) do{ MF; X[B]=EX(X[B]); X[B+1]=EX(X[B+1]); X[B+2]=EX(X[B+2]); X[B+3]=EX(X[B+3]); PIN(X); SBAR(); }while(0)
  #define VRD(i) do{ vlo[i]=vtr(vp_+(((i)>>2)*4096+((i)&3)*1024)); vhi[i]=vtr(vp_+(((i)>>2)*4096+((i)&3)*1024+512)); }while(0)
  #define KRD(G,j) do{ if(G){ kload2(kf,kp0+sl_next,j); SBAR(); } }while(0)
  #define STEP(C0,C1,P0,P1,t,GK,GV,GL) do{ SBAR(); BIAS(C0,C1,t); \
    const lds_cptr vp_=vp0+sl_prev; \
    VRD(0); SBAR(); float sacc=(P0[0]+P0[1]); \
    GAPA(C0=__builtin_amdgcn_mfma_f32_32x32x16_bf16(kf[0],qr[0],C0,0,0,0), P0[2],P0[3],P0[4],P0[5],     pw0[0]=PKW(P0,0), pw0[1]=PKW(P0,2), pw0); \
    VRD(4); SBAR(); GAPA(C1=__builtin_amdgcn_mfma_f32_32x32x16_bf16(kf[1],qr[0],C1,0,0,0), P0[6],P0[7],P0[8],P0[9],     pw0[2]=PKW(P0,4), pw0[3]=PKW(P0,6), pw0); \
    VRD(1); SBAR(); GAPA(C0=__builtin_amdgcn_mfma_f32_32x32x16_bf16(kf[2],qr[1],C0,0,0,0),   P0[10],P0[11],P0[12],P0[13], pw1[0]=PKW(P0,8), pw1[1]=PKW(P0,10), pw1); \
    VRD(5); SBAR(); GAPA(C1=__builtin_amdgcn_mfma_f32_32x32x16_bf16(kf[3],qr[1],C1,0,0,0),   P0[14],P0[15],P1[0],P1[1],   pw1[2]=PKW(P0,12),pw1[3]=PKW(P0,14), pw1); \
    VRD(2); SBAR(); GAPA(C0=__builtin_amdgcn_mfma_f32_32x32x16_bf16(kf[4],qr[2],C0,0,0,0),   P1[2],P1[3],P1[4],P1[5],     pw2[0]=PKW(P1,0), pw2[1]=PKW(P1,2), pw2); \
    VRD(6); SBAR(); GAPA(C1=__builtin_amdgcn_mfma_f32_32x32x16_bf16(kf[5],qr[2],C1,0,0,0),   P1[6],P1[7],P1[8],P1[9],     pw2[2]=PKW(P1,4), pw2[3]=PKW(P1,6), pw2); \
    VRD(3); SBAR(); GAPA(C0=__builtin_amdgcn_mfma_f32_32x32x16_bf16(kf[6],qr[3],C0,0,0,0),   P1[10],P1[11],P1[12],P1[13], pw3[0]=PKW(P1,8), pw3[1]=PKW(P1,10), pw3); \
    VRD(7); SBAR(); GAPA(C1=__builtin_amdgcn_mfma_f32_32x32x16_bf16(kf[7],qr[3],C1,0,0,0),   P1[14],P1[15],0.f,0.f,       pw3[2]=PKW(P1,12),pw3[3]=PKW(P1,14), pw3); \
    l_reg+=sacc; \
    if(GK){DMA_K((t)+3,sl_cur);} if(GV){DMA_V((t)+1,sl_next);} \
    CMASK(C0,C1,t); \
    { float a=MX3(C0[0],C0[1],C1[0]),b=MX3(C0[2],C0[3],C1[1]); a=MX3(a,C1[2],C1[3]); \
      _Pragma("unroll") for(int r=4;r<16;r+=4){a=MX3(a,C0[r],C0[r+1]);b=MX3(b,C0[r+2],C0[r+3]);a=MX3(a,C1[r],C1[r+1]);b=MX3(b,C1[r+2],C1[r+3]);} \
      float rm=__builtin_fmaxf(a,b); { auto rr=__builtin_amdgcn_permlane32_swap(__float_as_uint(rm),__float_as_uint(rm),false,false); rm=__builtin_fmaxf(__uint_as_float(rr[0]),__uint_as_float(rr[1])); } \
      resc=false; \
      if(__builtin_expect(__any(rm>(float)THRL),0)){ const float dl=__builtin_fmaxf(rm,0.f); mhat+=dl; \
        _Pragma("unroll") for(int r=0;r<16;++r){C0[r]-=dl;C1[r]-=dl;} \
        const float f=__builtin_amdgcn_exp2f(-dl); l_reg*=f; if(hi==0)wsf[r32]=f; resc=true; } } \
    SBAR(); \
    GAPB(o[0]=__builtin_amdgcn_mfma_f32_32x32x16_bf16(PAF(0),VFR(0),o[0],0,0,0), C0,0); \
    GAPB(o[1]=__builtin_amdgcn_mfma_f32_32x32x16_bf16(PAF(0),VFR(4),o[1],0,0,0), C0,4); \
    KRD(GL,0); GAPB(o[0]=__builtin_amdgcn_mfma_f32_32x32x16_bf16(PAF(1),VFR(1),o[0],0,0,0), C0,8); \
    KRD(GL,1); GAPB(o[1]=__builtin_amdgcn_mfma_f32_32x32x16_bf16(PAF(1),VFR(5),o[1],0,0,0), C0,12); \
    KRD(GL,2); GAPB(o[0]=__builtin_amdgcn_mfma_f32_32x32x16_bf16(PAF(2),VFR(2),o[0],0,0,0), C1,0); \
    KRD(GL,3); GAPB(o[1]=__builtin_amdgcn_mfma_f32_32x32x16_bf16(PAF(2),VFR(6),o[1],0,0,0), C1,4); \
    GAPB(o[0]=__builtin_amdgcn_mfma_f32_32x32x16_bf16(PAF(3),VFR(3),o[0],0,0,0), C1,8); \
    GAPB(o[1]=__builtin_amdgcn_mfma_f32_32x32x16_bf16(PAF(3),VFR(7),o[1],0,0,0), C1,12); \
    }while(0)
  int t=1;
  #undef CMASK
  #define CMASK(P0,P1,t) do{}while(0)
  for(;t+5<NT;t+=2){
    STEP(pB0,pB1,pA0,pA1,t,true,true,true);     WAIT_BAR(2); RESC(); ROT();
    STEP(pA0,pA1,pB0,pB1,t+1,true,true,true);   WAIT_BAR(2); RESC(); ROT();
  }
  #undef CMASK
  #define CMASK(P0,P1,t) do{int jb_=(t)-(NT-4); if(jb_>=0)cmask(P0,P1,jb_,qrel,hi);}while(0)
  #define ENDW(tt) do{ if((tt)+3<NT){WAIT_BAR(2);} else if((tt)+2<NT){WAIT_BAR(1);} else {WAIT_BAR(0);} }while(0)
  for(;t+1<NT;t+=2){
    STEP(pB0,pB1,pA0,pA1,t,(t+3<NT),(t+1<NT),(t+1<NT));       ENDW(t);   RESC(); ROT();
    STEP(pA0,pA1,pB0,pB1,t+1,(t+4<NT),(t+2<NT),(t+2<NT));     ENDW(t+1); RESC(); ROT();
  }
  STEP(pB0,pB1,pA0,pA1,NT-1,false,false,false); RESC();
  { float sacc=pB0[0]+pB0[1]; _Pragma("unroll") for(int r=2;r<16;++r)sacc+=pB0[r]; _Pragma("unroll") for(int r=0;r<16;++r)sacc+=pB1[r]; l_reg+=sacc;
    pw0=(u32x4){PKW(pB0,0),PKW(pB0,2),PKW(pB0,4),PKW(pB0,6)};pw1=(u32x4){PKW(pB0,8),PKW(pB0,10),PKW(pB0,12),PKW(pB0,14)};pw2=(u32x4){PKW(pB1,0),PKW(pB1,2),PKW(pB1,4),PKW(pB1,6)};pw3=(u32x4){PKW(pB1,8),PKW(pB1,10),PKW(pB1,12),PKW(pB1,14)};
    SBAR(); pv(o,vb0+sl_cur,PAF(0),PAF(1),PAF(2),PAF(3)); }
  #undef PKW
  #undef PAF
  #undef VFR
  #undef PIN
  #undef MX3
  #undef GAPA
  #undef GAPB
  #undef EX
  #undef VRD
  #undef KRD
  #undef STEP
  #undef ENDW
  {auto rr=__builtin_amdgcn_permlane32_swap(__float_as_uint(l_reg),__float_as_uint(l_reg),false,false);l_reg=__uint_as_float(rr[0])+__uint_as_float(rr[1]);}
  if(hi==0)wsf[32+r32]=l_reg;asm volatile("s_waitcnt lgkmcnt(0)":::"memory");
  float rli[16];
  #pragma unroll
  for(int r=0;r<16;++r)rli[r]=__builtin_amdgcn_rcpf(wsf[32+crow(r,hi)]);
  bf16*Ow=O+(rowbase+q0+wid*QBLK)*DMO+h*D;
  { bf16*stg=(bf16*)(shm+LDS_OST)+wid*2048;
    #pragma unroll
    for(int r=0;r<16;++r){const int orow=crow(r,hi);
      #pragma unroll
      for(int d0=0;d0<2;++d0)stg[orow*64+d0*32+r32]=__float2bfloat16(o[d0][r]*rli[r]);}
    asm volatile("s_waitcnt lgkmcnt(0)":::"memory");
    #pragma unroll
    for(int i=0;i<4;++i){const int row=i*8+(lane>>3),ch=lane&7; const u32x4 v=*(const u32x4*)(stg+row*64+ch*8); ATTN_STORE16(Ow+(long)row*DMO+ch*8,v);} }
  asm volatile("s_waitcnt lgkmcnt(0)\n\ts_barrier":::"memory");
  #undef DMA_K
  #undef DMA_V
  #undef CMASK
  #undef START
  #undef RESC
  #undef ROT
  #undef BIAS
}
constexpr int ATTN_LDS_BYTES=LDS_BYTES;
#undef SBAR
#undef WAIT_BAR
}

#define LAS __attribute__((address_space(3)))
typedef unsigned short bf16_t;
typedef short bf16x8 __attribute__((ext_vector_type(8)));
typedef short s16x4 __attribute__((ext_vector_type(4)));
typedef float f32x4 __attribute__((ext_vector_type(4)));
typedef float f32x16 __attribute__((ext_vector_type(16)));
typedef unsigned u32x4 __attribute__((ext_vector_type(4)));
typedef unsigned u32x2 __attribute__((ext_vector_type(2)));

constexpr int NB = 8, SEQ = 2048, DM = 1024, MTOK = NB * SEQ, DFF = 2816, NLAYER = 4, QKV_LD = 3072;
constexpr int NWAVES = 8, NTHR = 512;
constexpr float LOG2E = 1.4426950408889634f;
constexpr int LDS_BYTES = 147456;
constexpr int VROW = 192;
constexpr int VTILE = 32 * VROW;
constexpr int LDS_F = 49152;
constexpr int NPHASE = 2 + 5 * NLAYER;
constexpr int LDS_MISC = 131072;

constexpr size_t MiB = 1u << 20;
constexpr size_t SZ_WQKV = (size_t)3072 * 1024 * 2, SZ_WO = (size_t)1024 * 1024 * 2, SZ_WI = (size_t)5632 * 1024 * 2, SZ_WOUT = (size_t)1024 * 2816 * 2;
constexpr size_t SZ_WLAYER = SZ_WQKV + SZ_WO + SZ_WI + SZ_WOUT;
constexpr size_t WS_W = 0;
constexpr size_t WS_XB = 104 * MiB;
constexpr size_t WS_XRES = WS_XB + 32 * MiB;
constexpr size_t WS_QKV = WS_XRES + 64 * MiB;
constexpr size_t WS_ATT = WS_QKV + 96 * MiB;
constexpr size_t WS_SMALL = WS_ATT + 32 * MiB;
constexpr size_t WS_ROWSS = WS_SMALL;
constexpr size_t WS_ROT = WS_ROWSS + (size_t)9 * MTOK * 4;
constexpr size_t WS_WF = WS_ROT + (size_t)2048 * 16 * 4;
constexpr size_t WS_LOCF = WS_WF + (size_t)2 * 16 * 1024 * 4;
constexpr size_t WS_TOTF = WS_LOCF + (size_t)128 * 2048 * 4;
constexpr size_t WS_LSE = WS_TOTF + (size_t)128 * 32 * 4;
constexpr size_t WS_BAR = WS_LSE + (size_t)2 * MTOK * 8 * 4;
constexpr size_t WS_END = WS_BAR + 16384;
static_assert(SZ_WLAYER * 4 <= 104 * MiB, "weights fit");

struct Args {
    const float* x; const float* norm_mix; const float* w_qkv_even; const float* w_o_even; const float* w_qkvf_odd; const float* b_forget; const float* w_o_odd;
    const float* norm_ffn; const float* w_ffn_in; const float* w_ffn_out; const float* norm_final;
    float* out; unsigned char* ws; int ph_lo, ph_hi;
};

__device__ __forceinline__ unsigned f2bf(float f) { unsigned u = __builtin_bit_cast(unsigned, f); return (u + 0x7fffu + ((u >> 16) & 1u)) >> 16; }
__device__ __forceinline__ unsigned pk2(float lo, float hi) { return f2bf(lo) | (f2bf(hi) << 16); }
__device__ __forceinline__ unsigned cvtpk(float lo, float hi) { unsigned r; asm volatile("v_cvt_pk_bf16_f32 %0, %1, %2" : "=v"(r) : "v"(lo), "v"(hi)); return r; }
__device__ __forceinline__ float wave_sum(float v) {
#pragma unroll
    for (int o = 1; o < 64; o <<= 1) v += __shfl_xor(v, o);
    return v;
}
#define LDS_WAIT() asm volatile("s_waitcnt lgkmcnt(0)" ::: "memory")
__device__ __forceinline__ int otid() { int t = threadIdx.x; asm volatile("" : "+v"(t)); return t; }

__device__ __forceinline__ void transpose_item(const float* W, int ldw, int K, int k0, int src_col, bf16_t* WT, int dst_row, const float* gain, float cscale, LAS float* scr, int lane) {
    const int kr = lane >> 3, c4 = lane & 7;
    f32x4 v[8]; float g[8];
#pragma unroll
    for (int i = 0; i < 8; ++i) { const int kk = 8 * i + kr; v[i] = *(const f32x4*)(W + (size_t)(k0 + kk) * ldw + src_col + 4 * c4); g[i] = gain ? gain[k0 + kk] * cscale : cscale; }
#pragma unroll
    for (int i = 0; i < 8; ++i) { const int kk = 8 * i + kr; LAS float* d = scr + kk * 33 + 4 * c4; d[0] = v[i].x * g[i]; d[1] = v[i].y * g[i]; d[2] = v[i].z * g[i]; d[3] = v[i].w * g[i]; }
    LDS_WAIT(); asm volatile("" ::: "memory");
    const int c = lane & 7;
#pragma unroll
    for (int j = 0; j < 4; ++j) { const int n = (lane >> 3) + 8 * j; const LAS float* s = scr + (8 * c) * 33 + n;
        u32x4 o; o.x = pk2(s[0 * 33], s[1 * 33]); o.y = pk2(s[2 * 33], s[3 * 33]); o.z = pk2(s[4 * 33], s[5 * 33]); o.w = pk2(s[6 * 33], s[7 * 33]);
        *(u32x4*)(WT + (size_t)(dst_row + n) * K + k0 + 8 * c) = o; }
    LDS_WAIT(); asm volatile("" ::: "memory");
}

__device__ __forceinline__ void prologue(const Args& a, LAS unsigned char* lds, int vwg, int G) {
    const int tid = otid(), lane = tid & 63, wave = __builtin_amdgcn_readfirstlane(tid >> 6);
    LAS float* scr = (LAS float*)(lds + wave * 16384);
    const int gw = vwg * NWAVES + wave, NGW = G * NWAVES;
    constexpr int I_QKV = 16 * 96, I_O = 16 * 32, I_IN = 16 * 176, I_OUT = 44 * 32, I_LAYER = I_QKV + I_O + I_IN + I_OUT;
    for (int it = gw; it < NLAYER * I_LAYER; it += NGW) {
        const int l = it / I_LAYER; int r = it % I_LAYER;
        bf16_t* wl = (bf16_t*)(a.ws + WS_W + (size_t)l * SZ_WLAYER);
        if (r < I_QKV) {
            const int kb = r / 96, nb = r % 96, n0 = 32 * nb;
            const float* W = (l & 1) ? a.w_qkvf_odd + (size_t)(l >> 1) * 1024 * 3088 : a.w_qkv_even + (size_t)(l >> 1) * 1024 * 3072;
            transpose_item(W, (l & 1) ? 3088 : 3072, 1024, 64 * kb, n0, wl, n0, a.norm_mix + l * 1024, n0 < 1024 ? 0.125f * LOG2E : 1.0f, scr, lane);
            continue; }
        r -= I_QKV;
        if (r < I_O) {
            const int kb = r / 32, nb = r % 32, n0 = 32 * nb;
            const float* W = (l & 1) ? a.w_o_odd + (size_t)(l >> 1) * 1024 * 1024 : a.w_o_even + (size_t)(l >> 1) * 1024 * 1024;
            transpose_item(W, 1024, 1024, 64 * kb, n0, (bf16_t*)((unsigned char*)wl + SZ_WQKV), n0, nullptr, 1.0f, scr, lane);
            continue; }
        r -= I_O;
        if (r < I_IN) {
            const int kb = r / 176, nb = r % 176, n0 = 32 * nb;
            const int pn = n0 >> 8, bj = (n0 >> 7) & 1, c0 = n0 & 127;
            transpose_item(a.w_ffn_in + (size_t)l * 1024 * 5632, 5632, 1024, 64 * kb, bj * 2816 + 128 * pn + c0, (bf16_t*)((unsigned char*)wl + SZ_WQKV + SZ_WO), n0, a.norm_ffn + l * 1024, 1.0f, scr, lane);
            continue; }
        r -= I_IN;
        {
            const int kb = r / 32, nb = r % 32, n0 = 32 * nb;
            transpose_item(a.w_ffn_out + (size_t)l * 2816 * 1024, 1024, 2816, 64 * kb, n0, (bf16_t*)((unsigned char*)wl + SZ_WQKV + SZ_WO + SZ_WI), n0, nullptr, 1.0f, scr, lane);
        }
    }
    bf16_t* xb = (bf16_t*)(a.ws + WS_XB); float* rowss = (float*)(a.ws + WS_ROWSS);
    for (int m = gw; m < MTOK; m += NGW) {
        const f32x4* xr = (const f32x4*)(a.x + (size_t)m * DM) + lane; float s = 0.f; f32x4 v[4];
#pragma unroll
        for (int j = 0; j < 4; ++j) { v[j] = xr[64 * j]; s += (v[j].x * v[j].x + v[j].y * v[j].y) + (v[j].z * v[j].z + v[j].w * v[j].w); }
        s = wave_sum(s);
        unsigned long long* o8 = (unsigned long long*)(xb + (size_t)m * DM) + lane;
#pragma unroll
        for (int j = 0; j < 4; ++j) o8[64 * j] = (unsigned long long)pk2(v[j].x, v[j].y) | ((unsigned long long)pk2(v[j].z, v[j].w) << 32);
        if (lane == 0) rowss[m] = s;
    }
    const int gt = vwg * NTHR + tid, NGT = G * NTHR;
    for (int i = gt; i < 8 * MTOK; i += NGT) rowss[MTOK + i] = 0.f;
    float* rot = (float*)(a.ws + WS_ROT);
    for (int i = gt; i < 2048 * 8; i += NGT) {
        const int pos = i >> 3, j = i & 7;
        const float invf[8] = {1.0f, 0.19392274474868576f, 0.03760603093086393f, 0.007292664737217109f, 0.001414213562373095f, 0.0002742481756762073f, 5.318295896944988e-05f, 1.031338537721246e-05f};
        float fq = invf[0];
#pragma unroll
        for (int t = 1; t < 8; ++t) fq = (j == t) ? invf[t] : fq;
        const float ang = (float)pos * fq;
        const double rev = (double)ang * 0.15915494309189535; const float fr = (float)(rev - floor(rev));
        rot[pos * 16 + j] = __builtin_amdgcn_cosf(fr); rot[pos * 16 + 8 + j] = __builtin_amdgcn_sinf(fr);
    }
    float* wf = (float*)(a.ws + WS_WF);
    for (int i = gt; i < 2 * 16 * 1024; i += NGT) {
        const int lo = i >> 14, hd = (i >> 10) & 15, k = i & 1023;
        wf[i] = a.w_qkvf_odd[(size_t)lo * 1024 * 3088 + (size_t)k * 3088 + 3072 + hd] * a.norm_mix[(2 * lo + 1) * 1024 + k];
    }
}

__device__ __forceinline__ void fgate_phase(const Args& a, int lo, LAS unsigned char* lds, int vwg, int G) {
    const int tid = otid(), lane = tid & 63, wave = __builtin_amdgcn_readfirstlane(tid >> 6);
    const float* xres = (const float*)(a.ws + WS_XRES); const float* rowss = (const float*)(a.ws + WS_ROWSS) + (size_t)(2 * (2 * lo + 1)) * MTOK;
    const float* wf = (const float*)(a.ws + WS_WF) + (size_t)lo * 16 * 1024;
    float* locF = (float*)(a.ws + WS_LOCF); float* totF = (float*)(a.ws + WS_TOTF);
    LAS float* lf = (LAS float*)lds;
    const int r16 = lane & 15, g4 = lane >> 4, tile = wave & 3, kh = wave >> 2;
    for (int j = vwg; j < 256; j += G) {
        const f32x4* xr = (const f32x4*)(xres + (size_t)(64 * j + 16 * tile + r16) * DM + 512 * kh + 4 * g4);
        const f32x4* wr = (const f32x4*)(wf + (size_t)r16 * 1024 + 512 * kh + 4 * g4);
        f32x4 acc = {0.f, 0.f, 0.f, 0.f};
#pragma unroll 8
        for (int s = 0; s < 32; ++s) {
            const f32x4 xv = xr[4 * s], wv = wr[4 * s];
            acc = __builtin_amdgcn_mfma_f32_16x16x4f32(xv.x, wv.x, acc, 0, 0, 0);
            acc = __builtin_amdgcn_mfma_f32_16x16x4f32(xv.y, wv.y, acc, 0, 0, 0);
            acc = __builtin_amdgcn_mfma_f32_16x16x4f32(xv.z, wv.z, acc, 0, 0, 0);
            acc = __builtin_amdgcn_mfma_f32_16x16x4f32(xv.w, wv.w, acc, 0, 0, 0);
        }
#pragma unroll
        for (int jj = 0; jj < 4; ++jj) lf[(kh * 64 + 16 * tile + 4 * g4 + jj) * 16 + r16] = acc[jj];
        __syncthreads();
        if (tid < 16) {
            const int b = j >> 5, sl = j & 31; float run = 0.f; float* dst = locF + (size_t)(b * 16 + tid) * 2048 + sl * 64;
            const float bias = a.b_forget[lo * 16 + tid];
            for (int t = 0; t < 64; ++t) {
                const float fl = (lf[t * 16 + tid] + lf[(64 + t) * 16 + tid]) * pg8::rstd_of(rowss, 64 * j + t) + bias;
                const float z2 = fl * LOG2E; const float l2 = -(fmaxf(-z2, 0.f) + __builtin_amdgcn_logf(1.0f + __builtin_amdgcn_exp2f(-fabsf(z2))));
                run += l2; dst[t] = run;
            }
            totF[(b * 16 + tid) * 32 + sl] = run;
        }
        __syncthreads();
    }
}

__device__ __forceinline__ int phi32(int r) { return ((r >> 4) & 1) * 16 + ((r >> 2) & 1) * 8 + ((r >> 3) & 1) * 4 + (r & 3); }
__device__ __forceinline__ s16x4 vtr(const LAS unsigned char* p) { return __builtin_bit_cast(s16x4, __builtin_amdgcn_ds_read_tr16_b64_v4i16((LAS s16x4*)p)); }

template <int MODE, int DBG = 0>
__device__ __forceinline__ void attn_task(const bf16_t* qp, const bf16_t* kp, const bf16_t* vp, size_t rstride, int q0, int kb_lo, int kb_hi,
                                          LAS unsigned char* vlds, const LAS float* Fs, f32x16 (&O)[2], float& lse2) {
    const int lane = otid() & 63, n = lane & 31, hh = lane >> 5;
    bf16x8 qf[4];
    { const bf16_t* p = qp + (size_t)(q0 + n) * rstride + 8 * hh;
#pragma unroll
      for (int ks = 0; ks < 4; ++ks) qf[ks] = *(const bf16x8*)(p + 16 * ks); }
    const int qi = q0 + n;
    float Fq = 0.f; if (MODE == 0) Fq = Fs[qi];
#pragma unroll
    for (int r = 0; r < 16; ++r) { O[0][r] = 0.f; O[1][r] = 0.f; }
    float m = -1e30f, l = 0.f, R = 0.f;
    const bf16_t* kl = kp + (size_t)phi32(n) * rstride + 8 * hh;
    const bf16_t* vl = vp + (size_t)(lane >> 3) * rstride + 8 * (lane & 7);
    LAS unsigned char* vw = vlds + (lane >> 3) * VROW + (lane & 7) * 16;
    const LAS unsigned char* vr = vlds + (8 * hh + ((lane & 15) >> 2)) * VROW + (16 * ((lane >> 4) & 1) + 4 * (lane & 3)) * 2;
    bf16x8 kn[4]; u32x4 vn[4];
#define AT_ISSUE(kb) do { const bf16_t* kk_ = kl + (size_t)(kb) * 32 * rstride; const bf16_t* vv_ = vl + (size_t)(kb) * 32 * rstride; \
        _Pragma("unroll") for (int ks = 0; ks < 4; ++ks) kn[ks] = *(const bf16x8*)(kk_ + 16 * ks); \
        _Pragma("unroll") for (int ii = 0; ii < 4; ++ii) vn[ii] = *(const u32x4*)(vv_ + (size_t)(8 * ii) * rstride); } while (0)
    const int nblk = kb_hi - kb_lo + 1;
    int kb = (MODE == 2) ? kb_hi : kb_lo;
    AT_ISSUE(kb);
    for (int it = 0; it < nblk; ++it) {
        bf16x8 kc[4];
#pragma unroll
        for (int ks = 0; ks < 4; ++ks) kc[ks] = kn[ks];
        asm volatile("" ::: "memory");
#pragma unroll
        for (int ii = 0; ii < 4; ++ii) *(LAS u32x4*)(vw + ii * 8 * VROW) = vn[ii];
        asm volatile("" ::: "memory");
        const int kbn = (MODE == 2) ? kb - 1 : kb + 1;
        if (it + 1 < nblk && DBG != 1) AT_ISSUE(kbn);
        if (DBG != 2) {
        const int key0 = kb * 32 + 8 * hh;
        f32x16 s;
        if (MODE == 0) {
            const LAS f32x4* fk = (const LAS f32x4*)(Fs + key0);
            const f32x4 f0 = fk[0], f1 = fk[1], f2 = fk[4], f3 = fk[5];
#pragma unroll
            for (int e = 0; e < 4; ++e) { s[e] = Fq - f0[e]; s[4 + e] = Fq - f1[e]; s[8 + e] = Fq - f2[e]; s[12 + e] = Fq - f3[e]; }
        } else {
#pragma unroll
            for (int r = 0; r < 16; ++r) s[r] = 0.f;
        }
#pragma unroll
        for (int ks = 0; ks < 4; ++ks) s = __builtin_amdgcn_mfma_f32_32x32x16_bf16(kc[ks], qf[ks], s, 0, 0, 0);
        bf16x8 pb[2];
        if (MODE != 2) {
            const bool diag = (kb * 32 + 31 > q0);
            if (MODE == 1) {
#pragma unroll
                for (int r = 0; r < 16; ++r) { const int ki = key0 + 16 * (r >> 3) + (r & 7); if (ki > qi || ki < qi - 128) s[r] = -1e30f; }
            } else if (diag) {
#pragma unroll
                for (int r = 0; r < 16; ++r) { const int ki = key0 + 16 * (r >> 3) + (r & 7); if (ki > qi) s[r] = -1e30f; }
            }
            float bm = fmaxf(fmaxf(s[0], s[1]), fmaxf(s[2], s[3]));
#pragma unroll
            for (int r = 4; r < 16; r += 4) bm = fmaxf(bm, fmaxf(fmaxf(s[r], s[r + 1]), fmaxf(s[r + 2], s[r + 3])));
            bm = fmaxf(bm, __shfl_xor(bm, 32));
            const float mn = fmaxf(m, bm), alpha = __builtin_amdgcn_exp2f(m - mn); m = mn;
            float ps = 0.f;
#pragma unroll
            for (int r = 0; r < 16; ++r) { s[r] = __builtin_amdgcn_exp2f(s[r] - mn); ps += s[r]; }
            l = l * alpha + ps;
#pragma unroll
            for (int r = 0; r < 16; ++r) { O[0][r] *= alpha; O[1][r] *= alpha; }
        } else {
            const bool diag = (kb * 32 + 31 >= q0);
            float L[16];
#pragma unroll
            for (int r = 0; r < 16; ++r) {
                const float z = s[r], t = __builtin_amdgcn_exp2f(-fabsf(z)), sp = fmaxf(z, 0.f) + __builtin_amdgcn_logf(1.0f + t);
                L[r] = -sp; s[r] = z - sp;
            }
            if (diag) {
#pragma unroll
                for (int r = 0; r < 16; ++r) { const int ki = key0 + 16 * (r >> 3) + (r & 7); if (ki >= qi) { L[r] = 0.f; s[r] = -1e30f; } }
            }
            float sA = ((L[0] + L[1]) + (L[2] + L[3])) + ((L[4] + L[5]) + (L[6] + L[7]));
            float sB = ((L[8] + L[9]) + (L[10] + L[11])) + ((L[12] + L[13]) + (L[14] + L[15]));
            const float pA = __shfl_xor(sA, 32), pB = __shfl_xor(sB, 32);
            const float offA = sB + pB + (hh == 0 ? pA : 0.f), offB = (hh == 0 ? pB : 0.f);
            float run = R + offA;
#pragma unroll
            for (int e = 7; e >= 0; --e) { const float lr = L[e]; s[e] = __builtin_amdgcn_exp2f(s[e] + run); run += lr; }
            run = R + offB;
#pragma unroll
            for (int e = 15; e >= 8; --e) { const float lr = L[e]; s[e] = __builtin_amdgcn_exp2f(s[e] + run); run += lr; }
            R += (sA + sB) + (pA + pB);
        }
        { u32x4 w0, w1;
          w0.x = cvtpk(s[0], s[1]); w0.y = cvtpk(s[2], s[3]); w0.z = cvtpk(s[4], s[5]); w0.w = cvtpk(s[6], s[7]);
          w1.x = cvtpk(s[8], s[9]); w1.y = cvtpk(s[10], s[11]); w1.z = cvtpk(s[12], s[13]); w1.w = cvtpk(s[14], s[15]);
          pb[0] = __builtin_bit_cast(bf16x8, w0); pb[1] = __builtin_bit_cast(bf16x8, w1); }
        asm volatile("" ::: "memory");
#pragma unroll
        for (int db = 0; db < 2; ++db)
#pragma unroll
            for (int kk = 0; kk < 2; ++kk) {
                const s16x4 lo4 = vtr(vr + (16 * kk) * VROW + 64 * db), hi4 = vtr(vr + (16 * kk + 4) * VROW + 64 * db);
                const bf16x8 av = {lo4[0], lo4[1], lo4[2], lo4[3], hi4[0], hi4[1], hi4[2], hi4[3]};
                O[db] = __builtin_amdgcn_mfma_f32_32x32x16_bf16(av, pb[kk], O[db], 0, 0, 0);
            }
        asm volatile("s_waitcnt lgkmcnt(0)" ::: "memory");
        } else { asm volatile("s_waitcnt lgkmcnt(0)" ::: "memory"); O[0][0] += __builtin_bit_cast(float, (int)kc[0][0]) ; }
        if (MODE == 2) { if (__builtin_amdgcn_ballot_w64(R >= -160.f) == 0ull) break; }
        kb = kbn;
    }
#undef AT_ISSUE
    asm volatile("s_waitcnt vmcnt(0)" ::: "memory");
    if (MODE != 2) {
        l += __shfl_xor(l, 32);
        const float inv = 1.0f / l;
#pragma unroll
        for (int r = 0; r < 16; ++r) { O[0][r] *= inv; O[1][r] *= inv; }
        lse2 = m + __builtin_amdgcn_logf(l);
    }
}

__device__ __forceinline__ void store_o_bf16(const f32x16 (&O)[2], bf16_t* att_row  , int hh) {
#pragma unroll
    for (int db = 0; db < 2; ++db)
#pragma unroll
        for (int i = 0; i < 4; ++i) {
            u32x2 w; w.x = cvtpk(O[db][4 * i], O[db][4 * i + 1]); w.y = cvtpk(O[db][4 * i + 2], O[db][4 * i + 3]);
            *(u32x2*)(att_row + 32 * db + 8 * i + 4 * hh) = w;
        }
}

constexpr int LDS_FOXF = 90112;
__device__ __forceinline__ void fox_phase(const Args& a, unsigned char* lds_gen, LAS unsigned char* lds, int vwg, int G) {
    const int tid = otid();
    const bf16_t* qkv = (const bf16_t*)(a.ws + WS_QKV); bf16_t* att = (bf16_t*)(a.ws + WS_ATT);
    const float* locF = (const float*)(a.ws + WS_LOCF); const float* totF = (const float*)(a.ws + WS_TOTF);
    LAS float* Fs = (LAS float*)(lds + LDS_FOXF); LAS float* pre = Fs + 2048;
    for (int j = vwg; j < 256; j += G) {
        const int bh = j >> 1, b = bh >> 4, h = bh & 15;
        __syncthreads();
        if (tid < 32) { float p = 0.f; for (int s = 0; s < tid; ++s) p += totF[bh * 32 + s]; pre[tid] = p; }
        __syncthreads();
        for (int t = tid; t < 2048; t += NTHR) Fs[t] = locF[(size_t)bh * 2048 + t] + pre[t >> 6];
        __syncthreads();
        for (int ui = 0; ui < 4; ++ui) {
            const int u = (j & 1) ? ((ui < 2) ? 2 + ui : 7 - ui) : ((ui < 2) ? ui : 9 - ui);
            attn_body::attn_unit<8>(b, h, u, (const attn_body::bf16*)qkv, (const attn_body::bf16*)(qkv + 1024), (const attn_body::bf16*)(qkv + 2048), (attn_body::bf16*)att, (char*)lds_gen, Fs);
        }
    }
}

template <int PART>
__device__ __forceinline__ void even_attn_phase(const Args& a, LAS unsigned char* lds, int vwg, int G) {
    const int tid = otid(), lane = tid & 63, wave = __builtin_amdgcn_readfirstlane(tid >> 6), n = lane & 31, hh = lane >> 5;
    const bf16_t* qkv = (const bf16_t*)(a.ws + WS_QKV); bf16_t* att = (bf16_t*)(a.ws + WS_ATT);
    float* part = a.out;
    float* plse = (float*)(a.ws + WS_LSE);
    LAS unsigned char* vlds = lds + wave * VTILE;
    const LAS float* nof = (const LAS float*)lds;
    for (int j = vwg; j < 256; j += G) {
        const int bh = j >> 2, b = bh >> 3, hl = bh & 7, c = j & 3;
        if (PART & 1) { const bf16_t* base = qkv + (size_t)(b * SEQ) * QKV_LD + hl * 64;
          for (int ui = 0; ui < 2; ++ui) {
              const int u = ui ? 7 - c : c, qt = 8 * u + wave;
              f32x16 O[2]; float lse;
              attn_task<2>(base, base + 1024, base + 2048, (size_t)QKV_LD, 32 * qt, 0, qt, vlds, nof, O, lse);
              store_o_bf16(O, att + (size_t)(b * SEQ + 32 * qt + n) * DM + hl * 64, hh);
          } }
        if (!(PART & 2)) continue;
        const bf16_t* base = qkv + (size_t)(b * SEQ) * QKV_LD + (8 + hl) * 64;
        for (int p = 0; p < 2; ++p) {
            const int dil = p ? 4 : 1;
            for (int ti = 0; ti < 2; ++ti) {
                const int task = wave + 8 * ti;
                const int res = p ? (task & 3) : 0, tile = p ? (task >> 2) : task;
                const int q0 = (p ? 128 * c : 512 * c) + 32 * tile;
                const int kbh = q0 >> 5, kbl = kbh - 4 < 0 ? 0 : kbh - 4;
                const bf16_t* bp = base + (size_t)res * QKV_LD;
                f32x16 O[2]; float lse;
                attn_task<1>(bp, bp + 1024, bp + 2048, (size_t)dil * QKV_LD, q0, kbl, kbh, vlds, nof, O, lse);
                const int tok = res + dil * (q0 + n);
                float* pr = part + ((size_t)p * MTOK + (size_t)(b * SEQ + tok)) * 512 + hl * 64;
#pragma unroll
                for (int db = 0; db < 2; ++db)
#pragma unroll
                    for (int i = 0; i < 4; ++i) *(f32x4*)(pr + 32 * db + 8 * i + 4 * hh) = (f32x4){O[db][4 * i], O[db][4 * i + 1], O[db][4 * i + 2], O[db][4 * i + 3]};
                if (hh == 0) plse[((size_t)p * MTOK + (size_t)(b * SEQ + tok)) * 8 + hl] = lse;
            }
        }
        __syncthreads();
        for (int ti = 0; ti < 2; ++ti) {
            const int res = wave + 8 * ti, q0 = 32 * c;
            const bf16_t* bp = base + (size_t)res * QKV_LD;
            f32x16 O[2]; float lse3;
            attn_task<1>(bp, bp + 1024, bp + 2048, (size_t)16 * QKV_LD, q0, 0, c, vlds, nof, O, lse3);
            const int tok = res + 16 * (q0 + n); const size_t grow = (size_t)(b * SEQ + tok);
            const float l1 = plse[grow * 8 + hl], l2 = plse[((size_t)MTOK + grow) * 8 + hl];
            const float mx = fmaxf(lse3, fmaxf(l1, l2));
            float w1 = __builtin_amdgcn_exp2f(l1 - mx), w2 = __builtin_amdgcn_exp2f(l2 - mx), w3 = __builtin_amdgcn_exp2f(lse3 - mx);
            const float inv = 1.0f / (w1 + w2 + w3); w1 *= inv; w2 *= inv; w3 *= inv;
            const float* p1 = part + grow * 512 + hl * 64; const float* p2 = part + ((size_t)MTOK + grow) * 512 + hl * 64;
#pragma unroll
            for (int db = 0; db < 2; ++db)
#pragma unroll
                for (int i = 0; i < 4; ++i) {
                    const f32x4 a1 = *(const f32x4*)(p1 + 32 * db + 8 * i + 4 * hh), a2 = *(const f32x4*)(p2 + 32 * db + 8 * i + 4 * hh);
#pragma unroll
                    for (int e = 0; e < 4; ++e) O[db][4 * i + e] = O[db][4 * i + e] * w3 + a1[e] * w1 + a2[e] * w2;
                }
            store_o_bf16(O, att + grow * DM + (8 + hl) * 64, hh);
        }
        __syncthreads();
    }
}

__device__ __forceinline__ void final_phase(const Args& a, int vwg, int G) {
    const int tid = otid(), lane = tid & 63, wave = tid >> 6;
    const float* xres = (const float*)(a.ws + WS_XRES); const float* rowss = (const float*)(a.ws + WS_ROWSS) + (size_t)8 * MTOK;
    const int gw = vwg * NWAVES + wave, NGW = G * NWAVES;
    f32x4 g[4];
#pragma unroll
    for (int j = 0; j < 4; ++j) g[j] = ((const f32x4*)a.norm_final)[lane + 64 * j];
    for (int m = gw; m < MTOK; m += NGW) {
        const float rs = pg8::rstd_of(rowss, m);
        const f32x4* xr = (const f32x4*)(xres + (size_t)m * DM) + lane; f32x4* o = (f32x4*)(a.out + (size_t)m * DM) + lane;
#pragma unroll
        for (int j = 0; j < 4; ++j) o[64 * j] = xr[64 * j] * rs * g[j];
    }
}

#define XB_TMO      128
#define XB_XCNT(j)  (256  + 64 * (j))
#define XB_XSUB(j)  (1280 + 64 * (j))
#define XB_XGEN(j)  (2304 + 64 * (j))
#define XB_TOP      3328
#define XB_TOPGEN   3392
#define XCD_BAR_WORDS 3456
#define XB_SPIN_CAP (1u << 18)

__device__ __forceinline__ unsigned xb_ld(unsigned* p)              { return __hip_atomic_load(p, __ATOMIC_RELAXED, __HIP_MEMORY_SCOPE_AGENT); }
__device__ __forceinline__ unsigned xb_add(unsigned* p, unsigned v) { return __hip_atomic_fetch_add(p, v, __ATOMIC_RELAXED, __HIP_MEMORY_SCOPE_AGENT); }
__device__ __forceinline__ unsigned xb_xcc_id() { return (unsigned)__builtin_amdgcn_s_getreg((3 << 11) | 20) & 0xFu; }
#define XB_SPIN(cond, bar) do { unsigned _sp = 0; while (cond) { __builtin_amdgcn_s_sleep(1); \
    if ((++_sp & 255u) == 0u) { if (xb_ld(&(bar)[XB_TMO])) break; if (_sp > XB_SPIN_CAP) { atomicAdd(&(bar)[XB_TMO], 1u); break; } } } } while (0)

struct XcdBarrier {
    unsigned* bar; unsigned x;
    volatile LAS unsigned* st;
};

__device__ __forceinline__ XcdBarrier xcd_barrier_post(unsigned* bar, volatile LAS unsigned* st) {
    XcdBarrier b; b.bar = bar; b.x = xb_xcc_id(); b.st = st;
    if (threadIdx.x == 0) (void)xb_add(&bar[XB_XCNT(b.x)], 1u);
    return b;
}
__device__ __forceinline__ void xcd_barrier_complete(unsigned* bar, unsigned x, unsigned& nloc, unsigned& nx) {
    const unsigned G = gridDim.x * gridDim.y * gridDim.z;
    unsigned sum, cnt, mine, sp = 0u;
    for (;;) {
        sum = 0u; cnt = 0u; mine = 0u;
#pragma unroll
        for (unsigned j = 0; j < 16; ++j) { const unsigned c = xb_ld(&bar[XB_XCNT(j)]); sum += c; cnt += (c > 0u) ? 1u : 0u; mine = (j == x) ? c : mine; }
        if (sum == G) break;
        __builtin_amdgcn_s_sleep(1);
        if ((++sp & 255u) == 0u) { if (xb_ld(&bar[XB_TMO])) break; if (sp > XB_SPIN_CAP) { atomicAdd(&bar[XB_TMO], 1u); break; } }
    }
    nloc = mine > 0u ? mine : 1u; nx = cnt > 0u ? cnt : 1u;
}

__device__ __forceinline__ void xcd_barrier(const XcdBarrier& b) {
    asm volatile("s_waitcnt vmcnt(0)" ::: "memory");
    __syncthreads();
    if (threadIdx.x == 0) {
        unsigned* bar = b.bar;
        __builtin_amdgcn_s_waitcnt(0);
        unsigned nloc = b.st[0], nx = b.st[1];
        if (nloc == 0u) { xcd_barrier_complete(bar, b.x, nloc, nx); b.st[0] = nloc; b.st[1] = nx; }
        const unsigned old = xb_add(&bar[XB_XSUB(b.x)], 1u);
        const unsigned gen = old / nloc;
        if (old + 1u == (gen + 1u) * nloc) {
            __builtin_amdgcn_fence(__ATOMIC_RELEASE, "agent");
            asm volatile("s_waitcnt vmcnt(0)" ::: "memory");
            const unsigned og = xb_add(&bar[XB_TOP], 1u);
            const unsigned tg = og / nx;
            if (og + 1u == (tg + 1u) * nx) xb_add(&bar[XB_TOPGEN], 1u);
            else XB_SPIN(xb_ld(&bar[XB_TOPGEN]) == tg, bar);
            __builtin_amdgcn_fence(__ATOMIC_ACQUIRE, "agent");
            xb_add(&bar[XB_XGEN(b.x)], 1u);
            asm volatile("s_waitcnt vmcnt(0)" ::: "memory");
        } else {
            XB_SPIN(xb_ld(&bar[XB_XGEN(b.x)]) == gen, bar);
            __builtin_amdgcn_fence(__ATOMIC_ACQUIRE, "agent");
            asm volatile("s_waitcnt vmcnt(0)" ::: "memory");
        }
    }
    __syncthreads();
}

#ifndef DBG_EVEN
#define DBG_EVEN 0
#endif
#ifndef DBG_FOX
#define DBG_FOX 0
#endif
#ifndef REP_QKV
#define REP_QKV 1
#endif
#ifndef REP_FG
#define REP_FG 1
#endif
#ifndef REP_FFI
#define REP_FFI 1
#endif
#ifndef REP_PRO
#define REP_PRO 1
#endif
#ifndef REP_SYNC
#define REP_SYNC 1
#endif
#ifndef REP_FOX
#define REP_FOX 1
#endif
#ifndef REP_EVEN
#define REP_EVEN 1
#endif
__global__ void __launch_bounds__(NTHR, 2) fwd_kernel(Args a) {
    extern __shared__ __attribute__((aligned(16))) unsigned char lds_raw[];
    LAS unsigned char* lds = (LAS unsigned char*)lds_raw;
    cg::grid_group grid = cg::this_grid();
    const int G = gridDim.x, vwg = blockIdx.x;
    unsigned char* ws = a.ws;
    bf16_t* xb = (bf16_t*)(ws + WS_XB); float* xres = (float*)(ws + WS_XRES); bf16_t* qkv = (bf16_t*)(ws + WS_QKV); bf16_t* hid = (bf16_t*)(ws + WS_QKV);
    bf16_t* att = (bf16_t*)(ws + WS_ATT); float* rowss = (float*)(ws + WS_ROWSS); const float* rot = (const float*)(ws + WS_ROT);
    unsigned* barw = (unsigned*)(ws + WS_BAR);
    volatile LAS unsigned* bst = (volatile LAS unsigned*)(lds + LDS_MISC);
    if (threadIdx.x == 0) { bst[0] = 0u; bst[1] = 0u; }
    if (blockIdx.x == 0) { for (int i = threadIdx.x; i < XCD_BAR_WORDS; i += NTHR) barw[i] = 0u; }
    __syncthreads();
    XcdBarrier bar; bar.bar = barw; bar.x = 0; bar.st = bst;
    bool posted = false;
    for (int ph = a.ph_lo; ph < a.ph_hi; ++ph) {
        if (ph == 0) { for (int rep = 0; rep < REP_PRO; ++rep) { prologue(a, lds, vwg, G); __syncthreads(); } }
        else if (ph == NPHASE - 1) final_phase(a, vwg, G);
        else {
            const int l = (ph - 1) / 5, sp = (ph - 1) % 5;
            const bf16_t* wl = (const bf16_t*)(ws + WS_W + (size_t)l * SZ_WLAYER);
            const bf16_t* w_qkv = wl; const bf16_t* w_o = (const bf16_t*)((const unsigned char*)wl + SZ_WQKV);
            const bf16_t* w_in = (const bf16_t*)((const unsigned char*)wl + SZ_WQKV + SZ_WO); const bf16_t* w_out = (const bf16_t*)((const unsigned char*)wl + SZ_WQKV + SZ_WO + SZ_WI);
            if (sp == 0) {
                pg8::Gemm g{xb, w_qkv, MTOK, 3072, 1024}; pg8::StaticOrder S; S.init(MTOK, 3072, G, vwg);
                pg8::EpiQKV E{qkv, rowss + (size_t)(2 * l) * MTOK, rot, (l & 1) ? 0 : 1};
                for (int rep = 0; rep < REP_QKV; ++rep) { pg8::gemm_phase<pg8::EpiQKV, pg8::StaticOrder, true, true>(lds, g, S, E); __syncthreads(); }
                if (l & 1) { for (int rep = 0; rep < REP_FG; ++rep) { __syncthreads(); fgate_phase(a, l >> 1, lds, vwg, G); } }
            } else if (sp == 1) {
                if (l & 1) { fox_phase(a, lds_raw, lds, vwg, G); } else { if (DBG_EVEN) { even_attn_phase<DBG_EVEN>(a, lds, vwg, G); __syncthreads(); } even_attn_phase<3>(a, lds, vwg, G); }
            } else if (sp == 2) {
                pg8::Gemm g{att, w_o, MTOK, 1024, 1024}; pg8::StaticOrder S; S.init(MTOK, 1024, G, vwg);
                pg8::EpiResid E{l == 0 ? a.x : xres, xres, xb, rowss + (size_t)(2 * l + 1) * MTOK};
                pg8::gemm_phase<pg8::EpiResid, pg8::StaticOrder, true, true>(lds, g, S, E);
            } else if (sp == 3) {
                pg8::Gemm g{xb, w_in, MTOK, 5632, 1024}; pg8::StaticOrder S; S.init(MTOK, 5632, G, vwg);
                pg8::EpiSwiGLU E{hid, rowss + (size_t)(2 * l + 1) * MTOK};
                for (int rep = 0; rep < REP_FFI; ++rep) { pg8::gemm_phase<pg8::EpiSwiGLU, pg8::StaticOrder, true, true>(lds, g, S, E); __syncthreads(); }
            } else {
                pg8::Gemm g{hid, w_out, MTOK, 1024, 2816}; pg8::StaticOrder S; S.init(MTOK, 1024, G, vwg);
                pg8::EpiResid E{xres, xres, xb, rowss + (size_t)(2 * l + 2) * MTOK};
                pg8::gemm_phase<pg8::EpiResid, pg8::StaticOrder, true, true>(lds, g, S, E);
            }
        }
        if (ph + 1 < a.ph_hi) {
            if (!posted) { grid.sync(); bar = xcd_barrier_post(barw, bst); posted = true; }
            else { for (int rep = 0; rep < REP_SYNC; ++rep) xcd_barrier(bar); }
        }
    }
}

#ifndef N_LAUNCH_MODE
#define N_LAUNCH_MODE 1
#endif

extern "C" void kernel_launch(void* const* d_in, const int* in_sizes, int n_in, void* d_out, int out_size, void* d_ws, size_t ws_size, hipStream_t stream) {
    static int grid = 0;
    if (grid == 0) {
        if (n_in != 11 || out_size != MTOK * DM || ws_size < WS_END) { fprintf(stderr, "kernel_launch: unexpected sizes n_in %d out %d ws %zu (need %zu)\n", n_in, out_size, ws_size, (size_t)WS_END); grid = -1; return; }
        int dev = 0, cus = 0, per_cu = 0;
        hipGetDevice(&dev); hipDeviceGetAttribute(&cus, hipDeviceAttributeMultiprocessorCount, dev);
        if (hipFuncSetAttribute((const void*)fwd_kernel, hipFuncAttributeMaxDynamicSharedMemorySize, LDS_BYTES) != hipSuccess) { fprintf(stderr, "kernel_launch: hipFuncSetAttribute failed\n"); grid = -1; return; }
        if (hipOccupancyMaxActiveBlocksPerMultiprocessor(&per_cu, (const void*)fwd_kernel, NTHR, LDS_BYTES) != hipSuccess || per_cu < 1) { fprintf(stderr, "kernel_launch: occupancy query says %d\n", per_cu); per_cu = 1; }
        (void)hipGetLastError();
        grid = cus * 1;
        fprintf(stderr, "kernel_launch: grid %d (cus %d, per_cu %d)\n", grid, cus, per_cu);
    }
    if (grid < 0) return;
    Args a{};
    a.x = (const float*)d_in[0]; a.norm_mix = (const float*)d_in[1]; a.w_qkv_even = (const float*)d_in[2]; a.w_o_even = (const float*)d_in[3];
    a.w_qkvf_odd = (const float*)d_in[4]; a.b_forget = (const float*)d_in[5]; a.w_o_odd = (const float*)d_in[6]; a.norm_ffn = (const float*)d_in[7];
    a.w_ffn_in = (const float*)d_in[8]; a.w_ffn_out = (const float*)d_in[9]; a.norm_final = (const float*)d_in[10];
    a.out = (float*)d_out; a.ws = (unsigned char*)d_ws;
#if N_LAUNCH_MODE == 1
    a.ph_lo = 0; a.ph_hi = NPHASE;
    void* args[] = {&a};
    hipError_t e = hipLaunchCooperativeKernel((const void*)fwd_kernel, dim3(grid), dim3(NTHR), args, LDS_BYTES, stream);
    if (e != hipSuccess) fprintf(stderr, "cooperative launch failed: %s (grid %d)\n", hipGetErrorString(e), grid);
#else
    for (int ph = 0; ph < NPHASE; ++ph) {
        a.ph_lo = ph; a.ph_hi = ph + 1;
        hipLaunchKernelGGL(fwd_kernel, dim3(grid), dim3(NTHR), LDS_BYTES, stream, a);
    }
#endif
}
```

```cpp
#include <hip/hip_runtime.h>
#include <hip/hip_cooperative_groups.h>
#include <cstdio>
#include <cstdint>
namespace cg = cooperative_groups;
namespace pg8 {
#define PG8_LAS __attribute__((address_space(3)))
typedef unsigned short bf16_t;
typedef short bf16x8 __attribute__((ext_vector_type(8)));
typedef float f32x4 __attribute__((ext_vector_type(4)));
typedef unsigned u32x4 __attribute__((ext_vector_type(4)));
constexpr int BM = 256, BK = 64, HALF = 128, HTB = HALF * BK * 2  , STAGE_BYTES = 8 * HTB, NXCD = 8, WGM = 8;

__host__ __device__ __forceinline__ int lds_byte(int r, int c) { const int st = (r >> 4) * 2 + (c >> 5), rr = r & 15, cc = c & 31, ob = rr * 64 + cc * 2; return st * 1024 + (ob ^ (((ob >> 9) & 1) << 5)); }
__host__ __device__ __forceinline__ void stage_rc(int b, int& R, int& C) { const int st = b / 1024, sb = b % 1024, swz = sb ^ (((sb >> 9) & 1) << 5); R = (st >> 1) * 16 + swz / 64; C = (st & 1) * 32 + (swz % 64) / 2; }
__host__ __device__ __forceinline__ int perm32(int rho) { const int n = rho >> 4, i = rho & 15; return 8 * (i >> 2) + 4 * n + (i & 3); }

struct Unit { int pm, pn; };
struct Gemm { const bf16_t* A; const bf16_t* Bt; int M, N, K; };

struct StaticOrder {
    int nM, nN, nwg, G, c;
    __host__ __device__ void init(int M, int N, int G_, int c_) { nM = M / BM; nN = N / BM; nwg = nM * nN; G = G_; c = c_; }
    __host__ __device__ bool next(int i, Unit& u) const {
        const long L = (long)i * G + c; if (L >= nwg) return false;
        int wgid = (int)L; { const int q = nwg / NXCD, r = nwg % NXCD, xcd = wgid % NXCD, off = wgid / NXCD; wgid = (xcd < r ? xcd * (q + 1) : r * (q + 1) + (xcd - r) * q) + off; }
        const int nig = WGM * nN, gid = wgid / nig, fm = gid * WGM, gsz = (nM - fm) < WGM ? (nM - fm) : WGM;
        u.pm = fm + ((wgid % nig) % gsz); u.pn = (wgid % nig) / gsz; return true;
    }
    __device__ __forceinline__ void a_ready(const Unit&) const {}
    __device__ __forceinline__ void done(const Unit&) const {}
};

__device__ __forceinline__ unsigned cvt_pk_bf16(float lo, float hi) { unsigned r; asm volatile("v_cvt_pk_bf16_f32 %0, %1, %2" : "=v"(r) : "v"(lo), "v"(hi)); return r; }
constexpr float RMS_EPS_F = 1e-5f;
__device__ __forceinline__ float rstd_of(const float* rowss, int row) { return 1.0f / sqrtf(rowss[row] * (1.0f / 1024.0f) + RMS_EPS_F); }

struct EpiQKV {
    static constexpr bool PERM = true, AFTER_DRAIN = false;
    bf16_t* O; const float* rowss; const float* rot; int rope;
    __device__ __forceinline__ void operator()(const f32x4 (&acc)[2][2][4][2], const Unit& u, int wr, int wc, int fr, int fq) const {
        const int row0 = u.pm * BM + wr * 64 + fr;
        const int col0 = u.pn * BM + wc * 32 + 8 * fq;
        const bool rt = rope && ((u.pn & 2) != 0) && (u.pn < 8) && ((wc & 1) == 0);
#pragma unroll
        for (int ai = 0; ai < 2; ++ai)
#pragma unroll
            for (int m = 0; m < 4; ++m) {
                const int row = row0 + ai * HALF + m * 16;
                const float rs = rstd_of(rowss, row);
                bf16_t* rowp = O + (size_t)row * 3072 + col0;
                f32x4 c0 = {1.f, 1.f, 1.f, 1.f}, c1 = c0, s0 = {0.f, 0.f, 0.f, 0.f}, s1 = s0;
                if (rt) { const f32x4* rp = (const f32x4*)(rot + (size_t)(row & 2047) * 16); c0 = rp[0]; c1 = rp[1]; s0 = rp[2]; s1 = rp[3]; }
#pragma unroll
                for (int bj = 0; bj < 2; ++bj) {
                    f32x4 v0 = acc[ai][bj][m][0] * rs, v1 = acc[ai][bj][m][1] * rs;
                    if (rt) {
                        f32x4 p0, p1;
#pragma unroll
                        for (int e = 0; e < 4; ++e) { p0[e] = __shfl_xor(v0[e], 16); p1[e] = __shfl_xor(v1[e], 16); }
                        if (fq == 0) { v0 = v0 * c0 - p0 * s0; v1 = v1 * c1 - p1 * s1; }
                        else if (fq == 1) { v0 = v0 * c0 + p0 * s0; v1 = v1 * c1 + p1 * s1; }
                    }
                    u32x4 w; w.x = cvt_pk_bf16(v0[0], v0[1]); w.y = cvt_pk_bf16(v0[2], v0[3]); w.z = cvt_pk_bf16(v1[0], v1[1]); w.w = cvt_pk_bf16(v1[2], v1[3]);
                    *(u32x4*)(rowp + bj * HALF) = w;
                }
            }
    }
};

struct EpiResid {
    static constexpr bool PERM = true, AFTER_DRAIN = false;
    const float* xin; float* xout; bf16_t* xb; float* rowss_next;
    __device__ __forceinline__ void operator()(const f32x4 (&acc)[2][2][4][2], const Unit& u, int wr, int wc, int fr, int fq) const {
        const int row0 = u.pm * BM + wr * 64 + fr;
        const int col0 = u.pn * BM + wc * 32 + 8 * fq;
#pragma unroll
        for (int ai = 0; ai < 2; ++ai)
#pragma unroll
            for (int m = 0; m < 4; ++m) {
                const int row = row0 + ai * HALF + m * 16;
                float ss = 0.f;
#pragma unroll
                for (int bj = 0; bj < 2; ++bj) {
                    const size_t off = (size_t)row * 1024 + col0 + bj * HALF;
                    const f32x4* xi = (const f32x4*)(xin + off);
                    const f32x4 a0 = xi[0] + acc[ai][bj][m][0], a1 = xi[1] + acc[ai][bj][m][1];
                    f32x4* xo = (f32x4*)(xout + off); xo[0] = a0; xo[1] = a1;
                    ss += (a0[0] * a0[0] + a0[1] * a0[1]) + (a0[2] * a0[2] + a0[3] * a0[3]) + (a1[0] * a1[0] + a1[1] * a1[1]) + (a1[2] * a1[2] + a1[3] * a1[3]);
                    u32x4 w; w.x = cvt_pk_bf16(a0[0], a0[1]); w.y = cvt_pk_bf16(a0[2], a0[3]); w.z = cvt_pk_bf16(a1[0], a1[1]); w.w = cvt_pk_bf16(a1[2], a1[3]);
                    *(u32x4*)(xb + off) = w;
                }
                ss += __shfl_xor(ss, 16); ss += __shfl_xor(ss, 32);
                if (fq == 0) atomicAdd(rowss_next + row, ss);
            }
    }
};

struct EpiSwiGLU {
    static constexpr bool PERM = true, AFTER_DRAIN = false;
    bf16_t* H; const float* rowss;
    __device__ __forceinline__ void operator()(const f32x4 (&acc)[2][2][4][2], const Unit& u, int wr, int wc, int fr, int fq) const {
        const int row0 = u.pm * BM + wr * 64 + fr;
        const int col0 = u.pn * HALF + wc * 32 + 8 * fq;
#pragma unroll
        for (int ai = 0; ai < 2; ++ai)
#pragma unroll
            for (int m = 0; m < 4; ++m) {
                const int row = row0 + ai * HALF + m * 16;
                const float rs = rstd_of(rowss, row);
                float h[8];
#pragma unroll
                for (int n = 0; n < 2; ++n)
#pragma unroll
                    for (int e = 0; e < 4; ++e) {
                        const float g = acc[ai][0][m][n][e] * rs, up = acc[ai][1][m][n][e] * rs;
                        const float sg = g * __builtin_amdgcn_rcpf(1.0f + __builtin_amdgcn_exp2f(-1.4426950408889634f * g));
                        h[n * 4 + e] = sg * up;
                    }
                u32x4 w; w.x = cvt_pk_bf16(h[0], h[1]); w.y = cvt_pk_bf16(h[2], h[3]); w.z = cvt_pk_bf16(h[4], h[5]); w.w = cvt_pk_bf16(h[6], h[7]);
                *(u32x4*)(H + (size_t)row * 2816 + col0) = w;
            }
    }
};

template <class Epi, class Sched, bool ALIGN_EPI = false, bool SP2 = false>
__device__ __forceinline__ void gemm_phase(PG8_LAS unsigned char* lds, const Gemm g, const Sched& S, const Epi& E) {
    int tid_ = threadIdx.x; asm volatile("" : "+v"(tid_));
    const int tid = tid_, wid = __builtin_amdgcn_readfirstlane(tid >> 6), lane = tid & 63, wr = wid >> 2, wc = wid & 3, fr = lane & 15, fq = lane >> 4;
    const int K = g.K, nt = K / BK;
    unsigned voffA[2], voffB[2];
#pragma unroll
    for (int i = 0; i < 2; ++i) { int R, C; stage_rc(tid * 16 + i * 8192, R, C); const int Rb = Epi::PERM ? ((R & ~31) + perm32(R & 31)) : R;
        voffA[i] = (unsigned)(R * K + C) * 2u; voffB[i] = (unsigned)(Rb * K + C) * 2u; }
    const size_t kstep = (size_t)(BK * 2);
    const size_t hstep = (size_t)HALF * K * 2;
    const size_t tstep = 2 * hstep;
    const unsigned ldsw = (unsigned)wid * 1024u;
    const int aoff = lds_byte(wr * 64 + fr, fq * 8), boff = lds_byte(wc * 32 + fr, fq * 8);
#define PG8_SA(b, h) (((b) * 2 + (h)) * HTB)
#define PG8_SB(b, h) ((4 + (b) * 2 + (h)) * HTB)
#define PG8_STAGE(bufoff, gbase, voff) do { _Pragma("unroll") for (int _i = 0; _i < 2; ++_i) \
        __builtin_amdgcn_global_load_lds((const unsigned*)((const char*)(gbase) + (voff)[_i]), (PG8_LAS unsigned*)(lds + (bufoff) + ldsw + _i * 8192), 16, 0, 0); } while (0)
#define PG8_LDA(dst, b, h) do { _Pragma("unroll") for (int m = 0; m < 4; ++m) _Pragma("unroll") for (int k = 0; k < 2; ++k) dst[m][k] = *(const PG8_LAS bf16x8*)(lds + PG8_SA(b, h) + aoff + m * 2048 + k * 1024); } while (0)
#define PG8_LDB(dst, b, h) do { _Pragma("unroll") for (int n = 0; n < 2; ++n) _Pragma("unroll") for (int k = 0; k < 2; ++k) dst[n][k] = *(const PG8_LAS bf16x8*)(lds + PG8_SB(b, h) + boff + n * 2048 + k * 1024); } while (0)
#define PG8_MMA(ai, bj, At, Bt) do { __builtin_amdgcn_s_setprio(1); _Pragma("unroll") for (int m = 0; m < 4; ++m) _Pragma("unroll") for (int n = 0; n < 2; ++n) _Pragma("unroll") for (int k = 0; k < 2; ++k) \
        acc[ai][bj][m][n] = __builtin_amdgcn_mfma_f32_16x16x32_bf16(Bt[n][k], At[m][k], acc[ai][bj][m][n], 0, 0, 0); __builtin_amdgcn_s_setprio(0); } while (0)
#define PG8_WAIT_V(n) asm volatile("s_waitcnt vmcnt(" #n ")" ::: "memory")
#define PG8_WAIT_L(n) asm volatile("s_waitcnt lgkmcnt(" #n ")" ::: "memory")
#define PG8_BAR __builtin_amdgcn_s_barrier()
#define PG8_SCHED __builtin_amdgcn_sched_barrier(0)
    Unit cur, nxt; int ui = 0;
    if (!S.next(0, cur)) return;
    f32x4 acc[2][2][4][2];
#pragma unroll
    for (int a = 0; a < 2; ++a)
#pragma unroll
        for (int b = 0; b < 2; ++b)
#pragma unroll
            for (int m = 0; m < 4; ++m)
#pragma unroll
                for (int n = 0; n < 2; ++n) acc[a][b][m][n] = (f32x4){0.f, 0.f, 0.f, 0.f};
    bf16x8 At[4][2], B0[2][2], B1[2][2];
    const char* cA = (const char*)g.A + (size_t)cur.pm * tstep; const char* cB = (const char*)g.Bt + (size_t)cur.pn * tstep;
    S.a_ready(cur);
    if constexpr (SP2) {
        PG8_STAGE(PG8_SB(0, 0), cB, voffB); PG8_STAGE(PG8_SB(0, 1), cB + hstep, voffB); PG8_STAGE(PG8_SA(0, 0), cA, voffA); PG8_STAGE(PG8_SA(0, 1), cA + hstep, voffA);
        if (wr == 1) PG8_BAR;
        PG8_WAIT_V(2); PG8_BAR;
        PG8_STAGE(PG8_SB(1, 0), cB + kstep, voffB); PG8_STAGE(PG8_SA(1, 0), cA + kstep, voffA); PG8_STAGE(PG8_SB(1, 1), cB + hstep + kstep, voffB);
        PG8_WAIT_V(6); PG8_BAR;
    } else {
        PG8_STAGE(PG8_SB(0, 0), cB, voffB); PG8_STAGE(PG8_SA(0, 0), cA, voffA); PG8_STAGE(PG8_SB(0, 1), cB + hstep, voffB); PG8_STAGE(PG8_SA(0, 1), cA + hstep, voffA);
        if (wr == 1) PG8_BAR;
        PG8_WAIT_V(4); PG8_BAR;
        PG8_STAGE(PG8_SB(1, 0), cB + kstep, voffB); PG8_STAGE(PG8_SA(1, 0), cA + kstep, voffA); PG8_STAGE(PG8_SB(1, 1), cB + hstep + kstep, voffB);
        PG8_WAIT_V(6); PG8_BAR;
    }
    for (;;) {
        const bool has_next = S.next(ui + 1, nxt);
        const char* nA = has_next ? (const char*)g.A + (size_t)nxt.pm * tstep : cA; const char* nB = has_next ? (const char*)g.Bt + (size_t)nxt.pn * tstep : cB;
        for (int t = 0; t < nt; t += 2) {
            const bool last = (t == nt - 2);
            const char* a1 = cA + (size_t)(t + 1) * kstep;
            const char* a2 = last ? nA : cA + (size_t)(t + 2) * kstep; const char* b2 = last ? nB : cB + (size_t)(t + 2) * kstep;
            const char* a3 = a2 + kstep; const char* b3 = b2 + kstep;
            if (last && has_next) S.a_ready(nxt);
            if constexpr (SP2) {
            PG8_LDB(B0, 0, 0); PG8_LDB(B1, 0, 1); PG8_SCHED; PG8_LDA(At, 0, 0); PG8_STAGE(PG8_SA(1, 1), a1 + hstep, voffA);
            PG8_WAIT_V(8); PG8_WAIT_L(0); PG8_BAR; PG8_MMA(0, 0, At, B0); PG8_MMA(0, 1, At, B1); PG8_BAR; PG8_SCHED;
            PG8_LDA(At, 0, 1); PG8_STAGE(PG8_SB(0, 0), b2, voffB); PG8_STAGE(PG8_SB(0, 1), b2 + hstep, voffB); PG8_STAGE(PG8_SA(0, 0), a2, voffA);
            PG8_WAIT_V(8); PG8_WAIT_L(0); PG8_BAR; PG8_MMA(1, 0, At, B0); PG8_MMA(1, 1, At, B1); PG8_BAR; PG8_SCHED;
            PG8_LDB(B0, 1, 0); PG8_LDB(B1, 1, 1); PG8_SCHED; PG8_LDA(At, 1, 0); PG8_STAGE(PG8_SA(0, 1), a2 + hstep, voffA);
            PG8_WAIT_V(8); PG8_WAIT_L(0); PG8_BAR; PG8_MMA(0, 0, At, B0); PG8_MMA(0, 1, At, B1); PG8_BAR; PG8_SCHED;
            PG8_LDA(At, 1, 1); PG8_STAGE(PG8_SB(1, 0), b3, voffB); PG8_STAGE(PG8_SB(1, 1), b3 + hstep, voffB); PG8_STAGE(PG8_SA(1, 0), a3, voffA);
            PG8_WAIT_V(8); PG8_WAIT_L(0); PG8_BAR; PG8_MMA(1, 0, At, B0); PG8_MMA(1, 1, At, B1); PG8_BAR; PG8_SCHED;
            } else {
            PG8_LDB(B0, 0, 0); PG8_SCHED; PG8_LDA(At, 0, 0); PG8_STAGE(PG8_SA(1, 1), a1 + hstep, voffA);
            PG8_WAIT_L(8); PG8_BAR; PG8_WAIT_L(0); PG8_MMA(0, 0, At, B0); PG8_BAR; PG8_SCHED;
            PG8_LDB(B1, 0, 1); PG8_STAGE(PG8_SB(0, 0), b2, voffB);
            PG8_BAR; PG8_WAIT_L(0); PG8_MMA(0, 1, At, B1); PG8_BAR;
            PG8_LDA(At, 0, 1); PG8_STAGE(PG8_SA(0, 0), a2, voffA);
            PG8_BAR; PG8_WAIT_L(0); PG8_MMA(1, 0, At, B0); PG8_BAR; PG8_SCHED;
            PG8_STAGE(PG8_SB(0, 1), b2 + hstep, voffB);
            PG8_WAIT_V(6); PG8_BAR; PG8_MMA(1, 1, At, B1); PG8_BAR;
            PG8_LDB(B0, 1, 0); PG8_SCHED; PG8_LDA(At, 1, 0); PG8_STAGE(PG8_SA(0, 1), a2 + hstep, voffA);
            PG8_WAIT_L(8); PG8_BAR; PG8_WAIT_L(0); PG8_MMA(0, 0, At, B0); PG8_BAR; PG8_SCHED;
            PG8_LDB(B1, 1, 1); PG8_STAGE(PG8_SB(1, 0), b3, voffB);
            PG8_BAR; PG8_WAIT_L(0); PG8_MMA(0, 1, At, B1); PG8_BAR;
            PG8_LDA(At, 1, 1); PG8_STAGE(PG8_SA(1, 0), a3, voffA);
            PG8_BAR; PG8_WAIT_L(0); PG8_MMA(1, 0, At, B0); PG8_BAR; PG8_SCHED;
            PG8_STAGE(PG8_SB(1, 1), b3 + hstep, voffB);
            PG8_WAIT_V(6); PG8_BAR; PG8_MMA(1, 1, At, B1); PG8_BAR;
            }
        }
        if constexpr (ALIGN_EPI) { if (wr == 0) PG8_BAR; }
        if constexpr (!Epi::AFTER_DRAIN) { E(acc, cur, wr, wc, fr, fq); S.done(cur); }
        if (!has_next) break;
#pragma unroll
        for (int a = 0; a < 2; ++a)
#pragma unroll
            for (int b = 0; b < 2; ++b)
#pragma unroll
                for (int m = 0; m < 4; ++m)
#pragma unroll
                    for (int n = 0; n < 2; ++n) acc[a][b][m][n] = (f32x4){0.f, 0.f, 0.f, 0.f};
        cur = nxt; cA = nA; cB = nB; ++ui;
        if constexpr (ALIGN_EPI) { if (wr == 1) PG8_BAR; }
    }
    PG8_WAIT_V(0);
    if constexpr (!ALIGN_EPI) { if (wr == 0) PG8_BAR; }
    PG8_BAR;
    if constexpr (Epi::AFTER_DRAIN) { E.fused(acc, cur, wr, wc, fr, fq, lds, wid, lane); S.done(cur); }
#undef PG8_SA
#undef PG8_SB
#undef PG8_STAGE
#undef PG8_LDA
#undef PG8_LDB
#undef PG8_MMA
#undef PG8_WAIT_V
#undef PG8_WAIT_L
#undef PG8_BAR
#undef PG8_SCHED
}
}
#include <hip/hip_bf16.h>
#include <cmath>
namespace attn_body {
using bf16=__hip_bfloat16;
using bf16x8=__attribute__((ext_vector_type(8)))short;
using s16x4=__attribute__((ext_vector_type(4)))short;
using f32x16=__attribute__((ext_vector_type(16)))float;
using u32x4=__attribute__((ext_vector_type(4)))unsigned;
using f32x4_t=__attribute__((ext_vector_type(4)))float;
constexpr int BATCH=8,NHEAD=16,SEQ=2048,D=64,DM=3072,DMO=1024;
constexpr int NW=8,QBLK=32,QB=QBLK*NW,KVBLK=64,NQB=SEQ/QB;
constexpr int ATTN_PITCH=DM, ATTN_UNIT_ROWS=QB;
__device__ __forceinline__ int crow(int r,int hi){return (r&3)+8*(r>>2)+4*hi;}
#define SBAR() __builtin_amdgcn_sched_barrier(0)
__device__ __forceinline__ void cmask(f32x16&p0,f32x16&p1,int jb,int qrel,int hi){
  const float NEG=-INFINITY; int kb=64*jb+4*hi;
  #pragma unroll
  for(int r=0;r<16;++r){int kv=kb+(r&3)+8*(r>>2); if(kv>qrel)p0[r]=NEG; if(kv+32>qrel)p1[r]=NEG;}
}

constexpr int NSLOT=3, SLOTB=8192;
constexpr int LDS_K=0, LDS_V=NSLOT*SLOTB, LDS_WS=2*NSLOT*SLOTB, LDS_OST=LDS_WS+NW*64*4, LDS_BYTES=LDS_OST+NW*4096;
constexpr float C2=0.125f*1.4426950408889634f;
__device__ __forceinline__ void glds16(const void*gsrc,unsigned lds_dst){unsigned keep;
  asm volatile("s_mov_b32 %0, m0\n\ts_mov_b32 m0, %2\n\ts_nop 0\n\tglobal_load_lds_dwordx4 %1, off\n\ts_mov_b32 m0, %0":"=&s"(keep):"v"(gsrc),"s"(lds_dst):"memory");}
__device__ __forceinline__ float max3f(float a,float b,float c){float r;asm("v_max3_f32 %0, %1, %2, %3":"=v"(r):"v"(a),"v"(b),"v"(c));return r;}
__device__ __forceinline__ float max2f(float a,float b){float r;asm("v_max_f32_e32 %0, %1, %2":"=v"(r):"v"(a),"v"(b));return r;}
__device__ __forceinline__ float fadd_s(float a,float b){float r;asm("v_add_f32_e32 %0, %1, %2":"=v"(r):"v"(a),"v"(b));return r;}
__device__ __forceinline__ float fsub_s(float a,float b){float r;asm("v_sub_f32_e32 %0, %1, %2":"=v"(r):"v"(a),"v"(b));return r;}
typedef float f32x2_t __attribute__((ext_vector_type(2))); typedef __bf16 bf16x2_t __attribute__((ext_vector_type(2)));
__device__ __forceinline__ unsigned cvtpk_s(float lo,float hi){f32x2_t v={lo,hi};bf16x2_t b=__builtin_convertvector(v,bf16x2_t);return __builtin_bit_cast(unsigned,b);}
#define WAIT_BAR(N) asm volatile("s_waitcnt vmcnt(" #N ") lgkmcnt(0)\n\ts_barrier":::"memory")

__device__ __forceinline__ void qkt(f32x16&p0,f32x16&p1,const char*Kslot,const bf16x8*qr,int r32,int hi){
  const char*kb=Kslot+hi*1024+r32*16;
  #pragma unroll
  for(int d0=0;d0<4;++d0){
    const bf16x8 b0=*reinterpret_cast<const bf16x8*>(kb+d0*2048);
    const bf16x8 b1=*reinterpret_cast<const bf16x8*>(kb+d0*2048+512);
    p0=__builtin_amdgcn_mfma_f32_32x32x16_bf16(b0,qr[d0],p0,0,0,0);p1=__builtin_amdgcn_mfma_f32_32x32x16_bf16(b1,qr[d0],p1,0,0,0);}
}
typedef __attribute__((address_space(3))) const char* lds_cptr;
typedef short v4i16_t __attribute__((ext_vector_type(4)));
__device__ __forceinline__ void kload8(bf16x8*kf,lds_cptr kp){
  kf[0]=*(const __attribute__((address_space(3))) bf16x8*)(kp);      kf[1]=*(const __attribute__((address_space(3))) bf16x8*)(kp+512);
  kf[2]=*(const __attribute__((address_space(3))) bf16x8*)(kp+2048); kf[3]=*(const __attribute__((address_space(3))) bf16x8*)(kp+2560);
  kf[4]=*(const __attribute__((address_space(3))) bf16x8*)(kp+4096); kf[5]=*(const __attribute__((address_space(3))) bf16x8*)(kp+4608);
  kf[6]=*(const __attribute__((address_space(3))) bf16x8*)(kp+6144); kf[7]=*(const __attribute__((address_space(3))) bf16x8*)(kp+6656);
}
__device__ __forceinline__ void kload2(bf16x8*kf,lds_cptr kp,int j){ kf[2*j]=*(const __attribute__((address_space(3))) bf16x8*)(kp+j*2048); kf[2*j+1]=*(const __attribute__((address_space(3))) bf16x8*)(kp+j*2048+512); }
__device__ __forceinline__ s16x4 vtr(lds_cptr p){ return __builtin_bit_cast(s16x4,__builtin_amdgcn_ds_read_tr16_b64_v4i16((__attribute__((address_space(3))) v4i16_t*)p)); }
__device__ __forceinline__ float rowmax(const f32x16&p0,const f32x16&p1){
  float a=max3f(p0[0],p0[1],p1[0]),b=max3f(p0[2],p0[3],p1[1]);a=max3f(a,p1[2],p1[3]);
  #pragma unroll
  for(int r=4;r<16;r+=4){a=max3f(a,p0[r],p0[r+1]);b=max3f(b,p0[r+2],p0[r+3]);a=max3f(a,p1[r],p1[r+1]);b=max3f(b,p1[r+2],p1[r+3]);}
  const float m=max2f(a,b);
  auto rr=__builtin_amdgcn_permlane32_swap(__float_as_uint(m),__float_as_uint(m),false,false);
  return max2f(__uint_as_float(rr[0]),__uint_as_float(rr[1]));
}
__device__ __forceinline__ void pv(f32x16*o,int vb,bf16x8 pa0,bf16x8 pa1,bf16x8 pa2,bf16x8 pa3){
  #pragma unroll
  for(int d0=0;d0<2;++d0){s16x4 lo[4],hi[4];
    #pragma unroll
    for(int ks=0;ks<4;++ks){
      asm volatile("ds_read_b64_tr_b16 %0,%1 offset:%c2":"=&v"(lo[ks]):"v"(vb),"i"(d0*4096+ks*1024):"memory");
      asm volatile("ds_read_b64_tr_b16 %0,%1 offset:%c2":"=&v"(hi[ks]):"v"(vb),"i"(d0*4096+ks*1024+512):"memory");}
    asm volatile("s_waitcnt lgkmcnt(0)":::"memory");SBAR();
    #define PK(k) (bf16x8){lo[k][0],lo[k][1],lo[k][2],lo[k][3],hi[k][0],hi[k][1],hi[k][2],hi[k][3]}
    o[d0]=__builtin_amdgcn_mfma_f32_32x32x16_bf16(pa0,PK(0),o[d0],0,0,0);
    o[d0]=__builtin_amdgcn_mfma_f32_32x32x16_bf16(pa1,PK(1),o[d0],0,0,0);
    o[d0]=__builtin_amdgcn_mfma_f32_32x32x16_bf16(pa2,PK(2),o[d0],0,0,0);
    o[d0]=__builtin_amdgcn_mfma_f32_32x32x16_bf16(pa3,PK(3),o[d0],0,0,0);
    #undef PK
  }
}

#ifndef ATTN_STORE16
#define ATTN_STORE16(p,v) (*(u32x4*)(p)=(v))
#endif
template<int THRL> __device__ __forceinline__ void attn_unit(int b,int h,int qb,const bf16*Q,const bf16*__restrict__ K,const bf16*__restrict__ V,bf16*O,char*shm,const __attribute__((address_space(3))) float*Fs){
  int tid_=threadIdx.x; asm volatile("":"+v"(tid_)); const int tid=tid_,lane=tid&63,r32=lane&31,hi=lane>>5;   const int wid=__builtin_amdgcn_readfirstlane(tid>>6);
  const long rowbase=(long)b*SEQ; const int q0=qb*QB;
  const bf16*Qw=Q+(rowbase+q0+wid*QBLK)*DM+h*D;
  const bf16*Kh=K+rowbase*DM+h*D,*Vh=V+rowbase*DM+h*D;
  const unsigned lds0=(unsigned)(uintptr_t)shm;
  float*wsf=(float*)(shm+LDS_WS)+wid*64;
  const bf16*ksrc=Kh+(long)lane*DM+wid*8;
  const bf16*vsrc=Vh+(long)(16*(wid&3)+(lane>>2))*DM+(wid>>2)*32+(lane&3)*8;
  const unsigned kdst=lds0+LDS_K+wid*1024, vdst=lds0+LDS_V+wid*1024;
  #define DMA_K(t,slot) glds16(ksrc+(long)(t)*KVBLK*DM,(unsigned)__builtin_amdgcn_readfirstlane(kdst+(slot)))
  #define DMA_V(t,slot) glds16(vsrc+(long)(t)*KVBLK*DM,(unsigned)__builtin_amdgcn_readfirstlane(vdst+(slot)))
  const int vb0=(int)(lds0+LDS_V)+((lane>>4)&1)*32+(lane&3)*8+(4*hi+((lane&15)>>2))*64;
  const char*Kbase=shm+LDS_K; bf16x8 kf[8];
  const lds_cptr shm3=(lds_cptr)shm; const lds_cptr kp0=shm3+LDS_K+hi*1024+r32*16; const lds_cptr vp0=shm3+LDS_V+((lane>>4)&1)*32+(lane&3)*8+(4*hi+((lane&15)>>2))*64;
  const int NT=(q0+QB)/KVBLK;
  DMA_K(0,0);DMA_V(0,0);DMA_K(1,SLOTB);
  bf16x8 qr[4];
  #pragma unroll
  for(int d0=0;d0<4;++d0)qr[d0]=*reinterpret_cast<const bf16x8*>(&Qw[(long)r32*DM+d0*16+hi*8]);
  float mhat=0.f,l_reg=0.f;f32x16 o[2];o[0]=f32x16{};o[1]=f32x16{};
  const int qrel=wid*QBLK+r32;
  const float Fq=Fs[q0+qrel];
  #define BIAS(C0,C1,t) do{ const __attribute__((address_space(3))) f32x4_t*fk_=(const __attribute__((address_space(3))) f32x4_t*)(Fs+64*(t)+4*hi); const float fb_=Fq-mhat; \
    _Pragma("unroll") for(int g_=0;g_<4;++g_){ const f32x4_t a_=fk_[2*g_], b_=fk_[8+2*g_]; \
      _Pragma("unroll") for(int e_=0;e_<4;++e_){ C0[4*g_+e_]=fb_-a_[e_]; C1[4*g_+e_]=fb_-b_[e_]; } } }while(0)
  #define CMASK(P0,P1,t) do{int jb_=(t)-(NT-4); if(jb_>=0)cmask(P0,P1,jb_,qrel,hi);}while(0)
  bool resc=false;
  #define START(P0,P1) do{ const float rm=rowmax(P0,P1); resc=false; \
    { const float dl=rm; mhat=fadd_s(mhat,dl); \
      _Pragma("unroll") for(int r=0;r<16;++r){P0[r]=fsub_s(P0[r],dl);P1[r]=fsub_s(P1[r],dl);} \
      } \
    _Pragma("unroll") for(int r=0;r<16;++r)P0[r]=__builtin_amdgcn_exp2f(P0[r]); }while(0)
  #define RESC() do{ if(resc){ asm volatile("s_waitcnt lgkmcnt(0)":::"memory"); \
      _Pragma("unroll") for(int d_=0;d_<2;++d_) _Pragma("unroll") for(int r=0;r<16;++r)o[d_][r]*=wsf[crow(r,hi)]; } }while(0)
  f32x16 pA0,pA1,pB0,pB1;
  int sl_prev=0,sl_cur=0,sl_next=SLOTB;
  #define ROT() do{sl_prev=sl_cur;sl_cur=sl_next;sl_next=(sl_next==(NSLOT-1)*SLOTB)?0:sl_next+SLOTB;}while(0)
  DMA_K(2,2*SLOTB);
  WAIT_BAR(3);
  BIAS(pA0,pA1,0); qkt(pA0,pA1,Kbase,qr,r32,hi);asm volatile("s_nop 15\n\ts_nop 7":"+v"(pA0),"+v"(pA1));CMASK(pA0,pA1,0);
  START(pA0,pA1);
  _Pragma("unroll") for(int r=0;r<16;++r)pA1[r]=__builtin_amdgcn_exp2f(pA1[r]);
  WAIT_BAR(0);
  DMA_K(3,0);DMA_V(1,SLOTB);
  ROT();
  kload8(kf,kp0+sl_cur);
  WAIT_BAR(2);
  s16x4 vlo[8],vhi[8]; u32x4 pw0,pw1,pw2,pw3;
  #define PKW(P,B) cvtpk_s(P[B],P[B+1])
  #define PAF(k) __builtin_bit_cast(bf16x8,pw##k)
  #define VFR(i) (bf16x8){vlo[i][0],vlo[i][1],vlo[i][2],vlo[i][3],vhi[i][0],vhi[i][1],vhi[i][2],vhi[i][3]}
  #define PIN(x) asm volatile("":"+v"(x))
  #define MX3(a,b,c) __builtin_fmaxf(__builtin_fmaxf((a),(b)),(c))
  #define GAPA(MF,A0,A1,A2,A3,W0,W1,PW) do{ MF; sacc+=A0; sacc+=A1; sacc+=A2; sacc+=A3; PIN(sacc); W0; W1; PIN(PW); SBAR(); }while(0)
  #define EX(v) __builtin_amdgcn_exp2f(v)
  #define GAPB(MF,X,B) do{ MF; X[B]=EX(X[B]); X[B+1]=EX(X[B+1]); X[B+2]=EX(X[B+2]); X[B+3]=EX(X[B+3]); PIN(X); SBAR(); }while(0)
  #define VRD(i) do{ vlo[i]=vtr(vp_+(((i)>>2)*4096+((i)&3)*1024)); vhi[i]=vtr(vp_+(((i)>>2)*4096+((i)&3)*1024+512)); }while(0)
  #define KRD(G,j) do{ if(G){ kload2(kf,kp0+sl_next,j); SBAR(); } }while(0)
  #define STEP(C0,C1,P0,P1,t,GK,GV,GL) do{ SBAR(); BIAS(C0,C1,t); \
    const lds_cptr vp_=vp0+sl_prev; \
    VRD(0); SBAR(); float sacc=(P0[0]+P0[1]); \
    GAPA(C0=__builtin_amdgcn_mfma_f32_32x32x16_bf16(kf[0],qr[0],C0,0,0,0), P0[2],P0[3],P0[4],P0[5],     pw0[0]=PKW(P0,0), pw0[1]=PKW(P0,2), pw0); \
    VRD(4); SBAR(); GAPA(C1=__builtin_amdgcn_mfma_f32_32x32x16_bf16(kf[1],qr[0],C1,0,0,0), P0[6],P0[7],P0[8],P0[9],     pw0[2]=PKW(P0,4), pw0[3]=PKW(P0,6), pw0); \
    VRD(1); SBAR(); GAPA(C0=__builtin_amdgcn_mfma_f32_32x32x16_bf16(kf[2],qr[1],C0,0,0,0),   P0[10],P0[11],P0[12],P0[13], pw1[0]=PKW(P0,8), pw1[1]=PKW(P0,10), pw1); \
    VRD(5); SBAR(); GAPA(C1=__builtin_amdgcn_mfma_f32_32x32x16_bf16(kf[3],qr[1],C1,0,0,0),   P0[14],P0[15],P1[0],P1[1],   pw1[2]=PKW(P0,12),pw1[3]=PKW(P0,14), pw1); \
    VRD(2); SBAR(); GAPA(C0=__builtin_amdgcn_mfma_f32_32x32x16_bf16(kf[4],qr[2],C0,0,0,0),   P1[2],P1[3],P1[4],P1[5],     pw2[0]=PKW(P1,0), pw2[1]=PKW(P1,2), pw2); \
    VRD(6); SBAR(); GAPA(C1=__builtin_amdgcn_mfma_f32_32x32x16_bf16(kf[5],qr[2],C1,0,0,0),   P1[6],P1[7],P1[8],P1[9],     pw2[2]=PKW(P1,4), pw2[3]=PKW(P1,6), pw2); \
    VRD(3); SBAR(); GAPA(C0=__builtin_amdgcn_mfma_f32_32x32x16_bf16(kf[6],qr[3],C0,0,0,0),   P1[10],P1[11],P1[12],P1[13], pw3[0]=PKW(P1,8), pw3[1]=PKW(P1,10), pw3); \
    VRD(7); SBAR(); GAPA(C1=__builtin_amdgcn_mfma_f32_32x32x16_bf16(kf[7],qr[3],C1,0,0,0),   P1[14],P1[15],0.f,0.f,       pw3[2]=PKW(P1,12),pw3[3]=PKW(P1,14), pw3); \
    l_reg+=sacc; \
    if(GK){DMA_K((t)+3,sl_cur);} if(GV){DMA_V((t)+1,sl_next);} \
    CMASK(C0,C1,t); \
    { float a=MX3(C0[0],C0[1],C1[0]),b=MX3(C0[2],C0[3],C1[1]); a=MX3(a,C1[2],C1[3]); \
      _Pragma("unroll") for(int r=4;r<16;r+=4){a=MX3(a,C0[r],C0[r+1]);b=MX3(b,C0[r+2],C0[r+3]);a=MX3(a,C1[r],C1[r+1]);b=MX3(b,C1[r+2],C1[r+3]);} \
      float rm=__builtin_fmaxf(a,b); { auto rr=__builtin_amdgcn_permlane32_swap(__float_as_uint(rm),__float_as_uint(rm),false,false); rm=__builtin_fmaxf(__uint_as_float(rr[0]),__uint_as_float(rr[1])); } \
      resc=false; \
      if(__builtin_expect(__any(rm>(float)THRL),0)){ const float dl=__builtin_fmaxf(rm,0.f); mhat+=dl; \
        _Pragma("unroll") for(int r=0;r<16;++r){C0[r]-=dl;C1[r]-=dl;} \
        const float f=__builtin_amdgcn_exp2f(-dl); l_reg*=f; if(hi==0)wsf[r32]=f; resc=true; } } \
    SBAR(); \
    GAPB(o[0]=__builtin_amdgcn_mfma_f32_32x32x16_bf16(PAF(0),VFR(0),o[0],0,0,0), C0,0); \
    GAPB(o[1]=__builtin_amdgcn_mfma_f32_32x32x16_bf16(PAF(0),VFR(4),o[1],0,0,0), C0,4); \
    KRD(GL,0); GAPB(o[0]=__builtin_amdgcn_mfma_f32_32x32x16_bf16(PAF(1),VFR(1),o[0],0,0,0), C0,8); \
    KRD(GL,1); GAPB(o[1]=__builtin_amdgcn_mfma_f32_32x32x16_bf16(PAF(1),VFR(5),o[1],0,0,0), C0,12); \
    KRD(GL,2); GAPB(o[0]=__builtin_amdgcn_mfma_f32_32x32x16_bf16(PAF(2),VFR(2),o[0],0,0,0), C1,0); \
    KRD(GL,3); GAPB(o[1]=__builtin_amdgcn_mfma_f32_32x32x16_bf16(PAF(2),VFR(6),o[1],0,0,0), C1,4); \
    GAPB(o[0]=__builtin_amdgcn_mfma_f32_32x32x16_bf16(PAF(3),VFR(3),o[0],0,0,0), C1,8); \
    GAPB(o[1]=__builtin_amdgcn_mfma_f32_32x32x16_bf16(PAF(3),VFR(7),o[1],0,0,0), C1,12); \
    }while(0)
  int t=1;
  #undef CMASK
  #define CMASK(P0,P1,t) do{}while(0)
  for(;t+5<NT;t+=2){
    STEP(pB0,pB1,pA0,pA1,t,true,true,true);     WAIT_BAR(2); RESC(); ROT();
    STEP(pA0,pA1,pB0,pB1,t+1,true,true,true);   WAIT_BAR(2); RESC(); ROT();
  }
  #undef CMASK
  #define CMASK(P0,P1,t) do{int jb_=(t)-(NT-4); if(jb_>=0)cmask(P0,P1,jb_,qrel,hi);}while(0)
  #define ENDW(tt) do{ if((tt)+3<NT){WAIT_BAR(2);} else if((tt)+2<NT){WAIT_BAR(1);} else {WAIT_BAR(0);} }while(0)
  for(;t+1<NT;t+=2){
    STEP(pB0,pB1,pA0,pA1,t,(t+3<NT),(t+1<NT),(t+1<NT));       ENDW(t);   RESC(); ROT();
    STEP(pA0,pA1,pB0,pB1,t+1,(t+4<NT),(t+2<NT),(t+2<NT));     ENDW(t+1); RESC(); ROT();
  }
  STEP(pB0,pB1,pA0,pA1,NT-1,false,false,false); RESC();
  { float sacc=pB0[0]+pB0[1]; _Pragma("unroll") for(int r=2;r<16;++r)sacc+=pB0[r]; _Pragma("unroll") for(int r=0;r<16;++r)sacc+=pB1[r]; l_reg+=sacc;
    pw0=(u32x4){PKW(pB0,0),PKW(pB0,2),PKW(pB0,4),PKW(pB0,6)};pw1=(u32x4){PKW(pB0,8),PKW(pB0,10),PKW(pB0,12),PKW(pB0,14)};pw2=(u32x4){PKW(pB1,0),PKW(pB1,2),PKW(pB1,4),PKW(pB1,6)};pw3=(u32x4){PKW(pB1,8),PKW(pB1,10),PKW(pB1,12),PKW(pB1,14)};
    SBAR(); pv(o,vb0+sl_cur,PAF(0),PAF(1),PAF(2),PAF(3)); }
  #undef PKW
  #undef PAF
  #undef VFR
  #undef PIN
  #undef MX3
  #undef GAPA
  #undef GAPB
  #undef EX
  #undef VRD
  #undef KRD
  #undef STEP
  #undef ENDW
  {auto rr=__builtin_amdgcn_permlane32_swap(__float_as_uint(l_reg),__float_as_uint(l_reg),false,false);l_reg=__uint_as_float(rr[0])+__uint_as_float(rr[1]);}
  if(hi==0)wsf[32+r32]=l_reg;asm volatile("s_waitcnt lgkmcnt(0)":::"memory");
  float rli[16];
  #pragma unroll
  for(int r=0;r<16;++r)rli[r]=__builtin_amdgcn_rcpf(wsf[32+crow(r,hi)]);
  bf16*Ow=O+(rowbase+q0+wid*QBLK)*DMO+h*D;
  { bf16*stg=(bf16*)(shm+LDS_OST)+wid*2048;
    #pragma unroll
    for(int r=0;r<16;++r){const int orow=crow(r,hi);
      #pragma unroll
      for(int d0=0;d0<2;++d0)stg[orow*64+d0*32+r32]=__float2bfloat16(o[d0][r]*rli[r]);}
    asm volatile("s_waitcnt lgkmcnt(0)":::"memory");
    #pragma unroll
    for(int i=0;i<4;++i){const int row=i*8+(lane>>3),ch=lane&7; const u32x4 v=*(const u32x4*)(stg+row*64+ch*8); ATTN_STORE16(Ow+(long)row*DMO+ch*8,v);} }
  asm volatile("s_waitcnt lgkmcnt(0)\n\ts_barrier":::"memory");
  #undef DMA_K
  #undef DMA_V
  #undef CMASK
  #undef START
  #undef RESC
  #undef ROT
  #undef BIAS
}
constexpr int ATTN_LDS_BYTES=LDS_BYTES;
#undef SBAR
#undef WAIT_BAR
}

#define LAS __attribute__((address_space(3)))
typedef unsigned short bf16_t;
typedef short bf16x8 __attribute__((ext_vector_type(8)));
typedef short s16x4 __attribute__((ext_vector_type(4)));
typedef float f32x4 __attribute__((ext_vector_type(4)));
typedef float f32x16 __attribute__((ext_vector_type(16)));
typedef unsigned u32x4 __attribute__((ext_vector_type(4)));
typedef unsigned u32x2 __attribute__((ext_vector_type(2)));

constexpr int NB = 8, SEQ = 2048, DM = 1024, MTOK = NB * SEQ, DFF = 2816, NLAYER = 4, QKV_LD = 3072;
constexpr int NWAVES = 8, NTHR = 512;
constexpr float LOG2E = 1.4426950408889634f;
constexpr int LDS_BYTES = 147456;
constexpr int VROW = 192;
constexpr int VTILE = 32 * VROW;
constexpr int LDS_F = 49152;
constexpr int NPHASE = 2 + 5 * NLAYER;
constexpr int LDS_MISC = 131072;

constexpr size_t MiB = 1u << 20;
constexpr size_t SZ_WQKV = (size_t)3072 * 1024 * 2, SZ_WO = (size_t)1024 * 1024 * 2, SZ_WI = (size_t)5632 * 1024 * 2, SZ_WOUT = (size_t)1024 * 2816 * 2;
constexpr size_t SZ_WLAYER = SZ_WQKV + SZ_WO + SZ_WI + SZ_WOUT;
constexpr size_t WS_W = 0;
constexpr size_t WS_XB = 104 * MiB;
constexpr size_t WS_XRES = WS_XB + 32 * MiB;
constexpr size_t WS_QKV = WS_XRES + 64 * MiB;
constexpr size_t WS_ATT = WS_QKV + 96 * MiB;
constexpr size_t WS_SMALL = WS_ATT + 32 * MiB;
constexpr size_t WS_ROWSS = WS_SMALL;
constexpr size_t WS_ROT = WS_ROWSS + (size_t)9 * MTOK * 4;
constexpr size_t WS_WF = WS_ROT + (size_t)2048 * 16 * 4;
constexpr size_t WS_LOCF = WS_WF + (size_t)2 * 16 * 1024 * 4;
constexpr size_t WS_TOTF = WS_LOCF + (size_t)128 * 2048 * 4;
constexpr size_t WS_LSE = WS_TOTF + (size_t)128 * 32 * 4;
constexpr size_t WS_BAR = WS_LSE + (size_t)2 * MTOK * 8 * 4;
constexpr size_t WS_END = WS_BAR + 16384;
static_assert(SZ_WLAYER * 4 <= 104 * MiB, "weights fit");

struct Args {
    const float* x; const float* norm_mix; const float* w_qkv_even; const float* w_o_even; const float* w_qkvf_odd; const float* b_forget; const float* w_o_odd;
    const float* norm_ffn; const float* w_ffn_in; const float* w_ffn_out; const float* norm_final;
    float* out; unsigned char* ws; int ph_lo, ph_hi;
};

__device__ __forceinline__ unsigned f2bf(float f) { unsigned u = __builtin_bit_cast(unsigned, f); return (u + 0x7fffu + ((u >> 16) & 1u)) >> 16; }
__device__ __forceinline__ unsigned pk2(float lo, float hi) { return f2bf(lo) | (f2bf(hi) << 16); }
__device__ __forceinline__ unsigned cvtpk(float lo, float hi) { unsigned r; asm volatile("v_cvt_pk_bf16_f32 %0, %1, %2" : "=v"(r) : "v"(lo), "v"(hi)); return r; }
__device__ __forceinline__ float wave_sum(float v) {
#pragma unroll
    for (int o = 1; o < 64; o <<= 1) v += __shfl_xor(v, o);
    return v;
}
#define LDS_WAIT() asm volatile("s_waitcnt lgkmcnt(0)" ::: "memory")
__device__ __forceinline__ int otid() { int t = threadIdx.x; asm volatile("" : "+v"(t)); return t; }

__device__ __forceinline__ void transpose_item(const float* W, int ldw, int K, int k0, int src_col, bf16_t* WT, int dst_row, const float* gain, float cscale, LAS float* scr, int lane) {
    const int kr = lane >> 3, c4 = lane & 7;
    f32x4 v[8]; float g[8];
#pragma unroll
    for (int i = 0; i < 8; ++i) { const int kk = 8 * i + kr; v[i] = *(const f32x4*)(W + (size_t)(k0 + kk) * ldw + src_col + 4 * c4); g[i] = gain ? gain[k0 + kk] * cscale : cscale; }
#pragma unroll
    for (int i = 0; i < 8; ++i) { const int kk = 8 * i + kr; LAS float* d = scr + kk * 33 + 4 * c4; d[0] = v[i].x * g[i]; d[1] = v[i].y * g[i]; d[2] = v[i].z * g[i]; d[3] = v[i].w * g[i]; }
    LDS_WAIT(); asm volatile("" ::: "memory");
    const int c = lane & 7;
#pragma unroll
    for (int j = 0; j < 4; ++j) { const int n = (lane >> 3) + 8 * j; const LAS float* s = scr + (8 * c) * 33 + n;
        u32x4 o; o.x = pk2(s[0 * 33], s[1 * 33]); o.y = pk2(s[2 * 33], s[3 * 33]); o.z = pk2(s[4 * 33], s[5 * 33]); o.w = pk2(s[6 * 33], s[7 * 33]);
        *(u32x4*)(WT + (size_t)(dst_row + n) * K + k0 + 8 * c) = o; }
    LDS_WAIT(); asm volatile("" ::: "memory");
}

__device__ __forceinline__ void convert_weights(const Args& a, int l_lo, int l_hi, LAS unsigned char* lds, int gw, int NGW) {
    const int tid = otid(), lane = tid & 63, wave = __builtin_amdgcn_readfirstlane(tid >> 6);
    LAS float* scr = (LAS float*)(lds + wave * 16384);
    constexpr int I_QKV = 16 * 96, I_O = 16 * 32, I_IN = 16 * 176, I_OUT = 44 * 32, I_LAYER = I_QKV + I_O + I_IN + I_OUT;
    for (int it = l_lo * I_LAYER + gw; it < l_hi * I_LAYER; it += NGW) {
        const int l = it / I_LAYER; int r = it % I_LAYER;
        bf16_t* wl = (bf16_t*)(a.ws + WS_W + (size_t)l * SZ_WLAYER);
        if (r < I_QKV) {
            const int kb = r / 96, nb = r % 96, n0 = 32 * nb;
            const float* W = (l & 1) ? a.w_qkvf_odd + (size_t)(l >> 1) * 1024 * 3088 : a.w_qkv_even + (size_t)(l >> 1) * 1024 * 3072;
            transpose_item(W, (l & 1) ? 3088 : 3072, 1024, 64 * kb, n0, wl, n0, a.norm_mix + l * 1024, n0 < 1024 ? 0.125f * LOG2E : 1.0f, scr, lane);
            continue; }
        r -= I_QKV;
        if (r < I_O) {
            const int kb = r / 32, nb = r % 32, n0 = 32 * nb;
            const float* W = (l & 1) ? a.w_o_odd + (size_t)(l >> 1) * 1024 * 1024 : a.w_o_even + (size_t)(l >> 1) * 1024 * 1024;
            transpose_item(W, 1024, 1024, 64 * kb, n0, (bf16_t*)((unsigned char*)wl + SZ_WQKV), n0, nullptr, 1.0f, scr, lane);
            continue; }
        r -= I_O;
        if (r < I_IN) {
            const int kb = r / 176, nb = r % 176, n0 = 32 * nb;
            const int pn = n0 >> 8, bj = (n0 >> 7) & 1, c0 = n0 & 127;
            transpose_item(a.w_ffn_in + (size_t)l * 1024 * 5632, 5632, 1024, 64 * kb, bj * 2816 + 128 * pn + c0, (bf16_t*)((unsigned char*)wl + SZ_WQKV + SZ_WO), n0, a.norm_ffn + l * 1024, 1.0f, scr, lane);
            continue; }
        r -= I_IN;
        {
            const int kb = r / 32, nb = r % 32, n0 = 32 * nb;
            transpose_item(a.w_ffn_out + (size_t)l * 2816 * 1024, 1024, 2816, 64 * kb, n0, (bf16_t*)((unsigned char*)wl + SZ_WQKV + SZ_WO + SZ_WI), n0, nullptr, 1.0f, scr, lane);
        }
    }
}

__device__ __forceinline__ void prologue(const Args& a, LAS unsigned char* lds, int vwg, int G) {
    const int tid = otid(), lane = tid & 63, wave = __builtin_amdgcn_readfirstlane(tid >> 6);
    const int gw = vwg * NWAVES + wave, NGW = G * NWAVES;
    convert_weights(a, 0, (G == 256) ? 1 : NLAYER, lds, gw, NGW);
    bf16_t* xb = (bf16_t*)(a.ws + WS_XB); float* rowss = (float*)(a.ws + WS_ROWSS);
    for (int m = gw; m < MTOK; m += NGW) {
        const f32x4* xr = (const f32x4*)(a.x + (size_t)m * DM) + lane; float s = 0.f; f32x4 v[4];
#pragma unroll
        for (int j = 0; j < 4; ++j) { v[j] = xr[64 * j]; s += (v[j].x * v[j].x + v[j].y * v[j].y) + (v[j].z * v[j].z + v[j].w * v[j].w); }
        s = wave_sum(s);
        unsigned long long* o8 = (unsigned long long*)(xb + (size_t)m * DM) + lane;
#pragma unroll
        for (int j = 0; j < 4; ++j) o8[64 * j] = (unsigned long long)pk2(v[j].x, v[j].y) | ((unsigned long long)pk2(v[j].z, v[j].w) << 32);
        if (lane == 0) rowss[m] = s;
    }
    const int gt = vwg * NTHR + tid, NGT = G * NTHR;
    for (int i = gt; i < 8 * MTOK; i += NGT) rowss[MTOK + i] = 0.f;
    float* rot = (float*)(a.ws + WS_ROT);
    for (int i = gt; i < 2048 * 8; i += NGT) {
        const int pos = i >> 3, j = i & 7;
        const float invf[8] = {1.0f, 0.19392274474868576f, 0.03760603093086393f, 0.007292664737217109f, 0.001414213562373095f, 0.0002742481756762073f, 5.318295896944988e-05f, 1.031338537721246e-05f};
        float fq = invf[0];
#pragma unroll
        for (int t = 1; t < 8; ++t) fq = (j == t) ? invf[t] : fq;
        const float ang = (float)pos * fq;
        const double rev = (double)ang * 0.15915494309189535; const float fr = (float)(rev - floor(rev));
        rot[pos * 16 + j] = __builtin_amdgcn_cosf(fr); rot[pos * 16 + 8 + j] = __builtin_amdgcn_sinf(fr);
    }
    float* wf = (float*)(a.ws + WS_WF);
    for (int i = gt; i < 2 * 16 * 1024; i += NGT) {
        const int lo = i >> 14, hd = (i >> 10) & 15, k = i & 1023;
        wf[i] = a.w_qkvf_odd[(size_t)lo * 1024 * 3088 + (size_t)k * 3088 + 3072 + hd] * a.norm_mix[(2 * lo + 1) * 1024 + k];
    }
}

__device__ __forceinline__ void fgate_phase(const Args& a, int lo, LAS unsigned char* lds, int vwg, int G) {
    const int tid = otid(), lane = tid & 63, wave = __builtin_amdgcn_readfirstlane(tid >> 6);
    const float* xres = (const float*)(a.ws + WS_XRES); const float* rowss = (const float*)(a.ws + WS_ROWSS) + (size_t)(2 * (2 * lo + 1)) * MTOK;
    const float* wf = (const float*)(a.ws + WS_WF) + (size_t)lo * 16 * 1024;
    float* locF = (float*)(a.ws + WS_LOCF); float* totF = (float*)(a.ws + WS_TOTF);
    LAS float* lf = (LAS float*)lds;
    const int r16 = lane & 15, g4 = lane >> 4, tile = wave & 3, kh = wave >> 2;
    for (int j = vwg; j < 256; j += G) {
        const f32x4* xr = (const f32x4*)(xres + (size_t)(64 * j + 16 * tile + r16) * DM + 512 * kh + 4 * g4);
        const f32x4* wr = (const f32x4*)(wf + (size_t)r16 * 1024 + 512 * kh + 4 * g4);
        f32x4 acc = {0.f, 0.f, 0.f, 0.f};
#pragma unroll 8
        for (int s = 0; s < 32; ++s) {
            const f32x4 xv = xr[4 * s], wv = wr[4 * s];
            acc = __builtin_amdgcn_mfma_f32_16x16x4f32(xv.x, wv.x, acc, 0, 0, 0);
            acc = __builtin_amdgcn_mfma_f32_16x16x4f32(xv.y, wv.y, acc, 0, 0, 0);
            acc = __builtin_amdgcn_mfma_f32_16x16x4f32(xv.z, wv.z, acc, 0, 0, 0);
            acc = __builtin_amdgcn_mfma_f32_16x16x4f32(xv.w, wv.w, acc, 0, 0, 0);
        }
#pragma unroll
        for (int jj = 0; jj < 4; ++jj) lf[(kh * 64 + 16 * tile + 4 * g4 + jj) * 16 + r16] = acc[jj];
        __syncthreads();
        if (tid < 16) {
            const int b = j >> 5, sl = j & 31; float run = 0.f; float* dst = locF + (size_t)(b * 16 + tid) * 2048 + sl * 64;
            const float bias = a.b_forget[lo * 16 + tid];
            for (int t = 0; t < 64; ++t) {
                const float fl = (lf[t * 16 + tid] + lf[(64 + t) * 16 + tid]) * pg8::rstd_of(rowss, 64 * j + t) + bias;
                const float z2 = fl * LOG2E; const float l2 = -(fmaxf(-z2, 0.f) + __builtin_amdgcn_logf(1.0f + __builtin_amdgcn_exp2f(-fabsf(z2))));
                run += l2; dst[t] = run;
            }
            totF[(b * 16 + tid) * 32 + sl] = run;
        }
        __syncthreads();
    }
}

__device__ __forceinline__ int phi32(int r) { return ((r >> 4) & 1) * 16 + ((r >> 2) & 1) * 8 + ((r >> 3) & 1) * 4 + (r & 3); }
__device__ __forceinline__ s16x4 vtr(const LAS unsigned char* p) { return __builtin_bit_cast(s16x4, __builtin_amdgcn_ds_read_tr16_b64_v4i16((LAS s16x4*)p)); }

template <int MODE, int DBG = 0>
__device__ __forceinline__ void attn_task(const bf16_t* qp, const bf16_t* kp, const bf16_t* vp, size_t rstride, int q0, int kb_lo, int kb_hi,
                                          LAS unsigned char* vlds, const LAS float* Fs, f32x16 (&O)[2], float& lse2) {
    const int lane = otid() & 63, n = lane & 31, hh = lane >> 5;
    bf16x8 qf[4];
    { const bf16_t* p = qp + (size_t)(q0 + n) * rstride + 8 * hh;
#pragma unroll
      for (int ks = 0; ks < 4; ++ks) qf[ks] = *(const bf16x8*)(p + 16 * ks); }
    const int qi = q0 + n;
    float Fq = 0.f; if (MODE == 0) Fq = Fs[qi];
#pragma unroll
    for (int r = 0; r < 16; ++r) { O[0][r] = 0.f; O[1][r] = 0.f; }
    float m = -1e30f, l = 0.f, R = 0.f;
    const bf16_t* kl = kp + (size_t)phi32(n) * rstride + 8 * hh;
    const bf16_t* vl = vp + (size_t)(lane >> 3) * rstride + 8 * (lane & 7);
    LAS unsigned char* vw = vlds + (lane >> 3) * VROW + (lane & 7) * 16;
    const LAS unsigned char* vr = vlds + (8 * hh + ((lane & 15) >> 2)) * VROW + (16 * ((lane >> 4) & 1) + 4 * (lane & 3)) * 2;
    bf16x8 kn[4]; u32x4 vn[4];
#define AT_ISSUE(kb) do { const bf16_t* kk_ = kl + (size_t)(kb) * 32 * rstride; const bf16_t* vv_ = vl + (size_t)(kb) * 32 * rstride; \
        _Pragma("unroll") for (int ks = 0; ks < 4; ++ks) kn[ks] = *(const bf16x8*)(kk_ + 16 * ks); \
        _Pragma("unroll") for (int ii = 0; ii < 4; ++ii) vn[ii] = *(const u32x4*)(vv_ + (size_t)(8 * ii) * rstride); } while (0)
    const int nblk = kb_hi - kb_lo + 1;
    int kb = (MODE == 2) ? kb_hi : kb_lo;
    AT_ISSUE(kb);
    for (int it = 0; it < nblk; ++it) {
        bf16x8 kc[4];
#pragma unroll
        for (int ks = 0; ks < 4; ++ks) kc[ks] = kn[ks];
        asm volatile("" ::: "memory");
#pragma unroll
        for (int ii = 0; ii < 4; ++ii) *(LAS u32x4*)(vw + ii * 8 * VROW) = vn[ii];
        asm volatile("" ::: "memory");
        const int kbn = (MODE == 2) ? kb - 1 : kb + 1;
        if (it + 1 < nblk && DBG != 1) AT_ISSUE(kbn);
        if (DBG != 2) {
        const int key0 = kb * 32 + 8 * hh;
        f32x16 s;
        if (MODE == 0) {
            const LAS f32x4* fk = (const LAS f32x4*)(Fs + key0);
            const f32x4 f0 = fk[0], f1 = fk[1], f2 = fk[4], f3 = fk[5];
#pragma unroll
            for (int e = 0; e < 4; ++e) { s[e] = Fq - f0[e]; s[4 + e] = Fq - f1[e]; s[8 + e] = Fq - f2[e]; s[12 + e] = Fq - f3[e]; }
        } else {
#pragma unroll
            for (int r = 0; r < 16; ++r) s[r] = 0.f;
        }
#pragma unroll
        for (int ks = 0; ks < 4; ++ks) s = __builtin_amdgcn_mfma_f32_32x32x16_bf16(kc[ks], qf[ks], s, 0, 0, 0);
        bf16x8 pb[2];
        if (MODE != 2) {
            const bool diag = (kb * 32 + 31 > q0);
            if (MODE == 1) {
#pragma unroll
                for (int r = 0; r < 16; ++r) { const int ki = key0 + 16 * (r >> 3) + (r & 7); if (ki > qi || ki < qi - 128) s[r] = -1e30f; }
            } else if (diag) {
#pragma unroll
                for (int r = 0; r < 16; ++r) { const int ki = key0 + 16 * (r >> 3) + (r & 7); if (ki > qi) s[r] = -1e30f; }
            }
            float bm = fmaxf(fmaxf(s[0], s[1]), fmaxf(s[2], s[3]));
#pragma unroll
            for (int r = 4; r < 16; r += 4) bm = fmaxf(bm, fmaxf(fmaxf(s[r], s[r + 1]), fmaxf(s[r + 2], s[r + 3])));
            bm = fmaxf(bm, __shfl_xor(bm, 32));
            const float mn = fmaxf(m, bm), alpha = __builtin_amdgcn_exp2f(m - mn); m = mn;
            float ps = 0.f;
#pragma unroll
            for (int r = 0; r < 16; ++r) { s[r] = __builtin_amdgcn_exp2f(s[r] - mn); ps += s[r]; }
            l = l * alpha + ps;
#pragma unroll
            for (int r = 0; r < 16; ++r) { O[0][r] *= alpha; O[1][r] *= alpha; }
        } else {
            const bool diag = (kb * 32 + 31 >= q0);
            float L[16];
#pragma unroll
            for (int r = 0; r < 16; ++r) {
                const float z = s[r], t = __builtin_amdgcn_exp2f(-fabsf(z)), sp = fmaxf(z, 0.f) + __builtin_amdgcn_logf(1.0f + t);
                L[r] = -sp; s[r] = z - sp;
            }
            if (diag) {
#pragma unroll
                for (int r = 0; r < 16; ++r) { const int ki = key0 + 16 * (r >> 3) + (r & 7); if (ki >= qi) { L[r] = 0.f; s[r] = -1e30f; } }
            }
            float sA = ((L[0] + L[1]) + (L[2] + L[3])) + ((L[4] + L[5]) + (L[6] + L[7]));
            float sB = ((L[8] + L[9]) + (L[10] + L[11])) + ((L[12] + L[13]) + (L[14] + L[15]));
            const float pA = __shfl_xor(sA, 32), pB = __shfl_xor(sB, 32);
            const float offA = sB + pB + (hh == 0 ? pA : 0.f), offB = (hh == 0 ? pB : 0.f);
            float run = R + offA;
#pragma unroll
            for (int e = 7; e >= 0; --e) { const float lr = L[e]; s[e] = __builtin_amdgcn_exp2f(s[e] + run); run += lr; }
            run = R + offB;
#pragma unroll
            for (int e = 15; e >= 8; --e) { const float lr = L[e]; s[e] = __builtin_amdgcn_exp2f(s[e] + run); run += lr; }
            R += (sA + sB) + (pA + pB);
        }
        { u32x4 w0, w1;
          w0.x = cvtpk(s[0], s[1]); w0.y = cvtpk(s[2], s[3]); w0.z = cvtpk(s[4], s[5]); w0.w = cvtpk(s[6], s[7]);
          w1.x = cvtpk(s[8], s[9]); w1.y = cvtpk(s[10], s[11]); w1.z = cvtpk(s[12], s[13]); w1.w = cvtpk(s[14], s[15]);
          pb[0] = __builtin_bit_cast(bf16x8, w0); pb[1] = __builtin_bit_cast(bf16x8, w1); }
        asm volatile("" ::: "memory");
#pragma unroll
        for (int db = 0; db < 2; ++db)
#pragma unroll
            for (int kk = 0; kk < 2; ++kk) {
                const s16x4 lo4 = vtr(vr + (16 * kk) * VROW + 64 * db), hi4 = vtr(vr + (16 * kk + 4) * VROW + 64 * db);
                const bf16x8 av = {lo4[0], lo4[1], lo4[2], lo4[3], hi4[0], hi4[1], hi4[2], hi4[3]};
                O[db] = __builtin_amdgcn_mfma_f32_32x32x16_bf16(av, pb[kk], O[db], 0, 0, 0);
            }
        asm volatile("s_waitcnt lgkmcnt(0)" ::: "memory");
        } else { asm volatile("s_waitcnt lgkmcnt(0)" ::: "memory"); O[0][0] += __builtin_bit_cast(float, (int)kc[0][0]) ; }
        if (MODE == 2) { if (__builtin_amdgcn_ballot_w64(R >= -160.f) == 0ull) break; }
        kb = kbn;
    }
#undef AT_ISSUE
    asm volatile("s_waitcnt vmcnt(0)" ::: "memory");
    if (MODE != 2) {
        l += __shfl_xor(l, 32);
        const float inv = 1.0f / l;
#pragma unroll
        for (int r = 0; r < 16; ++r) { O[0][r] *= inv; O[1][r] *= inv; }
        lse2 = m + __builtin_amdgcn_logf(l);
    }
}

__device__ __forceinline__ void store_o_bf16(const f32x16 (&O)[2], bf16_t* att_row  , int hh) {
#pragma unroll
    for (int db = 0; db < 2; ++db)
#pragma unroll
        for (int i = 0; i < 4; ++i) {
            u32x2 w; w.x = cvtpk(O[db][4 * i], O[db][4 * i + 1]); w.y = cvtpk(O[db][4 * i + 2], O[db][4 * i + 3]);
            *(u32x2*)(att_row + 32 * db + 8 * i + 4 * hh) = w;
        }
}

constexpr int LDS_FOXF = 90112;
__device__ __forceinline__ void fox_phase(const Args& a, unsigned char* lds_gen, LAS unsigned char* lds, int vwg, int G) {
    const int tid = otid();
    const bf16_t* qkv = (const bf16_t*)(a.ws + WS_QKV); bf16_t* att = (bf16_t*)(a.ws + WS_ATT);
    const float* locF = (const float*)(a.ws + WS_LOCF); const float* totF = (const float*)(a.ws + WS_TOTF);
    LAS float* Fs = (LAS float*)(lds + LDS_FOXF); LAS float* pre = Fs + 2048;
    for (int j = vwg; j < 256; j += G) {
        const int bh = j >> 1, b = bh >> 4, h = bh & 15;
        __syncthreads();
        if (tid < 32) { float p = 0.f; for (int s = 0; s < tid; ++s) p += totF[bh * 32 + s]; pre[tid] = p; }
        __syncthreads();
        for (int t = tid; t < 2048; t += NTHR) Fs[t] = locF[(size_t)bh * 2048 + t] + pre[t >> 6];
        __syncthreads();
        for (int ui = 0; ui < 4; ++ui) {
            const int u = (j & 1) ? ((ui < 2) ? 2 + ui : 7 - ui) : ((ui < 2) ? ui : 9 - ui);
            attn_body::attn_unit<8>(b, h, u, (const attn_body::bf16*)qkv, (const attn_body::bf16*)(qkv + 1024), (const attn_body::bf16*)(qkv + 2048), (attn_body::bf16*)att, (char*)lds_gen, Fs);
        }
    }
}

template <int PART>
__device__ __forceinline__ void even_attn_phase(const Args& a, LAS unsigned char* lds, int vwg, int G) {
    const int tid = otid(), lane = tid & 63, wave = __builtin_amdgcn_readfirstlane(tid >> 6), n = lane & 31, hh = lane >> 5;
    const bf16_t* qkv = (const bf16_t*)(a.ws + WS_QKV); bf16_t* att = (bf16_t*)(a.ws + WS_ATT);
    bf16_t* part = (bf16_t*)a.out;
    float* plse = (float*)(a.ws + WS_LSE);
    LAS unsigned char* vlds = lds + wave * VTILE;
    const LAS float* nof = (const LAS float*)lds;
    for (int j = vwg; j < 256; j += G) {
        const int bh = j >> 2, b = bh >> 3, hl = bh & 7, c = j & 3;
        if (PART & 1) { const bf16_t* base = qkv + (size_t)(b * SEQ) * QKV_LD + hl * 64;
          for (int ui = 0; ui < 2; ++ui) {
              const int u = ui ? 7 - c : c, qt = 8 * u + wave;
              f32x16 O[2]; float lse;
              attn_task<2>(base, base + 1024, base + 2048, (size_t)QKV_LD, 32 * qt, 0, qt, vlds, nof, O, lse);
              store_o_bf16(O, att + (size_t)(b * SEQ + 32 * qt + n) * DM + hl * 64, hh);
          } }
        if (!(PART & 2)) continue;
        const bf16_t* base = qkv + (size_t)(b * SEQ) * QKV_LD + (8 + hl) * 64;
        for (int p = 0; p < 2; ++p) {
            const int dil = p ? 4 : 1;
            for (int ti = 0; ti < 2; ++ti) {
                const int task = wave + 8 * ti;
                const int res = p ? (task & 3) : 0, tile = p ? (task >> 2) : task;
                const int q0 = (p ? 128 * c : 512 * c) + 32 * tile;
                const int kbh = q0 >> 5, kbl = kbh - 4 < 0 ? 0 : kbh - 4;
                const bf16_t* bp = base + (size_t)res * QKV_LD;
                f32x16 O[2]; float lse;
                attn_task<1>(bp, bp + 1024, bp + 2048, (size_t)dil * QKV_LD, q0, kbl, kbh, vlds, nof, O, lse);
                const int tok = res + dil * (q0 + n);
                if (PART & 4) continue;
                store_o_bf16(O, part + ((size_t)p * MTOK + (size_t)(b * SEQ + tok)) * 512 + hl * 64, hh);
                if (hh == 0) plse[((size_t)p * MTOK + (size_t)(b * SEQ + tok)) * 8 + hl] = lse;
            }
        }
        __syncthreads();
        for (int ti = 0; ti < 2; ++ti) {
            const int res = wave + 8 * ti, q0 = 32 * c;
            const bf16_t* bp = base + (size_t)res * QKV_LD;
            f32x16 O[2]; float lse3;
            attn_task<1>(bp, bp + 1024, bp + 2048, (size_t)16 * QKV_LD, q0, 0, c, vlds, nof, O, lse3);
            const int tok = res + 16 * (q0 + n); const size_t grow = (size_t)(b * SEQ + tok);
            if (PART & 4) { store_o_bf16(O, att + grow * DM + (8 + hl) * 64, hh); continue; }
            const float l1 = plse[grow * 8 + hl], l2 = plse[((size_t)MTOK + grow) * 8 + hl];
            const float mx = fmaxf(lse3, fmaxf(l1, l2));
            float w1 = __builtin_amdgcn_exp2f(l1 - mx), w2 = __builtin_amdgcn_exp2f(l2 - mx), w3 = __builtin_amdgcn_exp2f(lse3 - mx);
            const float inv = 1.0f / (w1 + w2 + w3); w1 *= inv; w2 *= inv; w3 *= inv;
            const bf16_t* p1 = part + grow * 512 + hl * 64; const bf16_t* p2 = part + ((size_t)MTOK + grow) * 512 + hl * 64;
#pragma unroll
            for (int db = 0; db < 2; ++db)
#pragma unroll
                for (int i = 0; i < 4; ++i) {
                    const u32x2 r1 = *(const u32x2*)(p1 + 32 * db + 8 * i + 4 * hh), r2 = *(const u32x2*)(p2 + 32 * db + 8 * i + 4 * hh);
                    const float a1[4] = {__uint_as_float(r1.x << 16), __uint_as_float(r1.x & 0xffff0000u), __uint_as_float(r1.y << 16), __uint_as_float(r1.y & 0xffff0000u)};
                    const float a2[4] = {__uint_as_float(r2.x << 16), __uint_as_float(r2.x & 0xffff0000u), __uint_as_float(r2.y << 16), __uint_as_float(r2.y & 0xffff0000u)};
#pragma unroll
                    for (int e = 0; e < 4; ++e) O[db][4 * i + e] = O[db][4 * i + e] * w3 + a1[e] * w1 + a2[e] * w2;
                }
            store_o_bf16(O, att + grow * DM + (8 + hl) * 64, hh);
        }
        __syncthreads();
    }
}

__device__ __forceinline__ void final_phase(const Args& a, int vwg, int G) {
    const int tid = otid(), lane = tid & 63, wave = tid >> 6;
    const float* xres = (const float*)(a.ws + WS_XRES); const float* rowss = (const float*)(a.ws + WS_ROWSS) + (size_t)8 * MTOK;
    const int gw = vwg * NWAVES + wave, NGW = G * NWAVES;
    f32x4 g[4];
#pragma unroll
    for (int j = 0; j < 4; ++j) g[j] = ((const f32x4*)a.norm_final)[lane + 64 * j];
    for (int m = gw; m < MTOK; m += NGW) {
        const float rs = pg8::rstd_of(rowss, m);
        const f32x4* xr = (const f32x4*)(xres + (size_t)m * DM) + lane; f32x4* o = (f32x4*)(a.out + (size_t)m * DM) + lane;
#pragma unroll
        for (int j = 0; j < 4; ++j) o[64 * j] = xr[64 * j] * rs * g[j];
    }
}

#define XB_TMO      128
#define XB_XCNT(j)  (256  + 64 * (j))
#define XB_XSUB(j)  (1280 + 64 * (j))
#define XB_XGEN(j)  (2304 + 64 * (j))
#define XB_TOP      3328
#define XB_TOPGEN   3392
#define XCD_BAR_WORDS 3456
#define XB_SPIN_CAP (1u << 18)

__device__ __forceinline__ unsigned xb_ld(unsigned* p)              { return __hip_atomic_load(p, __ATOMIC_RELAXED, __HIP_MEMORY_SCOPE_AGENT); }
__device__ __forceinline__ unsigned xb_add(unsigned* p, unsigned v) { return __hip_atomic_fetch_add(p, v, __ATOMIC_RELAXED, __HIP_MEMORY_SCOPE_AGENT); }
__device__ __forceinline__ unsigned xb_xcc_id() { return (unsigned)__builtin_amdgcn_s_getreg((3 << 11) | 20) & 0xFu; }
#define XB_SPIN(cond, bar) do { unsigned _sp = 0; while (cond) { __builtin_amdgcn_s_sleep(1); \
    if ((++_sp & 255u) == 0u) { if (xb_ld(&(bar)[XB_TMO])) break; if (_sp > XB_SPIN_CAP) { atomicAdd(&(bar)[XB_TMO], 1u); break; } } } } while (0)

struct XcdBarrier {
    unsigned* bar; unsigned x;
    volatile LAS unsigned* st;
};

__device__ __forceinline__ XcdBarrier xcd_barrier_post(unsigned* bar, volatile LAS unsigned* st) {
    XcdBarrier b; b.bar = bar; b.x = xb_xcc_id(); b.st = st;
    if (threadIdx.x == 0) (void)xb_add(&bar[XB_XCNT(b.x)], 1u);
    return b;
}
__device__ __forceinline__ void xcd_barrier_complete(unsigned* bar, unsigned x, unsigned& nloc, unsigned& nx) {
    const unsigned G = gridDim.x * gridDim.y * gridDim.z;
    unsigned sum, cnt, mine, sp = 0u;
    for (;;) {
        sum = 0u; cnt = 0u; mine = 0u;
#pragma unroll
        for (unsigned j = 0; j < 16; ++j) { const unsigned c = xb_ld(&bar[XB_XCNT(j)]); sum += c; cnt += (c > 0u) ? 1u : 0u; mine = (j == x) ? c : mine; }
        if (sum == G) break;
        __builtin_amdgcn_s_sleep(1);
        if ((++sp & 255u) == 0u) { if (xb_ld(&bar[XB_TMO])) break; if (sp > XB_SPIN_CAP) { atomicAdd(&bar[XB_TMO], 1u); break; } }
    }
    nloc = mine > 0u ? mine : 1u; nx = cnt > 0u ? cnt : 1u;
}

__device__ __forceinline__ void xcd_barrier(const XcdBarrier& b) {
    asm volatile("s_waitcnt vmcnt(0)" ::: "memory");
    __syncthreads();
    if (threadIdx.x == 0) {
        unsigned* bar = b.bar;
        __builtin_amdgcn_s_waitcnt(0);
        unsigned nloc = b.st[0], nx = b.st[1];
        if (nloc == 0u) { xcd_barrier_complete(bar, b.x, nloc, nx); b.st[0] = nloc; b.st[1] = nx; }
        const unsigned old = xb_add(&bar[XB_XSUB(b.x)], 1u);
        const unsigned gen = old / nloc;
        if (old + 1u == (gen + 1u) * nloc) {
            __builtin_amdgcn_fence(__ATOMIC_RELEASE, "agent");
            asm volatile("s_waitcnt vmcnt(0)" ::: "memory");
            const unsigned og = xb_add(&bar[XB_TOP], 1u);
            const unsigned tg = og / nx;
            if (og + 1u == (tg + 1u) * nx) xb_add(&bar[XB_TOPGEN], 1u);
            else XB_SPIN(xb_ld(&bar[XB_TOPGEN]) == tg, bar);
            __builtin_amdgcn_fence(__ATOMIC_ACQUIRE, "agent");
            xb_add(&bar[XB_XGEN(b.x)], 1u);
            asm volatile("s_waitcnt vmcnt(0)" ::: "memory");
        } else {
            XB_SPIN(xb_ld(&bar[XB_XGEN(b.x)]) == gen, bar);
            __builtin_amdgcn_fence(__ATOMIC_ACQUIRE, "agent");
            asm volatile("s_waitcnt vmcnt(0)" ::: "memory");
        }
    }
    __syncthreads();
}

#ifndef DBG_EVEN
#define DBG_EVEN 0
#endif
#ifndef DBG_FOX
#define DBG_FOX 0
#endif
#ifndef REP_QKV
#define REP_QKV 1
#endif
#ifndef REP_FG
#define REP_FG 1
#endif
#ifndef REP_FFI
#define REP_FFI 1
#endif
#ifndef REP_PRO
#define REP_PRO 1
#endif
#ifndef REP_SYNC
#define REP_SYNC 1
#endif
#ifndef REP_FOX
#define REP_FOX 1
#endif
#ifndef REP_EVEN
#define REP_EVEN 1
#endif
__global__ void __launch_bounds__(NTHR, 2) fwd_kernel(Args a) {
    extern __shared__ __attribute__((aligned(16))) unsigned char lds_raw[];
    LAS unsigned char* lds = (LAS unsigned char*)lds_raw;
    cg::grid_group grid = cg::this_grid();
    const int G = gridDim.x, vwg = blockIdx.x;
    unsigned char* ws = a.ws;
    bf16_t* xb = (bf16_t*)(ws + WS_XB); float* xres = (float*)(ws + WS_XRES); bf16_t* qkv = (bf16_t*)(ws + WS_QKV); bf16_t* hid = (bf16_t*)(ws + WS_QKV);
    bf16_t* att = (bf16_t*)(ws + WS_ATT); float* rowss = (float*)(ws + WS_ROWSS); const float* rot = (const float*)(ws + WS_ROT);
    unsigned* barw = (unsigned*)(ws + WS_BAR);
    volatile LAS unsigned* bst = (volatile LAS unsigned*)(lds + LDS_MISC);
    if (threadIdx.x == 0) { bst[0] = 0u; bst[1] = 0u; }
    if (blockIdx.x == 0) { for (int i = threadIdx.x; i < XCD_BAR_WORDS; i += NTHR) barw[i] = 0u; }
    __syncthreads();
    XcdBarrier bar; bar.bar = barw; bar.x = 0; bar.st = bst;
    bool posted = false;
    for (int ph = a.ph_lo; ph < a.ph_hi; ++ph) {
        if (ph == 0) { for (int rep = 0; rep < REP_PRO; ++rep) { prologue(a, lds, vwg, G); __syncthreads(); } }
        else if (ph == NPHASE - 1) final_phase(a, vwg, G);
        else {
            const int l = (ph - 1) / 5, sp = (ph - 1) % 5;
            const bf16_t* wl = (const bf16_t*)(ws + WS_W + (size_t)l * SZ_WLAYER);
            const bf16_t* w_qkv = wl; const bf16_t* w_o = (const bf16_t*)((const unsigned char*)wl + SZ_WQKV);
            const bf16_t* w_in = (const bf16_t*)((const unsigned char*)wl + SZ_WQKV + SZ_WO); const bf16_t* w_out = (const bf16_t*)((const unsigned char*)wl + SZ_WQKV + SZ_WO + SZ_WI);
            if (sp == 0) {
                pg8::Gemm g{xb, w_qkv, MTOK, 3072, 1024}; pg8::StaticOrder S; S.init(MTOK, 3072, G, vwg);
                pg8::EpiQKV E{qkv, rowss + (size_t)(2 * l) * MTOK, rot, (l & 1) ? 0 : 1};
                for (int rep = 0; rep < REP_QKV; ++rep) { pg8::gemm_phase<pg8::EpiQKV, pg8::StaticOrder, true, true>(lds, g, S, E); __syncthreads(); }
                if (l & 1) { for (int rep = 0; rep < REP_FG; ++rep) { __syncthreads(); fgate_phase(a, l >> 1, lds, vwg, G); } }
            } else if (sp == 1) {
                if (l & 1) { fox_phase(a, lds_raw, lds, vwg, G); } else { if (DBG_EVEN) { even_attn_phase<DBG_EVEN>(a, lds, vwg, G); __syncthreads(); } even_attn_phase<3>(a, lds, vwg, G); }
            } else if (sp == 2) {
                pg8::Gemm g{att, w_o, MTOK, 1024, 1024}; pg8::StaticOrder S; S.init(MTOK, 1024, G, vwg);
                pg8::EpiResid E{l == 0 ? a.x : xres, xres, xb, rowss + (size_t)(2 * l + 1) * MTOK};
                pg8::gemm_phase<pg8::EpiResid, pg8::StaticOrder, true, true>(lds, g, S, E);
            } else if (sp == 3) {
                pg8::Gemm g{xb, w_in, MTOK, 5632, 1024}; pg8::StaticOrder S; S.init(MTOK, 5632, G, vwg);
                pg8::EpiSwiGLU E{hid, rowss + (size_t)(2 * l + 1) * MTOK};
                for (int rep = 0; rep < REP_FFI; ++rep) { pg8::gemm_phase<pg8::EpiSwiGLU, pg8::StaticOrder, true, true>(lds, g, S, E); __syncthreads(); }
                if (G == 256 && vwg >= 128 && l + 1 < NLAYER) { __syncthreads(); convert_weights(a, l + 1, l + 2, lds, (vwg - 128) * NWAVES + __builtin_amdgcn_readfirstlane((int)(threadIdx.x >> 6)), 128 * NWAVES); }
            } else {
                pg8::Gemm g{hid, w_out, MTOK, 1024, 2816}; pg8::StaticOrder S; S.init(MTOK, 1024, G, vwg);
                pg8::EpiResid E{xres, xres, xb, rowss + (size_t)(2 * l + 2) * MTOK};
                pg8::gemm_phase<pg8::EpiResid, pg8::StaticOrder, true, true>(lds, g, S, E);
            }
        }
        if (ph + 1 < a.ph_hi) {
            if (!posted) { grid.sync(); bar = xcd_barrier_post(barw, bst); posted = true; }
            else { for (int rep = 0; rep < REP_SYNC; ++rep) xcd_barrier(bar); }
        }
    }
}

#ifndef N_LAUNCH_MODE
#define N_LAUNCH_MODE 1
#endif

extern "C" void kernel_launch(void* const* d_in, const int* in_sizes, int n_in, void* d_out, int out_size, void* d_ws, size_t ws_size, hipStream_t stream) {
    static int grid = 0;
    if (grid == 0) {
        if (n_in != 11 || out_size != MTOK * DM || ws_size < WS_END) { fprintf(stderr, "kernel_launch: unexpected sizes n_in %d out %d ws %zu (need %zu)\n", n_in, out_size, ws_size, (size_t)WS_END); grid = -1; return; }
        int dev = 0, cus = 0, per_cu = 0;
        hipGetDevice(&dev); hipDeviceGetAttribute(&cus, hipDeviceAttributeMultiprocessorCount, dev);
        if (hipFuncSetAttribute((const void*)fwd_kernel, hipFuncAttributeMaxDynamicSharedMemorySize, LDS_BYTES) != hipSuccess) { fprintf(stderr, "kernel_launch: hipFuncSetAttribute failed\n"); grid = -1; return; }
        if (hipOccupancyMaxActiveBlocksPerMultiprocessor(&per_cu, (const void*)fwd_kernel, NTHR, LDS_BYTES) != hipSuccess || per_cu < 1) { fprintf(stderr, "kernel_launch: occupancy query says %d\n", per_cu); per_cu = 1; }
        (void)hipGetLastError();
        grid = cus * 1;
        fprintf(stderr, "kernel_launch: grid %d (cus %d, per_cu %d)\n", grid, cus, per_cu);
    }
    if (grid < 0) return;
    Args a{};
    a.x = (const float*)d_in[0]; a.norm_mix = (const float*)d_in[1]; a.w_qkv_even = (const float*)d_in[2]; a.w_o_even = (const float*)d_in[3];
    a.w_qkvf_odd = (const float*)d_in[4]; a.b_forget = (const float*)d_in[5]; a.w_o_odd = (const float*)d_in[6]; a.norm_ffn = (const float*)d_in[7];
    a.w_ffn_in = (const float*)d_in[8]; a.w_ffn_out = (const float*)d_in[9]; a.norm_final = (const float*)d_in[10];
    a.out = (float*)d_out; a.ws = (unsigned char*)d_ws;
#if N_LAUNCH_MODE == 1
    a.ph_lo = 0; a.ph_hi = NPHASE;
    void* args[] = {&a};
    hipError_t e = hipLaunchCooperativeKernel((const void*)fwd_kernel, dim3(grid), dim3(NTHR), args, LDS_BYTES, stream);
    if (e != hipSuccess) fprintf(stderr, "cooperative launch failed: %s (grid %d)\n", hipGetErrorString(e), grid);
#else
    for (int ph = 0; ph < NPHASE; ++ph) {
        a.ph_lo = ph; a.ph_hi = ph + 1;
        hipLaunchKernelGGL(fwd_kernel, dim3(grid), dim3(NTHR), LDS_BYTES, stream, a);
    }
#endif
}
```

```cpp
#include <hip/hip_runtime.h>
#include <hip/hip_cooperative_groups.h>
#include <cstdio>
#include <cstdint>
namespace cg = cooperative_groups;
namespace pg8 {
#define PG8_LAS __attribute__((address_space(3)))
typedef unsigned short bf16_t;
typedef short bf16x8 __attribute__((ext_vector_type(8)));
typedef float f32x4 __attribute__((ext_vector_type(4)));
typedef unsigned u32x4 __attribute__((ext_vector_type(4)));
constexpr int BM = 256, BK = 64, HALF = 128, HTB = HALF * BK * 2  , STAGE_BYTES = 8 * HTB, NXCD = 8, WGM = 8;

__host__ __device__ __forceinline__ int lds_byte(int r, int c) { const int st = (r >> 4) * 2 + (c >> 5), rr = r & 15, cc = c & 31, ob = rr * 64 + cc * 2; return st * 1024 + (ob ^ (((ob >> 9) & 1) << 5)); }
__host__ __device__ __forceinline__ void stage_rc(int b, int& R, int& C) { const int st = b / 1024, sb = b % 1024, swz = sb ^ (((sb >> 9) & 1) << 5); R = (st >> 1) * 16 + swz / 64; C = (st & 1) * 32 + (swz % 64) / 2; }
__host__ __device__ __forceinline__ int perm32(int rho) { const int n = rho >> 4, i = rho & 15; return 8 * (i >> 2) + 4 * n + (i & 3); }

struct Unit { int pm, pn; };
struct Gemm { const bf16_t* A; const bf16_t* Bt; int M, N, K; };

struct StaticOrder {
    int nM, nN, nwg, G, c;
    __host__ __device__ void init(int M, int N, int G_, int c_) { nM = M / BM; nN = N / BM; nwg = nM * nN; G = G_; c = c_; }
    __host__ __device__ bool next(int i, Unit& u) const {
        const long L = (long)i * G + c; if (L >= nwg) return false;
        int wgid = (int)L; { const int q = nwg / NXCD, r = nwg % NXCD, xcd = wgid % NXCD, off = wgid / NXCD; wgid = (xcd < r ? xcd * (q + 1) : r * (q + 1) + (xcd - r) * q) + off; }
        const int nig = WGM * nN, gid = wgid / nig, fm = gid * WGM, gsz = (nM - fm) < WGM ? (nM - fm) : WGM;
        u.pm = fm + ((wgid % nig) % gsz); u.pn = (wgid % nig) / gsz; return true;
    }
    __device__ __forceinline__ void a_ready(const Unit&) const {}
    __device__ __forceinline__ void done(const Unit&) const {}
};

__device__ __forceinline__ unsigned cvt_pk_bf16(float lo, float hi) { unsigned r; asm volatile("v_cvt_pk_bf16_f32 %0, %1, %2" : "=v"(r) : "v"(lo), "v"(hi)); return r; }
constexpr float RMS_EPS_F = 1e-5f;
__device__ __forceinline__ float rstd_of(const float* rowss, int row) { return 1.0f / sqrtf(rowss[row] * (1.0f / 1024.0f) + RMS_EPS_F); }

struct EpiQKV {
    static constexpr bool PERM = true, AFTER_DRAIN = false;
    bf16_t* O; const float* rowss; const float* rot; int rope;
    __device__ __forceinline__ void operator()(const f32x4 (&acc)[2][2][4][2], const Unit& u, int wr, int wc, int fr, int fq) const {
        const int row0 = u.pm * BM + wr * 64 + fr;
        const int col0 = u.pn * BM + wc * 32 + 8 * fq;
        const bool rt = rope && ((u.pn & 2) != 0) && (u.pn < 8) && ((wc & 1) == 0);
#pragma unroll
        for (int ai = 0; ai < 2; ++ai)
#pragma unroll
            for (int m = 0; m < 4; ++m) {
                const int row = row0 + ai * HALF + m * 16;
                const float rs = rstd_of(rowss, row);
                bf16_t* rowp = O + (size_t)row * 3072 + col0;
                f32x4 c0 = {1.f, 1.f, 1.f, 1.f}, c1 = c0, s0 = {0.f, 0.f, 0.f, 0.f}, s1 = s0;
                if (rt) { const f32x4* rp = (const f32x4*)(rot + (size_t)(row & 2047) * 16); c0 = rp[0]; c1 = rp[1]; s0 = rp[2]; s1 = rp[3]; }
#pragma unroll
                for (int bj = 0; bj < 2; ++bj) {
                    f32x4 v0 = acc[ai][bj][m][0] * rs, v1 = acc[ai][bj][m][1] * rs;
                    if (rt) {
                        f32x4 p0, p1;
#pragma unroll
                        for (int e = 0; e < 4; ++e) { p0[e] = __shfl_xor(v0[e], 16); p1[e] = __shfl_xor(v1[e], 16); }
                        if (fq == 0) { v0 = v0 * c0 - p0 * s0; v1 = v1 * c1 - p1 * s1; }
                        else if (fq == 1) { v0 = v0 * c0 + p0 * s0; v1 = v1 * c1 + p1 * s1; }
                    }
                    u32x4 w; w.x = cvt_pk_bf16(v0[0], v0[1]); w.y = cvt_pk_bf16(v0[2], v0[3]); w.z = cvt_pk_bf16(v1[0], v1[1]); w.w = cvt_pk_bf16(v1[2], v1[3]);
                    *(u32x4*)(rowp + bj * HALF) = w;
                }
            }
    }
};

struct EpiResid {
    static constexpr bool PERM = true, AFTER_DRAIN = false;
    const float* xin; float* xout; bf16_t* xb; float* rowss_next;
    __device__ __forceinline__ void operator()(const f32x4 (&acc)[2][2][4][2], const Unit& u, int wr, int wc, int fr, int fq) const {
        const int row0 = u.pm * BM + wr * 64 + fr;
        const int col0 = u.pn * BM + wc * 32 + 8 * fq;
#pragma unroll
        for (int ai = 0; ai < 2; ++ai)
#pragma unroll
            for (int m = 0; m < 4; ++m) {
                const int row = row0 + ai * HALF + m * 16;
                float ss = 0.f;
#pragma unroll
                for (int bj = 0; bj < 2; ++bj) {
                    const size_t off = (size_t)row * 1024 + col0 + bj * HALF;
                    const f32x4* xi = (const f32x4*)(xin + off);
                    const f32x4 a0 = xi[0] + acc[ai][bj][m][0], a1 = xi[1] + acc[ai][bj][m][1];
                    f32x4* xo = (f32x4*)(xout + off); xo[0] = a0; xo[1] = a1;
                    ss += (a0[0] * a0[0] + a0[1] * a0[1]) + (a0[2] * a0[2] + a0[3] * a0[3]) + (a1[0] * a1[0] + a1[1] * a1[1]) + (a1[2] * a1[2] + a1[3] * a1[3]);
                    u32x4 w; w.x = cvt_pk_bf16(a0[0], a0[1]); w.y = cvt_pk_bf16(a0[2], a0[3]); w.z = cvt_pk_bf16(a1[0], a1[1]); w.w = cvt_pk_bf16(a1[2], a1[3]);
                    *(u32x4*)(xb + off) = w;
                }
                ss += __shfl_xor(ss, 16); ss += __shfl_xor(ss, 32);
                if (fq == 0) atomicAdd(rowss_next + row, ss);
            }
    }
};

struct EpiSwiGLU {
    static constexpr bool PERM = true, AFTER_DRAIN = false;
    bf16_t* H; const float* rowss;
    __device__ __forceinline__ void operator()(const f32x4 (&acc)[2][2][4][2], const Unit& u, int wr, int wc, int fr, int fq) const {
        const int row0 = u.pm * BM + wr * 64 + fr;
        const int col0 = u.pn * HALF + wc * 32 + 8 * fq;
#pragma unroll
        for (int ai = 0; ai < 2; ++ai)
#pragma unroll
            for (int m = 0; m < 4; ++m) {
                const int row = row0 + ai * HALF + m * 16;
                const float rs = rstd_of(rowss, row);
                float h[8];
#pragma unroll
                for (int n = 0; n < 2; ++n)
#pragma unroll
                    for (int e = 0; e < 4; ++e) {
                        const float g = acc[ai][0][m][n][e] * rs, up = acc[ai][1][m][n][e] * rs;
                        const float sg = g * __builtin_amdgcn_rcpf(1.0f + __builtin_amdgcn_exp2f(-1.4426950408889634f * g));
                        h[n * 4 + e] = sg * up;
                    }
                u32x4 w; w.x = cvt_pk_bf16(h[0], h[1]); w.y = cvt_pk_bf16(h[2], h[3]); w.z = cvt_pk_bf16(h[4], h[5]); w.w = cvt_pk_bf16(h[6], h[7]);
                *(u32x4*)(H + (size_t)row * 2816 + col0) = w;
            }
    }
};

template <class Epi, class Sched, bool ALIGN_EPI = false, bool SP2 = false>
__device__ __forceinline__ void gemm_phase(PG8_LAS unsigned char* lds, const Gemm g, const Sched& S, const Epi& E) {
    int tid_ = threadIdx.x; asm volatile("" : "+v"(tid_));
    const int tid = tid_, wid = __builtin_amdgcn_readfirstlane(tid >> 6), lane = tid & 63, wr = wid >> 2, wc = wid & 3, fr = lane & 15, fq = lane >> 4;
    const int K = g.K, nt = K / BK;
    unsigned voffA[2], voffB[2];
#pragma unroll
    for (int i = 0; i < 2; ++i) { int R, C; stage_rc(tid * 16 + i * 8192, R, C); const int Rb = Epi::PERM ? ((R & ~31) + perm32(R & 31)) : R;
        voffA[i] = (unsigned)(R * K + C) * 2u; voffB[i] = (unsigned)(Rb * K + C) * 2u; }
    const size_t kstep = (size_t)(BK * 2);
    const size_t hstep = (size_t)HALF * K * 2;
    const size_t tstep = 2 * hstep;
    const unsigned ldsw = (unsigned)wid * 1024u;
    const int aoff = lds_byte(wr * 64 + fr, fq * 8), boff = lds_byte(wc * 32 + fr, fq * 8);
#define PG8_SA(b, h) (((b) * 2 + (h)) * HTB)
#define PG8_SB(b, h) ((4 + (b) * 2 + (h)) * HTB)
#define PG8_STAGE(bufoff, gbase, voff) do { _Pragma("unroll") for (int _i = 0; _i < 2; ++_i) \
        __builtin_amdgcn_global_load_lds((const unsigned*)((const char*)(gbase) + (voff)[_i]), (PG8_LAS unsigned*)(lds + (bufoff) + ldsw + _i * 8192), 16, 0, 0); } while (0)
#define PG8_LDA(dst, b, h) do { _Pragma("unroll") for (int m = 0; m < 4; ++m) _Pragma("unroll") for (int k = 0; k < 2; ++k) dst[m][k] = *(const PG8_LAS bf16x8*)(lds + PG8_SA(b, h) + aoff + m * 2048 + k * 1024); } while (0)
#define PG8_LDB(dst, b, h) do { _Pragma("unroll") for (int n = 0; n < 2; ++n) _Pragma("unroll") for (int k = 0; k < 2; ++k) dst[n][k] = *(const PG8_LAS bf16x8*)(lds + PG8_SB(b, h) + boff + n * 2048 + k * 1024); } while (0)
#define PG8_MMA(ai, bj, At, Bt) do { __builtin_amdgcn_s_setprio(1); _Pragma("unroll") for (int m = 0; m < 4; ++m) _Pragma("unroll") for (int n = 0; n < 2; ++n) _Pragma("unroll") for (int k = 0; k < 2; ++k) \
        acc[ai][bj][m][n] = __builtin_amdgcn_mfma_f32_16x16x32_bf16(Bt[n][k], At[m][k], acc[ai][bj][m][n], 0, 0, 0); __builtin_amdgcn_s_setprio(0); } while (0)
#define PG8_WAIT_V(n) asm volatile("s_waitcnt vmcnt(" #n ")" ::: "memory")
#define PG8_WAIT_L(n) asm volatile("s_waitcnt lgkmcnt(" #n ")" ::: "memory")
#define PG8_BAR __builtin_amdgcn_s_barrier()
#define PG8_SCHED __builtin_amdgcn_sched_barrier(0)
    Unit cur, nxt; int ui = 0;
    if (!S.next(0, cur)) return;
    f32x4 acc[2][2][4][2];
#pragma unroll
    for (int a = 0; a < 2; ++a)
#pragma unroll
        for (int b = 0; b < 2; ++b)
#pragma unroll
            for (int m = 0; m < 4; ++m)
#pragma unroll
                for (int n = 0; n < 2; ++n) acc[a][b][m][n] = (f32x4){0.f, 0.f, 0.f, 0.f};
    bf16x8 At[4][2], B0[2][2], B1[2][2];
    const char* cA = (const char*)g.A + (size_t)cur.pm * tstep; const char* cB = (const char*)g.Bt + (size_t)cur.pn * tstep;
    S.a_ready(cur);
    if constexpr (SP2) {
        PG8_STAGE(PG8_SB(0, 0), cB, voffB); PG8_STAGE(PG8_SB(0, 1), cB + hstep, voffB); PG8_STAGE(PG8_SA(0, 0), cA, voffA); PG8_STAGE(PG8_SA(0, 1), cA + hstep, voffA);
        if (wr == 1) PG8_BAR;
        PG8_WAIT_V(2); PG8_BAR;
        PG8_STAGE(PG8_SB(1, 0), cB + kstep, voffB); PG8_STAGE(PG8_SA(1, 0), cA + kstep, voffA); PG8_STAGE(PG8_SB(1, 1), cB + hstep + kstep, voffB);
        PG8_WAIT_V(6); PG8_BAR;
    } else {
        PG8_STAGE(PG8_SB(0, 0), cB, voffB); PG8_STAGE(PG8_SA(0, 0), cA, voffA); PG8_STAGE(PG8_SB(0, 1), cB + hstep, voffB); PG8_STAGE(PG8_SA(0, 1), cA + hstep, voffA);
        if (wr == 1) PG8_BAR;
        PG8_WAIT_V(4); PG8_BAR;
        PG8_STAGE(PG8_SB(1, 0), cB + kstep, voffB); PG8_STAGE(PG8_SA(1, 0), cA + kstep, voffA); PG8_STAGE(PG8_SB(1, 1), cB + hstep + kstep, voffB);
        PG8_WAIT_V(6); PG8_BAR;
    }
    for (;;) {
        const bool has_next = S.next(ui + 1, nxt);
        const char* nA = has_next ? (const char*)g.A + (size_t)nxt.pm * tstep : cA; const char* nB = has_next ? (const char*)g.Bt + (size_t)nxt.pn * tstep : cB;
        for (int t = 0; t < nt; t += 2) {
            const bool last = (t == nt - 2);
            const char* a1 = cA + (size_t)(t + 1) * kstep;
            const char* a2 = last ? nA : cA + (size_t)(t + 2) * kstep; const char* b2 = last ? nB : cB + (size_t)(t + 2) * kstep;
            const char* a3 = a2 + kstep; const char* b3 = b2 + kstep;
            if (last && has_next) S.a_ready(nxt);
            if constexpr (SP2) {
            PG8_LDB(B0, 0, 0); PG8_LDB(B1, 0, 1); PG8_SCHED; PG8_LDA(At, 0, 0); PG8_STAGE(PG8_SA(1, 1), a1 + hstep, voffA);
            PG8_WAIT_V(8); PG8_WAIT_L(0); PG8_BAR; PG8_MMA(0, 0, At, B0); PG8_MMA(0, 1, At, B1); PG8_BAR; PG8_SCHED;
            PG8_LDA(At, 0, 1); PG8_STAGE(PG8_SB(0, 0), b2, voffB); PG8_STAGE(PG8_SB(0, 1), b2 + hstep, voffB); PG8_STAGE(PG8_SA(0, 0), a2, voffA);
            PG8_WAIT_V(8); PG8_WAIT_L(0); PG8_BAR; PG8_MMA(1, 0, At, B0); PG8_MMA(1, 1, At, B1); PG8_BAR; PG8_SCHED;
            PG8_LDB(B0, 1, 0); PG8_LDB(B1, 1, 1); PG8_SCHED; PG8_LDA(At, 1, 0); PG8_STAGE(PG8_SA(0, 1), a2 + hstep, voffA);
            PG8_WAIT_V(8); PG8_WAIT_L(0); PG8_BAR; PG8_MMA(0, 0, At, B0); PG8_MMA(0, 1, At, B1); PG8_BAR; PG8_SCHED;
            PG8_LDA(At, 1, 1); PG8_STAGE(PG8_SB(1, 0), b3, voffB); PG8_STAGE(PG8_SB(1, 1), b3 + hstep, voffB); PG8_STAGE(PG8_SA(1, 0), a3, voffA);
            PG8_WAIT_V(8); PG8_WAIT_L(0); PG8_BAR; PG8_MMA(1, 0, At, B0); PG8_MMA(1, 1, At, B1); PG8_BAR; PG8_SCHED;
            } else {
            PG8_LDB(B0, 0, 0); PG8_SCHED; PG8_LDA(At, 0, 0); PG8_STAGE(PG8_SA(1, 1), a1 + hstep, voffA);
            PG8_WAIT_L(8); PG8_BAR; PG8_WAIT_L(0); PG8_MMA(0, 0, At, B0); PG8_BAR; PG8_SCHED;
            PG8_LDB(B1, 0, 1); PG8_STAGE(PG8_SB(0, 0), b2, voffB);
            PG8_BAR; PG8_WAIT_L(0); PG8_MMA(0, 1, At, B1); PG8_BAR;
            PG8_LDA(At, 0, 1); PG8_STAGE(PG8_SA(0, 0), a2, voffA);
            PG8_BAR; PG8_WAIT_L(0); PG8_MMA(1, 0, At, B0); PG8_BAR; PG8_SCHED;
            PG8_STAGE(PG8_SB(0, 1), b2 + hstep, voffB);
            PG8_WAIT_V(6); PG8_BAR; PG8_MMA(1, 1, At, B1); PG8_BAR;
            PG8_LDB(B0, 1, 0); PG8_SCHED; PG8_LDA(At, 1, 0); PG8_STAGE(PG8_SA(0, 1), a2 + hstep, voffA);
            PG8_WAIT_L(8); PG8_BAR; PG8_WAIT_L(0); PG8_MMA(0, 0, At, B0); PG8_BAR; PG8_SCHED;
            PG8_LDB(B1, 1, 1); PG8_STAGE(PG8_SB(1, 0), b3, voffB);
            PG8_BAR; PG8_WAIT_L(0); PG8_MMA(0, 1, At, B1); PG8_BAR;
            PG8_LDA(At, 1, 1); PG8_STAGE(PG8_SA(1, 0), a3, voffA);
            PG8_BAR; PG8_WAIT_L(0); PG8_MMA(1, 0, At, B0); PG8_BAR; PG8_SCHED;
            PG8_STAGE(PG8_SB(1, 1), b3 + hstep, voffB);
            PG8_WAIT_V(6); PG8_BAR; PG8_MMA(1, 1, At, B1); PG8_BAR;
            }
        }
        if constexpr (ALIGN_EPI) { if (wr == 0) PG8_BAR; }
        if constexpr (!Epi::AFTER_DRAIN) { E(acc, cur, wr, wc, fr, fq); S.done(cur); }
        if (!has_next) break;
#pragma unroll
        for (int a = 0; a < 2; ++a)
#pragma unroll
            for (int b = 0; b < 2; ++b)
#pragma unroll
                for (int m = 0; m < 4; ++m)
#pragma unroll
                    for (int n = 0; n < 2; ++n) acc[a][b][m][n] = (f32x4){0.f, 0.f, 0.f, 0.f};
        cur = nxt; cA = nA; cB = nB; ++ui;
        if constexpr (ALIGN_EPI) { if (wr == 1) PG8_BAR; }
    }
    PG8_WAIT_V(0);
    if constexpr (!ALIGN_EPI) { if (wr == 0) PG8_BAR; }
    PG8_BAR;
    if constexpr (Epi::AFTER_DRAIN) { E.fused(acc, cur, wr, wc, fr, fq, lds, wid, lane); S.done(cur); }
#undef PG8_SA
#undef PG8_SB
#undef PG8_STAGE
#undef PG8_LDA
#undef PG8_LDB
#undef PG8_MMA
#undef PG8_WAIT_V
#undef PG8_WAIT_L
#undef PG8_BAR
#undef PG8_SCHED
}
}
#include <hip/hip_bf16.h>
#include <cmath>
namespace attn_body {
using bf16=__hip_bfloat16;
using bf16x8=__attribute__((ext_vector_type(8)))short;
using s16x4=__attribute__((ext_vector_type(4)))short;
using f32x16=__attribute__((ext_vector_type(16)))float;
using u32x4=__attribute__((ext_vector_type(4)))unsigned;
using f32x4_t=__attribute__((ext_vector_type(4)))float;
constexpr int BATCH=8,NHEAD=16,SEQ=2048,D=64,DM=3072,DMO=1024;
constexpr int NW=8,QBLK=32,QB=QBLK*NW,KVBLK=64,NQB=SEQ/QB;
constexpr int ATTN_PITCH=DM, ATTN_UNIT_ROWS=QB;
__device__ __forceinline__ int crow(int r,int hi){return (r&3)+8*(r>>2)+4*hi;}
#define SBAR() __builtin_amdgcn_sched_barrier(0)
__device__ __forceinline__ void cmask(f32x16&p0,f32x16&p1,int jb,int qrel,int hi){
  const float NEG=-INFINITY; int kb=64*jb+4*hi;
  #pragma unroll
  for(int r=0;r<16;++r){int kv=kb+(r&3)+8*(r>>2); if(kv>qrel)p0[r]=NEG; if(kv+32>qrel)p1[r]=NEG;}
}

constexpr int NSLOT=3, SLOTB=8192;
constexpr int LDS_K=0, LDS_V=NSLOT*SLOTB, LDS_WS=2*NSLOT*SLOTB, LDS_OST=LDS_WS+NW*64*4, LDS_BYTES=LDS_OST+NW*4096;
constexpr float C2=0.125f*1.4426950408889634f;
__device__ __forceinline__ void glds16(const void*gsrc,unsigned lds_dst){unsigned keep;
  asm volatile("s_mov_b32 %0, m0\n\ts_mov_b32 m0, %2\n\ts_nop 0\n\tglobal_load_lds_dwordx4 %1, off\n\ts_mov_b32 m0, %0":"=&s"(keep):"v"(gsrc),"s"(lds_dst):"memory");}
__device__ __forceinline__ float max3f(float a,float b,float c){float r;asm("v_max3_f32 %0, %1, %2, %3":"=v"(r):"v"(a),"v"(b),"v"(c));return r;}
__device__ __forceinline__ float max2f(float a,float b){float r;asm("v_max_f32_e32 %0, %1, %2":"=v"(r):"v"(a),"v"(b));return r;}
__device__ __forceinline__ float fadd_s(float a,float b){float r;asm("v_add_f32_e32 %0, %1, %2":"=v"(r):"v"(a),"v"(b));return r;}
__device__ __forceinline__ float fsub_s(float a,float b){float r;asm("v_sub_f32_e32 %0, %1, %2":"=v"(r):"v"(a),"v"(b));return r;}
typedef float f32x2_t __attribute__((ext_vector_type(2))); typedef __bf16 bf16x2_t __attribute__((ext_vector_type(2)));
__device__ __forceinline__ unsigned cvtpk_s(float lo,float hi){f32x2_t v={lo,hi};bf16x2_t b=__builtin_convertvector(v,bf16x2_t);return __builtin_bit_cast(unsigned,b);}
#define WAIT_BAR(N) asm volatile("s_waitcnt vmcnt(" #N ") lgkmcnt(0)\n\ts_barrier":::"memory")

__device__ __forceinline__ void qkt(f32x16&p0,f32x16&p1,const char*Kslot,const bf16x8*qr,int r32,int hi){
  const char*kb=Kslot+hi*1024+r32*16;
  #pragma unroll
  for(int d0=0;d0<4;++d0){
    const bf16x8 b0=*reinterpret_cast<const bf16x8*>(kb+d0*2048);
    const bf16x8 b1=*reinterpret_cast<const bf16x8*>(kb+d0*2048+512);
    p0=__builtin_amdgcn_mfma_f32_32x32x16_bf16(b0,qr[d0],p0,0,0,0);p1=__builtin_amdgcn_mfma_f32_32x32x16_bf16(b1,qr[d0],p1,0,0,0);}
}
typedef __attribute__((address_space(3))) const char* lds_cptr;
typedef short v4i16_t __attribute__((ext_vector_type(4)));
__device__ __forceinline__ void kload8(bf16x8*kf,lds_cptr kp){
  kf[0]=*(const __attribute__((address_space(3))) bf16x8*)(kp);      kf[1]=*(const __attribute__((address_space(3))) bf16x8*)(kp+512);
  kf[2]=*(const __attribute__((address_space(3))) bf16x8*)(kp+2048); kf[3]=*(const __attribute__((address_space(3))) bf16x8*)(kp+2560);
  kf[4]=*(const __attribute__((address_space(3))) bf16x8*)(kp+4096); kf[5]=*(const __attribute__((address_space(3))) bf16x8*)(kp+4608);
  kf[6]=*(const __attribute__((address_space(3))) bf16x8*)(kp+6144); kf[7]=*(const __attribute__((address_space(3))) bf16x8*)(kp+6656);
}
__device__ __forceinline__ void kload2(bf16x8*kf,lds_cptr kp,int j){ kf[2*j]=*(const __attribute__((address_space(3))) bf16x8*)(kp+j*2048); kf[2*j+1]=*(const __attribute__((address_space(3))) bf16x8*)(kp+j*2048+512); }
__device__ __forceinline__ s16x4 vtr(lds_cptr p){ return __builtin_bit_cast(s16x4,__builtin_amdgcn_ds_read_tr16_b64_v4i16((__attribute__((address_space(3))) v4i16_t*)p)); }
__device__ __forceinline__ float rowmax(const f32x16&p0,const f32x16&p1){
  float a=max3f(p0[0],p0[1],p1[0]),b=max3f(p0[2],p0[3],p1[1]);a=max3f(a,p1[2],p1[3]);
  #pragma unroll
  for(int r=4;r<16;r+=4){a=max3f(a,p0[r],p0[r+1]);b=max3f(b,p0[r+2],p0[r+3]);a=max3f(a,p1[r],p1[r+1]);b=max3f(b,p1[r+2],p1[r+3]);}
  const float m=max2f(a,b);
  auto rr=__builtin_amdgcn_permlane32_swap(__float_as_uint(m),__float_as_uint(m),false,false);
  return max2f(__uint_as_float(rr[0]),__uint_as_float(rr[1]));
}
__device__ __forceinline__ void pv(f32x16*o,int vb,bf16x8 pa0,bf16x8 pa1,bf16x8 pa2,bf16x8 pa3){
  #pragma unroll
  for(int d0=0;d0<2;++d0){s16x4 lo[4],hi[4];
    #pragma unroll
    for(int ks=0;ks<4;++ks){
      asm volatile("ds_read_b64_tr_b16 %0,%1 offset:%c2":"=&v"(lo[ks]):"v"(vb),"i"(d0*4096+ks*1024):"memory");
      asm volatile("ds_read_b64_tr_b16 %0,%1 offset:%c2":"=&v"(hi[ks]):"v"(vb),"i"(d0*4096+ks*1024+512):"memory");}
    asm volatile("s_waitcnt lgkmcnt(0)":::"memory");SBAR();
    #define PK(k) (bf16x8){lo[k][0],lo[k][1],lo[k][2],lo[k][3],hi[k][0],hi[k][1],hi[k][2],hi[k][3]}
    o[d0]=__builtin_amdgcn_mfma_f32_32x32x16_bf16(pa0,PK(0),o[d0],0,0,0);
    o[d0]=__builtin_amdgcn_mfma_f32_32x32x16_bf16(pa1,PK(1),o[d0],0,0,0);
    o[d0]=__builtin_amdgcn_mfma_f32_32x32x16_bf16(pa2,PK(2),o[d0],0,0,0);
    o[d0]=__builtin_amdgcn_mfma_f32_32x32x16_bf16(pa3,PK(3),o[d0],0,0,0);
    #undef PK
  }
}

#ifndef ATTN_STORE16
#define ATTN_STORE16(p,v) (*(u32x4*)(p)=(v))
#endif
template<int THRL> __device__ __forceinline__ void attn_unit(int b,int h,int qb,const bf16*Q,const bf16*__restrict__ K,const bf16*__restrict__ V,bf16*O,char*shm,const __attribute__((address_space(3))) float*Fs){
  int tid_=threadIdx.x; asm volatile("":"+v"(tid_)); const int tid=tid_,lane=tid&63,r32=lane&31,hi=lane>>5;   const int wid=__builtin_amdgcn_readfirstlane(tid>>6);
  const long rowbase=(long)b*SEQ; const int q0=qb*QB;
  const bf16*Qw=Q+(rowbase+q0+wid*QBLK)*DM+h*D;
  const bf16*Kh=K+rowbase*DM+h*D,*Vh=V+rowbase*DM+h*D;
  const unsigned lds0=(unsigned)(uintptr_t)shm;
  float*wsf=(float*)(shm+LDS_WS)+wid*64;
  const bf16*ksrc=Kh+(long)lane*DM+wid*8;
  const bf16*vsrc=Vh+(long)(16*(wid&3)+(lane>>2))*DM+(wid>>2)*32+(lane&3)*8;
  const unsigned kdst=lds0+LDS_K+wid*1024, vdst=lds0+LDS_V+wid*1024;
  #define DMA_K(t,slot) glds16(ksrc+(long)(t)*KVBLK*DM,(unsigned)__builtin_amdgcn_readfirstlane(kdst+(slot)))
  #define DMA_V(t,slot) glds16(vsrc+(long)(t)*KVBLK*DM,(unsigned)__builtin_amdgcn_readfirstlane(vdst+(slot)))
  const int vb0=(int)(lds0+LDS_V)+((lane>>4)&1)*32+(lane&3)*8+(4*hi+((lane&15)>>2))*64;
  const char*Kbase=shm+LDS_K; bf16x8 kf[8];
  const lds_cptr shm3=(lds_cptr)shm; const lds_cptr kp0=shm3+LDS_K+hi*1024+r32*16; const lds_cptr vp0=shm3+LDS_V+((lane>>4)&1)*32+(lane&3)*8+(4*hi+((lane&15)>>2))*64;
  const int NT=(q0+QB)/KVBLK;
  DMA_K(0,0);DMA_V(0,0);DMA_K(1,SLOTB);
  bf16x8 qr[4];
  #pragma unroll
  for(int d0=0;d0<4;++d0)qr[d0]=*reinterpret_cast<const bf16x8*>(&Qw[(long)r32*DM+d0*16+hi*8]);
  float mhat=0.f,l_reg=0.f;f32x16 o[2];o[0]=f32x16{};o[1]=f32x16{};
  const int qrel=wid*QBLK+r32;
  const float Fq=Fs[q0+qrel];
  #define BIAS(C0,C1,t) do{ const __attribute__((address_space(3))) f32x4_t*fk_=(const __attribute__((address_space(3))) f32x4_t*)(Fs+64*(t)+4*hi); const float fb_=Fq-mhat; \
    _Pragma("unroll") for(int g_=0;g_<4;++g_){ const f32x4_t a_=fk_[2*g_], b_=fk_[8+2*g_]; \
      _Pragma("unroll") for(int e_=0;e_<4;++e_){ C0[4*g_+e_]=fb_-a_[e_]; C1[4*g_+e_]=fb_-b_[e_]; } } }while(0)
  #define CMASK(P0,P1,t) do{int jb_=(t)-(NT-4); if(jb_>=0)cmask(P0,P1,jb_,qrel,hi);}while(0)
  bool resc=false;
  #define START(P0,P1) do{ const float rm=rowmax(P0,P1); resc=false; \
    { const float dl=rm; mhat=fadd_s(mhat,dl); \
      _Pragma("unroll") for(int r=0;r<16;++r){P0[r]=fsub_s(P0[r],dl);P1[r]=fsub_s(P1[r],dl);} \
      } \
    _Pragma("unroll") for(int r=0;r<16;++r)P0[r]=__builtin_amdgcn_exp2f(P0[r]); }while(0)
  #define RESC() do{ if(resc){ asm volatile("s_waitcnt lgkmcnt(0)":::"memory"); \
      _Pragma("unroll") for(int d_=0;d_<2;++d_) _Pragma("unroll") for(int r=0;r<16;++r)o[d_][r]*=wsf[crow(r,hi)]; } }while(0)
  f32x16 pA0,pA1,pB0,pB1;
  int sl_prev=0,sl_cur=0,sl_next=SLOTB;
  #define ROT() do{sl_prev=sl_cur;sl_cur=sl_next;sl_next=(sl_next==(NSLOT-1)*SLOTB)?0:sl_next+SLOTB;}while(0)
  DMA_K(2,2*SLOTB);
  WAIT_BAR(3);
  BIAS(pA0,pA1,0); qkt(pA0,pA1,Kbase,qr,r32,hi);asm volatile("s_nop 15\n\ts_nop 7":"+v"(pA0),"+v"(pA1));CMASK(pA0,pA1,0);
  START(pA0,pA1);
  _Pragma("unroll") for(int r=0;r<16;++r)pA1[r]=__builtin_amdgcn_exp2f(pA1[r]);
  WAIT_BAR(0);
  DMA_K(3,0);DMA_V(1,SLOTB);
  ROT();
  kload8(kf,kp0+sl_cur);
  WAIT_BAR(2);
  s16x4 vlo[8],vhi[8]; u32x4 pw0,pw1,pw2,pw3;
  #define PKW(P,B) cvtpk_s(P[B],P[B+1])
  #define PAF(k) __builtin_bit_cast(bf16x8,pw##k)
  #define VFR(i) (bf16x8){vlo[i][0],vlo[i][1],vlo[i][2],vlo[i][3],vhi[i][0],vhi[i][1],vhi[i][2],vhi[i][3]}
  #define PIN(x) asm volatile("":"+v"(x))
  #define MX3(a,b,c) __builtin_fmaxf(__builtin_fmaxf((a),(b)),(c))
  #define GAPA(MF,A0,A1,A2,A3,W0,W1,PW) do{ MF; sacc+=A0; sacc+=A1; sacc+=A2; sacc+=A3; PIN(sacc); W0; W1; PIN(PW); SBAR(); }while(0)
  #define EX(v) __builtin_amdgcn_exp2f(v)
  #define GAPB(MF,X,B) do{ MF; X[B]=EX(X[B]); X[B+1]=EX(X[B+1]); X[B+2]=EX(X[B+2]); X[B+3]=EX(X[B+3]); PIN(X); SBAR(); }while(0)
  #define VRD(i) do{ vlo[i]=vtr(vp_+(((i)>>2)*4096+((i)&3)*1024)); vhi[i]=vtr(vp_+(((i)>>2)*4096+((i)&3)*1024+512)); }while(0)
  #define KRD(G,j) do{ if(G){ kload2(kf,kp0+sl_next,j); SBAR(); } }while(0)
  #define STEP(C0,C1,P0,P1,t,GK,GV,GL) do{ SBAR(); BIAS(C0,C1,t); \
    const lds_cptr vp_=vp0+sl_prev; \
    VRD(0); SBAR(); float sacc=(P0[0]+P0[1]); \
    GAPA(C0=__builtin_amdgcn_mfma_f32_32x32x16_bf16(kf[0],qr[0],C0,0,0,0), P0[2],P0[3],P0[4],P0[5],     pw0[0]=PKW(P0,0), pw0[1]=PKW(P0,2), pw0); \
    VRD(4); SBAR(); GAPA(C1=__builtin_amdgcn_mfma_f32_32x32x16_bf16(kf[1],qr[0],C1,0,0,0), P0[6],P0[7],P0[8],P0[9],     pw0[2]=PKW(P0,4), pw0[3]=PKW(P0,6), pw0); \
    VRD(1); SBAR(); GAPA(C0=__builtin_amdgcn_mfma_f32_32x32x16_bf16(kf[2],qr[1],C0,0,0,0),   P0[10],P0[11],P0[12],P0[13], pw1[0]=PKW(P0,8), pw1[1]=PKW(P0,10), pw1); \
    VRD(5); SBAR(); GAPA(C1=__builtin_amdgcn_mfma_f32_32x32x16_bf16(kf[3],qr[1],C1,0,0,0),   P0[14],P0[15],P1[0],P1[1],   pw1[2]=PKW(P0,12),pw1[3]=PKW(P0,14), pw1); \
    VRD(2); SBAR(); GAPA(C0=__builtin_amdgcn_mfma_f32_32x32x16_bf16(kf[4],qr[2],C0,0,0,0),   P1[2],P1[3],P1[4],P1[5],     pw2[0]=PKW(P1,0), pw2[1]=PKW(P1,2), pw2); \
    VRD(6); SBAR(); GAPA(C1=__builtin_amdgcn_mfma_f32_32x32x16_bf16(kf[5],qr[2],C1,0,0,0),   P1[6],P1[7],P1[8],P1[9],     pw2[2]=PKW(P1,4), pw2[3]=PKW(P1,6), pw2); \
    VRD(3); SBAR(); GAPA(C0=__builtin_amdgcn_mfma_f32_32x32x16_bf16(kf[6],qr[3],C0,0,0,0),   P1[10],P1[11],P1[12],P1[13], pw3[0]=PKW(P1,8), pw3[1]=PKW(P1,10), pw3); \
    VRD(7); SBAR(); GAPA(C1=__builtin_amdgcn_mfma_f32_32x32x16_bf16(kf[7],qr[3],C1,0,0,0),   P1[14],P1[15],0.f,0.f,       pw3[2]=PKW(P1,12),pw3[3]=PKW(P1,14), pw3); \
    l_reg+=sacc; \
    if(GK){DMA_K((t)+3,sl_cur);} if(GV){DMA_V((t)+1,sl_next);} \
    CMASK(C0,C1,t); \
    { float a=MX3(C0[0],C0[1],C1[0]),b=MX3(C0[2],C0[3],C1[1]); a=MX3(a,C1[2],C1[3]); \
      _Pragma("unroll") for(int r=4;r<16;r+=4){a=MX3(a,C0[r],C0[r+1]);b=MX3(b,C0[r+2],C0[r+3]);a=MX3(a,C1[r],C1[r+1]);b=MX3(b,C1[r+2],C1[r+3]);} \
      float rm=__builtin_fmaxf(a,b); { auto rr=__builtin_amdgcn_permlane32_swap(__float_as_uint(rm),__float_as_uint(rm),false,false); rm=__builtin_fmaxf(__uint_as_float(rr[0]),__uint_as_float(rr[1])); } \
      resc=false; \
      if(__builtin_expect(__any(rm>(float)THRL),0)){ const float dl=__builtin_fmaxf(rm,0.f); mhat+=dl; \
        _Pragma("unroll") for(int r=0;r<16;++r){C0[r]-=dl;C1[r]-=dl;} \
        const float f=__builtin_amdgcn_exp2f(-dl); l_reg*=f; if(hi==0)wsf[r32]=f; resc=true; } } \
    SBAR(); \
    GAPB(o[0]=__builtin_amdgcn_mfma_f32_32x32x16_bf16(PAF(0),VFR(0),o[0],0,0,0), C0,0); \
    GAPB(o[1]=__builtin_amdgcn_mfma_f32_32x32x16_bf16(PAF(0),VFR(4),o[1],0,0,0), C0,4); \
    KRD(GL,0); GAPB(o[0]=__builtin_amdgcn_mfma_f32_32x32x16_bf16(PAF(1),VFR(1),o[0],0,0,0), C0,8); \
    KRD(GL,1); GAPB(o[1]=__builtin_amdgcn_mfma_f32_32x32x16_bf16(PAF(1),VFR(5),o[1],0,0,0), C0,12); \
    KRD(GL,2); GAPB(o[0]=__builtin_amdgcn_mfma_f32_32x32x16_bf16(PAF(2),VFR(2),o[0],0,0,0), C1,0); \
    KRD(GL,3); GAPB(o[1]=__builtin_amdgcn_mfma_f32_32x32x16_bf16(PAF(2),VFR(6),o[1],0,0,0), C1,4); \
    GAPB(o[0]=__builtin_amdgcn_mfma_f32_32x32x16_bf16(PAF(3),VFR(3),o[0],0,0,0), C1,8); \
    GAPB(o[1]=__builtin_amdgcn_mfma_f32_32x32x16_bf16(PAF(3),VFR(7),o[1],0,0,0), C1,12); \
    }while(0)
  int t=1;
  #undef CMASK
  #define CMASK(P0,P1,t) do{}while(0)
  for(;t+5<NT;t+=2){
    STEP(pB0,pB1,pA0,pA1,t,true,true,true);     WAIT_BAR(2); RESC(); ROT();
    STEP(pA0,pA1,pB0,pB1,t+1,true,true,true);   WAIT_BAR(2); RESC(); ROT();
  }
  #undef CMASK
  #define CMASK(P0,P1,t) do{int jb_=(t)-(NT-4); if(jb_>=0)cmask(P0,P1,jb_,qrel,hi);}while(0)
  #define ENDW(tt) do{ if((tt)+3<NT){WAIT_BAR(2);} else if((tt)+2<NT){WAIT_BAR(1);} else {WAIT_BAR(0);} }while(0)
  for(;t+1<NT;t+=2){
    STEP(pB0,pB1,pA0,pA1,t,(t+3<NT),(t+1<NT),(t+1<NT));       ENDW(t);   RESC(); ROT();
    STEP(pA0,pA1,pB0,pB1,t+1,(t+4<NT),(t+2<NT),(t+2<NT));     ENDW(t+1); RESC(); ROT();
  }
  STEP(pB0,pB1,pA0,pA1,NT-1,false,false,false); RESC();
  { float sacc=pB0[0]+pB0[1]; _Pragma("unroll") for(int r=2;r<16;++r)sacc+=pB0[r]; _Pragma("unroll") for(int r=0;r<16;++r)sacc+=pB1[r]; l_reg+=sacc;
    pw0=(u32x4){PKW(pB0,0),PKW(pB0,2),PKW(pB0,4),PKW(pB0,6)};pw1=(u32x4){PKW(pB0,8),PKW(pB0,10),PKW(pB0,12),PKW(pB0,14)};pw2=(u32x4){PKW(pB1,0),PKW(pB1,2),PKW(pB1,4),PKW(pB1,6)};pw3=(u32x4){PKW(pB1,8),PKW(pB1,10),PKW(pB1,12),PKW(pB1,14)};
    SBAR(); pv(o,vb0+sl_cur,PAF(0),PAF(1),PAF(2),PAF(3)); }
  #undef PKW
  #undef PAF
  #undef VFR
  #undef PIN
  #undef MX3
  #undef GAPA
  #undef GAPB
  #undef EX
  #undef VRD
  #undef KRD
  #undef STEP
  #undef ENDW
  {auto rr=__builtin_amdgcn_permlane32_swap(__float_as_uint(l_reg),__float_as_uint(l_reg),false,false);l_reg=__uint_as_float(rr[0])+__uint_as_float(rr[1]);}
  if(hi==0)wsf[32+r32]=l_reg;asm volatile("s_waitcnt lgkmcnt(0)":::"memory");
  float rli[16];
  #pragma unroll
  for(int r=0;r<16;++r)rli[r]=__builtin_amdgcn_rcpf(wsf[32+crow(r,hi)]);
  bf16*Ow=O+(rowbase+q0+wid*QBLK)*DMO+h*D;
  { bf16*stg=(bf16*)(shm+LDS_OST)+wid*2048;
    #pragma unroll
    for(int r=0;r<16;++r){const int orow=crow(r,hi);
      #pragma unroll
      for(int d0=0;d0<2;++d0)stg[orow*64+d0*32+r32]=__float2bfloat16(o[d0][r]*rli[r]);}
    asm volatile("s_waitcnt lgkmcnt(0)":::"memory");
    #pragma unroll
    for(int i=0;i<4;++i){const int row=i*8+(lane>>3),ch=lane&7; const u32x4 v=*(const u32x4*)(stg+row*64+ch*8); ATTN_STORE16(Ow+(long)row*DMO+ch*8,v);} }
  asm volatile("s_waitcnt lgkmcnt(0)\n\ts_barrier":::"memory");
  #undef DMA_K
  #undef DMA_V
  #undef CMASK
  #undef START
  #undef RESC
  #undef ROT
  #undef BIAS
}
constexpr int ATTN_LDS_BYTES=LDS_BYTES;
#undef SBAR
#undef WAIT_BAR
}

#define LAS __attribute__((address_space(3)))
typedef unsigned short bf16_t;
typedef short bf16x8 __attribute__((ext_vector_type(8)));
typedef short s16x4 __attribute__((ext_vector_type(4)));
typedef float f32x4 __attribute__((ext_vector_type(4)));
typedef float f32x16 __attribute__((ext_vector_type(16)));
typedef unsigned u32x4 __attribute__((ext_vector_type(4)));
typedef unsigned u32x2 __attribute__((ext_vector_type(2)));

constexpr int NB = 8, SEQ = 2048, DM = 1024, MTOK = NB * SEQ, DFF = 2816, NLAYER = 4, QKV_LD = 3072;
constexpr int NWAVES = 8, NTHR = 512;
constexpr float LOG2E = 1.4426950408889634f;
constexpr int LDS_BYTES = 147456;
constexpr int VROW = 192;
constexpr int VTILE = 32 * VROW;
constexpr int LDS_F = 49152;
constexpr int NPHASE = 2 + 5 * NLAYER;
constexpr int LDS_MISC = 131072;

constexpr size_t MiB = 1u << 20;
constexpr size_t SZ_WQKV = (size_t)3072 * 1024 * 2, SZ_WO = (size_t)1024 * 1024 * 2, SZ_WI = (size_t)5632 * 1024 * 2, SZ_WOUT = (size_t)1024 * 2816 * 2;
constexpr size_t SZ_WLAYER = SZ_WQKV + SZ_WO + SZ_WI + SZ_WOUT;
constexpr size_t WS_W = 0;
constexpr size_t WS_XB = 104 * MiB;
constexpr size_t WS_XRES = WS_XB + 32 * MiB;
constexpr size_t WS_QKV = WS_XRES + 64 * MiB;
constexpr size_t WS_ATT = WS_QKV + 96 * MiB;
constexpr size_t WS_SMALL = WS_ATT + 32 * MiB;
constexpr size_t WS_ROWSS = WS_SMALL;
constexpr size_t WS_ROT = WS_ROWSS + (size_t)9 * MTOK * 4;
constexpr size_t WS_WF = WS_ROT + (size_t)2048 * 16 * 4;
constexpr size_t WS_LOCF = WS_WF + (size_t)2 * 16 * 1024 * 4;
constexpr size_t WS_TOTF = WS_LOCF + (size_t)128 * 2048 * 4;
constexpr size_t WS_LSE = WS_TOTF + (size_t)128 * 32 * 4;
constexpr size_t WS_BAR = WS_LSE + (size_t)2 * MTOK * 8 * 4;
constexpr size_t WS_END = WS_BAR + 16384;
static_assert(SZ_WLAYER * 4 <= 104 * MiB, "weights fit");

struct Args {
    const float* x; const float* norm_mix; const float* w_qkv_even; const float* w_o_even; const float* w_qkvf_odd; const float* b_forget; const float* w_o_odd;
    const float* norm_ffn; const float* w_ffn_in; const float* w_ffn_out; const float* norm_final;
    float* out; unsigned char* ws; int ph_lo, ph_hi;
};

__device__ __forceinline__ unsigned f2bf(float f) { unsigned u = __builtin_bit_cast(unsigned, f); return (u + 0x7fffu + ((u >> 16) & 1u)) >> 16; }
__device__ __forceinline__ unsigned pk2(float lo, float hi) { return f2bf(lo) | (f2bf(hi) << 16); }
__device__ __forceinline__ unsigned cvtpk(float lo, float hi) { unsigned r; asm volatile("v_cvt_pk_bf16_f32 %0, %1, %2" : "=v"(r) : "v"(lo), "v"(hi)); return r; }
__device__ __forceinline__ float wave_sum(float v) {
#pragma unroll
    for (int o = 1; o < 64; o <<= 1) v += __shfl_xor(v, o);
    return v;
}
#define LDS_WAIT() asm volatile("s_waitcnt lgkmcnt(0)" ::: "memory")
__device__ __forceinline__ int otid() { int t = threadIdx.x; asm volatile("" : "+v"(t)); return t; }

#ifndef CONV_SPLIT
#define CONV_SPLIT 1
#endif
__device__ __forceinline__ void transpose_item(const float* W, int ldw, int K, int k0, int src_col, bf16_t* WT, int dst_row, const float* gain, float cscale, LAS float* scr, int lane) {
    const int kr = lane >> 3, c4 = lane & 7;
    f32x4 v[8]; float g[8];
#pragma unroll
    for (int i = 0; i < 8; ++i) { const int kk = 8 * i + kr; v[i] = *(const f32x4*)(W + (size_t)(k0 + kk) * ldw + src_col + 4 * c4); g[i] = gain ? gain[k0 + kk] * cscale : cscale; }
#pragma unroll
    for (int i = 0; i < 8; ++i) { const int kk = 8 * i + kr; LAS float* d = scr + kk * 33 + 4 * c4; d[0] = v[i].x * g[i]; d[1] = v[i].y * g[i]; d[2] = v[i].z * g[i]; d[3] = v[i].w * g[i]; }
    LDS_WAIT(); asm volatile("" ::: "memory");
    const int c = lane & 7;
#pragma unroll
    for (int j = 0; j < 4; ++j) { const int n = (lane >> 3) + 8 * j; const LAS float* s = scr + (8 * c) * 33 + n;
        u32x4 o; o.x = pk2(s[0 * 33], s[1 * 33]); o.y = pk2(s[2 * 33], s[3 * 33]); o.z = pk2(s[4 * 33], s[5 * 33]); o.w = pk2(s[6 * 33], s[7 * 33]);
        *(u32x4*)(WT + (size_t)(dst_row + n) * K + k0 + 8 * c) = o; }
    LDS_WAIT(); asm volatile("" ::: "memory");
}

__device__ __forceinline__ void convert_weights(const Args& a, int l_lo, int l_hi, LAS unsigned char* lds, int gw, int NGW) {
    const int tid = otid(), lane = tid & 63, wave = __builtin_amdgcn_readfirstlane(tid >> 6);
    LAS float* scr = (LAS float*)(lds + wave * 16384);
    constexpr int I_QKV = 16 * 96, I_O = 16 * 32, I_IN = 16 * 176, I_OUT = 44 * 32, I_LAYER = I_QKV + I_O + I_IN + I_OUT;
    for (int it = l_lo * I_LAYER + gw; it < l_hi * I_LAYER; it += NGW) {
        const int l = it / I_LAYER; int r = it % I_LAYER;
        bf16_t* wl = (bf16_t*)(a.ws + WS_W + (size_t)l * SZ_WLAYER);
        if (r < I_QKV) {
            const int kb = r / 96, nb = r % 96, n0 = 32 * nb;
            const float* W = (l & 1) ? a.w_qkvf_odd + (size_t)(l >> 1) * 1024 * 3088 : a.w_qkv_even + (size_t)(l >> 1) * 1024 * 3072;
            transpose_item(W, (l & 1) ? 3088 : 3072, 1024, 64 * kb, n0, wl, n0, a.norm_mix + l * 1024, n0 < 1024 ? 0.125f * LOG2E : 1.0f, scr, lane);
            continue; }
        r -= I_QKV;
        if (r < I_O) {
            const int kb = r / 32, nb = r % 32, n0 = 32 * nb;
            const float* W = (l & 1) ? a.w_o_odd + (size_t)(l >> 1) * 1024 * 1024 : a.w_o_even + (size_t)(l >> 1) * 1024 * 1024;
            transpose_item(W, 1024, 1024, 64 * kb, n0, (bf16_t*)((unsigned char*)wl + SZ_WQKV), n0, nullptr, 1.0f, scr, lane);
            continue; }
        r -= I_O;
        if (r < I_IN) {
            const int kb = r / 176, nb = r % 176, n0 = 32 * nb;
            const int pn = n0 >> 8, bj = (n0 >> 7) & 1, c0 = n0 & 127;
            transpose_item(a.w_ffn_in + (size_t)l * 1024 * 5632, 5632, 1024, 64 * kb, bj * 2816 + 128 * pn + c0, (bf16_t*)((unsigned char*)wl + SZ_WQKV + SZ_WO), n0, a.norm_ffn + l * 1024, 1.0f, scr, lane);
            continue; }
        r -= I_IN;
        {
            const int kb = r / 32, nb = r % 32, n0 = 32 * nb;
            transpose_item(a.w_ffn_out + (size_t)l * 2816 * 1024, 1024, 2816, 64 * kb, n0, (bf16_t*)((unsigned char*)wl + SZ_WQKV + SZ_WO + SZ_WI), n0, nullptr, 1.0f, scr, lane);
        }
    }
}

__device__ __forceinline__ void prologue(const Args& a, LAS unsigned char* lds, int vwg, int G) {
    const int tid = otid(), lane = tid & 63, wave = __builtin_amdgcn_readfirstlane(tid >> 6);
    const int gw = vwg * NWAVES + wave, NGW = G * NWAVES;
    convert_weights(a, 0, (CONV_SPLIT && G == 256) ? 1 : NLAYER, lds, gw, NGW);
    bf16_t* xb = (bf16_t*)(a.ws + WS_XB); float* rowss = (float*)(a.ws + WS_ROWSS);
    for (int m = gw; m < MTOK; m += NGW) {
        const f32x4* xr = (const f32x4*)(a.x + (size_t)m * DM) + lane; float s = 0.f; f32x4 v[4];
#pragma unroll
        for (int j = 0; j < 4; ++j) { v[j] = xr[64 * j]; s += (v[j].x * v[j].x + v[j].y * v[j].y) + (v[j].z * v[j].z + v[j].w * v[j].w); }
        s = wave_sum(s);
        unsigned long long* o8 = (unsigned long long*)(xb + (size_t)m * DM) + lane;
#pragma unroll
        for (int j = 0; j < 4; ++j) o8[64 * j] = (unsigned long long)pk2(v[j].x, v[j].y) | ((unsigned long long)pk2(v[j].z, v[j].w) << 32);
        if (lane == 0) rowss[m] = s;
    }
    const int gt = vwg * NTHR + tid, NGT = G * NTHR;
    for (int i = gt; i < 8 * MTOK; i += NGT) rowss[MTOK + i] = 0.f;
    float* rot = (float*)(a.ws + WS_ROT);
    for (int i = gt; i < 2048 * 8; i += NGT) {
        const int pos = i >> 3, j = i & 7;
        const float invf[8] = {1.0f, 0.19392274474868576f, 0.03760603093086393f, 0.007292664737217109f, 0.001414213562373095f, 0.0002742481756762073f, 5.318295896944988e-05f, 1.031338537721246e-05f};
        float fq = invf[0];
#pragma unroll
        for (int t = 1; t < 8; ++t) fq = (j == t) ? invf[t] : fq;
        const float ang = (float)pos * fq;
        const double rev = (double)ang * 0.15915494309189535; const float fr = (float)(rev - floor(rev));
        rot[pos * 16 + j] = __builtin_amdgcn_cosf(fr); rot[pos * 16 + 8 + j] = __builtin_amdgcn_sinf(fr);
    }
    float* wf = (float*)(a.ws + WS_WF);
    for (int i = gt; i < 2 * 16 * 1024; i += NGT) {
        const int lo = i >> 14, hd = (i >> 10) & 15, k = i & 1023;
        wf[i] = a.w_qkvf_odd[(size_t)lo * 1024 * 3088 + (size_t)k * 3088 + 3072 + hd] * a.norm_mix[(2 * lo + 1) * 1024 + k];
    }
}

__device__ __forceinline__ void fgate_phase(const Args& a, int lo, LAS unsigned char* lds, int vwg, int G) {
    const int tid = otid(), lane = tid & 63, wave = __builtin_amdgcn_readfirstlane(tid >> 6);
    const float* xres = (const float*)(a.ws + WS_XRES); const float* rowss = (const float*)(a.ws + WS_ROWSS) + (size_t)(2 * (2 * lo + 1)) * MTOK;
    const float* wf = (const float*)(a.ws + WS_WF) + (size_t)lo * 16 * 1024;
    float* locF = (float*)(a.ws + WS_LOCF); float* totF = (float*)(a.ws + WS_TOTF);
    LAS float* lf = (LAS float*)lds;
    const int r16 = lane & 15, g4 = lane >> 4, tile = wave & 3, kh = wave >> 2;
    for (int j = vwg; j < 256; j += G) {
        const f32x4* xr = (const f32x4*)(xres + (size_t)(64 * j + 16 * tile + r16) * DM + 512 * kh + 4 * g4);
        const f32x4* wr = (const f32x4*)(wf + (size_t)r16 * 1024 + 512 * kh + 4 * g4);
        f32x4 acc = {0.f, 0.f, 0.f, 0.f};
#pragma unroll 8
        for (int s = 0; s < 32; ++s) {
            const f32x4 xv = xr[4 * s], wv = wr[4 * s];
            acc = __builtin_amdgcn_mfma_f32_16x16x4f32(xv.x, wv.x, acc, 0, 0, 0);
            acc = __builtin_amdgcn_mfma_f32_16x16x4f32(xv.y, wv.y, acc, 0, 0, 0);
            acc = __builtin_amdgcn_mfma_f32_16x16x4f32(xv.z, wv.z, acc, 0, 0, 0);
            acc = __builtin_amdgcn_mfma_f32_16x16x4f32(xv.w, wv.w, acc, 0, 0, 0);
        }
#pragma unroll
        for (int jj = 0; jj < 4; ++jj) lf[(kh * 64 + 16 * tile + 4 * g4 + jj) * 16 + r16] = acc[jj];
        __syncthreads();
        if (tid < 16) {
            const int b = j >> 5, sl = j & 31; float run = 0.f; float* dst = locF + (size_t)(b * 16 + tid) * 2048 + sl * 64;
            const float bias = a.b_forget[lo * 16 + tid];
            for (int t = 0; t < 64; ++t) {
                const float fl = (lf[t * 16 + tid] + lf[(64 + t) * 16 + tid]) * pg8::rstd_of(rowss, 64 * j + t) + bias;
                const float z2 = fl * LOG2E; const float l2 = -(fmaxf(-z2, 0.f) + __builtin_amdgcn_logf(1.0f + __builtin_amdgcn_exp2f(-fabsf(z2))));
                run += l2; dst[t] = run;
            }
            totF[(b * 16 + tid) * 32 + sl] = run;
        }
        __syncthreads();
    }
}

__device__ __forceinline__ int phi32(int r) { return ((r >> 4) & 1) * 16 + ((r >> 2) & 1) * 8 + ((r >> 3) & 1) * 4 + (r & 3); }
__device__ __forceinline__ s16x4 vtr(const LAS unsigned char* p) { return __builtin_bit_cast(s16x4, __builtin_amdgcn_ds_read_tr16_b64_v4i16((LAS s16x4*)p)); }

template <int MODE, int DBG = 0>
__device__ __forceinline__ void attn_task(const bf16_t* qp, const bf16_t* kp, const bf16_t* vp, size_t rstride, int q0, int kb_lo, int kb_hi,
                                          LAS unsigned char* vlds, const LAS float* Fs, f32x16 (&O)[2], float& lse2) {
    const int lane = otid() & 63, n = lane & 31, hh = lane >> 5;
    bf16x8 qf[4];
    { const bf16_t* p = qp + (size_t)(q0 + n) * rstride + 8 * hh;
#pragma unroll
      for (int ks = 0; ks < 4; ++ks) qf[ks] = *(const bf16x8*)(p + 16 * ks); }
    const int qi = q0 + n;
    float Fq = 0.f; if (MODE == 0) Fq = Fs[qi];
#pragma unroll
    for (int r = 0; r < 16; ++r) { O[0][r] = 0.f; O[1][r] = 0.f; }
    float m = -1e30f, l = 0.f, R = 0.f;
    const bf16_t* kl = kp + (size_t)phi32(n) * rstride + 8 * hh;
    const bf16_t* vl = vp + (size_t)(lane >> 3) * rstride + 8 * (lane & 7);
    LAS unsigned char* vw = vlds + (lane >> 3) * VROW + (lane & 7) * 16;
    const LAS unsigned char* vr = vlds + (8 * hh + ((lane & 15) >> 2)) * VROW + (16 * ((lane >> 4) & 1) + 4 * (lane & 3)) * 2;
    bf16x8 kn[4]; u32x4 vn[4];
#define AT_ISSUE(kb) do { const bf16_t* kk_ = kl + (size_t)(kb) * 32 * rstride; const bf16_t* vv_ = vl + (size_t)(kb) * 32 * rstride; \
        _Pragma("unroll") for (int ks = 0; ks < 4; ++ks) kn[ks] = *(const bf16x8*)(kk_ + 16 * ks); \
        _Pragma("unroll") for (int ii = 0; ii < 4; ++ii) vn[ii] = *(const u32x4*)(vv_ + (size_t)(8 * ii) * rstride); } while (0)
    const int nblk = kb_hi - kb_lo + 1;
    int kb = (MODE == 2) ? kb_hi : kb_lo;
    AT_ISSUE(kb);
    for (int it = 0; it < nblk; ++it) {
        bf16x8 kc[4];
#pragma unroll
        for (int ks = 0; ks < 4; ++ks) kc[ks] = kn[ks];
        asm volatile("" ::: "memory");
#pragma unroll
        for (int ii = 0; ii < 4; ++ii) *(LAS u32x4*)(vw + ii * 8 * VROW) = vn[ii];
        asm volatile("" ::: "memory");
        const int kbn = (MODE == 2) ? kb - 1 : kb + 1;
        if (it + 1 < nblk && DBG != 1) AT_ISSUE(kbn);
        if (DBG != 2) {
        const int key0 = kb * 32 + 8 * hh;
        f32x16 s;
        if (MODE == 0) {
            const LAS f32x4* fk = (const LAS f32x4*)(Fs + key0);
            const f32x4 f0 = fk[0], f1 = fk[1], f2 = fk[4], f3 = fk[5];
#pragma unroll
            for (int e = 0; e < 4; ++e) { s[e] = Fq - f0[e]; s[4 + e] = Fq - f1[e]; s[8 + e] = Fq - f2[e]; s[12 + e] = Fq - f3[e]; }
        } else {
#pragma unroll
            for (int r = 0; r < 16; ++r) s[r] = 0.f;
        }
#pragma unroll
        for (int ks = 0; ks < 4; ++ks) s = __builtin_amdgcn_mfma_f32_32x32x16_bf16(kc[ks], qf[ks], s, 0, 0, 0);
        bf16x8 pb[2];
        if (MODE != 2) {
            const bool diag = (kb * 32 + 31 > q0);
            if (MODE == 1) {
                if (diag || kb * 32 < q0 - 97) {
#pragma unroll
                    for (int r = 0; r < 16; ++r) { const int ki = key0 + 16 * (r >> 3) + (r & 7); if (ki > qi || ki < qi - 128) s[r] = -1e30f; }
                }
            } else if (diag) {
#pragma unroll
                for (int r = 0; r < 16; ++r) { const int ki = key0 + 16 * (r >> 3) + (r & 7); if (ki > qi) s[r] = -1e30f; }
            }
            float bm = fmaxf(fmaxf(s[0], s[1]), fmaxf(s[2], s[3]));
#pragma unroll
            for (int r = 4; r < 16; r += 4) bm = fmaxf(bm, fmaxf(fmaxf(s[r], s[r + 1]), fmaxf(s[r + 2], s[r + 3])));
            bm = fmaxf(bm, __shfl_xor(bm, 32));
            const float mn = fmaxf(m, bm), alpha = __builtin_amdgcn_exp2f(m - mn); m = mn;
            float ps = 0.f;
#pragma unroll
            for (int r = 0; r < 16; ++r) { s[r] = __builtin_amdgcn_exp2f(s[r] - mn); ps += s[r]; }
            l = l * alpha + ps;
#pragma unroll
            for (int r = 0; r < 16; ++r) { O[0][r] *= alpha; O[1][r] *= alpha; }
        } else {
            const bool diag = (kb * 32 + 31 >= q0);
            float L[16];
#pragma unroll
            for (int r = 0; r < 16; ++r) {
                const float z = s[r], t = __builtin_amdgcn_exp2f(-fabsf(z)), sp = fmaxf(z, 0.f) + __builtin_amdgcn_logf(1.0f + t);
                L[r] = -sp; s[r] = z - sp;
            }
            if (diag) {
#pragma unroll
                for (int r = 0; r < 16; ++r) { const int ki = key0 + 16 * (r >> 3) + (r & 7); if (ki >= qi) { L[r] = 0.f; s[r] = -1e30f; } }
            }
            float sA = ((L[0] + L[1]) + (L[2] + L[3])) + ((L[4] + L[5]) + (L[6] + L[7]));
            float sB = ((L[8] + L[9]) + (L[10] + L[11])) + ((L[12] + L[13]) + (L[14] + L[15]));
            const float pA = __shfl_xor(sA, 32), pB = __shfl_xor(sB, 32);
            const float offA = sB + pB + (hh == 0 ? pA : 0.f), offB = (hh == 0 ? pB : 0.f);
            float run = R + offA;
#pragma unroll
            for (int e = 7; e >= 0; --e) { const float lr = L[e]; s[e] = __builtin_amdgcn_exp2f(s[e] + run); run += lr; }
            run = R + offB;
#pragma unroll
            for (int e = 15; e >= 8; --e) { const float lr = L[e]; s[e] = __builtin_amdgcn_exp2f(s[e] + run); run += lr; }
            R += (sA + sB) + (pA + pB);
        }
        { u32x4 w0, w1;
          w0.x = cvtpk(s[0], s[1]); w0.y = cvtpk(s[2], s[3]); w0.z = cvtpk(s[4], s[5]); w0.w = cvtpk(s[6], s[7]);
          w1.x = cvtpk(s[8], s[9]); w1.y = cvtpk(s[10], s[11]); w1.z = cvtpk(s[12], s[13]); w1.w = cvtpk(s[14], s[15]);
          pb[0] = __builtin_bit_cast(bf16x8, w0); pb[1] = __builtin_bit_cast(bf16x8, w1); }
        asm volatile("" ::: "memory");
#pragma unroll
        for (int db = 0; db < 2; ++db)
#pragma unroll
            for (int kk = 0; kk < 2; ++kk) {
                const s16x4 lo4 = vtr(vr + (16 * kk) * VROW + 64 * db), hi4 = vtr(vr + (16 * kk + 4) * VROW + 64 * db);
                const bf16x8 av = {lo4[0], lo4[1], lo4[2], lo4[3], hi4[0], hi4[1], hi4[2], hi4[3]};
                O[db] = __builtin_amdgcn_mfma_f32_32x32x16_bf16(av, pb[kk], O[db], 0, 0, 0);
            }
        asm volatile("s_waitcnt lgkmcnt(0)" ::: "memory");
        } else { asm volatile("s_waitcnt lgkmcnt(0)" ::: "memory"); O[0][0] += __builtin_bit_cast(float, (int)kc[0][0]) ; }
        if (MODE == 2) { if (__builtin_amdgcn_ballot_w64(R >= -160.f) == 0ull) break; }
        kb = kbn;
    }
#undef AT_ISSUE
    asm volatile("s_waitcnt vmcnt(0)" ::: "memory");
    if (MODE != 2) {
        l += __shfl_xor(l, 32);
        const float inv = 1.0f / l;
#pragma unroll
        for (int r = 0; r < 16; ++r) { O[0][r] *= inv; O[1][r] *= inv; }
        lse2 = m + __builtin_amdgcn_logf(l);
    }
}

__device__ __forceinline__ void store_o_bf16(const f32x16 (&O)[2], bf16_t* att_row  , int hh) {
#pragma unroll
    for (int db = 0; db < 2; ++db)
#pragma unroll
        for (int i = 0; i < 4; ++i) {
            u32x2 w; w.x = cvtpk(O[db][4 * i], O[db][4 * i + 1]); w.y = cvtpk(O[db][4 * i + 2], O[db][4 * i + 3]);
            *(u32x2*)(att_row + 32 * db + 8 * i + 4 * hh) = w;
        }
}

constexpr int LDS_FOXF = 90112;
__device__ __forceinline__ void fox_phase(const Args& a, unsigned char* lds_gen, LAS unsigned char* lds, int vwg, int G) {
    const int tid = otid();
    const bf16_t* qkv = (const bf16_t*)(a.ws + WS_QKV); bf16_t* att = (bf16_t*)(a.ws + WS_ATT);
    const float* locF = (const float*)(a.ws + WS_LOCF); const float* totF = (const float*)(a.ws + WS_TOTF);
    LAS float* Fs = (LAS float*)(lds + LDS_FOXF); LAS float* pre = Fs + 2048;
    for (int j = vwg; j < 256; j += G) {
        const int bh = j >> 1, b = bh >> 4, h = bh & 15;
        __syncthreads();
        if (tid < 32) { float p = 0.f; for (int s = 0; s < tid; ++s) p += totF[bh * 32 + s]; pre[tid] = p; }
        __syncthreads();
        for (int t = tid; t < 2048; t += NTHR) Fs[t] = locF[(size_t)bh * 2048 + t] + pre[t >> 6];
        __syncthreads();
        for (int ui = 0; ui < 4; ++ui) {
            const int u = (j & 1) ? ((ui < 2) ? 2 + ui : 7 - ui) : ((ui < 2) ? ui : 9 - ui);
            attn_body::attn_unit<8>(b, h, u, (const attn_body::bf16*)qkv, (const attn_body::bf16*)(qkv + 1024), (const attn_body::bf16*)(qkv + 2048), (attn_body::bf16*)att, (char*)lds_gen, Fs);
        }
    }
}

template <int PART>
__device__ __forceinline__ void even_attn_phase(const Args& a, LAS unsigned char* lds, int vwg, int G) {
    const int tid = otid(), lane = tid & 63, wave = __builtin_amdgcn_readfirstlane(tid >> 6), n = lane & 31, hh = lane >> 5;
    const bf16_t* qkv = (const bf16_t*)(a.ws + WS_QKV); bf16_t* att = (bf16_t*)(a.ws + WS_ATT);
    bf16_t* part = (bf16_t*)a.out;
    float* plse = (float*)(a.ws + WS_LSE);
    LAS unsigned char* vlds = lds + wave * VTILE;
    const LAS float* nof = (const LAS float*)lds;
    for (int j = vwg; j < 256; j += G) {
        const int bh = j >> 2, b = bh >> 3, hl = bh & 7, c = j & 3;
        if (PART & 1) { const bf16_t* base = qkv + (size_t)(b * SEQ) * QKV_LD + hl * 64;
          for (int ui = 0; ui < 2; ++ui) {
              const int u = ui ? 7 - c : c, qt = 8 * u + wave;
              f32x16 O[2]; float lse;
              attn_task<2>(base, base + 1024, base + 2048, (size_t)QKV_LD, 32 * qt, 0, qt, vlds, nof, O, lse);
              store_o_bf16(O, att + (size_t)(b * SEQ + 32 * qt + n) * DM + hl * 64, hh);
          } }
        if (!(PART & 2)) continue;
        const bf16_t* base = qkv + (size_t)(b * SEQ) * QKV_LD + (8 + hl) * 64;
        for (int p = 0; p < 2; ++p) {
            const int dil = p ? 4 : 1;
            for (int ti = 0; ti < 2; ++ti) {
                const int task = wave + 8 * ti;
                const int res = p ? (task & 3) : 0, tile = p ? (task >> 2) : task;
                const int q0 = (p ? 128 * c : 512 * c) + 32 * tile;
                const int kbh = q0 >> 5, kbl = kbh - 4 < 0 ? 0 : kbh - 4;
                const bf16_t* bp = base + (size_t)res * QKV_LD;
                f32x16 O[2]; float lse;
                attn_task<1>(bp, bp + 1024, bp + 2048, (size_t)dil * QKV_LD, q0, kbl, kbh, vlds, nof, O, lse);
                const int tok = res + dil * (q0 + n);
                if (PART & 4) continue;
                store_o_bf16(O, part + ((size_t)p * MTOK + (size_t)(b * SEQ + tok)) * 512 + hl * 64, hh);
                if (hh == 0) plse[((size_t)p * MTOK + (size_t)(b * SEQ + tok)) * 8 + hl] = lse;
            }
        }
        __syncthreads();
        for (int ti = 0; ti < 2; ++ti) {
            const int res = wave + 8 * ti, q0 = 32 * c;
            const bf16_t* bp = base + (size_t)res * QKV_LD;
            f32x16 O[2]; float lse3;
            attn_task<1>(bp, bp + 1024, bp + 2048, (size_t)16 * QKV_LD, q0, 0, c, vlds, nof, O, lse3);
            const int tok = res + 16 * (q0 + n); const size_t grow = (size_t)(b * SEQ + tok);
            if (PART & 4) { store_o_bf16(O, att + grow * DM + (8 + hl) * 64, hh); continue; }
            const float l1 = plse[grow * 8 + hl], l2 = plse[((size_t)MTOK + grow) * 8 + hl];
            const float mx = fmaxf(lse3, fmaxf(l1, l2));
            float w1 = __builtin_amdgcn_exp2f(l1 - mx), w2 = __builtin_amdgcn_exp2f(l2 - mx), w3 = __builtin_amdgcn_exp2f(lse3 - mx);
            const float inv = 1.0f / (w1 + w2 + w3); w1 *= inv; w2 *= inv; w3 *= inv;
            const bf16_t* p1 = part + grow * 512 + hl * 64; const bf16_t* p2 = part + ((size_t)MTOK + grow) * 512 + hl * 64;
#pragma unroll
            for (int db = 0; db < 2; ++db)
#pragma unroll
                for (int i = 0; i < 4; ++i) {
                    const u32x2 r1 = *(const u32x2*)(p1 + 32 * db + 8 * i + 4 * hh), r2 = *(const u32x2*)(p2 + 32 * db + 8 * i + 4 * hh);
                    const float a1[4] = {__uint_as_float(r1.x << 16), __uint_as_float(r1.x & 0xffff0000u), __uint_as_float(r1.y << 16), __uint_as_float(r1.y & 0xffff0000u)};
                    const float a2[4] = {__uint_as_float(r2.x << 16), __uint_as_float(r2.x & 0xffff0000u), __uint_as_float(r2.y << 16), __uint_as_float(r2.y & 0xffff0000u)};
#pragma unroll
                    for (int e = 0; e < 4; ++e) O[db][4 * i + e] = O[db][4 * i + e] * w3 + a1[e] * w1 + a2[e] * w2;
                }
            store_o_bf16(O, att + grow * DM + (8 + hl) * 64, hh);
        }
        __syncthreads();
    }
}

__device__ __forceinline__ void final_phase(const Args& a, int vwg, int G) {
    const int tid = otid(), lane = tid & 63, wave = tid >> 6;
    const float* xres = (const float*)(a.ws + WS_XRES); const float* rowss = (const float*)(a.ws + WS_ROWSS) + (size_t)8 * MTOK;
    const int gw = vwg * NWAVES + wave, NGW = G * NWAVES;
    f32x4 g[4];
#pragma unroll
    for (int j = 0; j < 4; ++j) g[j] = ((const f32x4*)a.norm_final)[lane + 64 * j];
    for (int m = gw; m < MTOK; m += NGW) {
        const float rs = pg8::rstd_of(rowss, m);
        const f32x4* xr = (const f32x4*)(xres + (size_t)m * DM) + lane; f32x4* o = (f32x4*)(a.out + (size_t)m * DM) + lane;
#pragma unroll
        for (int j = 0; j < 4; ++j) o[64 * j] = xr[64 * j] * rs * g[j];
    }
}

#define XB_TMO      128
#define XB_XCNT(j)  (256  + 64 * (j))
#define XB_XSUB(j)  (1280 + 64 * (j))
#define XB_XGEN(j)  (2304 + 64 * (j))
#define XB_TOP      3328
#define XB_TOPGEN   3392
#define XCD_BAR_WORDS 3456
#define XB_SPIN_CAP (1u << 18)

__device__ __forceinline__ unsigned xb_ld(unsigned* p)              { return __hip_atomic_load(p, __ATOMIC_RELAXED, __HIP_MEMORY_SCOPE_AGENT); }
__device__ __forceinline__ unsigned xb_add(unsigned* p, unsigned v) { return __hip_atomic_fetch_add(p, v, __ATOMIC_RELAXED, __HIP_MEMORY_SCOPE_AGENT); }
__device__ __forceinline__ unsigned xb_xcc_id() { return (unsigned)__builtin_amdgcn_s_getreg((3 << 11) | 20) & 0xFu; }
#define XB_SPIN(cond, bar) do { unsigned _sp = 0; while (cond) { __builtin_amdgcn_s_sleep(1); \
    if ((++_sp & 255u) == 0u) { if (xb_ld(&(bar)[XB_TMO])) break; if (_sp > XB_SPIN_CAP) { atomicAdd(&(bar)[XB_TMO], 1u); break; } } } } while (0)

struct XcdBarrier {
    unsigned* bar; unsigned x;
    volatile LAS unsigned* st;
};

__device__ __forceinline__ XcdBarrier xcd_barrier_post(unsigned* bar, volatile LAS unsigned* st) {
    XcdBarrier b; b.bar = bar; b.x = xb_xcc_id(); b.st = st;
    if (threadIdx.x == 0) (void)xb_add(&bar[XB_XCNT(b.x)], 1u);
    return b;
}
__device__ __forceinline__ void xcd_barrier_complete(unsigned* bar, unsigned x, unsigned& nloc, unsigned& nx) {
    const unsigned G = gridDim.x * gridDim.y * gridDim.z;
    unsigned sum, cnt, mine, sp = 0u;
    for (;;) {
        sum = 0u; cnt = 0u; mine = 0u;
#pragma unroll
        for (unsigned j = 0; j < 16; ++j) { const unsigned c = xb_ld(&bar[XB_XCNT(j)]); sum += c; cnt += (c > 0u) ? 1u : 0u; mine = (j == x) ? c : mine; }
        if (sum == G) break;
        __builtin_amdgcn_s_sleep(1);
        if ((++sp & 255u) == 0u) { if (xb_ld(&bar[XB_TMO])) break; if (sp > XB_SPIN_CAP) { atomicAdd(&bar[XB_TMO], 1u); break; } }
    }
    nloc = mine > 0u ? mine : 1u; nx = cnt > 0u ? cnt : 1u;
}

__device__ __forceinline__ void xcd_barrier(const XcdBarrier& b) {
    asm volatile("s_waitcnt vmcnt(0)" ::: "memory");
    __syncthreads();
    if (threadIdx.x == 0) {
        unsigned* bar = b.bar;
        __builtin_amdgcn_s_waitcnt(0);
        unsigned nloc = b.st[0], nx = b.st[1];
        if (nloc == 0u) { xcd_barrier_complete(bar, b.x, nloc, nx); b.st[0] = nloc; b.st[1] = nx; }
        const unsigned old = xb_add(&bar[XB_XSUB(b.x)], 1u);
        const unsigned gen = old / nloc;
        if (old + 1u == (gen + 1u) * nloc) {
            __builtin_amdgcn_fence(__ATOMIC_RELEASE, "agent");
            asm volatile("s_waitcnt vmcnt(0)" ::: "memory");
            const unsigned og = xb_add(&bar[XB_TOP], 1u);
            const unsigned tg = og / nx;
            if (og + 1u == (tg + 1u) * nx) xb_add(&bar[XB_TOPGEN], 1u);
            else XB_SPIN(xb_ld(&bar[XB_TOPGEN]) == tg, bar);
            __builtin_amdgcn_fence(__ATOMIC_ACQUIRE, "agent");
            xb_add(&bar[XB_XGEN(b.x)], 1u);
            asm volatile("s_waitcnt vmcnt(0)" ::: "memory");
        } else {
            XB_SPIN(xb_ld(&bar[XB_XGEN(b.x)]) == gen, bar);
            __builtin_amdgcn_fence(__ATOMIC_ACQUIRE, "agent");
            asm volatile("s_waitcnt vmcnt(0)" ::: "memory");
        }
    }
    __syncthreads();
}

#ifndef DBG_EVEN
#define DBG_EVEN 0
#endif
#ifndef DBG_FOX
#define DBG_FOX 0
#endif
#ifndef REP_QKV
#define REP_QKV 1
#endif
#ifndef REP_FG
#define REP_FG 1
#endif
#ifndef REP_FFI
#define REP_FFI 1
#endif
#ifndef REP_PRO
#define REP_PRO 1
#endif
#ifndef REP_SYNC
#define REP_SYNC 1
#endif
#ifndef REP_FOX
#define REP_FOX 1
#endif
#ifndef REP_EVEN
#define REP_EVEN 1
#endif
__global__ void __launch_bounds__(NTHR, 2) fwd_kernel(Args a) {
    extern __shared__ __attribute__((aligned(16))) unsigned char lds_raw[];
    LAS unsigned char* lds = (LAS unsigned char*)lds_raw;
    cg::grid_group grid = cg::this_grid();
    const int G = gridDim.x, vwg = blockIdx.x;
    unsigned char* ws = a.ws;
    bf16_t* xb = (bf16_t*)(ws + WS_XB); float* xres = (float*)(ws + WS_XRES); bf16_t* qkv = (bf16_t*)(ws + WS_QKV); bf16_t* hid = (bf16_t*)(ws + WS_QKV);
    bf16_t* att = (bf16_t*)(ws + WS_ATT); float* rowss = (float*)(ws + WS_ROWSS); const float* rot = (const float*)(ws + WS_ROT);
    unsigned* barw = (unsigned*)(ws + WS_BAR);
    volatile LAS unsigned* bst = (volatile LAS unsigned*)(lds + LDS_MISC);
    if (threadIdx.x == 0) { bst[0] = 0u; bst[1] = 0u; }
    if (blockIdx.x == 0) { for (int i = threadIdx.x; i < XCD_BAR_WORDS; i += NTHR) barw[i] = 0u; }
    __syncthreads();
    XcdBarrier bar; bar.bar = barw; bar.x = 0; bar.st = bst;
    const bool multi = (a.ph_hi - a.ph_lo) > 1;
    if (multi) { grid.sync(); bar = xcd_barrier_post(barw, bst); }
    for (int ph = a.ph_lo; ph < a.ph_hi; ++ph) {
        if (ph == 0) { for (int rep = 0; rep < REP_PRO; ++rep) { prologue(a, lds, vwg, G); __syncthreads(); } }
        else if (ph == NPHASE - 1) final_phase(a, vwg, G);
        else {
            const int l = (ph - 1) / 5, sp = (ph - 1) % 5;
            const bf16_t* wl = (const bf16_t*)(ws + WS_W + (size_t)l * SZ_WLAYER);
            const bf16_t* w_qkv = wl; const bf16_t* w_o = (const bf16_t*)((const unsigned char*)wl + SZ_WQKV);
            const bf16_t* w_in = (const bf16_t*)((const unsigned char*)wl + SZ_WQKV + SZ_WO); const bf16_t* w_out = (const bf16_t*)((const unsigned char*)wl + SZ_WQKV + SZ_WO + SZ_WI);
            if (sp == 0) {
                pg8::Gemm g{xb, w_qkv, MTOK, 3072, 1024}; pg8::StaticOrder S; S.init(MTOK, 3072, G, vwg);
                pg8::EpiQKV E{qkv, rowss + (size_t)(2 * l) * MTOK, rot, (l & 1) ? 0 : 1};
                for (int rep = 0; rep < REP_QKV; ++rep) { pg8::gemm_phase<pg8::EpiQKV, pg8::StaticOrder, true, true>(lds, g, S, E); __syncthreads(); }
                if (l & 1) { for (int rep = 0; rep < REP_FG; ++rep) { __syncthreads(); fgate_phase(a, l >> 1, lds, vwg, G); } }
            } else if (sp == 1) {
                if (l & 1) { fox_phase(a, lds_raw, lds, vwg, G); } else { if (DBG_EVEN) { even_attn_phase<DBG_EVEN>(a, lds, vwg, G); __syncthreads(); } even_attn_phase<3>(a, lds, vwg, G); }
            } else if (sp == 2) {
                pg8::Gemm g{att, w_o, MTOK, 1024, 1024}; pg8::StaticOrder S; S.init(MTOK, 1024, G, vwg);
                pg8::EpiResid E{l == 0 ? a.x : xres, xres, xb, rowss + (size_t)(2 * l + 1) * MTOK};
                pg8::gemm_phase<pg8::EpiResid, pg8::StaticOrder, true, true>(lds, g, S, E);
            } else if (sp == 3) {
                pg8::Gemm g{xb, w_in, MTOK, 5632, 1024}; pg8::StaticOrder S; S.init(MTOK, 5632, G, vwg);
                pg8::EpiSwiGLU E{hid, rowss + (size_t)(2 * l + 1) * MTOK};
                for (int rep = 0; rep < REP_FFI; ++rep) { pg8::gemm_phase<pg8::EpiSwiGLU, pg8::StaticOrder, true, true>(lds, g, S, E); __syncthreads(); }
                if (CONV_SPLIT && G == 256 && vwg >= 128 && l + 1 < NLAYER) { __syncthreads(); convert_weights(a, l + 1, l + 2, lds, (vwg - 128) * NWAVES + __builtin_amdgcn_readfirstlane((int)(threadIdx.x >> 6)), 128 * NWAVES); }
            } else {
                pg8::Gemm g{hid, w_out, MTOK, 1024, 2816}; pg8::StaticOrder S; S.init(MTOK, 1024, G, vwg);
                pg8::EpiResid E{xres, xres, xb, rowss + (size_t)(2 * l + 2) * MTOK};
                pg8::gemm_phase<pg8::EpiResid, pg8::StaticOrder, true, true>(lds, g, S, E);
            }
        }
        if (ph + 1 < a.ph_hi) {
            for (int rep = 0; rep < REP_SYNC; ++rep) xcd_barrier(bar);
        }
    }
}

#ifndef N_LAUNCH_MODE
#define N_LAUNCH_MODE 1
#endif

extern "C" void kernel_launch(void* const* d_in, const int* in_sizes, int n_in, void* d_out, int out_size, void* d_ws, size_t ws_size, hipStream_t stream) {
    static int grid = 0;
    if (grid == 0) {
        if (n_in != 11 || out_size != MTOK * DM || ws_size < WS_END) { fprintf(stderr, "kernel_launch: unexpected sizes n_in %d out %d ws %zu (need %zu)\n", n_in, out_size, ws_size, (size_t)WS_END); grid = -1; return; }
        int dev = 0, cus = 0, per_cu = 0;
        hipGetDevice(&dev); hipDeviceGetAttribute(&cus, hipDeviceAttributeMultiprocessorCount, dev);
        if (hipFuncSetAttribute((const void*)fwd_kernel, hipFuncAttributeMaxDynamicSharedMemorySize, LDS_BYTES) != hipSuccess) { fprintf(stderr, "kernel_launch: hipFuncSetAttribute failed\n"); grid = -1; return; }
        if (hipOccupancyMaxActiveBlocksPerMultiprocessor(&per_cu, (const void*)fwd_kernel, NTHR, LDS_BYTES) != hipSuccess || per_cu < 1) { fprintf(stderr, "kernel_launch: occupancy query says %d\n", per_cu); per_cu = 1; }
        (void)hipGetLastError();
        grid = cus * 1;
        fprintf(stderr, "kernel_launch: grid %d (cus %d, per_cu %d)\n", grid, cus, per_cu);
    }
    if (grid < 0) return;
    Args a{};
    a.x = (const float*)d_in[0]; a.norm_mix = (const float*)d_in[1]; a.w_qkv_even = (const float*)d_in[2]; a.w_o_even = (const float*)d_in[3];
    a.w_qkvf_odd = (const float*)d_in[4]; a.b_forget = (const float*)d_in[5]; a.w_o_odd = (const float*)d_in[6]; a.norm_ffn = (const float*)d_in[7];
    a.w_ffn_in = (const float*)d_in[8]; a.w_ffn_out = (const float*)d_in[9]; a.norm_final = (const float*)d_in[10];
    a.out = (float*)d_out; a.ws = (unsigned char*)d_ws;
#if N_LAUNCH_MODE == 1
    a.ph_lo = 0; a.ph_hi = NPHASE;
    void* args[] = {&a};
    hipError_t e = hipLaunchCooperativeKernel((const void*)fwd_kernel, dim3(grid), dim3(NTHR), args, LDS_BYTES, stream);
    if (e != hipSuccess) fprintf(stderr, "cooperative launch failed: %s (grid %d)\n", hipGetErrorString(e), grid);
#else
    for (int ph = 0; ph < NPHASE; ++ph) {
        a.ph_lo = ph; a.ph_hi = ph + 1;
        hipLaunchKernelGGL(fwd_kernel, dim3(grid), dim3(NTHR), LDS_BYTES, stream, a);
    }
#endif
}
```

```cpp
#include <hip/hip_runtime.h>
#include <hip/hip_cooperative_groups.h>
#include <cstdio>
#include <cstdint>
namespace cg = cooperative_groups;
namespace pg8 {
#define PG8_LAS __attribute__((address_space(3)))
typedef unsigned short bf16_t;
typedef short bf16x8 __attribute__((ext_vector_type(8)));
typedef float f32x4 __attribute__((ext_vector_type(4)));
typedef unsigned u32x4 __attribute__((ext_vector_type(4)));
constexpr int BM = 256, BK = 64, HALF = 128, HTB = HALF * BK * 2  , STAGE_BYTES = 8 * HTB, NXCD = 8, WGM = 8;

__host__ __device__ __forceinline__ int lds_byte(int r, int c) { const int st = (r >> 4) * 2 + (c >> 5), rr = r & 15, cc = c & 31, ob = rr * 64 + cc * 2; return st * 1024 + (ob ^ (((ob >> 9) & 1) << 5)); }
__host__ __device__ __forceinline__ void stage_rc(int b, int& R, int& C) { const int st = b / 1024, sb = b % 1024, swz = sb ^ (((sb >> 9) & 1) << 5); R = (st >> 1) * 16 + swz / 64; C = (st & 1) * 32 + (swz % 64) / 2; }
__host__ __device__ __forceinline__ int perm32(int rho) { const int n = rho >> 4, i = rho & 15; return 8 * (i >> 2) + 4 * n + (i & 3); }

struct Unit { int pm, pn; };
struct Gemm { const bf16_t* A; const bf16_t* Bt; int M, N, K; };

struct StaticOrder {
    int nM, nN, nwg, G, c;
    __host__ __device__ void init(int M, int N, int G_, int c_) { nM = M / BM; nN = N / BM; nwg = nM * nN; G = G_; c = c_; }
    __host__ __device__ bool next(int i, Unit& u) const {
        const long L = (long)i * G + c; if (L >= nwg) return false;
        int wgid = (int)L; { const int q = nwg / NXCD, r = nwg % NXCD, xcd = wgid % NXCD, off = wgid / NXCD; wgid = (xcd < r ? xcd * (q + 1) : r * (q + 1) + (xcd - r) * q) + off; }
        const int nig = WGM * nN, gid = wgid / nig, fm = gid * WGM, gsz = (nM - fm) < WGM ? (nM - fm) : WGM;
        u.pm = fm + ((wgid % nig) % gsz); u.pn = (wgid % nig) / gsz; return true;
    }
    __device__ __forceinline__ void a_ready(const Unit&) const {}
    __device__ __forceinline__ void done(const Unit&) const {}
};

__device__ __forceinline__ unsigned cvt_pk_bf16(float lo, float hi) { unsigned r; asm volatile("v_cvt_pk_bf16_f32 %0, %1, %2" : "=v"(r) : "v"(lo), "v"(hi)); return r; }
constexpr float RMS_EPS_F = 1e-5f;
__device__ __forceinline__ float rstd_of(const float* rowss, int row) { return 1.0f / sqrtf(rowss[row] * (1.0f / 1024.0f) + RMS_EPS_F); }

struct EpiQKV {
    static constexpr bool PERM = true, AFTER_DRAIN = false;
    bf16_t* O; const float* rowss; const float* rot; int rope;
    __device__ __forceinline__ void operator()(const f32x4 (&acc)[2][2][4][2], const Unit& u, int wr, int wc, int fr, int fq) const {
        const int row0 = u.pm * BM + wr * 64 + fr;
        const int col0 = u.pn * BM + wc * 32 + 8 * fq;
        const bool rt = rope && ((u.pn & 2) != 0) && (u.pn < 8) && ((wc & 1) == 0);
#pragma unroll
        for (int ai = 0; ai < 2; ++ai)
#pragma unroll
            for (int m = 0; m < 4; ++m) {
                const int row = row0 + ai * HALF + m * 16;
                const float rs = rstd_of(rowss, row);
                bf16_t* rowp = O + (size_t)row * 3072 + col0;
                f32x4 c0 = {1.f, 1.f, 1.f, 1.f}, c1 = c0, s0 = {0.f, 0.f, 0.f, 0.f}, s1 = s0;
                if (rt) { const f32x4* rp = (const f32x4*)(rot + (size_t)(row & 2047) * 16); c0 = rp[0]; c1 = rp[1]; s0 = rp[2]; s1 = rp[3]; }
#pragma unroll
                for (int bj = 0; bj < 2; ++bj) {
                    f32x4 v0 = acc[ai][bj][m][0] * rs, v1 = acc[ai][bj][m][1] * rs;
                    if (rt) {
                        f32x4 p0, p1;
#pragma unroll
                        for (int e = 0; e < 4; ++e) { p0[e] = __shfl_xor(v0[e], 16); p1[e] = __shfl_xor(v1[e], 16); }
                        if (fq == 0) { v0 = v0 * c0 - p0 * s0; v1 = v1 * c1 - p1 * s1; }
                        else if (fq == 1) { v0 = v0 * c0 + p0 * s0; v1 = v1 * c1 + p1 * s1; }
                    }
                    u32x4 w; w.x = cvt_pk_bf16(v0[0], v0[1]); w.y = cvt_pk_bf16(v0[2], v0[3]); w.z = cvt_pk_bf16(v1[0], v1[1]); w.w = cvt_pk_bf16(v1[2], v1[3]);
                    *(u32x4*)(rowp + bj * HALF) = w;
                }
            }
    }
};

struct EpiResid {
    static constexpr bool PERM = true, AFTER_DRAIN = false;
    const float* xin; float* xout; bf16_t* xb; float* rowss_next;
    __device__ __forceinline__ void operator()(const f32x4 (&acc)[2][2][4][2], const Unit& u, int wr, int wc, int fr, int fq) const {
        const int row0 = u.pm * BM + wr * 64 + fr;
        const int col0 = u.pn * BM + wc * 32 + 8 * fq;
#pragma unroll
        for (int ai = 0; ai < 2; ++ai)
#pragma unroll
            for (int m = 0; m < 4; ++m) {
                const int row = row0 + ai * HALF + m * 16;
                float ss = 0.f;
#pragma unroll
                for (int bj = 0; bj < 2; ++bj) {
                    const size_t off = (size_t)row * 1024 + col0 + bj * HALF;
                    const f32x4* xi = (const f32x4*)(xin + off);
                    const f32x4 a0 = xi[0] + acc[ai][bj][m][0], a1 = xi[1] + acc[ai][bj][m][1];
                    f32x4* xo = (f32x4*)(xout + off); xo[0] = a0; xo[1] = a1;
                    ss += (a0[0] * a0[0] + a0[1] * a0[1]) + (a0[2] * a0[2] + a0[3] * a0[3]) + (a1[0] * a1[0] + a1[1] * a1[1]) + (a1[2] * a1[2] + a1[3] * a1[3]);
                    u32x4 w; w.x = cvt_pk_bf16(a0[0], a0[1]); w.y = cvt_pk_bf16(a0[2], a0[3]); w.z = cvt_pk_bf16(a1[0], a1[1]); w.w = cvt_pk_bf16(a1[2], a1[3]);
                    *(u32x4*)(xb + off) = w;
                }
                ss += __shfl_xor(ss, 16); ss += __shfl_xor(ss, 32);
                if (fq == 0) atomicAdd(rowss_next + row, ss);
            }
    }
};

struct EpiSwiGLU {
    static constexpr bool PERM = true, AFTER_DRAIN = false;
    bf16_t* H; const float* rowss;
    __device__ __forceinline__ void operator()(const f32x4 (&acc)[2][2][4][2], const Unit& u, int wr, int wc, int fr, int fq) const {
        const int row0 = u.pm * BM + wr * 64 + fr;
        const int col0 = u.pn * HALF + wc * 32 + 8 * fq;
#pragma unroll
        for (int ai = 0; ai < 2; ++ai)
#pragma unroll
            for (int m = 0; m < 4; ++m) {
                const int row = row0 + ai * HALF + m * 16;
                const float rs = rstd_of(rowss, row);
                float h[8];
#pragma unroll
                for (int n = 0; n < 2; ++n)
#pragma unroll
                    for (int e = 0; e < 4; ++e) {
                        const float g = acc[ai][0][m][n][e] * rs, up = acc[ai][1][m][n][e] * rs;
                        const float sg = g * __builtin_amdgcn_rcpf(1.0f + __builtin_amdgcn_exp2f(-1.4426950408889634f * g));
                        h[n * 4 + e] = sg * up;
                    }
                u32x4 w; w.x = cvt_pk_bf16(h[0], h[1]); w.y = cvt_pk_bf16(h[2], h[3]); w.z = cvt_pk_bf16(h[4], h[5]); w.w = cvt_pk_bf16(h[6], h[7]);
                *(u32x4*)(H + (size_t)row * 2816 + col0) = w;
            }
    }
};

struct EpiFinal {
    static constexpr bool PERM = true, AFTER_DRAIN = false;
    const float* xin; float* out; float* rowss_next; const float* gfin; unsigned* cnt;
    __device__ __forceinline__ void operator()(f32x4 (&acc)[2][2][4][2], const Unit& u, int wr, int wc, int fr, int fq) const {
        const int row0 = u.pm * BM + wr * 64 + fr;
        const int col0 = u.pn * BM + wc * 32 + 8 * fq;
#pragma unroll
        for (int ai = 0; ai < 2; ++ai)
#pragma unroll
            for (int m = 0; m < 4; ++m) {
                const int row = row0 + ai * HALF + m * 16;
                float ss = 0.f;
#pragma unroll
                for (int bj = 0; bj < 2; ++bj) {
                    const f32x4* xi = (const f32x4*)(xin + (size_t)row * 1024 + col0 + bj * HALF);
                    const f32x4 a0 = xi[0] + acc[ai][bj][m][0], a1 = xi[1] + acc[ai][bj][m][1];
                    acc[ai][bj][m][0] = a0; acc[ai][bj][m][1] = a1;
                    ss += (a0[0] * a0[0] + a0[1] * a0[1]) + (a0[2] * a0[2] + a0[3] * a0[3]) + (a1[0] * a1[0] + a1[1] * a1[1]) + (a1[2] * a1[2] + a1[3] * a1[3]);
                }
                ss += __shfl_xor(ss, 16); ss += __shfl_xor(ss, 32);
                if (fq == 0) atomicAdd(rowss_next + row, ss);
            }
        asm volatile("s_waitcnt vmcnt(0)" ::: "memory");
        unsigned* c = cnt + 64 * u.pm;
        if ((threadIdx.x & 63) == 0) __hip_atomic_fetch_add(c, 1u, __ATOMIC_RELAXED, __HIP_MEMORY_SCOPE_AGENT);
        { unsigned sp = 0;
          while ((unsigned)__builtin_amdgcn_readfirstlane((int)__hip_atomic_load(c, __ATOMIC_RELAXED, __HIP_MEMORY_SCOPE_AGENT)) < 32u) { __builtin_amdgcn_s_sleep(1); if (++sp > (1u << 22)) break; } }
        __builtin_amdgcn_fence(__ATOMIC_ACQUIRE, "agent");
        f32x4 g0[2], g1[2];
#pragma unroll
        for (int bj = 0; bj < 2; ++bj) { const f32x4* gp = (const f32x4*)(gfin + col0 + bj * HALF); g0[bj] = gp[0]; g1[bj] = gp[1]; }
#pragma unroll
        for (int ai = 0; ai < 2; ++ai)
#pragma unroll
            for (int m = 0; m < 4; ++m) {
                const int row = row0 + ai * HALF + m * 16;
                const float tot = __hip_atomic_load(rowss_next + row, __ATOMIC_RELAXED, __HIP_MEMORY_SCOPE_AGENT);
                const float rs = 1.0f / sqrtf(tot * (1.0f / 1024.0f) + RMS_EPS_F);
#pragma unroll
                for (int bj = 0; bj < 2; ++bj) {
                    f32x4* o = (f32x4*)(out + (size_t)row * 1024 + col0 + bj * HALF);
                    o[0] = acc[ai][bj][m][0] * rs * g0[bj]; o[1] = acc[ai][bj][m][1] * rs * g1[bj];
                }
            }
    }
};

template <class Epi, class Sched, bool ALIGN_EPI = false, bool SP2 = false>
__device__ __forceinline__ void gemm_phase(PG8_LAS unsigned char* lds, const Gemm g, const Sched& S, const Epi& E) {
    int tid_ = threadIdx.x; asm volatile("" : "+v"(tid_));
    const int tid = tid_, wid = __builtin_amdgcn_readfirstlane(tid >> 6), lane = tid & 63, wr = wid >> 2, wc = wid & 3, fr = lane & 15, fq = lane >> 4;
    const int K = g.K, nt = K / BK;
    unsigned voffA[2], voffB[2];
#pragma unroll
    for (int i = 0; i < 2; ++i) { int R, C; stage_rc(tid * 16 + i * 8192, R, C); const int Rb = Epi::PERM ? ((R & ~31) + perm32(R & 31)) : R;
        voffA[i] = (unsigned)(R * K + C) * 2u; voffB[i] = (unsigned)(Rb * K + C) * 2u; }
    const size_t kstep = (size_t)(BK * 2);
    const size_t hstep = (size_t)HALF * K * 2;
    const size_t tstep = 2 * hstep;
    const unsigned ldsw = (unsigned)wid * 1024u;
    const int aoff = lds_byte(wr * 64 + fr, fq * 8), boff = lds_byte(wc * 32 + fr, fq * 8);
#define PG8_SA(b, h) (((b) * 2 + (h)) * HTB)
#define PG8_SB(b, h) ((4 + (b) * 2 + (h)) * HTB)
#define PG8_STAGE(bufoff, gbase, voff) do { _Pragma("unroll") for (int _i = 0; _i < 2; ++_i) \
        __builtin_amdgcn_global_load_lds((const unsigned*)((const char*)(gbase) + (voff)[_i]), (PG8_LAS unsigned*)(lds + (bufoff) + ldsw + _i * 8192), 16, 0, 0); } while (0)
#define PG8_LDA(dst, b, h) do { _Pragma("unroll") for (int m = 0; m < 4; ++m) _Pragma("unroll") for (int k = 0; k < 2; ++k) dst[m][k] = *(const PG8_LAS bf16x8*)(lds + PG8_SA(b, h) + aoff + m * 2048 + k * 1024); } while (0)
#define PG8_LDB(dst, b, h) do { _Pragma("unroll") for (int n = 0; n < 2; ++n) _Pragma("unroll") for (int k = 0; k < 2; ++k) dst[n][k] = *(const PG8_LAS bf16x8*)(lds + PG8_SB(b, h) + boff + n * 2048 + k * 1024); } while (0)
#define PG8_MMA(ai, bj, At, Bt) do { __builtin_amdgcn_s_setprio(1); _Pragma("unroll") for (int m = 0; m < 4; ++m) _Pragma("unroll") for (int n = 0; n < 2; ++n) _Pragma("unroll") for (int k = 0; k < 2; ++k) \
        acc[ai][bj][m][n] = __builtin_amdgcn_mfma_f32_16x16x32_bf16(Bt[n][k], At[m][k], acc[ai][bj][m][n], 0, 0, 0); __builtin_amdgcn_s_setprio(0); } while (0)
#define PG8_WAIT_V(n) asm volatile("s_waitcnt vmcnt(" #n ")" ::: "memory")
#define PG8_WAIT_L(n) asm volatile("s_waitcnt lgkmcnt(" #n ")" ::: "memory")
#define PG8_BAR __builtin_amdgcn_s_barrier()
#define PG8_SCHED __builtin_amdgcn_sched_barrier(0)
    Unit cur, nxt; int ui = 0;
    if (!S.next(0, cur)) return;
    f32x4 acc[2][2][4][2];
#pragma unroll
    for (int a = 0; a < 2; ++a)
#pragma unroll
        for (int b = 0; b < 2; ++b)
#pragma unroll
            for (int m = 0; m < 4; ++m)
#pragma unroll
                for (int n = 0; n < 2; ++n) acc[a][b][m][n] = (f32x4){0.f, 0.f, 0.f, 0.f};
    bf16x8 At[4][2], B0[2][2], B1[2][2];
    const char* cA = (const char*)g.A + (size_t)cur.pm * tstep; const char* cB = (const char*)g.Bt + (size_t)cur.pn * tstep;
    S.a_ready(cur);
    if constexpr (SP2) {
        PG8_STAGE(PG8_SB(0, 0), cB, voffB); PG8_STAGE(PG8_SB(0, 1), cB + hstep, voffB); PG8_STAGE(PG8_SA(0, 0), cA, voffA); PG8_STAGE(PG8_SA(0, 1), cA + hstep, voffA);
        if (wr == 1) PG8_BAR;
        PG8_WAIT_V(2); PG8_BAR;
        PG8_STAGE(PG8_SB(1, 0), cB + kstep, voffB); PG8_STAGE(PG8_SA(1, 0), cA + kstep, voffA); PG8_STAGE(PG8_SB(1, 1), cB + hstep + kstep, voffB);
        PG8_WAIT_V(6); PG8_BAR;
    } else {
        PG8_STAGE(PG8_SB(0, 0), cB, voffB); PG8_STAGE(PG8_SA(0, 0), cA, voffA); PG8_STAGE(PG8_SB(0, 1), cB + hstep, voffB); PG8_STAGE(PG8_SA(0, 1), cA + hstep, voffA);
        if (wr == 1) PG8_BAR;
        PG8_WAIT_V(4); PG8_BAR;
        PG8_STAGE(PG8_SB(1, 0), cB + kstep, voffB); PG8_STAGE(PG8_SA(1, 0), cA + kstep, voffA); PG8_STAGE(PG8_SB(1, 1), cB + hstep + kstep, voffB);
        PG8_WAIT_V(6); PG8_BAR;
    }
    for (;;) {
        const bool has_next = S.next(ui + 1, nxt);
        const char* nA = has_next ? (const char*)g.A + (size_t)nxt.pm * tstep : cA; const char* nB = has_next ? (const char*)g.Bt + (size_t)nxt.pn * tstep : cB;
        for (int t = 0; t < nt; t += 2) {
            const bool last = (t == nt - 2);
            const char* a1 = cA + (size_t)(t + 1) * kstep;
            const char* a2 = last ? nA : cA + (size_t)(t + 2) * kstep; const char* b2 = last ? nB : cB + (size_t)(t + 2) * kstep;
            const char* a3 = a2 + kstep; const char* b3 = b2 + kstep;
            if (last && has_next) S.a_ready(nxt);
            if constexpr (SP2) {
            PG8_LDB(B0, 0, 0); PG8_LDB(B1, 0, 1); PG8_SCHED; PG8_LDA(At, 0, 0); PG8_STAGE(PG8_SA(1, 1), a1 + hstep, voffA);
            PG8_WAIT_V(8); PG8_WAIT_L(0); PG8_BAR; PG8_MMA(0, 0, At, B0); PG8_MMA(0, 1, At, B1); PG8_BAR; PG8_SCHED;
            PG8_LDA(At, 0, 1); PG8_STAGE(PG8_SB(0, 0), b2, voffB); PG8_STAGE(PG8_SB(0, 1), b2 + hstep, voffB); PG8_STAGE(PG8_SA(0, 0), a2, voffA);
            PG8_WAIT_V(8); PG8_WAIT_L(0); PG8_BAR; PG8_MMA(1, 0, At, B0); PG8_MMA(1, 1, At, B1); PG8_BAR; PG8_SCHED;
            PG8_LDB(B0, 1, 0); PG8_LDB(B1, 1, 1); PG8_SCHED; PG8_LDA(At, 1, 0); PG8_STAGE(PG8_SA(0, 1), a2 + hstep, voffA);
            PG8_WAIT_V(8); PG8_WAIT_L(0); PG8_BAR; PG8_MMA(0, 0, At, B0); PG8_MMA(0, 1, At, B1); PG8_BAR; PG8_SCHED;
            PG8_LDA(At, 1, 1); PG8_STAGE(PG8_SB(1, 0), b3, voffB); PG8_STAGE(PG8_SB(1, 1), b3 + hstep, voffB); PG8_STAGE(PG8_SA(1, 0), a3, voffA);
            PG8_WAIT_V(8); PG8_WAIT_L(0); PG8_BAR; PG8_MMA(1, 0, At, B0); PG8_MMA(1, 1, At, B1); PG8_BAR; PG8_SCHED;
            } else {
            PG8_LDB(B0, 0, 0); PG8_SCHED; PG8_LDA(At, 0, 0); PG8_STAGE(PG8_SA(1, 1), a1 + hstep, voffA);
            PG8_WAIT_L(8); PG8_BAR; PG8_WAIT_L(0); PG8_MMA(0, 0, At, B0); PG8_BAR; PG8_SCHED;
            PG8_LDB(B1, 0, 1); PG8_STAGE(PG8_SB(0, 0), b2, voffB);
            PG8_BAR; PG8_WAIT_L(0); PG8_MMA(0, 1, At, B1); PG8_BAR;
            PG8_LDA(At, 0, 1); PG8_STAGE(PG8_SA(0, 0), a2, voffA);
            PG8_BAR; PG8_WAIT_L(0); PG8_MMA(1, 0, At, B0); PG8_BAR; PG8_SCHED;
            PG8_STAGE(PG8_SB(0, 1), b2 + hstep, voffB);
            PG8_WAIT_V(6); PG8_BAR; PG8_MMA(1, 1, At, B1); PG8_BAR;
            PG8_LDB(B0, 1, 0); PG8_SCHED; PG8_LDA(At, 1, 0); PG8_STAGE(PG8_SA(0, 1), a2 + hstep, voffA);
            PG8_WAIT_L(8); PG8_BAR; PG8_WAIT_L(0); PG8_MMA(0, 0, At, B0); PG8_BAR; PG8_SCHED;
            PG8_LDB(B1, 1, 1); PG8_STAGE(PG8_SB(1, 0), b3, voffB);
            PG8_BAR; PG8_WAIT_L(0); PG8_MMA(0, 1, At, B1); PG8_BAR;
            PG8_LDA(At, 1, 1); PG8_STAGE(PG8_SA(1, 0), a3, voffA);
            PG8_BAR; PG8_WAIT_L(0); PG8_MMA(1, 0, At, B0); PG8_BAR; PG8_SCHED;
            PG8_STAGE(PG8_SB(1, 1), b3 + hstep, voffB);
            PG8_WAIT_V(6); PG8_BAR; PG8_MMA(1, 1, At, B1); PG8_BAR;
            }
        }
        if constexpr (ALIGN_EPI) { if (wr == 0) PG8_BAR; }
        if constexpr (!Epi::AFTER_DRAIN) { E(acc, cur, wr, wc, fr, fq); S.done(cur); }
        if (!has_next) break;
#pragma unroll
        for (int a = 0; a < 2; ++a)
#pragma unroll
            for (int b = 0; b < 2; ++b)
#pragma unroll
                for (int m = 0; m < 4; ++m)
#pragma unroll
                    for (int n = 0; n < 2; ++n) acc[a][b][m][n] = (f32x4){0.f, 0.f, 0.f, 0.f};
        cur = nxt; cA = nA; cB = nB; ++ui;
        if constexpr (ALIGN_EPI) { if (wr == 1) PG8_BAR; }
    }
    PG8_WAIT_V(0);
    if constexpr (!ALIGN_EPI) { if (wr == 0) PG8_BAR; }
    PG8_BAR;
    if constexpr (Epi::AFTER_DRAIN) { E.fused(acc, cur, wr, wc, fr, fq, lds, wid, lane); S.done(cur); }
#undef PG8_SA
#undef PG8_SB
#undef PG8_STAGE
#undef PG8_LDA
#undef PG8_LDB
#undef PG8_MMA
#undef PG8_WAIT_V
#undef PG8_WAIT_L
#undef PG8_BAR
#undef PG8_SCHED
}
}
#include <hip/hip_bf16.h>
#include <cmath>
namespace attn_body {
using bf16=__hip_bfloat16;
using bf16x8=__attribute__((ext_vector_type(8)))short;
using s16x4=__attribute__((ext_vector_type(4)))short;
using f32x16=__attribute__((ext_vector_type(16)))float;
using u32x4=__attribute__((ext_vector_type(4)))unsigned;
using f32x4_t=__attribute__((ext_vector_type(4)))float;
constexpr int BATCH=8,NHEAD=16,SEQ=2048,D=64,DM=3072,DMO=1024;
constexpr int NW=8,QBLK=32,QB=QBLK*NW,KVBLK=64,NQB=SEQ/QB;
constexpr int ATTN_PITCH=DM, ATTN_UNIT_ROWS=QB;
__device__ __forceinline__ int crow(int r,int hi){return (r&3)+8*(r>>2)+4*hi;}
#define SBAR() __builtin_amdgcn_sched_barrier(0)
__device__ __forceinline__ void cmask(f32x16&p0,f32x16&p1,int jb,int qrel,int hi){
  const float NEG=-INFINITY; int kb=64*jb+4*hi;
  #pragma unroll
  for(int r=0;r<16;++r){int kv=kb+(r&3)+8*(r>>2); if(kv>qrel)p0[r]=NEG; if(kv+32>qrel)p1[r]=NEG;}
}

constexpr int NSLOT=3, SLOTB=8192;
constexpr int LDS_K=0, LDS_V=NSLOT*SLOTB, LDS_WS=2*NSLOT*SLOTB, LDS_OST=LDS_WS+NW*64*4, LDS_BYTES=LDS_OST+NW*4096;
constexpr float C2=0.125f*1.4426950408889634f;
__device__ __forceinline__ void glds16(const void*gsrc,unsigned lds_dst){unsigned keep;
  asm volatile("s_mov_b32 %0, m0\n\ts_mov_b32 m0, %2\n\ts_nop 0\n\tglobal_load_lds_dwordx4 %1, off\n\ts_mov_b32 m0, %0":"=&s"(keep):"v"(gsrc),"s"(lds_dst):"memory");}
__device__ __forceinline__ float max3f(float a,float b,float c){float r;asm("v_max3_f32 %0, %1, %2, %3":"=v"(r):"v"(a),"v"(b),"v"(c));return r;}
__device__ __forceinline__ float max2f(float a,float b){float r;asm("v_max_f32_e32 %0, %1, %2":"=v"(r):"v"(a),"v"(b));return r;}
__device__ __forceinline__ float fadd_s(float a,float b){float r;asm("v_add_f32_e32 %0, %1, %2":"=v"(r):"v"(a),"v"(b));return r;}
__device__ __forceinline__ float fsub_s(float a,float b){float r;asm("v_sub_f32_e32 %0, %1, %2":"=v"(r):"v"(a),"v"(b));return r;}
typedef float f32x2_t __attribute__((ext_vector_type(2))); typedef __bf16 bf16x2_t __attribute__((ext_vector_type(2)));
__device__ __forceinline__ unsigned cvtpk_s(float lo,float hi){f32x2_t v={lo,hi};bf16x2_t b=__builtin_convertvector(v,bf16x2_t);return __builtin_bit_cast(unsigned,b);}
#define WAIT_BAR(N) asm volatile("s_waitcnt vmcnt(" #N ") lgkmcnt(0)\n\ts_barrier":::"memory")

__device__ __forceinline__ void qkt(f32x16&p0,f32x16&p1,const char*Kslot,const bf16x8*qr,int r32,int hi){
  const char*kb=Kslot+hi*1024+r32*16;
  #pragma unroll
  for(int d0=0;d0<4;++d0){
    const bf16x8 b0=*reinterpret_cast<const bf16x8*>(kb+d0*2048);
    const bf16x8 b1=*reinterpret_cast<const bf16x8*>(kb+d0*2048+512);
    p0=__builtin_amdgcn_mfma_f32_32x32x16_bf16(b0,qr[d0],p0,0,0,0);p1=__builtin_amdgcn_mfma_f32_32x32x16_bf16(b1,qr[d0],p1,0,0,0);}
}
typedef __attribute__((address_space(3))) const char* lds_cptr;
typedef short v4i16_t __attribute__((ext_vector_type(4)));
__device__ __forceinline__ void kload8(bf16x8*kf,lds_cptr kp){
  kf[0]=*(const __attribute__((address_space(3))) bf16x8*)(kp);      kf[1]=*(const __attribute__((address_space(3))) bf16x8*)(kp+512);
  kf[2]=*(const __attribute__((address_space(3))) bf16x8*)(kp+2048); kf[3]=*(const __attribute__((address_space(3))) bf16x8*)(kp+2560);
  kf[4]=*(const __attribute__((address_space(3))) bf16x8*)(kp+4096); kf[5]=*(const __attribute__((address_space(3))) bf16x8*)(kp+4608);
  kf[6]=*(const __attribute__((address_space(3))) bf16x8*)(kp+6144); kf[7]=*(const __attribute__((address_space(3))) bf16x8*)(kp+6656);
}
__device__ __forceinline__ void kload2(bf16x8*kf,lds_cptr kp,int j){ kf[2*j]=*(const __attribute__((address_space(3))) bf16x8*)(kp+j*2048); kf[2*j+1]=*(const __attribute__((address_space(3))) bf16x8*)(kp+j*2048+512); }
__device__ __forceinline__ s16x4 vtr(lds_cptr p){ return __builtin_bit_cast(s16x4,__builtin_amdgcn_ds_read_tr16_b64_v4i16((__attribute__((address_space(3))) v4i16_t*)p)); }
__device__ __forceinline__ float rowmax(const f32x16&p0,const f32x16&p1){
  float a=max3f(p0[0],p0[1],p1[0]),b=max3f(p0[2],p0[3],p1[1]);a=max3f(a,p1[2],p1[3]);
  #pragma unroll
  for(int r=4;r<16;r+=4){a=max3f(a,p0[r],p0[r+1]);b=max3f(b,p0[r+2],p0[r+3]);a=max3f(a,p1[r],p1[r+1]);b=max3f(b,p1[r+2],p1[r+3]);}
  const float m=max2f(a,b);
  auto rr=__builtin_amdgcn_permlane32_swap(__float_as_uint(m),__float_as_uint(m),false,false);
  return max2f(__uint_as_float(rr[0]),__uint_as_float(rr[1]));
}
__device__ __forceinline__ void pv(f32x16*o,int vb,bf16x8 pa0,bf16x8 pa1,bf16x8 pa2,bf16x8 pa3){
  #pragma unroll
  for(int d0=0;d0<2;++d0){s16x4 lo[4],hi[4];
    #pragma unroll
    for(int ks=0;ks<4;++ks){
      asm volatile("ds_read_b64_tr_b16 %0,%1 offset:%c2":"=&v"(lo[ks]):"v"(vb),"i"(d0*4096+ks*1024):"memory");
      asm volatile("ds_read_b64_tr_b16 %0,%1 offset:%c2":"=&v"(hi[ks]):"v"(vb),"i"(d0*4096+ks*1024+512):"memory");}
    asm volatile("s_waitcnt lgkmcnt(0)":::"memory");SBAR();
    #define PK(k) (bf16x8){lo[k][0],lo[k][1],lo[k][2],lo[k][3],hi[k][0],hi[k][1],hi[k][2],hi[k][3]}
    o[d0]=__builtin_amdgcn_mfma_f32_32x32x16_bf16(pa0,PK(0),o[d0],0,0,0);
    o[d0]=__builtin_amdgcn_mfma_f32_32x32x16_bf16(pa1,PK(1),o[d0],0,0,0);
    o[d0]=__builtin_amdgcn_mfma_f32_32x32x16_bf16(pa2,PK(2),o[d0],0,0,0);
    o[d0]=__builtin_amdgcn_mfma_f32_32x32x16_bf16(pa3,PK(3),o[d0],0,0,0);
    #undef PK
  }
}

#ifndef ATTN_STORE16
#define ATTN_STORE16(p,v) (*(u32x4*)(p)=(v))
#endif
template<int THRL> __device__ __forceinline__ void attn_unit(int b,int h,int qb,const bf16*Q,const bf16*__restrict__ K,const bf16*__restrict__ V,bf16*O,char*shm,const __attribute__((address_space(3))) float*Fs){
  int tid_=threadIdx.x; asm volatile("":"+v"(tid_)); const int tid=tid_,lane=tid&63,r32=lane&31,hi=lane>>5;   const int wid=__builtin_amdgcn_readfirstlane(tid>>6);
  const long rowbase=(long)b*SEQ; const int q0=qb*QB;
  const bf16*Qw=Q+(rowbase+q0+wid*QBLK)*DM+h*D;
  const bf16*Kh=K+rowbase*DM+h*D,*Vh=V+rowbase*DM+h*D;
  const unsigned lds0=(unsigned)(uintptr_t)shm;
  float*wsf=(float*)(shm+LDS_WS)+wid*64;
  const bf16*ksrc=Kh+(long)lane*DM+wid*8;
  const bf16*vsrc=Vh+(long)(16*(wid&3)+(lane>>2))*DM+(wid>>2)*32+(lane&3)*8;
  const unsigned kdst=lds0+LDS_K+wid*1024, vdst=lds0+LDS_V+wid*1024;
  #define DMA_K(t,slot) glds16(ksrc+(long)(t)*KVBLK*DM,(unsigned)__builtin_amdgcn_readfirstlane(kdst+(slot)))
  #define DMA_V(t,slot) glds16(vsrc+(long)(t)*KVBLK*DM,(unsigned)__builtin_amdgcn_readfirstlane(vdst+(slot)))
  const int vb0=(int)(lds0+LDS_V)+((lane>>4)&1)*32+(lane&3)*8+(4*hi+((lane&15)>>2))*64;
  const char*Kbase=shm+LDS_K; bf16x8 kf[8];
  const lds_cptr shm3=(lds_cptr)shm; const lds_cptr kp0=shm3+LDS_K+hi*1024+r32*16; const lds_cptr vp0=shm3+LDS_V+((lane>>4)&1)*32+(lane&3)*8+(4*hi+((lane&15)>>2))*64;
  const int NT=(q0+QB)/KVBLK;
  DMA_K(0,0);DMA_V(0,0);DMA_K(1,SLOTB);
  bf16x8 qr[4];
  #pragma unroll
  for(int d0=0;d0<4;++d0)qr[d0]=*reinterpret_cast<const bf16x8*>(&Qw[(long)r32*DM+d0*16+hi*8]);
  float mhat=0.f,l_reg=0.f;f32x16 o[2];o[0]=f32x16{};o[1]=f32x16{};
  const int qrel=wid*QBLK+r32;
  const float Fq=Fs[q0+qrel];
  #define BIAS(C0,C1,t) do{ const __attribute__((address_space(3))) f32x4_t*fk_=(const __attribute__((address_space(3))) f32x4_t*)(Fs+64*(t)+4*hi); const float fb_=Fq-mhat; \
    _Pragma("unroll") for(int g_=0;g_<4;++g_){ const f32x4_t a_=fk_[2*g_], b_=fk_[8+2*g_]; \
      _Pragma("unroll") for(int e_=0;e_<4;++e_){ C0[4*g_+e_]=fb_-a_[e_]; C1[4*g_+e_]=fb_-b_[e_]; } } }while(0)
  #define CMASK(P0,P1,t) do{int jb_=(t)-(NT-4); if(jb_>=0)cmask(P0,P1,jb_,qrel,hi);}while(0)
  bool resc=false;
  #define START(P0,P1) do{ const float rm=rowmax(P0,P1); resc=false; \
    { const float dl=rm; mhat=fadd_s(mhat,dl); \
      _Pragma("unroll") for(int r=0;r<16;++r){P0[r]=fsub_s(P0[r],dl);P1[r]=fsub_s(P1[r],dl);} \
      } \
    _Pragma("unroll") for(int r=0;r<16;++r)P0[r]=__builtin_amdgcn_exp2f(P0[r]); }while(0)
  #define RESC() do{ if(resc){ asm volatile("s_waitcnt lgkmcnt(0)":::"memory"); \
      _Pragma("unroll") for(int d_=0;d_<2;++d_) _Pragma("unroll") for(int r=0;r<16;++r)o[d_][r]*=wsf[crow(r,hi)]; } }while(0)
  f32x16 pA0,pA1,pB0,pB1;
  int sl_prev=0,sl_cur=0,sl_next=SLOTB;
  #define ROT() do{sl_prev=sl_cur;sl_cur=sl_next;sl_next=(sl_next==(NSLOT-1)*SLOTB)?0:sl_next+SLOTB;}while(0)
  DMA_K(2,2*SLOTB);
  WAIT_BAR(3);
  BIAS(pA0,pA1,0); qkt(pA0,pA1,Kbase,qr,r32,hi);asm volatile("s_nop 15\n\ts_nop 7":"+v"(pA0),"+v"(pA1));CMASK(pA0,pA1,0);
  START(pA0,pA1);
  _Pragma("unroll") for(int r=0;r<16;++r)pA1[r]=__builtin_amdgcn_exp2f(pA1[r]);
  WAIT_BAR(0);
  DMA_K(3,0);DMA_V(1,SLOTB);
  ROT();
  kload8(kf,kp0+sl_cur);
  WAIT_BAR(2);
  s16x4 vlo[8],vhi[8]; u32x4 pw0,pw1,pw2,pw3;
  #define PKW(P,B) cvtpk_s(P[B],P[B+1])
  #define PAF(k) __builtin_bit_cast(bf16x8,pw##k)
  #define VFR(i) (bf16x8){vlo[i][0],vlo[i][1],vlo[i][2],vlo[i][3],vhi[i][0],vhi[i][1],vhi[i][2],vhi[i][3]}
  #define PIN(x) asm volatile("":"+v"(x))
  #define MX3(a,b,c) __builtin_fmaxf(__builtin_fmaxf((a),(b)),(c))
  #define GAPA(MF,A0,A1,A2,A3,W0,W1,PW) do{ MF; sacc+=A0; sacc+=A1; sacc+=A2; sacc+=A3; PIN(sacc); W0; W1; PIN(PW); SBAR(); }while(0)
  #define EX(v) __builtin_amdgcn_exp2f(v)
  #define GAPB(MF,X,B) do{ MF; X[B]=EX(X[B]); X[B+1]=EX(X[B+1]); X[B+2]=EX(X[B+2]); X[B+3]=EX(X[B+3]); PIN(X); SBAR(); }while(0)
  #define VRD(i) do{ vlo[i]=vtr(vp_+(((i)>>2)*4096+((i)&3)*1024)); vhi[i]=vtr(vp_+(((i)>>2)*4096+((i)&3)*1024+512)); }while(0)
  #define KRD(G,j) do{ if(G){ kload2(kf,kp0+sl_next,j); SBAR(); } }while(0)
  #define STEP(C0,C1,P0,P1,t,GK,GV,GL) do{ SBAR(); BIAS(C0,C1,t); \
    const lds_cptr vp_=vp0+sl_prev; \
    VRD(0); SBAR(); float sacc=(P0[0]+P0[1]); \
    GAPA(C0=__builtin_amdgcn_mfma_f32_32x32x16_bf16(kf[0],qr[0],C0,0,0,0), P0[2],P0[3],P0[4],P0[5],     pw0[0]=PKW(P0,0), pw0[1]=PKW(P0,2), pw0); \
    VRD(4); SBAR(); GAPA(C1=__builtin_amdgcn_mfma_f32_32x32x16_bf16(kf[1],qr[0],C1,0,0,0), P0[6],P0[7],P0[8],P0[9],     pw0[2]=PKW(P0,4), pw0[3]=PKW(P0,6), pw0); \
    VRD(1); SBAR(); GAPA(C0=__builtin_amdgcn_mfma_f32_32x32x16_bf16(kf[2],qr[1],C0,0,0,0),   P0[10],P0[11],P0[12],P0[13], pw1[0]=PKW(P0,8), pw1[1]=PKW(P0,10), pw1); \
    VRD(5); SBAR(); GAPA(C1=__builtin_amdgcn_mfma_f32_32x32x16_bf16(kf[3],qr[1],C1,0,0,0),   P0[14],P0[15],P1[0],P1[1],   pw1[2]=PKW(P0,12),pw1[3]=PKW(P0,14), pw1); \
    VRD(2); SBAR(); GAPA(C0=__builtin_amdgcn_mfma_f32_32x32x16_bf16(kf[4],qr[2],C0,0,0,0),   P1[2],P1[3],P1[4],P1[5],     pw2[0]=PKW(P1,0), pw2[1]=PKW(P1,2), pw2); \
    VRD(6); SBAR(); GAPA(C1=__builtin_amdgcn_mfma_f32_32x32x16_bf16(kf[5],qr[2],C1,0,0,0),   P1[6],P1[7],P1[8],P1[9],     pw2[2]=PKW(P1,4), pw2[3]=PKW(P1,6), pw2); \
    VRD(3); SBAR(); GAPA(C0=__builtin_amdgcn_mfma_f32_32x32x16_bf16(kf[6],qr[3],C0,0,0,0),   P1[10],P1[11],P1[12],P1[13], pw3[0]=PKW(P1,8), pw3[1]=PKW(P1,10), pw3); \
    VRD(7); SBAR(); GAPA(C1=__builtin_amdgcn_mfma_f32_32x32x16_bf16(kf[7],qr[3],C1,0,0,0),   P1[14],P1[15],0.f,0.f,       pw3[2]=PKW(P1,12),pw3[3]=PKW(P1,14), pw3); \
    l_reg+=sacc; \
    if(GK){DMA_K((t)+3,sl_cur);} if(GV){DMA_V((t)+1,sl_next);} \
    CMASK(C0,C1,t); \
    { float a=MX3(C0[0],C0[1],C1[0]),b=MX3(C0[2],C0[3],C1[1]); a=MX3(a,C1[2],C1[3]); \
      _Pragma("unroll") for(int r=4;r<16;r+=4){a=MX3(a,C0[r],C0[r+1]);b=MX3(b,C0[r+2],C0[r+3]);a=MX3(a,C1[r],C1[r+1]);b=MX3(b,C1[r+2],C1[r+3]);} \
      float rm=__builtin_fmaxf(a,b); { auto rr=__builtin_amdgcn_permlane32_swap(__float_as_uint(rm),__float_as_uint(rm),false,false); rm=__builtin_fmaxf(__uint_as_float(rr[0]),__uint_as_float(rr[1])); } \
      resc=false; \
      if(__builtin_expect(__any(rm>(float)THRL),0)){ const float dl=__builtin_fmaxf(rm,0.f); mhat+=dl; \
        _Pragma("unroll") for(int r=0;r<16;++r){C0[r]-=dl;C1[r]-=dl;} \
        const float f=__builtin_amdgcn_exp2f(-dl); l_reg*=f; if(hi==0)wsf[r32]=f; resc=true; } } \
    SBAR(); \
    GAPB(o[0]=__builtin_amdgcn_mfma_f32_32x32x16_bf16(PAF(0),VFR(0),o[0],0,0,0), C0,0); \
    GAPB(o[1]=__builtin_amdgcn_mfma_f32_32x32x16_bf16(PAF(0),VFR(4),o[1],0,0,0), C0,4); \
    KRD(GL,0); GAPB(o[0]=__builtin_amdgcn_mfma_f32_32x32x16_bf16(PAF(1),VFR(1),o[0],0,0,0), C0,8); \
    KRD(GL,1); GAPB(o[1]=__builtin_amdgcn_mfma_f32_32x32x16_bf16(PAF(1),VFR(5),o[1],0,0,0), C0,12); \
    KRD(GL,2); GAPB(o[0]=__builtin_amdgcn_mfma_f32_32x32x16_bf16(PAF(2),VFR(2),o[0],0,0,0), C1,0); \
    KRD(GL,3); GAPB(o[1]=__builtin_amdgcn_mfma_f32_32x32x16_bf16(PAF(2),VFR(6),o[1],0,0,0), C1,4); \
    GAPB(o[0]=__builtin_amdgcn_mfma_f32_32x32x16_bf16(PAF(3),VFR(3),o[0],0,0,0), C1,8); \
    GAPB(o[1]=__builtin_amdgcn_mfma_f32_32x32x16_bf16(PAF(3),VFR(7),o[1],0,0,0), C1,12); \
    }while(0)
  int t=1;
  #undef CMASK
  #define CMASK(P0,P1,t) do{}while(0)
  for(;t+5<NT;t+=2){
    STEP(pB0,pB1,pA0,pA1,t,true,true,true);     WAIT_BAR(2); RESC(); ROT();
    STEP(pA0,pA1,pB0,pB1,t+1,true,true,true);   WAIT_BAR(2); RESC(); ROT();
  }
  #undef CMASK
  #define CMASK(P0,P1,t) do{int jb_=(t)-(NT-4); if(jb_>=0)cmask(P0,P1,jb_,qrel,hi);}while(0)
  #define ENDW(tt) do{ if((tt)+3<NT){WAIT_BAR(2);} else if((tt)+2<NT){WAIT_BAR(1);} else {WAIT_BAR(0);} }while(0)
  for(;t+1<NT;t+=2){
    STEP(pB0,pB1,pA0,pA1,t,(t+3<NT),(t+1<NT),(t+1<NT));       ENDW(t);   RESC(); ROT();
    STEP(pA0,pA1,pB0,pB1,t+1,(t+4<NT),(t+2<NT),(t+2<NT));     ENDW(t+1); RESC(); ROT();
  }
  STEP(pB0,pB1,pA0,pA1,NT-1,false,false,false); RESC();
  { float sacc=pB0[0]+pB0[1]; _Pragma("unroll") for(int r=2;r<16;++r)sacc+=pB0[r]; _Pragma("unroll") for(int r=0;r<16;++r)sacc+=pB1[r]; l_reg+=sacc;
    pw0=(u32x4){PKW(pB0,0),PKW(pB0,2),PKW(pB0,4),PKW(pB0,6)};pw1=(u32x4){PKW(pB0,8),PKW(pB0,10),PKW(pB0,12),PKW(pB0,14)};pw2=(u32x4){PKW(pB1,0),PKW(pB1,2),PKW(pB1,4),PKW(pB1,6)};pw3=(u32x4){PKW(pB1,8),PKW(pB1,10),PKW(pB1,12),PKW(pB1,14)};
    SBAR(); pv(o,vb0+sl_cur,PAF(0),PAF(1),PAF(2),PAF(3)); }
  #undef PKW
  #undef PAF
  #undef VFR
  #undef PIN
  #undef MX3
  #undef GAPA
  #undef GAPB
  #undef EX
  #undef VRD
  #undef KRD
  #undef STEP
  #undef ENDW
  {auto rr=__builtin_amdgcn_permlane32_swap(__float_as_uint(l_reg),__float_as_uint(l_reg),false,false);l_reg=__uint_as_float(rr[0])+__uint_as_float(rr[1]);}
  if(hi==0)wsf[32+r32]=l_reg;asm volatile("s_waitcnt lgkmcnt(0)":::"memory");
  float rli[16];
  #pragma unroll
  for(int r=0;r<16;++r)rli[r]=__builtin_amdgcn_rcpf(wsf[32+crow(r,hi)]);
  bf16*Ow=O+(rowbase+q0+wid*QBLK)*DMO+h*D;
  { bf16*stg=(bf16*)(shm+LDS_OST)+wid*2048;
    #pragma unroll
    for(int r=0;r<16;++r){const int orow=crow(r,hi);
      #pragma unroll
      for(int d0=0;d0<2;++d0)stg[orow*64+d0*32+r32]=__float2bfloat16(o[d0][r]*rli[r]);}
    asm volatile("s_waitcnt lgkmcnt(0)":::"memory");
    #pragma unroll
    for(int i=0;i<4;++i){const int row=i*8+(lane>>3),ch=lane&7; const u32x4 v=*(const u32x4*)(stg+row*64+ch*8); ATTN_STORE16(Ow+(long)row*DMO+ch*8,v);} }
  asm volatile("s_waitcnt lgkmcnt(0)\n\ts_barrier":::"memory");
  #undef DMA_K
  #undef DMA_V
  #undef CMASK
  #undef START
  #undef RESC
  #undef ROT
  #undef BIAS
}
constexpr int ATTN_LDS_BYTES=LDS_BYTES;
#undef SBAR
#undef WAIT_BAR
}

#define LAS __attribute__((address_space(3)))
typedef unsigned short bf16_t;
typedef short bf16x8 __attribute__((ext_vector_type(8)));
typedef short s16x4 __attribute__((ext_vector_type(4)));
typedef float f32x4 __attribute__((ext_vector_type(4)));
typedef float f32x16 __attribute__((ext_vector_type(16)));
typedef unsigned u32x4 __attribute__((ext_vector_type(4)));
typedef unsigned u32x2 __attribute__((ext_vector_type(2)));

constexpr int NB = 8, SEQ = 2048, DM = 1024, MTOK = NB * SEQ, DFF = 2816, NLAYER = 4, QKV_LD = 3072;
constexpr int NWAVES = 8, NTHR = 512;
constexpr float LOG2E = 1.4426950408889634f;
constexpr int LDS_BYTES = 147456;
constexpr int VROW = 192;
constexpr int VTILE = 32 * VROW;
constexpr int LDS_F = 49152;
constexpr int NPHASE = 2 + 5 * NLAYER;
constexpr int LDS_MISC = 131072;

constexpr size_t MiB = 1u << 20;
constexpr size_t SZ_WQKV = (size_t)3072 * 1024 * 2, SZ_WO = (size_t)1024 * 1024 * 2, SZ_WI = (size_t)5632 * 1024 * 2, SZ_WOUT = (size_t)1024 * 2816 * 2;
constexpr size_t SZ_WLAYER = SZ_WQKV + SZ_WO + SZ_WI + SZ_WOUT;
constexpr size_t WS_W = 0;
constexpr size_t WS_XB = 104 * MiB;
constexpr size_t WS_XRES = WS_XB + 32 * MiB;
constexpr size_t WS_QKV = WS_XRES + 64 * MiB;
constexpr size_t WS_ATT = WS_QKV + 96 * MiB;
constexpr size_t WS_SMALL = WS_ATT + 32 * MiB;
constexpr size_t WS_ROWSS = WS_SMALL;
constexpr size_t WS_ROT = WS_ROWSS + (size_t)9 * MTOK * 4;
constexpr size_t WS_WF = WS_ROT + (size_t)2048 * 16 * 4;
constexpr size_t WS_LOCF = WS_WF + (size_t)2 * 16 * 1024 * 4;
constexpr size_t WS_TOTF = WS_LOCF + (size_t)128 * 2048 * 4;
constexpr size_t WS_LSE = WS_TOTF + (size_t)128 * 32 * 4;
constexpr size_t WS_BAR = WS_LSE + (size_t)2 * MTOK * 8 * 4;
constexpr size_t WS_PCNT = WS_BAR + 16384;
constexpr size_t WS_END = WS_PCNT + 16384;
static_assert(SZ_WLAYER * 4 <= 104 * MiB, "weights fit");

struct Args {
    const float* x; const float* norm_mix; const float* w_qkv_even; const float* w_o_even; const float* w_qkvf_odd; const float* b_forget; const float* w_o_odd;
    const float* norm_ffn; const float* w_ffn_in; const float* w_ffn_out; const float* norm_final;
    float* out; unsigned char* ws; int ph_lo, ph_hi;
};

__device__ __forceinline__ unsigned f2bf(float f) { unsigned u = __builtin_bit_cast(unsigned, f); return (u + 0x7fffu + ((u >> 16) & 1u)) >> 16; }
__device__ __forceinline__ unsigned pk2(float lo, float hi) { return f2bf(lo) | (f2bf(hi) << 16); }
__device__ __forceinline__ unsigned cvtpk(float lo, float hi) { unsigned r; asm volatile("v_cvt_pk_bf16_f32 %0, %1, %2" : "=v"(r) : "v"(lo), "v"(hi)); return r; }
__device__ __forceinline__ float wave_sum(float v) {
#pragma unroll
    for (int o = 1; o < 64; o <<= 1) v += __shfl_xor(v, o);
    return v;
}
#define LDS_WAIT() asm volatile("s_waitcnt lgkmcnt(0)" ::: "memory")
__device__ __forceinline__ int otid() { int t = threadIdx.x; asm volatile("" : "+v"(t)); return t; }

#ifndef FUSE_FINAL
#define FUSE_FINAL 1
#endif
#ifndef CONV_SPLIT
#define CONV_SPLIT 1
#endif
__device__ __forceinline__ void transpose_item(const float* W, int ldw, int K, int k0, int src_col, bf16_t* WT, int dst_row, const float* gain, float cscale, LAS float* scr, int lane) {
    const int kr = lane >> 3, c4 = lane & 7;
    f32x4 v[8]; float g[8];
#pragma unroll
    for (int i = 0; i < 8; ++i) { const int kk = 8 * i + kr; v[i] = *(const f32x4*)(W + (size_t)(k0 + kk) * ldw + src_col + 4 * c4); g[i] = gain ? gain[k0 + kk] * cscale : cscale; }
#pragma unroll
    for (int i = 0; i < 8; ++i) { const int kk = 8 * i + kr; LAS float* d = scr + kk * 33 + 4 * c4; d[0] = v[i].x * g[i]; d[1] = v[i].y * g[i]; d[2] = v[i].z * g[i]; d[3] = v[i].w * g[i]; }
    LDS_WAIT(); asm volatile("" ::: "memory");
    const int c = lane & 7;
#pragma unroll
    for (int j = 0; j < 4; ++j) { const int n = (lane >> 3) + 8 * j; const LAS float* s = scr + (8 * c) * 33 + n;
        u32x4 o; o.x = pk2(s[0 * 33], s[1 * 33]); o.y = pk2(s[2 * 33], s[3 * 33]); o.z = pk2(s[4 * 33], s[5 * 33]); o.w = pk2(s[6 * 33], s[7 * 33]);
        *(u32x4*)(WT + (size_t)(dst_row + n) * K + k0 + 8 * c) = o; }
    LDS_WAIT(); asm volatile("" ::: "memory");
}

__device__ __forceinline__ void convert_weights(const Args& a, int l_lo, int l_hi, LAS unsigned char* lds, int gw, int NGW) {
    const int tid = otid(), lane = tid & 63, wave = __builtin_amdgcn_readfirstlane(tid >> 6);
    LAS float* scr = (LAS float*)(lds + wave * 16384);
    constexpr int I_QKV = 16 * 96, I_O = 16 * 32, I_IN = 16 * 176, I_OUT = 44 * 32, I_LAYER = I_QKV + I_O + I_IN + I_OUT;
    for (int it = l_lo * I_LAYER + gw; it < l_hi * I_LAYER; it += NGW) {
        const int l = it / I_LAYER; int r = it % I_LAYER;
        bf16_t* wl = (bf16_t*)(a.ws + WS_W + (size_t)l * SZ_WLAYER);
        if (r < I_QKV) {
            const int kb = r / 96, nb = r % 96, n0 = 32 * nb;
            const float* W = (l & 1) ? a.w_qkvf_odd + (size_t)(l >> 1) * 1024 * 3088 : a.w_qkv_even + (size_t)(l >> 1) * 1024 * 3072;
            transpose_item(W, (l & 1) ? 3088 : 3072, 1024, 64 * kb, n0, wl, n0, a.norm_mix + l * 1024, n0 < 1024 ? 0.125f * LOG2E : 1.0f, scr, lane);
            continue; }
        r -= I_QKV;
        if (r < I_O) {
            const int kb = r / 32, nb = r % 32, n0 = 32 * nb;
            const float* W = (l & 1) ? a.w_o_odd + (size_t)(l >> 1) * 1024 * 1024 : a.w_o_even + (size_t)(l >> 1) * 1024 * 1024;
            transpose_item(W, 1024, 1024, 64 * kb, n0, (bf16_t*)((unsigned char*)wl + SZ_WQKV), n0, nullptr, 1.0f, scr, lane);
            continue; }
        r -= I_O;
        if (r < I_IN) {
            const int kb = r / 176, nb = r % 176, n0 = 32 * nb;
            const int pn = n0 >> 8, bj = (n0 >> 7) & 1, c0 = n0 & 127;
            transpose_item(a.w_ffn_in + (size_t)l * 1024 * 5632, 5632, 1024, 64 * kb, bj * 2816 + 128 * pn + c0, (bf16_t*)((unsigned char*)wl + SZ_WQKV + SZ_WO), n0, a.norm_ffn + l * 1024, 1.0f, scr, lane);
            continue; }
        r -= I_IN;
        {
            const int kb = r / 32, nb = r % 32, n0 = 32 * nb;
            transpose_item(a.w_ffn_out + (size_t)l * 2816 * 1024, 1024, 2816, 64 * kb, n0, (bf16_t*)((unsigned char*)wl + SZ_WQKV + SZ_WO + SZ_WI), n0, nullptr, 1.0f, scr, lane);
        }
    }
}

__device__ __forceinline__ void prologue(const Args& a, LAS unsigned char* lds, int vwg, int G) {
    const int tid = otid(), lane = tid & 63, wave = __builtin_amdgcn_readfirstlane(tid >> 6);
    const int gw = vwg * NWAVES + wave, NGW = G * NWAVES;
    convert_weights(a, 0, (CONV_SPLIT && G == 256) ? 1 : NLAYER, lds, gw, NGW);
    bf16_t* xb = (bf16_t*)(a.ws + WS_XB); float* rowss = (float*)(a.ws + WS_ROWSS);
    for (int m = gw; m < MTOK; m += NGW) {
        const f32x4* xr = (const f32x4*)(a.x + (size_t)m * DM) + lane; float s = 0.f; f32x4 v[4];
#pragma unroll
        for (int j = 0; j < 4; ++j) { v[j] = xr[64 * j]; s += (v[j].x * v[j].x + v[j].y * v[j].y) + (v[j].z * v[j].z + v[j].w * v[j].w); }
        s = wave_sum(s);
        unsigned long long* o8 = (unsigned long long*)(xb + (size_t)m * DM) + lane;
#pragma unroll
        for (int j = 0; j < 4; ++j) o8[64 * j] = (unsigned long long)pk2(v[j].x, v[j].y) | ((unsigned long long)pk2(v[j].z, v[j].w) << 32);
        if (lane == 0) rowss[m] = s;
    }
    const int gt = vwg * NTHR + tid, NGT = G * NTHR;
    for (int i = gt; i < 8 * MTOK; i += NGT) rowss[MTOK + i] = 0.f;
    float* rot = (float*)(a.ws + WS_ROT);
    for (int i = gt; i < 2048 * 8; i += NGT) {
        const int pos = i >> 3, j = i & 7;
        const float invf[8] = {1.0f, 0.19392274474868576f, 0.03760603093086393f, 0.007292664737217109f, 0.001414213562373095f, 0.0002742481756762073f, 5.318295896944988e-05f, 1.031338537721246e-05f};
        float fq = invf[0];
#pragma unroll
        for (int t = 1; t < 8; ++t) fq = (j == t) ? invf[t] : fq;
        const float ang = (float)pos * fq;
        const double rev = (double)ang * 0.15915494309189535; const float fr = (float)(rev - floor(rev));
        rot[pos * 16 + j] = __builtin_amdgcn_cosf(fr); rot[pos * 16 + 8 + j] = __builtin_amdgcn_sinf(fr);
    }
    float* wf = (float*)(a.ws + WS_WF);
    for (int i = gt; i < 2 * 16 * 1024; i += NGT) {
        const int lo = i >> 14, hd = (i >> 10) & 15, k = i & 1023;
        wf[i] = a.w_qkvf_odd[(size_t)lo * 1024 * 3088 + (size_t)k * 3088 + 3072 + hd] * a.norm_mix[(2 * lo + 1) * 1024 + k];
    }
}

__device__ __forceinline__ void fgate_phase(const Args& a, int lo, LAS unsigned char* lds, int vwg, int G) {
    const int tid = otid(), lane = tid & 63, wave = __builtin_amdgcn_readfirstlane(tid >> 6);
    const float* xres = (const float*)(a.ws + WS_XRES); const float* rowss = (const float*)(a.ws + WS_ROWSS) + (size_t)(2 * (2 * lo + 1)) * MTOK;
    const float* wf = (const float*)(a.ws + WS_WF) + (size_t)lo * 16 * 1024;
    float* locF = (float*)(a.ws + WS_LOCF); float* totF = (float*)(a.ws + WS_TOTF);
    LAS float* lf = (LAS float*)lds;
    const int r16 = lane & 15, g4 = lane >> 4, tile = wave & 3, kh = wave >> 2;
    for (int j = vwg; j < 256; j += G) {
        const f32x4* xr = (const f32x4*)(xres + (size_t)(64 * j + 16 * tile + r16) * DM + 512 * kh + 4 * g4);
        const f32x4* wr = (const f32x4*)(wf + (size_t)r16 * 1024 + 512 * kh + 4 * g4);
        f32x4 acc = {0.f, 0.f, 0.f, 0.f};
#pragma unroll 8
        for (int s = 0; s < 32; ++s) {
            const f32x4 xv = xr[4 * s], wv = wr[4 * s];
            acc = __builtin_amdgcn_mfma_f32_16x16x4f32(xv.x, wv.x, acc, 0, 0, 0);
            acc = __builtin_amdgcn_mfma_f32_16x16x4f32(xv.y, wv.y, acc, 0, 0, 0);
            acc = __builtin_amdgcn_mfma_f32_16x16x4f32(xv.z, wv.z, acc, 0, 0, 0);
            acc = __builtin_amdgcn_mfma_f32_16x16x4f32(xv.w, wv.w, acc, 0, 0, 0);
        }
#pragma unroll
        for (int jj = 0; jj < 4; ++jj) lf[(kh * 64 + 16 * tile + 4 * g4 + jj) * 16 + r16] = acc[jj];
        __syncthreads();
        if (tid < 16) {
            const int b = j >> 5, sl = j & 31; float run = 0.f; float* dst = locF + (size_t)(b * 16 + tid) * 2048 + sl * 64;
            const float bias = a.b_forget[lo * 16 + tid];
            for (int t = 0; t < 64; ++t) {
                const float fl = (lf[t * 16 + tid] + lf[(64 + t) * 16 + tid]) * pg8::rstd_of(rowss, 64 * j + t) + bias;
                const float z2 = fl * LOG2E; const float l2 = -(fmaxf(-z2, 0.f) + __builtin_amdgcn_logf(1.0f + __builtin_amdgcn_exp2f(-fabsf(z2))));
                run += l2; dst[t] = run;
            }
            totF[(b * 16 + tid) * 32 + sl] = run;
        }
        __syncthreads();
    }
}

__device__ __forceinline__ int phi32(int r) { return ((r >> 4) & 1) * 16 + ((r >> 2) & 1) * 8 + ((r >> 3) & 1) * 4 + (r & 3); }
__device__ __forceinline__ s16x4 vtr(const LAS unsigned char* p) { return __builtin_bit_cast(s16x4, __builtin_amdgcn_ds_read_tr16_b64_v4i16((LAS s16x4*)p)); }

template <int MODE, int DBG = 0>
__device__ __forceinline__ void attn_task(const bf16_t* qp, const bf16_t* kp, const bf16_t* vp, size_t rstride, int q0, int kb_lo, int kb_hi,
                                          LAS unsigned char* vlds, const LAS float* Fs, f32x16 (&O)[2], float& lse2) {
    const int lane = otid() & 63, n = lane & 31, hh = lane >> 5;
    bf16x8 qf[4];
    { const bf16_t* p = qp + (size_t)(q0 + n) * rstride + 8 * hh;
#pragma unroll
      for (int ks = 0; ks < 4; ++ks) qf[ks] = *(const bf16x8*)(p + 16 * ks); }
    const int qi = q0 + n;
    float Fq = 0.f; if (MODE == 0) Fq = Fs[qi];
#pragma unroll
    for (int r = 0; r < 16; ++r) { O[0][r] = 0.f; O[1][r] = 0.f; }
    float m = -1e30f, l = 0.f, R = 0.f;
    const bf16_t* kl = kp + (size_t)phi32(n) * rstride + 8 * hh;
    const bf16_t* vl = vp + (size_t)(lane >> 3) * rstride + 8 * (lane & 7);
    LAS unsigned char* vw = vlds + (lane >> 3) * VROW + (lane & 7) * 16;
    const LAS unsigned char* vr = vlds + (8 * hh + ((lane & 15) >> 2)) * VROW + (16 * ((lane >> 4) & 1) + 4 * (lane & 3)) * 2;
    bf16x8 kn[4]; u32x4 vn[4];
#define AT_ISSUE(kb) do { const bf16_t* kk_ = kl + (size_t)(kb) * 32 * rstride; const bf16_t* vv_ = vl + (size_t)(kb) * 32 * rstride; \
        _Pragma("unroll") for (int ks = 0; ks < 4; ++ks) kn[ks] = *(const bf16x8*)(kk_ + 16 * ks); \
        _Pragma("unroll") for (int ii = 0; ii < 4; ++ii) vn[ii] = *(const u32x4*)(vv_ + (size_t)(8 * ii) * rstride); } while (0)
    const int nblk = kb_hi - kb_lo + 1;
    int kb = (MODE == 2) ? kb_hi : kb_lo;
    AT_ISSUE(kb);
    for (int it = 0; it < nblk; ++it) {
        bf16x8 kc[4];
#pragma unroll
        for (int ks = 0; ks < 4; ++ks) kc[ks] = kn[ks];
        asm volatile("" ::: "memory");
#pragma unroll
        for (int ii = 0; ii < 4; ++ii) *(LAS u32x4*)(vw + ii * 8 * VROW) = vn[ii];
        asm volatile("" ::: "memory");
        const int kbn = (MODE == 2) ? kb - 1 : kb + 1;
        if (it + 1 < nblk && DBG != 1) AT_ISSUE(kbn);
        if (DBG != 2) {
        const int key0 = kb * 32 + 8 * hh;
        f32x16 s;
        if (MODE == 0) {
            const LAS f32x4* fk = (const LAS f32x4*)(Fs + key0);
            const f32x4 f0 = fk[0], f1 = fk[1], f2 = fk[4], f3 = fk[5];
#pragma unroll
            for (int e = 0; e < 4; ++e) { s[e] = Fq - f0[e]; s[4 + e] = Fq - f1[e]; s[8 + e] = Fq - f2[e]; s[12 + e] = Fq - f3[e]; }
        } else {
#pragma unroll
            for (int r = 0; r < 16; ++r) s[r] = 0.f;
        }
#pragma unroll
        for (int ks = 0; ks < 4; ++ks) s = __builtin_amdgcn_mfma_f32_32x32x16_bf16(kc[ks], qf[ks], s, 0, 0, 0);
        bf16x8 pb[2];
        if (MODE != 2) {
            const bool diag = (kb * 32 + 31 > q0);
            if (MODE == 1) {
                if (diag || kb * 32 < q0 - 97) {
#pragma unroll
                    for (int r = 0; r < 16; ++r) { const int ki = key0 + 16 * (r >> 3) + (r & 7); if (ki > qi || ki < qi - 128) s[r] = -1e30f; }
                }
            } else if (diag) {
#pragma unroll
                for (int r = 0; r < 16; ++r) { const int ki = key0 + 16 * (r >> 3) + (r & 7); if (ki > qi) s[r] = -1e30f; }
            }
            float bm = fmaxf(fmaxf(s[0], s[1]), fmaxf(s[2], s[3]));
#pragma unroll
            for (int r = 4; r < 16; r += 4) bm = fmaxf(bm, fmaxf(fmaxf(s[r], s[r + 1]), fmaxf(s[r + 2], s[r + 3])));
            bm = fmaxf(bm, __shfl_xor(bm, 32));
            const float mn = fmaxf(m, bm), alpha = __builtin_amdgcn_exp2f(m - mn); m = mn;
            float ps = 0.f;
#pragma unroll
            for (int r = 0; r < 16; ++r) { s[r] = __builtin_amdgcn_exp2f(s[r] - mn); ps += s[r]; }
            l = l * alpha + ps;
#pragma unroll
            for (int r = 0; r < 16; ++r) { O[0][r] *= alpha; O[1][r] *= alpha; }
        } else {
            const bool diag = (kb * 32 + 31 >= q0);
            float L[16];
#pragma unroll
            for (int r = 0; r < 16; ++r) {
                const float z = s[r], t = __builtin_amdgcn_exp2f(-fabsf(z)), sp = fmaxf(z, 0.f) + __builtin_amdgcn_logf(1.0f + t);
                L[r] = -sp; s[r] = z - sp;
            }
            if (diag) {
#pragma unroll
                for (int r = 0; r < 16; ++r) { const int ki = key0 + 16 * (r >> 3) + (r & 7); if (ki >= qi) { L[r] = 0.f; s[r] = -1e30f; } }
            }
            float sA = ((L[0] + L[1]) + (L[2] + L[3])) + ((L[4] + L[5]) + (L[6] + L[7]));
            float sB = ((L[8] + L[9]) + (L[10] + L[11])) + ((L[12] + L[13]) + (L[14] + L[15]));
            const float pA = __shfl_xor(sA, 32), pB = __shfl_xor(sB, 32);
            const float offA = sB + pB + (hh == 0 ? pA : 0.f), offB = (hh == 0 ? pB : 0.f);
            float run = R + offA;
#pragma unroll
            for (int e = 7; e >= 0; --e) { const float lr = L[e]; s[e] = __builtin_amdgcn_exp2f(s[e] + run); run += lr; }
            run = R + offB;
#pragma unroll
            for (int e = 15; e >= 8; --e) { const float lr = L[e]; s[e] = __builtin_amdgcn_exp2f(s[e] + run); run += lr; }
            R += (sA + sB) + (pA + pB);
        }
        { u32x4 w0, w1;
          w0.x = cvtpk(s[0], s[1]); w0.y = cvtpk(s[2], s[3]); w0.z = cvtpk(s[4], s[5]); w0.w = cvtpk(s[6], s[7]);
          w1.x = cvtpk(s[8], s[9]); w1.y = cvtpk(s[10], s[11]); w1.z = cvtpk(s[12], s[13]); w1.w = cvtpk(s[14], s[15]);
          pb[0] = __builtin_bit_cast(bf16x8, w0); pb[1] = __builtin_bit_cast(bf16x8, w1); }
        asm volatile("" ::: "memory");
#pragma unroll
        for (int db = 0; db < 2; ++db)
#pragma unroll
            for (int kk = 0; kk < 2; ++kk) {
                const s16x4 lo4 = vtr(vr + (16 * kk) * VROW + 64 * db), hi4 = vtr(vr + (16 * kk + 4) * VROW + 64 * db);
                const bf16x8 av = {lo4[0], lo4[1], lo4[2], lo4[3], hi4[0], hi4[1], hi4[2], hi4[3]};
                O[db] = __builtin_amdgcn_mfma_f32_32x32x16_bf16(av, pb[kk], O[db], 0, 0, 0);
            }
        asm volatile("s_waitcnt lgkmcnt(0)" ::: "memory");
        } else { asm volatile("s_waitcnt lgkmcnt(0)" ::: "memory"); O[0][0] += __builtin_bit_cast(float, (int)kc[0][0]) ; }
        if (MODE == 2) { if (__builtin_amdgcn_ballot_w64(R >= -160.f) == 0ull) break; }
        kb = kbn;
    }
#undef AT_ISSUE
    asm volatile("s_waitcnt vmcnt(0)" ::: "memory");
    if (MODE != 2) {
        l += __shfl_xor(l, 32);
        const float inv = 1.0f / l;
#pragma unroll
        for (int r = 0; r < 16; ++r) { O[0][r] *= inv; O[1][r] *= inv; }
        lse2 = m + __builtin_amdgcn_logf(l);
    }
}

__device__ __forceinline__ void store_o_bf16(const f32x16 (&O)[2], bf16_t* att_row  , int hh) {
#pragma unroll
    for (int db = 0; db < 2; ++db)
#pragma unroll
        for (int i = 0; i < 4; ++i) {
            u32x2 w; w.x = cvtpk(O[db][4 * i], O[db][4 * i + 1]); w.y = cvtpk(O[db][4 * i + 2], O[db][4 * i + 3]);
            *(u32x2*)(att_row + 32 * db + 8 * i + 4 * hh) = w;
        }
}

constexpr int LDS_FOXF = 90112;
__device__ __forceinline__ void fox_phase(const Args& a, unsigned char* lds_gen, LAS unsigned char* lds, int vwg, int G) {
    const int tid = otid();
    const bf16_t* qkv = (const bf16_t*)(a.ws + WS_QKV); bf16_t* att = (bf16_t*)(a.ws + WS_ATT);
    const float* locF = (const float*)(a.ws + WS_LOCF); const float* totF = (const float*)(a.ws + WS_TOTF);
    LAS float* Fs = (LAS float*)(lds + LDS_FOXF); LAS float* pre = Fs + 2048;
    for (int j = vwg; j < 256; j += G) {
        const int bh = j >> 1, b = bh >> 4, h = bh & 15;
        __syncthreads();
        if (tid < 32) { float p = 0.f; for (int s = 0; s < tid; ++s) p += totF[bh * 32 + s]; pre[tid] = p; }
        __syncthreads();
        for (int t = tid; t < 2048; t += NTHR) Fs[t] = locF[(size_t)bh * 2048 + t] + pre[t >> 6];
        __syncthreads();
        for (int ui = 0; ui < 4; ++ui) {
            const int u = (j & 1) ? ((ui < 2) ? 2 + ui : 7 - ui) : ((ui < 2) ? ui : 9 - ui);
            attn_body::attn_unit<8>(b, h, u, (const attn_body::bf16*)qkv, (const attn_body::bf16*)(qkv + 1024), (const attn_body::bf16*)(qkv + 2048), (attn_body::bf16*)att, (char*)lds_gen, Fs);
        }
    }
}

template <int PART>
__device__ __forceinline__ void even_attn_phase(const Args& a, LAS unsigned char* lds, int vwg, int G) {
    const int tid = otid(), lane = tid & 63, wave = __builtin_amdgcn_readfirstlane(tid >> 6), n = lane & 31, hh = lane >> 5;
    const bf16_t* qkv = (const bf16_t*)(a.ws + WS_QKV); bf16_t* att = (bf16_t*)(a.ws + WS_ATT);
    bf16_t* part = (bf16_t*)a.out;
    float* plse = (float*)(a.ws + WS_LSE);
    LAS unsigned char* vlds = lds + wave * VTILE;
    const LAS float* nof = (const LAS float*)lds;
    for (int j = vwg; j < 256; j += G) {
        const int bh = j >> 2, b = bh >> 3, hl = bh & 7, c = j & 3;
        if (PART & 1) { const bf16_t* base = qkv + (size_t)(b * SEQ) * QKV_LD + hl * 64;
          for (int ui = 0; ui < 2; ++ui) {
              const int u = ui ? 7 - c : c, qt = 8 * u + wave;
              f32x16 O[2]; float lse;
              attn_task<2>(base, base + 1024, base + 2048, (size_t)QKV_LD, 32 * qt, 0, qt, vlds, nof, O, lse);
              store_o_bf16(O, att + (size_t)(b * SEQ + 32 * qt + n) * DM + hl * 64, hh);
          } }
        if (!(PART & 2)) continue;
        const bf16_t* base = qkv + (size_t)(b * SEQ) * QKV_LD + (8 + hl) * 64;
        for (int p = 0; p < 2; ++p) {
            const int dil = p ? 4 : 1;
            for (int ti = 0; ti < 2; ++ti) {
                const int task = wave + 8 * ti;
                const int res = p ? (task & 3) : 0, tile = p ? (task >> 2) : task;
                const int q0 = (p ? 128 * c : 512 * c) + 32 * tile;
                const int kbh = q0 >> 5, kbl = kbh - 4 < 0 ? 0 : kbh - 4;
                const bf16_t* bp = base + (size_t)res * QKV_LD;
                f32x16 O[2]; float lse;
                attn_task<1>(bp, bp + 1024, bp + 2048, (size_t)dil * QKV_LD, q0, kbl, kbh, vlds, nof, O, lse);
                const int tok = res + dil * (q0 + n);
                if (PART & 4) continue;
                store_o_bf16(O, part + ((size_t)p * MTOK + (size_t)(b * SEQ + tok)) * 512 + hl * 64, hh);
                if (hh == 0) plse[((size_t)p * MTOK + (size_t)(b * SEQ + tok)) * 8 + hl] = lse;
            }
        }
        __syncthreads();
        for (int ti = 0; ti < 2; ++ti) {
            const int res = wave + 8 * ti, q0 = 32 * c;
            const bf16_t* bp = base + (size_t)res * QKV_LD;
            f32x16 O[2]; float lse3;
            attn_task<1>(bp, bp + 1024, bp + 2048, (size_t)16 * QKV_LD, q0, 0, c, vlds, nof, O, lse3);
            const int tok = res + 16 * (q0 + n); const size_t grow = (size_t)(b * SEQ + tok);
            if (PART & 4) { store_o_bf16(O, att + grow * DM + (8 + hl) * 64, hh); continue; }
            const float l1 = plse[grow * 8 + hl], l2 = plse[((size_t)MTOK + grow) * 8 + hl];
            const float mx = fmaxf(lse3, fmaxf(l1, l2));
            float w1 = __builtin_amdgcn_exp2f(l1 - mx), w2 = __builtin_amdgcn_exp2f(l2 - mx), w3 = __builtin_amdgcn_exp2f(lse3 - mx);
            const float inv = 1.0f / (w1 + w2 + w3); w1 *= inv; w2 *= inv; w3 *= inv;
            const bf16_t* p1 = part + grow * 512 + hl * 64; const bf16_t* p2 = part + ((size_t)MTOK + grow) * 512 + hl * 64;
#pragma unroll
            for (int db = 0; db < 2; ++db)
#pragma unroll
                for (int i = 0; i < 4; ++i) {
                    const u32x2 r1 = *(const u32x2*)(p1 + 32 * db + 8 * i + 4 * hh), r2 = *(const u32x2*)(p2 + 32 * db + 8 * i + 4 * hh);
                    const float a1[4] = {__uint_as_float(r1.x << 16), __uint_as_float(r1.x & 0xffff0000u), __uint_as_float(r1.y << 16), __uint_as_float(r1.y & 0xffff0000u)};
                    const float a2[4] = {__uint_as_float(r2.x << 16), __uint_as_float(r2.x & 0xffff0000u), __uint_as_float(r2.y << 16), __uint_as_float(r2.y & 0xffff0000u)};
#pragma unroll
                    for (int e = 0; e < 4; ++e) O[db][4 * i + e] = O[db][4 * i + e] * w3 + a1[e] * w1 + a2[e] * w2;
                }
            store_o_bf16(O, att + grow * DM + (8 + hl) * 64, hh);
        }
        __syncthreads();
    }
}

__device__ __forceinline__ void final_phase(const Args& a, int vwg, int G) {
    const int tid = otid(), lane = tid & 63, wave = tid >> 6;
    const float* xres = (const float*)(a.ws + WS_XRES); const float* rowss = (const float*)(a.ws + WS_ROWSS) + (size_t)8 * MTOK;
    const int gw = vwg * NWAVES + wave, NGW = G * NWAVES;
    f32x4 g[4];
#pragma unroll
    for (int j = 0; j < 4; ++j) g[j] = ((const f32x4*)a.norm_final)[lane + 64 * j];
    for (int m = gw; m < MTOK; m += NGW) {
        const float rs = pg8::rstd_of(rowss, m);
        const f32x4* xr = (const f32x4*)(xres + (size_t)m * DM) + lane; f32x4* o = (f32x4*)(a.out + (size_t)m * DM) + lane;
#pragma unroll
        for (int j = 0; j < 4; ++j) o[64 * j] = xr[64 * j] * rs * g[j];
    }
}

#define XB_TMO      128
#define XB_XCNT(j)  (256  + 64 * (j))
#define XB_XSUB(j)  (1280 + 64 * (j))
#define XB_XGEN(j)  (2304 + 64 * (j))
#define XB_TOP      3328
#define XB_TOPGEN   3392
#define XCD_BAR_WORDS 3456
#define XB_SPIN_CAP (1u << 18)

__device__ __forceinline__ unsigned xb_ld(unsigned* p)              { return __hip_atomic_load(p, __ATOMIC_RELAXED, __HIP_MEMORY_SCOPE_AGENT); }
__device__ __forceinline__ unsigned xb_add(unsigned* p, unsigned v) { return __hip_atomic_fetch_add(p, v, __ATOMIC_RELAXED, __HIP_MEMORY_SCOPE_AGENT); }
__device__ __forceinline__ unsigned xb_xcc_id() { return (unsigned)__builtin_amdgcn_s_getreg((3 << 11) | 20) & 0xFu; }
#define XB_SPIN(cond, bar) do { unsigned _sp = 0; while (cond) { __builtin_amdgcn_s_sleep(1); \
    if ((++_sp & 255u) == 0u) { if (xb_ld(&(bar)[XB_TMO])) break; if (_sp > XB_SPIN_CAP) { atomicAdd(&(bar)[XB_TMO], 1u); break; } } } } while (0)

struct XcdBarrier {
    unsigned* bar; unsigned x;
    volatile LAS unsigned* st;
};

__device__ __forceinline__ XcdBarrier xcd_barrier_post(unsigned* bar, volatile LAS unsigned* st) {
    XcdBarrier b; b.bar = bar; b.x = xb_xcc_id(); b.st = st;
    if (threadIdx.x == 0) (void)xb_add(&bar[XB_XCNT(b.x)], 1u);
    return b;
}
__device__ __forceinline__ void xcd_barrier_complete(unsigned* bar, unsigned x, unsigned& nloc, unsigned& nx) {
    const unsigned G = gridDim.x * gridDim.y * gridDim.z;
    unsigned sum, cnt, mine, sp = 0u;
    for (;;) {
        sum = 0u; cnt = 0u; mine = 0u;
#pragma unroll
        for (unsigned j = 0; j < 16; ++j) { const unsigned c = xb_ld(&bar[XB_XCNT(j)]); sum += c; cnt += (c > 0u) ? 1u : 0u; mine = (j == x) ? c : mine; }
        if (sum == G) break;
        __builtin_amdgcn_s_sleep(1);
        if ((++sp & 255u) == 0u) { if (xb_ld(&bar[XB_TMO])) break; if (sp > XB_SPIN_CAP) { atomicAdd(&bar[XB_TMO], 1u); break; } }
    }
    nloc = mine > 0u ? mine : 1u; nx = cnt > 0u ? cnt : 1u;
}

__device__ __forceinline__ void xcd_barrier(const XcdBarrier& b) {
    asm volatile("s_waitcnt vmcnt(0)" ::: "memory");
    __syncthreads();
    if (threadIdx.x == 0) {
        unsigned* bar = b.bar;
        __builtin_amdgcn_s_waitcnt(0);
        unsigned nloc = b.st[0], nx = b.st[1];
        if (nloc == 0u) { xcd_barrier_complete(bar, b.x, nloc, nx); b.st[0] = nloc; b.st[1] = nx; }
        const unsigned old = xb_add(&bar[XB_XSUB(b.x)], 1u);
        const unsigned gen = old / nloc;
        if (old + 1u == (gen + 1u) * nloc) {
            __builtin_amdgcn_fence(__ATOMIC_RELEASE, "agent");
            asm volatile("s_waitcnt vmcnt(0)" ::: "memory");
            const unsigned og = xb_add(&bar[XB_TOP], 1u);
            const unsigned tg = og / nx;
            if (og + 1u == (tg + 1u) * nx) xb_add(&bar[XB_TOPGEN], 1u);
            else XB_SPIN(xb_ld(&bar[XB_TOPGEN]) == tg, bar);
            __builtin_amdgcn_fence(__ATOMIC_ACQUIRE, "agent");
            xb_add(&bar[XB_XGEN(b.x)], 1u);
            asm volatile("s_waitcnt vmcnt(0)" ::: "memory");
        } else {
            XB_SPIN(xb_ld(&bar[XB_XGEN(b.x)]) == gen, bar);
            __builtin_amdgcn_fence(__ATOMIC_ACQUIRE, "agent");
            asm volatile("s_waitcnt vmcnt(0)" ::: "memory");
        }
    }
    __syncthreads();
}

#ifndef DBG_EVEN
#define DBG_EVEN 0
#endif
#ifndef DBG_FOX
#define DBG_FOX 0
#endif
#ifndef REP_QKV
#define REP_QKV 1
#endif
#ifndef REP_FG
#define REP_FG 1
#endif
#ifndef REP_FFI
#define REP_FFI 1
#endif
#ifndef REP_PRO
#define REP_PRO 1
#endif
#ifndef REP_SYNC
#define REP_SYNC 1
#endif
#ifndef REP_FOX
#define REP_FOX 1
#endif
#ifndef REP_EVEN
#define REP_EVEN 1
#endif
__global__ void __launch_bounds__(NTHR, 2) fwd_kernel(Args a) {
    extern __shared__ __attribute__((aligned(16))) unsigned char lds_raw[];
    LAS unsigned char* lds = (LAS unsigned char*)lds_raw;
    cg::grid_group grid = cg::this_grid();
    const int G = gridDim.x, vwg = blockIdx.x;
    unsigned char* ws = a.ws;
    bf16_t* xb = (bf16_t*)(ws + WS_XB); float* xres = (float*)(ws + WS_XRES); bf16_t* qkv = (bf16_t*)(ws + WS_QKV); bf16_t* hid = (bf16_t*)(ws + WS_QKV);
    bf16_t* att = (bf16_t*)(ws + WS_ATT); float* rowss = (float*)(ws + WS_ROWSS); const float* rot = (const float*)(ws + WS_ROT);
    unsigned* barw = (unsigned*)(ws + WS_BAR);
    volatile LAS unsigned* bst = (volatile LAS unsigned*)(lds + LDS_MISC);
    if (threadIdx.x == 0) { bst[0] = 0u; bst[1] = 0u; }
    if (blockIdx.x == 0) { for (int i = threadIdx.x; i < 8192; i += NTHR) barw[i] = 0u; }
    __syncthreads();
    XcdBarrier bar; bar.bar = barw; bar.x = 0; bar.st = bst;
    const bool multi = (a.ph_hi - a.ph_lo) > 1;
    if (multi) { grid.sync(); bar = xcd_barrier_post(barw, bst); }
    for (int ph = a.ph_lo; ph < a.ph_hi; ++ph) {
        if (ph == 0) { for (int rep = 0; rep < REP_PRO; ++rep) { prologue(a, lds, vwg, G); __syncthreads(); } }
        else if (ph == NPHASE - 1) { if (!(FUSE_FINAL && G == 256)) final_phase(a, vwg, G); }
        else {
            const int l = (ph - 1) / 5, sp = (ph - 1) % 5;
            const bf16_t* wl = (const bf16_t*)(ws + WS_W + (size_t)l * SZ_WLAYER);
            const bf16_t* w_qkv = wl; const bf16_t* w_o = (const bf16_t*)((const unsigned char*)wl + SZ_WQKV);
            const bf16_t* w_in = (const bf16_t*)((const unsigned char*)wl + SZ_WQKV + SZ_WO); const bf16_t* w_out = (const bf16_t*)((const unsigned char*)wl + SZ_WQKV + SZ_WO + SZ_WI);
            if (sp == 0) {
                pg8::Gemm g{xb, w_qkv, MTOK, 3072, 1024}; pg8::StaticOrder S; S.init(MTOK, 3072, G, vwg);
                pg8::EpiQKV E{qkv, rowss + (size_t)(2 * l) * MTOK, rot, (l & 1) ? 0 : 1};
                for (int rep = 0; rep < REP_QKV; ++rep) { pg8::gemm_phase<pg8::EpiQKV, pg8::StaticOrder, true, true>(lds, g, S, E); __syncthreads(); }
                if (l & 1) { for (int rep = 0; rep < REP_FG; ++rep) { __syncthreads(); fgate_phase(a, l >> 1, lds, vwg, G); } }
            } else if (sp == 1) {
                if (l & 1) { fox_phase(a, lds_raw, lds, vwg, G); } else { if (DBG_EVEN) { even_attn_phase<DBG_EVEN>(a, lds, vwg, G); __syncthreads(); } even_attn_phase<3>(a, lds, vwg, G); }
            } else if (sp == 2) {
                pg8::Gemm g{att, w_o, MTOK, 1024, 1024}; pg8::StaticOrder S; S.init(MTOK, 1024, G, vwg);
                pg8::EpiResid E{l == 0 ? a.x : xres, xres, xb, rowss + (size_t)(2 * l + 1) * MTOK};
                pg8::gemm_phase<pg8::EpiResid, pg8::StaticOrder, true, true>(lds, g, S, E);
            } else if (sp == 3) {
                pg8::Gemm g{xb, w_in, MTOK, 5632, 1024}; pg8::StaticOrder S; S.init(MTOK, 5632, G, vwg);
                pg8::EpiSwiGLU E{hid, rowss + (size_t)(2 * l + 1) * MTOK};
                for (int rep = 0; rep < REP_FFI; ++rep) { pg8::gemm_phase<pg8::EpiSwiGLU, pg8::StaticOrder, true, true>(lds, g, S, E); __syncthreads(); }
                if (CONV_SPLIT && G == 256 && vwg >= 128 && l + 1 < NLAYER) { __syncthreads(); convert_weights(a, l + 1, l + 2, lds, (vwg - 128) * NWAVES + __builtin_amdgcn_readfirstlane((int)(threadIdx.x >> 6)), 128 * NWAVES); }
            } else {
                pg8::Gemm g{hid, w_out, MTOK, 1024, 2816}; pg8::StaticOrder S; S.init(MTOK, 1024, G, vwg);
                if (FUSE_FINAL && l == NLAYER - 1 && G == 256) {
                    pg8::EpiFinal E{xres, a.out, rowss + (size_t)8 * MTOK, a.norm_final, (unsigned*)(ws + WS_PCNT)};
                    pg8::gemm_phase<pg8::EpiFinal, pg8::StaticOrder, true, true>(lds, g, S, E);
                } else {
                    pg8::EpiResid E{xres, xres, xb, rowss + (size_t)(2 * l + 2) * MTOK};
                    pg8::gemm_phase<pg8::EpiResid, pg8::StaticOrder, true, true>(lds, g, S, E);
                }
            }
        }
        if (ph + 1 < a.ph_hi && !(FUSE_FINAL && G == 256 && ph == NPHASE - 2)) {
            for (int rep = 0; rep < REP_SYNC; ++rep) xcd_barrier(bar);
        }
    }
}

#ifndef N_LAUNCH_MODE
#define N_LAUNCH_MODE 1
#endif

extern "C" void kernel_launch(void* const* d_in, const int* in_sizes, int n_in, void* d_out, int out_size, void* d_ws, size_t ws_size, hipStream_t stream) {
    static int grid = 0;
    if (grid == 0) {
        if (n_in != 11 || out_size != MTOK * DM || ws_size < WS_END) { fprintf(stderr, "kernel_launch: unexpected sizes n_in %d out %d ws %zu (need %zu)\n", n_in, out_size, ws_size, (size_t)WS_END); grid = -1; return; }
        int dev = 0, cus = 0, per_cu = 0;
        hipGetDevice(&dev); hipDeviceGetAttribute(&cus, hipDeviceAttributeMultiprocessorCount, dev);
        if (hipFuncSetAttribute((const void*)fwd_kernel, hipFuncAttributeMaxDynamicSharedMemorySize, LDS_BYTES) != hipSuccess) { fprintf(stderr, "kernel_launch: hipFuncSetAttribute failed\n"); grid = -1; return; }
        if (hipOccupancyMaxActiveBlocksPerMultiprocessor(&per_cu, (const void*)fwd_kernel, NTHR, LDS_BYTES) != hipSuccess || per_cu < 1) { fprintf(stderr, "kernel_launch: occupancy query says %d\n", per_cu); per_cu = 1; }
        (void)hipGetLastError();
        grid = cus * 1;
        fprintf(stderr, "kernel_launch: grid %d (cus %d, per_cu %d)\n", grid, cus, per_cu);
    }
    if (grid < 0) return;
    Args a{};
    a.x = (const float*)d_in[0]; a.norm_mix = (const float*)d_in[1]; a.w_qkv_even = (const float*)d_in[2]; a.w_o_even = (const float*)d_in[3];
    a.w_qkvf_odd = (const float*)d_in[4]; a.b_forget = (const float*)d_in[5]; a.w_o_odd = (const float*)d_in[6]; a.norm_ffn = (const float*)d_in[7];
    a.w_ffn_in = (const float*)d_in[8]; a.w_ffn_out = (const float*)d_in[9]; a.norm_final = (const float*)d_in[10];
    a.out = (float*)d_out; a.ws = (unsigned char*)d_ws;
#if N_LAUNCH_MODE == 1
    a.ph_lo = 0; a.ph_hi = NPHASE;
    void* args[] = {&a};
    hipError_t e = hipLaunchCooperativeKernel((const void*)fwd_kernel, dim3(grid), dim3(NTHR), args, LDS_BYTES, stream);
    if (e != hipSuccess) fprintf(stderr, "cooperative launch failed: %s (grid %d)\n", hipGetErrorString(e), grid);
#else
    for (int ph = 0; ph < NPHASE; ++ph) {
        a.ph_lo = ph; a.ph_hi = ph + 1;
        hipLaunchKernelGGL(fwd_kernel, dim3(grid), dim3(NTHR), LDS_BYTES, stream, a);
    }
#endif
}
```

```cpp
#include <hip/hip_runtime.h>
#include <hip/hip_cooperative_groups.h>
#include <cstdio>
#include <cstdint>
namespace cg = cooperative_groups;
namespace pg8 {
#define PG8_LAS __attribute__((address_space(3)))
typedef unsigned short bf16_t;
typedef short bf16x8 __attribute__((ext_vector_type(8)));
typedef float f32x4 __attribute__((ext_vector_type(4)));
typedef unsigned u32x4 __attribute__((ext_vector_type(4)));
constexpr int BM = 256, BK = 64, HALF = 128, HTB = HALF * BK * 2  , STAGE_BYTES = 8 * HTB, NXCD = 8, WGM = 8;

__host__ __device__ __forceinline__ int lds_byte(int r, int c) { const int st = (r >> 4) * 2 + (c >> 5), rr = r & 15, cc = c & 31, ob = rr * 64 + cc * 2; return st * 1024 + (ob ^ (((ob >> 9) & 1) << 5)); }
__host__ __device__ __forceinline__ void stage_rc(int b, int& R, int& C) { const int st = b / 1024, sb = b % 1024, swz = sb ^ (((sb >> 9) & 1) << 5); R = (st >> 1) * 16 + swz / 64; C = (st & 1) * 32 + (swz % 64) / 2; }
__host__ __device__ __forceinline__ int perm32(int rho) { const int n = rho >> 4, i = rho & 15; return 8 * (i >> 2) + 4 * n + (i & 3); }

struct Unit { int pm, pn; };
struct Gemm { const bf16_t* A; const bf16_t* Bt; int M, N, K; };

struct StaticOrder {
    int nM, nN, nwg, G, c;
    __host__ __device__ void init(int M, int N, int G_, int c_) { nM = M / BM; nN = N / BM; nwg = nM * nN; G = G_; c = c_; }
    __host__ __device__ bool next(int i, Unit& u) const {
        const long L = (long)i * G + c; if (L >= nwg) return false;
        int wgid = (int)L; { const int q = nwg / NXCD, r = nwg % NXCD, xcd = wgid % NXCD, off = wgid / NXCD; wgid = (xcd < r ? xcd * (q + 1) : r * (q + 1) + (xcd - r) * q) + off; }
        const int nig = WGM * nN, gid = wgid / nig, fm = gid * WGM, gsz = (nM - fm) < WGM ? (nM - fm) : WGM;
        u.pm = fm + ((wgid % nig) % gsz); u.pn = (wgid % nig) / gsz; return true;
    }
    __device__ __forceinline__ void a_ready(const Unit&) const {}
    __device__ __forceinline__ void done(const Unit&) const {}
};

__device__ __forceinline__ unsigned cvt_pk_bf16(float lo, float hi) { unsigned r; asm volatile("v_cvt_pk_bf16_f32 %0, %1, %2" : "=v"(r) : "v"(lo), "v"(hi)); return r; }
constexpr float RMS_EPS_F = 1e-5f;
__device__ __forceinline__ float rstd_of(const float* rowss, int row) { return 1.0f / sqrtf(rowss[row] * (1.0f / 1024.0f) + RMS_EPS_F); }

struct EpiQKV {
    static constexpr bool PERM = true, AFTER_DRAIN = false;
    bf16_t* O; const float* rowss; const float* rot; int rope;
    __device__ __forceinline__ void operator()(const f32x4 (&acc)[2][2][4][2], const Unit& u, int wr, int wc, int fr, int fq) const {
        const int row0 = u.pm * BM + wr * 64 + fr;
        const int col0 = u.pn * BM + wc * 32 + 8 * fq;
        const bool rt = rope && ((u.pn & 2) != 0) && (u.pn < 8) && ((wc & 1) == 0);
#pragma unroll
        for (int ai = 0; ai < 2; ++ai)
#pragma unroll
            for (int m = 0; m < 4; ++m) {
                const int row = row0 + ai * HALF + m * 16;
                const float rs = rstd_of(rowss, row);
                bf16_t* rowp = O + (size_t)row * 3072 + col0;
                f32x4 c0 = {1.f, 1.f, 1.f, 1.f}, c1 = c0, s0 = {0.f, 0.f, 0.f, 0.f}, s1 = s0;
                if (rt) { const f32x4* rp = (const f32x4*)(rot + (size_t)(row & 2047) * 16); c0 = rp[0]; c1 = rp[1]; s0 = rp[2]; s1 = rp[3]; }
#pragma unroll
                for (int bj = 0; bj < 2; ++bj) {
                    f32x4 v0 = acc[ai][bj][m][0] * rs, v1 = acc[ai][bj][m][1] * rs;
                    if (rt) {
                        f32x4 p0, p1;
#pragma unroll
                        for (int e = 0; e < 4; ++e) { p0[e] = __shfl_xor(v0[e], 16); p1[e] = __shfl_xor(v1[e], 16); }
                        if (fq == 0) { v0 = v0 * c0 - p0 * s0; v1 = v1 * c1 - p1 * s1; }
                        else if (fq == 1) { v0 = v0 * c0 + p0 * s0; v1 = v1 * c1 + p1 * s1; }
                    }
                    u32x4 w; w.x = cvt_pk_bf16(v0[0], v0[1]); w.y = cvt_pk_bf16(v0[2], v0[3]); w.z = cvt_pk_bf16(v1[0], v1[1]); w.w = cvt_pk_bf16(v1[2], v1[3]);
                    *(u32x4*)(rowp + bj * HALF) = w;
                }
            }
    }
};

struct EpiResid {
    static constexpr bool PERM = true, AFTER_DRAIN = false;
    const float* xin; float* xout; bf16_t* xb; float* rowss_next;
    __device__ __forceinline__ void operator()(const f32x4 (&acc)[2][2][4][2], const Unit& u, int wr, int wc, int fr, int fq) const {
        const int row0 = u.pm * BM + wr * 64 + fr;
        const int col0 = u.pn * BM + wc * 32 + 8 * fq;
#pragma unroll
        for (int ai = 0; ai < 2; ++ai)
#pragma unroll
            for (int m = 0; m < 4; ++m) {
                const int row = row0 + ai * HALF + m * 16;
                float ss = 0.f;
#pragma unroll
                for (int bj = 0; bj < 2; ++bj) {
                    const size_t off = (size_t)row * 1024 + col0 + bj * HALF;
                    const f32x4* xi = (const f32x4*)(xin + off);
                    const f32x4 a0 = xi[0] + acc[ai][bj][m][0], a1 = xi[1] + acc[ai][bj][m][1];
                    f32x4* xo = (f32x4*)(xout + off); xo[0] = a0; xo[1] = a1;
                    ss += (a0[0] * a0[0] + a0[1] * a0[1]) + (a0[2] * a0[2] + a0[3] * a0[3]) + (a1[0] * a1[0] + a1[1] * a1[1]) + (a1[2] * a1[2] + a1[3] * a1[3]);
                    u32x4 w; w.x = cvt_pk_bf16(a0[0], a0[1]); w.y = cvt_pk_bf16(a0[2], a0[3]); w.z = cvt_pk_bf16(a1[0], a1[1]); w.w = cvt_pk_bf16(a1[2], a1[3]);
                    *(u32x4*)(xb + off) = w;
                }
                ss += __shfl_xor(ss, 16); ss += __shfl_xor(ss, 32);
                if (fq == 0) atomicAdd(rowss_next + row, ss);
            }
    }
};

struct EpiSwiGLU {
    static constexpr bool PERM = true, AFTER_DRAIN = false;
    bf16_t* H; const float* rowss;
    __device__ __forceinline__ void operator()(const f32x4 (&acc)[2][2][4][2], const Unit& u, int wr, int wc, int fr, int fq) const {
        const int row0 = u.pm * BM + wr * 64 + fr;
        const int col0 = u.pn * HALF + wc * 32 + 8 * fq;
#pragma unroll
        for (int ai = 0; ai < 2; ++ai)
#pragma unroll
            for (int m = 0; m < 4; ++m) {
                const int row = row0 + ai * HALF + m * 16;
                const float rs = rstd_of(rowss, row);
                float h[8];
#pragma unroll
                for (int n = 0; n < 2; ++n)
#pragma unroll
                    for (int e = 0; e < 4; ++e) {
                        const float g = acc[ai][0][m][n][e] * rs, up = acc[ai][1][m][n][e] * rs;
                        const float sg = g * __builtin_amdgcn_rcpf(1.0f + __builtin_amdgcn_exp2f(-1.4426950408889634f * g));
                        h[n * 4 + e] = sg * up;
                    }
                u32x4 w; w.x = cvt_pk_bf16(h[0], h[1]); w.y = cvt_pk_bf16(h[2], h[3]); w.z = cvt_pk_bf16(h[4], h[5]); w.w = cvt_pk_bf16(h[6], h[7]);
                *(u32x4*)(H + (size_t)row * 2816 + col0) = w;
            }
    }
};

struct EpiFinal {
    static constexpr bool PERM = true, AFTER_DRAIN = false;
    const float* xin; float* out; float* rowss_next; const float* gfin; unsigned* cnt;
    __device__ __forceinline__ void operator()(f32x4 (&acc)[2][2][4][2], const Unit& u, int wr, int wc, int fr, int fq) const {
        const int row0 = u.pm * BM + wr * 64 + fr;
        const int col0 = u.pn * BM + wc * 32 + 8 * fq;
#pragma unroll
        for (int ai = 0; ai < 2; ++ai)
#pragma unroll
            for (int m = 0; m < 4; ++m) {
                const int row = row0 + ai * HALF + m * 16;
                float ss = 0.f;
#pragma unroll
                for (int bj = 0; bj < 2; ++bj) {
                    const f32x4* xi = (const f32x4*)(xin + (size_t)row * 1024 + col0 + bj * HALF);
                    const f32x4 a0 = xi[0] + acc[ai][bj][m][0], a1 = xi[1] + acc[ai][bj][m][1];
                    acc[ai][bj][m][0] = a0; acc[ai][bj][m][1] = a1;
                    ss += (a0[0] * a0[0] + a0[1] * a0[1]) + (a0[2] * a0[2] + a0[3] * a0[3]) + (a1[0] * a1[0] + a1[1] * a1[1]) + (a1[2] * a1[2] + a1[3] * a1[3]);
                }
                ss += __shfl_xor(ss, 16); ss += __shfl_xor(ss, 32);
                if (fq == 0) atomicAdd(rowss_next + row, ss);
            }
        asm volatile("s_waitcnt vmcnt(0)" ::: "memory");
        unsigned* c = cnt + 64 * u.pm;
        if ((threadIdx.x & 63) == 0) __hip_atomic_fetch_add(c, 1u, __ATOMIC_RELAXED, __HIP_MEMORY_SCOPE_AGENT);
        { unsigned sp = 0;
          while ((unsigned)__builtin_amdgcn_readfirstlane((int)__hip_atomic_load(c, __ATOMIC_RELAXED, __HIP_MEMORY_SCOPE_AGENT)) < 32u) { __builtin_amdgcn_s_sleep(1); if (++sp > (1u << 22)) break; } }
        __builtin_amdgcn_fence(__ATOMIC_ACQUIRE, "agent");
        f32x4 g0[2], g1[2];
#pragma unroll
        for (int bj = 0; bj < 2; ++bj) { const f32x4* gp = (const f32x4*)(gfin + col0 + bj * HALF); g0[bj] = gp[0]; g1[bj] = gp[1]; }
#pragma unroll
        for (int ai = 0; ai < 2; ++ai)
#pragma unroll
            for (int m = 0; m < 4; ++m) {
                const int row = row0 + ai * HALF + m * 16;
                const float tot = __hip_atomic_load(rowss_next + row, __ATOMIC_RELAXED, __HIP_MEMORY_SCOPE_AGENT);
                const float rs = 1.0f / sqrtf(tot * (1.0f / 1024.0f) + RMS_EPS_F);
#pragma unroll
                for (int bj = 0; bj < 2; ++bj) {
                    f32x4* o = (f32x4*)(out + (size_t)row * 1024 + col0 + bj * HALF);
                    o[0] = acc[ai][bj][m][0] * rs * g0[bj]; o[1] = acc[ai][bj][m][1] * rs * g1[bj];
                }
            }
    }
};

template <class Epi, class Sched, bool ALIGN_EPI = false, bool SP2 = false>
__device__ __forceinline__ void gemm_phase(PG8_LAS unsigned char* lds, const Gemm g, const Sched& S, const Epi& E) {
    int tid_ = threadIdx.x; asm volatile("" : "+v"(tid_));
    const int tid = tid_, wid = __builtin_amdgcn_readfirstlane(tid >> 6), lane = tid & 63, wr = wid >> 2, wc = wid & 3, fr = lane & 15, fq = lane >> 4;
    const int K = g.K, nt = K / BK;
    unsigned voffA[2], voffB[2];
#pragma unroll
    for (int i = 0; i < 2; ++i) { int R, C; stage_rc(tid * 16 + i * 8192, R, C); const int Rb = Epi::PERM ? ((R & ~31) + perm32(R & 31)) : R;
        voffA[i] = (unsigned)(R * K + C) * 2u; voffB[i] = (unsigned)(Rb * K + C) * 2u; }
    const size_t kstep = (size_t)(BK * 2);
    const size_t hstep = (size_t)HALF * K * 2;
    const size_t tstep = 2 * hstep;
    const unsigned ldsw = (unsigned)wid * 1024u;
    const int aoff = lds_byte(wr * 64 + fr, fq * 8), boff = lds_byte(wc * 32 + fr, fq * 8);
#define PG8_SA(b, h) (((b) * 2 + (h)) * HTB)
#define PG8_SB(b, h) ((4 + (b) * 2 + (h)) * HTB)
#define PG8_STAGE(bufoff, gbase, voff) do { _Pragma("unroll") for (int _i = 0; _i < 2; ++_i) \
        __builtin_amdgcn_global_load_lds((const unsigned*)((const char*)(gbase) + (voff)[_i]), (PG8_LAS unsigned*)(lds + (bufoff) + ldsw + _i * 8192), 16, 0, 0); } while (0)
#define PG8_LDA(dst, b, h) do { _Pragma("unroll") for (int m = 0; m < 4; ++m) _Pragma("unroll") for (int k = 0; k < 2; ++k) dst[m][k] = *(const PG8_LAS bf16x8*)(lds + PG8_SA(b, h) + aoff + m * 2048 + k * 1024); } while (0)
#define PG8_LDB(dst, b, h) do { _Pragma("unroll") for (int n = 0; n < 2; ++n) _Pragma("unroll") for (int k = 0; k < 2; ++k) dst[n][k] = *(const PG8_LAS bf16x8*)(lds + PG8_SB(b, h) + boff + n * 2048 + k * 1024); } while (0)
#define PG8_MMA(ai, bj, At, Bt) do { __builtin_amdgcn_s_setprio(1); _Pragma("unroll") for (int m = 0; m < 4; ++m) _Pragma("unroll") for (int n = 0; n < 2; ++n) _Pragma("unroll") for (int k = 0; k < 2; ++k) \
        acc[ai][bj][m][n] = __builtin_amdgcn_mfma_f32_16x16x32_bf16(Bt[n][k], At[m][k], acc[ai][bj][m][n], 0, 0, 0); __builtin_amdgcn_s_setprio(0); } while (0)
#define PG8_WAIT_V(n) asm volatile("s_waitcnt vmcnt(" #n ")" ::: "memory")
#define PG8_WAIT_L(n) asm volatile("s_waitcnt lgkmcnt(" #n ")" ::: "memory")
#define PG8_BAR __builtin_amdgcn_s_barrier()
#define PG8_SCHED __builtin_amdgcn_sched_barrier(0)
    Unit cur, nxt; int ui = 0;
    if (!S.next(0, cur)) return;
    f32x4 acc[2][2][4][2];
#pragma unroll
    for (int a = 0; a < 2; ++a)
#pragma unroll
        for (int b = 0; b < 2; ++b)
#pragma unroll
            for (int m = 0; m < 4; ++m)
#pragma unroll
                for (int n = 0; n < 2; ++n) acc[a][b][m][n] = (f32x4){0.f, 0.f, 0.f, 0.f};
    bf16x8 At[4][2], B0[2][2], B1[2][2];
    const char* cA = (const char*)g.A + (size_t)cur.pm * tstep; const char* cB = (const char*)g.Bt + (size_t)cur.pn * tstep;
    S.a_ready(cur);
    if constexpr (SP2) {
        PG8_STAGE(PG8_SB(0, 0), cB, voffB); PG8_STAGE(PG8_SB(0, 1), cB + hstep, voffB); PG8_STAGE(PG8_SA(0, 0), cA, voffA); PG8_STAGE(PG8_SA(0, 1), cA + hstep, voffA);
        if (wr == 1) PG8_BAR;
        PG8_WAIT_V(2); PG8_BAR;
        PG8_STAGE(PG8_SB(1, 0), cB + kstep, voffB); PG8_STAGE(PG8_SA(1, 0), cA + kstep, voffA); PG8_STAGE(PG8_SB(1, 1), cB + hstep + kstep, voffB);
        PG8_WAIT_V(6); PG8_BAR;
    } else {
        PG8_STAGE(PG8_SB(0, 0), cB, voffB); PG8_STAGE(PG8_SA(0, 0), cA, voffA); PG8_STAGE(PG8_SB(0, 1), cB + hstep, voffB); PG8_STAGE(PG8_SA(0, 1), cA + hstep, voffA);
        if (wr == 1) PG8_BAR;
        PG8_WAIT_V(4); PG8_BAR;
        PG8_STAGE(PG8_SB(1, 0), cB + kstep, voffB); PG8_STAGE(PG8_SA(1, 0), cA + kstep, voffA); PG8_STAGE(PG8_SB(1, 1), cB + hstep + kstep, voffB);
        PG8_WAIT_V(6); PG8_BAR;
    }
    for (;;) {
        const bool has_next = S.next(ui + 1, nxt);
        const char* nA = has_next ? (const char*)g.A + (size_t)nxt.pm * tstep : cA; const char* nB = has_next ? (const char*)g.Bt + (size_t)nxt.pn * tstep : cB;
        for (int t = 0; t < nt; t += 2) {
            const bool last = (t == nt - 2);
            const char* a1 = cA + (size_t)(t + 1) * kstep;
            const char* a2 = last ? nA : cA + (size_t)(t + 2) * kstep; const char* b2 = last ? nB : cB + (size_t)(t + 2) * kstep;
            const char* a3 = a2 + kstep; const char* b3 = b2 + kstep;
            if (last && has_next) S.a_ready(nxt);
            if constexpr (SP2) {
            PG8_LDB(B0, 0, 0); PG8_LDB(B1, 0, 1); PG8_SCHED; PG8_LDA(At, 0, 0); PG8_STAGE(PG8_SA(1, 1), a1 + hstep, voffA);
            PG8_WAIT_V(8); PG8_WAIT_L(0); PG8_BAR; PG8_MMA(0, 0, At, B0); PG8_MMA(0, 1, At, B1); PG8_BAR; PG8_SCHED;
            PG8_LDA(At, 0, 1); PG8_STAGE(PG8_SB(0, 0), b2, voffB); PG8_STAGE(PG8_SB(0, 1), b2 + hstep, voffB); PG8_STAGE(PG8_SA(0, 0), a2, voffA);
            PG8_WAIT_V(8); PG8_WAIT_L(0); PG8_BAR; PG8_MMA(1, 0, At, B0); PG8_MMA(1, 1, At, B1); PG8_BAR; PG8_SCHED;
            PG8_LDB(B0, 1, 0); PG8_LDB(B1, 1, 1); PG8_SCHED; PG8_LDA(At, 1, 0); PG8_STAGE(PG8_SA(0, 1), a2 + hstep, voffA);
            PG8_WAIT_V(8); PG8_WAIT_L(0); PG8_BAR; PG8_MMA(0, 0, At, B0); PG8_MMA(0, 1, At, B1); PG8_BAR; PG8_SCHED;
            PG8_LDA(At, 1, 1); PG8_STAGE(PG8_SB(1, 0), b3, voffB); PG8_STAGE(PG8_SB(1, 1), b3 + hstep, voffB); PG8_STAGE(PG8_SA(1, 0), a3, voffA);
            PG8_WAIT_V(8); PG8_WAIT_L(0); PG8_BAR; PG8_MMA(1, 0, At, B0); PG8_MMA(1, 1, At, B1); PG8_BAR; PG8_SCHED;
            } else {
            PG8_LDB(B0, 0, 0); PG8_SCHED; PG8_LDA(At, 0, 0); PG8_STAGE(PG8_SA(1, 1), a1 + hstep, voffA);
            PG8_WAIT_L(8); PG8_BAR; PG8_WAIT_L(0); PG8_MMA(0, 0, At, B0); PG8_BAR; PG8_SCHED;
            PG8_LDB(B1, 0, 1); PG8_STAGE(PG8_SB(0, 0), b2, voffB);
            PG8_BAR; PG8_WAIT_L(0); PG8_MMA(0, 1, At, B1); PG8_BAR;
            PG8_LDA(At, 0, 1); PG8_STAGE(PG8_SA(0, 0), a2, voffA);
            PG8_BAR; PG8_WAIT_L(0); PG8_MMA(1, 0, At, B0); PG8_BAR; PG8_SCHED;
            PG8_STAGE(PG8_SB(0, 1), b2 + hstep, voffB);
            PG8_WAIT_V(6); PG8_BAR; PG8_MMA(1, 1, At, B1); PG8_BAR;
            PG8_LDB(B0, 1, 0); PG8_SCHED; PG8_LDA(At, 1, 0); PG8_STAGE(PG8_SA(0, 1), a2 + hstep, voffA);
            PG8_WAIT_L(8); PG8_BAR; PG8_WAIT_L(0); PG8_MMA(0, 0, At, B0); PG8_BAR; PG8_SCHED;
            PG8_LDB(B1, 1, 1); PG8_STAGE(PG8_SB(1, 0), b3, voffB);
            PG8_BAR; PG8_WAIT_L(0); PG8_MMA(0, 1, At, B1); PG8_BAR;
            PG8_LDA(At, 1, 1); PG8_STAGE(PG8_SA(1, 0), a3, voffA);
            PG8_BAR; PG8_WAIT_L(0); PG8_MMA(1, 0, At, B0); PG8_BAR; PG8_SCHED;
            PG8_STAGE(PG8_SB(1, 1), b3 + hstep, voffB);
            PG8_WAIT_V(6); PG8_BAR; PG8_MMA(1, 1, At, B1); PG8_BAR;
            }
        }
        if constexpr (ALIGN_EPI) { if (wr == 0) PG8_BAR; }
        if constexpr (!Epi::AFTER_DRAIN) { E(acc, cur, wr, wc, fr, fq); S.done(cur); }
        if (!has_next) break;
#pragma unroll
        for (int a = 0; a < 2; ++a)
#pragma unroll
            for (int b = 0; b < 2; ++b)
#pragma unroll
                for (int m = 0; m < 4; ++m)
#pragma unroll
                    for (int n = 0; n < 2; ++n) acc[a][b][m][n] = (f32x4){0.f, 0.f, 0.f, 0.f};
        cur = nxt; cA = nA; cB = nB; ++ui;
        if constexpr (ALIGN_EPI) { if (wr == 1) PG8_BAR; }
    }
    PG8_WAIT_V(0);
    if constexpr (!ALIGN_EPI) { if (wr == 0) PG8_BAR; }
    PG8_BAR;
    if constexpr (Epi::AFTER_DRAIN) { E.fused(acc, cur, wr, wc, fr, fq, lds, wid, lane); S.done(cur); }
#undef PG8_SA
#undef PG8_SB
#undef PG8_STAGE
#undef PG8_LDA
#undef PG8_LDB
#undef PG8_MMA
#undef PG8_WAIT_V
#undef PG8_WAIT_L
#undef PG8_BAR
#undef PG8_SCHED
}
}
#include <hip/hip_bf16.h>
#include <cmath>
namespace attn_body {
using bf16=__hip_bfloat16;
using bf16x8=__attribute__((ext_vector_type(8)))short;
using s16x4=__attribute__((ext_vector_type(4)))short;
using f32x16=__attribute__((ext_vector_type(16)))float;
using u32x4=__attribute__((ext_vector_type(4)))unsigned;
using f32x4_t=__attribute__((ext_vector_type(4)))float;
constexpr int BATCH=8,NHEAD=16,SEQ=2048,D=64,DM=3072,DMO=1024;
constexpr int NW=8,QBLK=32,QB=QBLK*NW,KVBLK=64,NQB=SEQ/QB;
constexpr int ATTN_PITCH=DM, ATTN_UNIT_ROWS=QB;
__device__ __forceinline__ int crow(int r,int hi){return (r&3)+8*(r>>2)+4*hi;}
#define SBAR() __builtin_amdgcn_sched_barrier(0)
__device__ __forceinline__ void cmask(f32x16&p0,f32x16&p1,int jb,int qrel,int hi){
  const float NEG=-INFINITY; int kb=64*jb+4*hi;
  #pragma unroll
  for(int r=0;r<16;++r){int kv=kb+(r&3)+8*(r>>2); if(kv>qrel)p0[r]=NEG; if(kv+32>qrel)p1[r]=NEG;}
}

constexpr int NSLOT=3, SLOTB=8192;
constexpr int LDS_K=0, LDS_V=NSLOT*SLOTB, LDS_WS=2*NSLOT*SLOTB, LDS_OST=LDS_WS+NW*64*4, LDS_BYTES=LDS_OST+NW*4096;
constexpr float C2=0.125f*1.4426950408889634f;
__device__ __forceinline__ void glds16(const void*gsrc,unsigned lds_dst){unsigned keep;
  asm volatile("s_mov_b32 %0, m0\n\ts_mov_b32 m0, %2\n\ts_nop 0\n\tglobal_load_lds_dwordx4 %1, off\n\ts_mov_b32 m0, %0":"=&s"(keep):"v"(gsrc),"s"(lds_dst):"memory");}
__device__ __forceinline__ float max3f(float a,float b,float c){float r;asm("v_max3_f32 %0, %1, %2, %3":"=v"(r):"v"(a),"v"(b),"v"(c));return r;}
__device__ __forceinline__ float max2f(float a,float b){float r;asm("v_max_f32_e32 %0, %1, %2":"=v"(r):"v"(a),"v"(b));return r;}
__device__ __forceinline__ float fadd_s(float a,float b){float r;asm("v_add_f32_e32 %0, %1, %2":"=v"(r):"v"(a),"v"(b));return r;}
__device__ __forceinline__ float fsub_s(float a,float b){float r;asm("v_sub_f32_e32 %0, %1, %2":"=v"(r):"v"(a),"v"(b));return r;}
typedef float f32x2_t __attribute__((ext_vector_type(2))); typedef __bf16 bf16x2_t __attribute__((ext_vector_type(2)));
__device__ __forceinline__ unsigned cvtpk_s(float lo,float hi){f32x2_t v={lo,hi};bf16x2_t b=__builtin_convertvector(v,bf16x2_t);return __builtin_bit_cast(unsigned,b);}
#define WAIT_BAR(N) asm volatile("s_waitcnt vmcnt(" #N ") lgkmcnt(0)\n\ts_barrier":::"memory")

__device__ __forceinline__ void qkt(f32x16&p0,f32x16&p1,const char*Kslot,const bf16x8*qr,int r32,int hi){
  const char*kb=Kslot+hi*1024+r32*16;
  #pragma unroll
  for(int d0=0;d0<4;++d0){
    const bf16x8 b0=*reinterpret_cast<const bf16x8*>(kb+d0*2048);
    const bf16x8 b1=*reinterpret_cast<const bf16x8*>(kb+d0*2048+512);
    p0=__builtin_amdgcn_mfma_f32_32x32x16_bf16(b0,qr[d0],p0,0,0,0);p1=__builtin_amdgcn_mfma_f32_32x32x16_bf16(b1,qr[d0],p1,0,0,0);}
}
typedef __attribute__((address_space(3))) const char* lds_cptr;
typedef short v4i16_t __attribute__((ext_vector_type(4)));
__device__ __forceinline__ void kload8(bf16x8*kf,lds_cptr kp){
  kf[0]=*(const __attribute__((address_space(3))) bf16x8*)(kp);      kf[1]=*(const __attribute__((address_space(3))) bf16x8*)(kp+512);
  kf[2]=*(const __attribute__((address_space(3))) bf16x8*)(kp+2048); kf[3]=*(const __attribute__((address_space(3))) bf16x8*)(kp+2560);
  kf[4]=*(const __attribute__((address_space(3))) bf16x8*)(kp+4096); kf[5]=*(const __attribute__((address_space(3))) bf16x8*)(kp+4608);
  kf[6]=*(const __attribute__((address_space(3))) bf16x8*)(kp+6144); kf[7]=*(const __attribute__((address_space(3))) bf16x8*)(kp+6656);
}
__device__ __forceinline__ void kload2(bf16x8*kf,lds_cptr kp,int j){ kf[2*j]=*(const __attribute__((address_space(3))) bf16x8*)(kp+j*2048); kf[2*j+1]=*(const __attribute__((address_space(3))) bf16x8*)(kp+j*2048+512); }
__device__ __forceinline__ s16x4 vtr(lds_cptr p){ return __builtin_bit_cast(s16x4,__builtin_amdgcn_ds_read_tr16_b64_v4i16((__attribute__((address_space(3))) v4i16_t*)p)); }
__device__ __forceinline__ float rowmax(const f32x16&p0,const f32x16&p1){
  float a=max3f(p0[0],p0[1],p1[0]),b=max3f(p0[2],p0[3],p1[1]);a=max3f(a,p1[2],p1[3]);
  #pragma unroll
  for(int r=4;r<16;r+=4){a=max3f(a,p0[r],p0[r+1]);b=max3f(b,p0[r+2],p0[r+3]);a=max3f(a,p1[r],p1[r+1]);b=max3f(b,p1[r+2],p1[r+3]);}
  const float m=max2f(a,b);
  auto rr=__builtin_amdgcn_permlane32_swap(__float_as_uint(m),__float_as_uint(m),false,false);
  return max2f(__uint_as_float(rr[0]),__uint_as_float(rr[1]));
}
__device__ __forceinline__ void pv(f32x16*o,int vb,bf16x8 pa0,bf16x8 pa1,bf16x8 pa2,bf16x8 pa3){
  #pragma unroll
  for(int d0=0;d0<2;++d0){s16x4 lo[4],hi[4];
    #pragma unroll
    for(int ks=0;ks<4;++ks){
      asm volatile("ds_read_b64_tr_b16 %0,%1 offset:%c2":"=&v"(lo[ks]):"v"(vb),"i"(d0*4096+ks*1024):"memory");
      asm volatile("ds_read_b64_tr_b16 %0,%1 offset:%c2":"=&v"(hi[ks]):"v"(vb),"i"(d0*4096+ks*1024+512):"memory");}
    asm volatile("s_waitcnt lgkmcnt(0)":::"memory");SBAR();
    #define PK(k) (bf16x8){lo[k][0],lo[k][1],lo[k][2],lo[k][3],hi[k][0],hi[k][1],hi[k][2],hi[k][3]}
    o[d0]=__builtin_amdgcn_mfma_f32_32x32x16_bf16(pa0,PK(0),o[d0],0,0,0);
    o[d0]=__builtin_amdgcn_mfma_f32_32x32x16_bf16(pa1,PK(1),o[d0],0,0,0);
    o[d0]=__builtin_amdgcn_mfma_f32_32x32x16_bf16(pa2,PK(2),o[d0],0,0,0);
    o[d0]=__builtin_amdgcn_mfma_f32_32x32x16_bf16(pa3,PK(3),o[d0],0,0,0);
    #undef PK
  }
}

#ifndef ATTN_STORE16
#define ATTN_STORE16(p,v) (*(u32x4*)(p)=(v))
#endif
template<int THRL> __device__ __forceinline__ void attn_unit(int b,int h,int qb,const bf16*Q,const bf16*__restrict__ K,const bf16*__restrict__ V,bf16*O,char*shm,const __attribute__((address_space(3))) float*Fs){
  int tid_=threadIdx.x; asm volatile("":"+v"(tid_)); const int tid=tid_,lane=tid&63,r32=lane&31,hi=lane>>5;   const int wid=__builtin_amdgcn_readfirstlane(tid>>6);
  const long rowbase=(long)b*SEQ; const int q0=qb*QB;
  const bf16*Qw=Q+(rowbase+q0+wid*QBLK)*DM+h*D;
  const bf16*Kh=K+rowbase*DM+h*D,*Vh=V+rowbase*DM+h*D;
  const unsigned lds0=(unsigned)(uintptr_t)shm;
  float*wsf=(float*)(shm+LDS_WS)+wid*64;
  const bf16*ksrc=Kh+(long)lane*DM+wid*8;
  const bf16*vsrc=Vh+(long)(16*(wid&3)+(lane>>2))*DM+(wid>>2)*32+(lane&3)*8;
  const unsigned kdst=lds0+LDS_K+wid*1024, vdst=lds0+LDS_V+wid*1024;
  #define DMA_K(t,slot) glds16(ksrc+(long)(t)*KVBLK*DM,(unsigned)__builtin_amdgcn_readfirstlane(kdst+(slot)))
  #define DMA_V(t,slot) glds16(vsrc+(long)(t)*KVBLK*DM,(unsigned)__builtin_amdgcn_readfirstlane(vdst+(slot)))
  const int vb0=(int)(lds0+LDS_V)+((lane>>4)&1)*32+(lane&3)*8+(4*hi+((lane&15)>>2))*64;
  const char*Kbase=shm+LDS_K; bf16x8 kf[8];
  const lds_cptr shm3=(lds_cptr)shm; const lds_cptr kp0=shm3+LDS_K+hi*1024+r32*16; const lds_cptr vp0=shm3+LDS_V+((lane>>4)&1)*32+(lane&3)*8+(4*hi+((lane&15)>>2))*64;
  const int NT=(q0+QB)/KVBLK;
  DMA_K(0,0);DMA_V(0,0);DMA_K(1,SLOTB);
  bf16x8 qr[4];
  #pragma unroll
  for(int d0=0;d0<4;++d0)qr[d0]=*reinterpret_cast<const bf16x8*>(&Qw[(long)r32*DM+d0*16+hi*8]);
  float mhat=0.f,l_reg=0.f;f32x16 o[2];o[0]=f32x16{};o[1]=f32x16{};
  const int qrel=wid*QBLK+r32;
  const float Fq=Fs[q0+qrel];
  #define BIAS(C0,C1,t) do{ const __attribute__((address_space(3))) f32x4_t*fk_=(const __attribute__((address_space(3))) f32x4_t*)(Fs+64*(t)+4*hi); const float fb_=Fq-mhat; \
    _Pragma("unroll") for(int g_=0;g_<4;++g_){ const f32x4_t a_=fk_[2*g_], b_=fk_[8+2*g_]; \
      _Pragma("unroll") for(int e_=0;e_<4;++e_){ C0[4*g_+e_]=fb_-a_[e_]; C1[4*g_+e_]=fb_-b_[e_]; } } }while(0)
  #define CMASK(P0,P1,t) do{int jb_=(t)-(NT-4); if(jb_>=0)cmask(P0,P1,jb_,qrel,hi);}while(0)
  bool resc=false;
  #define START(P0,P1) do{ const float rm=rowmax(P0,P1); resc=false; \
    { const float dl=rm; mhat=fadd_s(mhat,dl); \
      _Pragma("unroll") for(int r=0;r<16;++r){P0[r]=fsub_s(P0[r],dl);P1[r]=fsub_s(P1[r],dl);} \
      } \
    _Pragma("unroll") for(int r=0;r<16;++r)P0[r]=__builtin_amdgcn_exp2f(P0[r]); }while(0)
  #define RESC() do{ if(resc){ asm volatile("s_waitcnt lgkmcnt(0)":::"memory"); \
      _Pragma("unroll") for(int d_=0;d_<2;++d_) _Pragma("unroll") for(int r=0;r<16;++r)o[d_][r]*=wsf[crow(r,hi)]; } }while(0)
  f32x16 pA0,pA1,pB0,pB1;
  int sl_prev=0,sl_cur=0,sl_next=SLOTB;
  #define ROT() do{sl_prev=sl_cur;sl_cur=sl_next;sl_next=(sl_next==(NSLOT-1)*SLOTB)?0:sl_next+SLOTB;}while(0)
  DMA_K(2,2*SLOTB);
  WAIT_BAR(3);
  BIAS(pA0,pA1,0); qkt(pA0,pA1,Kbase,qr,r32,hi);asm volatile("s_nop 15\n\ts_nop 7":"+v"(pA0),"+v"(pA1));CMASK(pA0,pA1,0);
  START(pA0,pA1);
  _Pragma("unroll") for(int r=0;r<16;++r)pA1[r]=__builtin_amdgcn_exp2f(pA1[r]);
  WAIT_BAR(0);
  DMA_K(3,0);DMA_V(1,SLOTB);
  ROT();
  kload8(kf,kp0+sl_cur);
  WAIT_BAR(2);
  s16x4 vlo[8],vhi[8]; u32x4 pw0,pw1,pw2,pw3;
  #define PKW(P,B) cvtpk_s(P[B],P[B+1])
  #define PAF(k) __builtin_bit_cast(bf16x8,pw##k)
  #define VFR(i) (bf16x8){vlo[i][0],vlo[i][1],vlo[i][2],vlo[i][3],vhi[i][0],vhi[i][1],vhi[i][2],vhi[i][3]}
  #define PIN(x) asm volatile("":"+v"(x))
  #define MX3(a,b,c) __builtin_fmaxf(__builtin_fmaxf((a),(b)),(c))
  #define GAPA(MF,A0,A1,A2,A3,W0,W1,PW) do{ MF; sacc+=A0; sacc+=A1; sacc+=A2; sacc+=A3; PIN(sacc); W0; W1; PIN(PW); SBAR(); }while(0)
  #define EX(v) __builtin_amdgcn_exp2f(v)
  #define GAPB(MF,X,B) do{ MF; X[B]=EX(X[B]); X[B+1]=EX(X[B+1]); X[B+2]=EX(X[B+2]); X[B+3]=EX(X[B+3]); PIN(X); SBAR(); }while(0)
  #define VRD(i) do{ vlo[i]=vtr(vp_+(((i)>>2)*4096+((i)&3)*1024)); vhi[i]=vtr(vp_+(((i)>>2)*4096+((i)&3)*1024+512)); }while(0)
  #define KRD(G,j) do{ if(G){ kload2(kf,kp0+sl_next,j); SBAR(); } }while(0)
  #define STEP(C0,C1,P0,P1,t,GK,GV,GL) do{ SBAR(); BIAS(C0,C1,t); \
    const lds_cptr vp_=vp0+sl_prev; \
    VRD(0); SBAR(); float sacc=(P0[0]+P0[1]); \
    GAPA(C0=__builtin_amdgcn_mfma_f32_32x32x16_bf16(kf[0],qr[0],C0,0,0,0), P0[2],P0[3],P0[4],P0[5],     pw0[0]=PKW(P0,0), pw0[1]=PKW(P0,2), pw0); \
    VRD(4); SBAR(); GAPA(C1=__builtin_amdgcn_mfma_f32_32x32x16_bf16(kf[1],qr[0],C1,0,0,0), P0[6],P0[7],P0[8],P0[9],     pw0[2]=PKW(P0,4), pw0[3]=PKW(P0,6), pw0); \
    VRD(1); SBAR(); GAPA(C0=__builtin_amdgcn_mfma_f32_32x32x16_bf16(kf[2],qr[1],C0,0,0,0),   P0[10],P0[11],P0[12],P0[13], pw1[0]=PKW(P0,8), pw1[1]=PKW(P0,10), pw1); \
    VRD(5); SBAR(); GAPA(C1=__builtin_amdgcn_mfma_f32_32x32x16_bf16(kf[3],qr[1],C1,0,0,0),   P0[14],P0[15],P1[0],P1[1],   pw1[2]=PKW(P0,12),pw1[3]=PKW(P0,14), pw1); \
    VRD(2); SBAR(); GAPA(C0=__builtin_amdgcn_mfma_f32_32x32x16_bf16(kf[4],qr[2],C0,0,0,0),   P1[2],P1[3],P1[4],P1[5],     pw2[0]=PKW(P1,0), pw2[1]=PKW(P1,2), pw2); \
    VRD(6); SBAR(); GAPA(C1=__builtin_amdgcn_mfma_f32_32x32x16_bf16(kf[5],qr[2],C1,0,0,0),   P1[6],P1[7],P1[8],P1[9],     pw2[2]=PKW(P1,4), pw2[3]=PKW(P1,6), pw2); \
    VRD(3); SBAR(); GAPA(C0=__builtin_amdgcn_mfma_f32_32x32x16_bf16(kf[6],qr[3],C0,0,0,0),   P1[10],P1[11],P1[12],P1[13], pw3[0]=PKW(P1,8), pw3[1]=PKW(P1,10), pw3); \
    VRD(7); SBAR(); GAPA(C1=__builtin_amdgcn_mfma_f32_32x32x16_bf16(kf[7],qr[3],C1,0,0,0),   P1[14],P1[15],0.f,0.f,       pw3[2]=PKW(P1,12),pw3[3]=PKW(P1,14), pw3); \
    l_reg+=sacc; \
    if(GK){DMA_K((t)+3,sl_cur);} if(GV){DMA_V((t)+1,sl_next);} \
    CMASK(C0,C1,t); \
    { float a=MX3(C0[0],C0[1],C1[0]),b=MX3(C0[2],C0[3],C1[1]); a=MX3(a,C1[2],C1[3]); \
      _Pragma("unroll") for(int r=4;r<16;r+=4){a=MX3(a,C0[r],C0[r+1]);b=MX3(b,C0[r+2],C0[r+3]);a=MX3(a,C1[r],C1[r+1]);b=MX3(b,C1[r+2],C1[r+3]);} \
      float rm=__builtin_fmaxf(a,b); { auto rr=__builtin_amdgcn_permlane32_swap(__float_as_uint(rm),__float_as_uint(rm),false,false); rm=__builtin_fmaxf(__uint_as_float(rr[0]),__uint_as_float(rr[1])); } \
      resc=false; \
      if(__builtin_expect(__any(rm>(float)THRL),0)){ const float dl=__builtin_fmaxf(rm,0.f); mhat+=dl; \
        _Pragma("unroll") for(int r=0;r<16;++r){C0[r]-=dl;C1[r]-=dl;} \
        const float f=__builtin_amdgcn_exp2f(-dl); l_reg*=f; if(hi==0)wsf[r32]=f; resc=true; } } \
    SBAR(); \
    GAPB(o[0]=__builtin_amdgcn_mfma_f32_32x32x16_bf16(PAF(0),VFR(0),o[0],0,0,0), C0,0); \
    GAPB(o[1]=__builtin_amdgcn_mfma_f32_32x32x16_bf16(PAF(0),VFR(4),o[1],0,0,0), C0,4); \
    KRD(GL,0); GAPB(o[0]=__builtin_amdgcn_mfma_f32_32x32x16_bf16(PAF(1),VFR(1),o[0],0,0,0), C0,8); \
    KRD(GL,1); GAPB(o[1]=__builtin_amdgcn_mfma_f32_32x32x16_bf16(PAF(1),VFR(5),o[1],0,0,0), C0,12); \
    KRD(GL,2); GAPB(o[0]=__builtin_amdgcn_mfma_f32_32x32x16_bf16(PAF(2),VFR(2),o[0],0,0,0), C1,0); \
    KRD(GL,3); GAPB(o[1]=__builtin_amdgcn_mfma_f32_32x32x16_bf16(PAF(2),VFR(6),o[1],0,0,0), C1,4); \
    GAPB(o[0]=__builtin_amdgcn_mfma_f32_32x32x16_bf16(PAF(3),VFR(3),o[0],0,0,0), C1,8); \
    GAPB(o[1]=__builtin_amdgcn_mfma_f32_32x32x16_bf16(PAF(3),VFR(7),o[1],0,0,0), C1,12); \
    }while(0)
  int t=1;
  #undef CMASK
  #define CMASK(P0,P1,t) do{}while(0)
  for(;t+5<NT;t+=2){
    STEP(pB0,pB1,pA0,pA1,t,true,true,true);     WAIT_BAR(2); RESC(); ROT();
    STEP(pA0,pA1,pB0,pB1,t+1,true,true,true);   WAIT_BAR(2); RESC(); ROT();
  }
  #undef CMASK
  #define CMASK(P0,P1,t) do{int jb_=(t)-(NT-4); if(jb_>=0)cmask(P0,P1,jb_,qrel,hi);}while(0)
  #define ENDW(tt) do{ if((tt)+3<NT){WAIT_BAR(2);} else if((tt)+2<NT){WAIT_BAR(1);} else {WAIT_BAR(0);} }while(0)
  for(;t+1<NT;t+=2){
    STEP(pB0,pB1,pA0,pA1,t,(t+3<NT),(t+1<NT),(t+1<NT));       ENDW(t);   RESC(); ROT();
    STEP(pA0,pA1,pB0,pB1,t+1,(t+4<NT),(t+2<NT),(t+2<NT));     ENDW(t+1); RESC(); ROT();
  }
  STEP(pB0,pB1,pA0,pA1,NT-1,false,false,false); RESC();
  { float sacc=pB0[0]+pB0[1]; _Pragma("unroll") for(int r=2;r<16;++r)sacc+=pB0[r]; _Pragma("unroll") for(int r=0;r<16;++r)sacc+=pB1[r]; l_reg+=sacc;
    pw0=(u32x4){PKW(pB0,0),PKW(pB0,2),PKW(pB0,4),PKW(pB0,6)};pw1=(u32x4){PKW(pB0,8),PKW(pB0,10),PKW(pB0,12),PKW(pB0,14)};pw2=(u32x4){PKW(pB1,0),PKW(pB1,2),PKW(pB1,4),PKW(pB1,6)};pw3=(u32x4){PKW(pB1,8),PKW(pB1,10),PKW(pB1,12),PKW(pB1,14)};
    SBAR(); pv(o,vb0+sl_cur,PAF(0),PAF(1),PAF(2),PAF(3)); }
  #undef PKW
  #undef PAF
  #undef VFR
  #undef PIN
  #undef MX3
  #undef GAPA
  #undef GAPB
  #undef EX
  #undef VRD
  #undef KRD
  #undef STEP
  #undef ENDW
  {auto rr=__builtin_amdgcn_permlane32_swap(__float_as_uint(l_reg),__float_as_uint(l_reg),false,false);l_reg=__uint_as_float(rr[0])+__uint_as_float(rr[1]);}
  if(hi==0)wsf[32+r32]=l_reg;asm volatile("s_waitcnt lgkmcnt(0)":::"memory");
  float rli[16];
  #pragma unroll
  for(int r=0;r<16;++r)rli[r]=__builtin_amdgcn_rcpf(wsf[32+crow(r,hi)]);
  bf16*Ow=O+(rowbase+q0+wid*QBLK)*DMO+h*D;
  { bf16*stg=(bf16*)(shm+LDS_OST)+wid*2048;
    #pragma unroll
    for(int r=0;r<16;++r){const int orow=crow(r,hi);
      #pragma unroll
      for(int d0=0;d0<2;++d0)stg[orow*64+d0*32+r32]=__float2bfloat16(o[d0][r]*rli[r]);}
    asm volatile("s_waitcnt lgkmcnt(0)":::"memory");
    #pragma unroll
    for(int i=0;i<4;++i){const int row=i*8+(lane>>3),ch=lane&7; const u32x4 v=*(const u32x4*)(stg+row*64+ch*8); ATTN_STORE16(Ow+(long)row*DMO+ch*8,v);} }
  asm volatile("s_waitcnt lgkmcnt(0)\n\ts_barrier":::"memory");
  #undef DMA_K
  #undef DMA_V
  #undef CMASK
  #undef START
  #undef RESC
  #undef ROT
  #undef BIAS
}
constexpr int ATTN_LDS_BYTES=LDS_BYTES;
#undef SBAR
#undef WAIT_BAR
}

#define LAS __attribute__((address_space(3)))
typedef unsigned short bf16_t;
typedef short bf16x8 __attribute__((ext_vector_type(8)));
typedef short s16x4 __attribute__((ext_vector_type(4)));
typedef float f32x4 __attribute__((ext_vector_type(4)));
typedef float f32x16 __attribute__((ext_vector_type(16)));
typedef unsigned u32x4 __attribute__((ext_vector_type(4)));
typedef unsigned u32x2 __attribute__((ext_vector_type(2)));

constexpr int NB = 8, SEQ = 2048, DM = 1024, MTOK = NB * SEQ, DFF = 2816, NLAYER = 4, QKV_LD = 3072;
constexpr int NWAVES = 8, NTHR = 512;
constexpr float LOG2E = 1.4426950408889634f;
constexpr int LDS_BYTES = 147456;
constexpr int VROW = 192;
constexpr int VTILE = 32 * VROW;
constexpr int LDS_F = 49152;
constexpr int NPHASE = 2 + 5 * NLAYER;
constexpr int LDS_MISC = 131072;

constexpr size_t MiB = 1u << 20;
constexpr size_t SZ_WQKV = (size_t)3072 * 1024 * 2, SZ_WO = (size_t)1024 * 1024 * 2, SZ_WI = (size_t)5632 * 1024 * 2, SZ_WOUT = (size_t)1024 * 2816 * 2;
constexpr size_t SZ_WLAYER = SZ_WQKV + SZ_WO + SZ_WI + SZ_WOUT;
constexpr size_t WS_W = 0;
constexpr size_t WS_XB = 104 * MiB;
constexpr size_t WS_XRES = WS_XB + 32 * MiB;
constexpr size_t WS_QKV = WS_XRES + 64 * MiB;
constexpr size_t WS_ATT = WS_QKV + 96 * MiB;
constexpr size_t WS_SMALL = WS_ATT + 32 * MiB;
constexpr size_t WS_ROWSS = WS_SMALL;
constexpr size_t WS_ROT = WS_ROWSS + (size_t)9 * MTOK * 4;
constexpr size_t WS_WF = WS_ROT + (size_t)2048 * 16 * 4;
constexpr size_t WS_LOCF = WS_WF + (size_t)2 * 16 * 1024 * 4;
constexpr size_t WS_TOTF = WS_LOCF + (size_t)128 * 2048 * 4;
constexpr size_t WS_LSE = WS_TOTF + (size_t)128 * 32 * 4;
constexpr size_t WS_BAR = WS_LSE + (size_t)2 * MTOK * 8 * 4;
constexpr size_t WS_PCNT = WS_BAR + 16384;
constexpr size_t WS_END = WS_PCNT + 16384;
static_assert(SZ_WLAYER * 4 <= 104 * MiB, "weights fit");

struct Args {
    const float* x; const float* norm_mix; const float* w_qkv_even; const float* w_o_even; const float* w_qkvf_odd; const float* b_forget; const float* w_o_odd;
    const float* norm_ffn; const float* w_ffn_in; const float* w_ffn_out; const float* norm_final;
    float* out; unsigned char* ws; int ph_lo, ph_hi;
};

__device__ __forceinline__ unsigned f2bf(float f) { unsigned u = __builtin_bit_cast(unsigned, f); return (u + 0x7fffu + ((u >> 16) & 1u)) >> 16; }
__device__ __forceinline__ unsigned pk2(float lo, float hi) { return f2bf(lo) | (f2bf(hi) << 16); }
__device__ __forceinline__ unsigned cvtpk(float lo, float hi) { unsigned r; asm volatile("v_cvt_pk_bf16_f32 %0, %1, %2" : "=v"(r) : "v"(lo), "v"(hi)); return r; }
__device__ __forceinline__ float wave_sum(float v) {
#pragma unroll
    for (int o = 1; o < 64; o <<= 1) v += __shfl_xor(v, o);
    return v;
}
#define LDS_WAIT() asm volatile("s_waitcnt lgkmcnt(0)" ::: "memory")
__device__ __forceinline__ int otid() { int t = threadIdx.x; asm volatile("" : "+v"(t)); return t; }

#ifndef FUSE_FINAL
#define FUSE_FINAL 1
#endif
#ifndef CONV_SPLIT
#define CONV_SPLIT 1
#endif
__device__ __forceinline__ void transpose_item(const float* W, int ldw, int K, int k0, int src_col, bf16_t* WT, int dst_row, const float* gain, float cscale, LAS float* scr, int lane) {
    const int kr = lane >> 3, c4 = lane & 7;
    f32x4 v[8]; float g[8];
#pragma unroll
    for (int i = 0; i < 8; ++i) { const int kk = 8 * i + kr; v[i] = *(const f32x4*)(W + (size_t)(k0 + kk) * ldw + src_col + 4 * c4); g[i] = gain ? gain[k0 + kk] * cscale : cscale; }
#pragma unroll
    for (int i = 0; i < 8; ++i) { const int kk = 8 * i + kr; LAS float* d = scr + kk * 33 + 4 * c4; d[0] = v[i].x * g[i]; d[1] = v[i].y * g[i]; d[2] = v[i].z * g[i]; d[3] = v[i].w * g[i]; }
    LDS_WAIT(); asm volatile("" ::: "memory");
    const int c = lane & 7;
#pragma unroll
    for (int j = 0; j < 4; ++j) { const int n = (lane >> 3) + 8 * j; const LAS float* s = scr + (8 * c) * 33 + n;
        u32x4 o; o.x = pk2(s[0 * 33], s[1 * 33]); o.y = pk2(s[2 * 33], s[3 * 33]); o.z = pk2(s[4 * 33], s[5 * 33]); o.w = pk2(s[6 * 33], s[7 * 33]);
        *(u32x4*)(WT + (size_t)(dst_row + n) * K + k0 + 8 * c) = o; }
    LDS_WAIT(); asm volatile("" ::: "memory");
}

__device__ __forceinline__ void convert_weights(const Args& a, int l_lo, int l_hi, LAS unsigned char* lds, int gw, int NGW) {
    const int tid = otid(), lane = tid & 63, wave = __builtin_amdgcn_readfirstlane(tid >> 6);
    LAS float* scr = (LAS float*)(lds + wave * 16384);
    constexpr int I_QKV = 16 * 96, I_O = 16 * 32, I_IN = 16 * 176, I_OUT = 44 * 32, I_LAYER = I_QKV + I_O + I_IN + I_OUT;
    for (int it = l_lo * I_LAYER + gw; it < l_hi * I_LAYER; it += NGW) {
        const int l = it / I_LAYER; int r = it % I_LAYER;
        bf16_t* wl = (bf16_t*)(a.ws + WS_W + (size_t)l * SZ_WLAYER);
        if (r < I_QKV) {
            const int kb = r / 96, nb = r % 96, n0 = 32 * nb;
            const float* W = (l & 1) ? a.w_qkvf_odd + (size_t)(l >> 1) * 1024 * 3088 : a.w_qkv_even + (size_t)(l >> 1) * 1024 * 3072;
            transpose_item(W, (l & 1) ? 3088 : 3072, 1024, 64 * kb, n0, wl, n0, a.norm_mix + l * 1024, n0 < 1024 ? 0.125f * LOG2E : 1.0f, scr, lane);
            continue; }
        r -= I_QKV;
        if (r < I_O) {
            const int kb = r / 32, nb = r % 32, n0 = 32 * nb;
            const float* W = (l & 1) ? a.w_o_odd + (size_t)(l >> 1) * 1024 * 1024 : a.w_o_even + (size_t)(l >> 1) * 1024 * 1024;
            transpose_item(W, 1024, 1024, 64 * kb, n0, (bf16_t*)((unsigned char*)wl + SZ_WQKV), n0, nullptr, 1.0f, scr, lane);
            continue; }
        r -= I_O;
        if (r < I_IN) {
            const int kb = r / 176, nb = r % 176, n0 = 32 * nb;
            const int pn = n0 >> 8, bj = (n0 >> 7) & 1, c0 = n0 & 127;
            transpose_item(a.w_ffn_in + (size_t)l * 1024 * 5632, 5632, 1024, 64 * kb, bj * 2816 + 128 * pn + c0, (bf16_t*)((unsigned char*)wl + SZ_WQKV + SZ_WO), n0, a.norm_ffn + l * 1024, 1.0f, scr, lane);
            continue; }
        r -= I_IN;
        {
            const int kb = r / 32, nb = r % 32, n0 = 32 * nb;
            transpose_item(a.w_ffn_out + (size_t)l * 2816 * 1024, 1024, 2816, 64 * kb, n0, (bf16_t*)((unsigned char*)wl + SZ_WQKV + SZ_WO + SZ_WI), n0, nullptr, 1.0f, scr, lane);
        }
    }
}

__device__ __forceinline__ void prologue(const Args& a, LAS unsigned char* lds, int vwg, int G) {
    const int tid = otid(), lane = tid & 63, wave = __builtin_amdgcn_readfirstlane(tid >> 6);
    const int gw = vwg * NWAVES + wave, NGW = G * NWAVES;
    convert_weights(a, 0, (CONV_SPLIT && G == 256) ? 1 : NLAYER, lds, gw, NGW);
    bf16_t* xb = (bf16_t*)(a.ws + WS_XB); float* rowss = (float*)(a.ws + WS_ROWSS);
    for (int m = gw; m < MTOK; m += NGW) {
        const f32x4* xr = (const f32x4*)(a.x + (size_t)m * DM) + lane; float s = 0.f; f32x4 v[4];
#pragma unroll
        for (int j = 0; j < 4; ++j) { v[j] = xr[64 * j]; s += (v[j].x * v[j].x + v[j].y * v[j].y) + (v[j].z * v[j].z + v[j].w * v[j].w); }
        s = wave_sum(s);
        unsigned long long* o8 = (unsigned long long*)(xb + (size_t)m * DM) + lane;
#pragma unroll
        for (int j = 0; j < 4; ++j) o8[64 * j] = (unsigned long long)pk2(v[j].x, v[j].y) | ((unsigned long long)pk2(v[j].z, v[j].w) << 32);
        if (lane == 0) rowss[m] = s;
    }
    const int gt = vwg * NTHR + tid, NGT = G * NTHR;
    for (int i = gt; i < 8 * MTOK; i += NGT) rowss[MTOK + i] = 0.f;
    float* rot = (float*)(a.ws + WS_ROT);
    for (int i = gt; i < 2048 * 8; i += NGT) {
        const int pos = i >> 3, j = i & 7;
        const float invf[8] = {1.0f, 0.19392274474868576f, 0.03760603093086393f, 0.007292664737217109f, 0.001414213562373095f, 0.0002742481756762073f, 5.318295896944988e-05f, 1.031338537721246e-05f};
        float fq = invf[0];
#pragma unroll
        for (int t = 1; t < 8; ++t) fq = (j == t) ? invf[t] : fq;
        const float ang = (float)pos * fq;
        const double rev = (double)ang * 0.15915494309189535; const float fr = (float)(rev - floor(rev));
        rot[pos * 16 + j] = __builtin_amdgcn_cosf(fr); rot[pos * 16 + 8 + j] = __builtin_amdgcn_sinf(fr);
    }
    float* wf = (float*)(a.ws + WS_WF);
    for (int i = gt; i < 2 * 16 * 1024; i += NGT) {
        const int lo = i >> 14, hd = (i >> 10) & 15, k = i & 1023;
        wf[i] = a.w_qkvf_odd[(size_t)lo * 1024 * 3088 + (size_t)k * 3088 + 3072 + hd] * a.norm_mix[(2 * lo + 1) * 1024 + k];
    }
}

__device__ __forceinline__ void fgate_phase(const Args& a, int lo, LAS unsigned char* lds, int vwg, int G) {
    const int tid = otid(), lane = tid & 63, wave = __builtin_amdgcn_readfirstlane(tid >> 6);
    const float* xres = (const float*)(a.ws + WS_XRES); const float* rowss = (const float*)(a.ws + WS_ROWSS) + (size_t)(2 * (2 * lo + 1)) * MTOK;
    const float* wf = (const float*)(a.ws + WS_WF) + (size_t)lo * 16 * 1024;
    float* locF = (float*)(a.ws + WS_LOCF); float* totF = (float*)(a.ws + WS_TOTF);
    LAS float* lf = (LAS float*)lds;
    const int r16 = lane & 15, g4 = lane >> 4, tile = wave & 3, kh = wave >> 2;
    for (int j = vwg; j < 256; j += G) {
        const f32x4* xr = (const f32x4*)(xres + (size_t)(64 * j + 16 * tile + r16) * DM + 512 * kh + 4 * g4);
        const f32x4* wr = (const f32x4*)(wf + (size_t)r16 * 1024 + 512 * kh + 4 * g4);
        f32x4 acc = {0.f, 0.f, 0.f, 0.f};
#pragma unroll 8
        for (int s = 0; s < 32; ++s) {
            const f32x4 xv = xr[4 * s], wv = wr[4 * s];
            acc = __builtin_amdgcn_mfma_f32_16x16x4f32(xv.x, wv.x, acc, 0, 0, 0);
            acc = __builtin_amdgcn_mfma_f32_16x16x4f32(xv.y, wv.y, acc, 0, 0, 0);
            acc = __builtin_amdgcn_mfma_f32_16x16x4f32(xv.z, wv.z, acc, 0, 0, 0);
            acc = __builtin_amdgcn_mfma_f32_16x16x4f32(xv.w, wv.w, acc, 0, 0, 0);
        }
#pragma unroll
        for (int jj = 0; jj < 4; ++jj) lf[(kh * 64 + 16 * tile + 4 * g4 + jj) * 16 + r16] = acc[jj];
        __syncthreads();
        float l2v[2];
#pragma unroll
        for (int q = 0; q < 2; ++q) {
            const int idx = tid + 512 * q, t = idx >> 4, hd = idx & 15;
            const float fl = (lf[idx] + lf[1024 + idx]) * pg8::rstd_of(rowss, 64 * j + t) + a.b_forget[lo * 16 + hd];
            const float z2 = fl * LOG2E; l2v[q] = -(fmaxf(-z2, 0.f) + __builtin_amdgcn_logf(1.0f + __builtin_amdgcn_exp2f(-fabsf(z2))));
        }
        __syncthreads();
        lf[tid] = l2v[0]; lf[tid + 512] = l2v[1];
        __syncthreads();
        if (tid < 16) {
            const int b = j >> 5, sl = j & 31; float run = 0.f; float* dst = locF + (size_t)(b * 16 + tid) * 2048 + sl * 64;
#pragma unroll 8
            for (int t = 0; t < 64; ++t) { run += lf[t * 16 + tid]; dst[t] = run; }
            totF[(b * 16 + tid) * 32 + sl] = run;
        }
        __syncthreads();
    }
}

__device__ __forceinline__ int phi32(int r) { return ((r >> 4) & 1) * 16 + ((r >> 2) & 1) * 8 + ((r >> 3) & 1) * 4 + (r & 3); }
__device__ __forceinline__ s16x4 vtr(const LAS unsigned char* p) { return __builtin_bit_cast(s16x4, __builtin_amdgcn_ds_read_tr16_b64_v4i16((LAS s16x4*)p)); }

template <int MODE, int DBG = 0>
__device__ __forceinline__ void attn_task(const bf16_t* qp, const bf16_t* kp, const bf16_t* vp, size_t rstride, int q0, int kb_lo, int kb_hi,
                                          LAS unsigned char* vlds, const LAS float* Fs, f32x16 (&O)[2], float& lse2) {
    const int lane = otid() & 63, n = lane & 31, hh = lane >> 5;
    bf16x8 qf[4];
    { const bf16_t* p = qp + (size_t)(q0 + n) * rstride + 8 * hh;
#pragma unroll
      for (int ks = 0; ks < 4; ++ks) qf[ks] = *(const bf16x8*)(p + 16 * ks); }
    const int qi = q0 + n;
    float Fq = 0.f; if (MODE == 0) Fq = Fs[qi];
#pragma unroll
    for (int r = 0; r < 16; ++r) { O[0][r] = 0.f; O[1][r] = 0.f; }
    float m = -1e30f, l = 0.f, R = 0.f;
    const bf16_t* kl = kp + (size_t)phi32(n) * rstride + 8 * hh;
    const bf16_t* vl = vp + (size_t)(lane >> 3) * rstride + 8 * (lane & 7);
    LAS unsigned char* vw = vlds + (lane >> 3) * VROW + (lane & 7) * 16;
    const LAS unsigned char* vr = vlds + (8 * hh + ((lane & 15) >> 2)) * VROW + (16 * ((lane >> 4) & 1) + 4 * (lane & 3)) * 2;
    bf16x8 kn[4]; u32x4 vn[4];
#define AT_ISSUE(kb) do { const bf16_t* kk_ = kl + (size_t)(kb) * 32 * rstride; const bf16_t* vv_ = vl + (size_t)(kb) * 32 * rstride; \
        _Pragma("unroll") for (int ks = 0; ks < 4; ++ks) kn[ks] = *(const bf16x8*)(kk_ + 16 * ks); \
        _Pragma("unroll") for (int ii = 0; ii < 4; ++ii) vn[ii] = *(const u32x4*)(vv_ + (size_t)(8 * ii) * rstride); } while (0)
    const int nblk = kb_hi - kb_lo + 1;
    int kb = (MODE == 2) ? kb_hi : kb_lo;
    AT_ISSUE(kb);
    for (int it = 0; it < nblk; ++it) {
        bf16x8 kc[4];
#pragma unroll
        for (int ks = 0; ks < 4; ++ks) kc[ks] = kn[ks];
        asm volatile("" ::: "memory");
#pragma unroll
        for (int ii = 0; ii < 4; ++ii) *(LAS u32x4*)(vw + ii * 8 * VROW) = vn[ii];
        asm volatile("" ::: "memory");
        const int kbn = (MODE == 2) ? kb - 1 : kb + 1;
        if (it + 1 < nblk && DBG != 1) AT_ISSUE(kbn);
        if (DBG != 2) {
        const int key0 = kb * 32 + 8 * hh;
        f32x16 s;
        if (MODE == 0) {
            const LAS f32x4* fk = (const LAS f32x4*)(Fs + key0);
            const f32x4 f0 = fk[0], f1 = fk[1], f2 = fk[4], f3 = fk[5];
#pragma unroll
            for (int e = 0; e < 4; ++e) { s[e] = Fq - f0[e]; s[4 + e] = Fq - f1[e]; s[8 + e] = Fq - f2[e]; s[12 + e] = Fq - f3[e]; }
        } else {
#pragma unroll
            for (int r = 0; r < 16; ++r) s[r] = 0.f;
        }
#pragma unroll
        for (int ks = 0; ks < 4; ++ks) s = __builtin_amdgcn_mfma_f32_32x32x16_bf16(kc[ks], qf[ks], s, 0, 0, 0);
        bf16x8 pb[2];
        if (MODE != 2) {
            const bool diag = (kb * 32 + 31 > q0);
            if (MODE == 1) {
                if (diag || kb * 32 < q0 - 97) {
#pragma unroll
                    for (int r = 0; r < 16; ++r) { const int ki = key0 + 16 * (r >> 3) + (r & 7); if (ki > qi || ki < qi - 128) s[r] = -1e30f; }
                }
            } else if (diag) {
#pragma unroll
                for (int r = 0; r < 16; ++r) { const int ki = key0 + 16 * (r >> 3) + (r & 7); if (ki > qi) s[r] = -1e30f; }
            }
            float bm = fmaxf(fmaxf(s[0], s[1]), fmaxf(s[2], s[3]));
#pragma unroll
            for (int r = 4; r < 16; r += 4) bm = fmaxf(bm, fmaxf(fmaxf(s[r], s[r + 1]), fmaxf(s[r + 2], s[r + 3])));
            bm = fmaxf(bm, __shfl_xor(bm, 32));
            const float mn = fmaxf(m, bm), alpha = __builtin_amdgcn_exp2f(m - mn); m = mn;
            float ps = 0.f;
#pragma unroll
            for (int r = 0; r < 16; ++r) { s[r] = __builtin_amdgcn_exp2f(s[r] - mn); ps += s[r]; }
            l = l * alpha + ps;
#pragma unroll
            for (int r = 0; r < 16; ++r) { O[0][r] *= alpha; O[1][r] *= alpha; }
        } else {
            const bool diag = (kb * 32 + 31 >= q0);
            float L[16];
#pragma unroll
            for (int r = 0; r < 16; ++r) {
                const float z = s[r], t = __builtin_amdgcn_exp2f(-fabsf(z)), sp = fmaxf(z, 0.f) + __builtin_amdgcn_logf(1.0f + t);
                L[r] = -sp; s[r] = z - sp;
            }
            if (diag) {
#pragma unroll
                for (int r = 0; r < 16; ++r) { const int ki = key0 + 16 * (r >> 3) + (r & 7); if (ki >= qi) { L[r] = 0.f; s[r] = -1e30f; } }
            }
            float sA = ((L[0] + L[1]) + (L[2] + L[3])) + ((L[4] + L[5]) + (L[6] + L[7]));
            float sB = ((L[8] + L[9]) + (L[10] + L[11])) + ((L[12] + L[13]) + (L[14] + L[15]));
            const float pA = __shfl_xor(sA, 32), pB = __shfl_xor(sB, 32);
            const float offA = sB + pB + (hh == 0 ? pA : 0.f), offB = (hh == 0 ? pB : 0.f);
            float run = R + offA;
#pragma unroll
            for (int e = 7; e >= 0; --e) { const float lr = L[e]; s[e] = __builtin_amdgcn_exp2f(s[e] + run); run += lr; }
            run = R + offB;
#pragma unroll
            for (int e = 15; e >= 8; --e) { const float lr = L[e]; s[e] = __builtin_amdgcn_exp2f(s[e] + run); run += lr; }
            R += (sA + sB) + (pA + pB);
        }
        { u32x4 w0, w1;
          w0.x = cvtpk(s[0], s[1]); w0.y = cvtpk(s[2], s[3]); w0.z = cvtpk(s[4], s[5]); w0.w = cvtpk(s[6], s[7]);
          w1.x = cvtpk(s[8], s[9]); w1.y = cvtpk(s[10], s[11]); w1.z = cvtpk(s[12], s[13]); w1.w = cvtpk(s[14], s[15]);
          pb[0] = __builtin_bit_cast(bf16x8, w0); pb[1] = __builtin_bit_cast(bf16x8, w1); }
        asm volatile("" ::: "memory");
#pragma unroll
        for (int db = 0; db < 2; ++db)
#pragma unroll
            for (int kk = 0; kk < 2; ++kk) {
                const s16x4 lo4 = vtr(vr + (16 * kk) * VROW + 64 * db), hi4 = vtr(vr + (16 * kk + 4) * VROW + 64 * db);
                const bf16x8 av = {lo4[0], lo4[1], lo4[2], lo4[3], hi4[0], hi4[1], hi4[2], hi4[3]};
                O[db] = __builtin_amdgcn_mfma_f32_32x32x16_bf16(av, pb[kk], O[db], 0, 0, 0);
            }
        asm volatile("s_waitcnt lgkmcnt(0)" ::: "memory");
        } else { asm volatile("s_waitcnt lgkmcnt(0)" ::: "memory"); O[0][0] += __builtin_bit_cast(float, (int)kc[0][0]) ; }
        if (MODE == 2) { if (__builtin_amdgcn_ballot_w64(R >= -160.f) == 0ull) break; }
        kb = kbn;
    }
#undef AT_ISSUE
    asm volatile("s_waitcnt vmcnt(0)" ::: "memory");
    if (MODE != 2) {
        l += __shfl_xor(l, 32);
        const float inv = 1.0f / l;
#pragma unroll
        for (int r = 0; r < 16; ++r) { O[0][r] *= inv; O[1][r] *= inv; }
        lse2 = m + __builtin_amdgcn_logf(l);
    }
}

__device__ __forceinline__ void store_o_bf16(const f32x16 (&O)[2], bf16_t* att_row  , int hh) {
#pragma unroll
    for (int db = 0; db < 2; ++db)
#pragma unroll
        for (int i = 0; i < 4; ++i) {
            u32x2 w; w.x = cvtpk(O[db][4 * i], O[db][4 * i + 1]); w.y = cvtpk(O[db][4 * i + 2], O[db][4 * i + 3]);
            *(u32x2*)(att_row + 32 * db + 8 * i + 4 * hh) = w;
        }
}

constexpr int LDS_FOXF = 90112;
__device__ __forceinline__ void fox_phase(const Args& a, unsigned char* lds_gen, LAS unsigned char* lds, int vwg, int G) {
    const int tid = otid();
    const bf16_t* qkv = (const bf16_t*)(a.ws + WS_QKV); bf16_t* att = (bf16_t*)(a.ws + WS_ATT);
    const float* locF = (const float*)(a.ws + WS_LOCF); const float* totF = (const float*)(a.ws + WS_TOTF);
    LAS float* Fs = (LAS float*)(lds + LDS_FOXF); LAS float* pre = Fs + 2048;
    for (int j = vwg; j < 256; j += G) {
        const int bh = j >> 1, b = bh >> 4, h = bh & 15;
        __syncthreads();
        if (tid < 64) {
            const float v = (tid < 32) ? totF[bh * 32 + tid] : 0.f; float s = v;
#pragma unroll
            for (int o = 1; o < 32; o <<= 1) { const float t2 = __shfl_up(s, o); if ((tid & 63) >= o) s += t2; }
            if (tid < 32) pre[tid] = s - v;
        }
        __syncthreads();
        for (int t = tid; t < 2048; t += NTHR) Fs[t] = locF[(size_t)bh * 2048 + t] + pre[t >> 6];
        __syncthreads();
        for (int ui = 0; ui < 4; ++ui) {
            const int u = (j & 1) ? ((ui < 2) ? 2 + ui : 7 - ui) : ((ui < 2) ? ui : 9 - ui);
            attn_body::attn_unit<8>(b, h, u, (const attn_body::bf16*)qkv, (const attn_body::bf16*)(qkv + 1024), (const attn_body::bf16*)(qkv + 2048), (attn_body::bf16*)att, (char*)lds_gen, Fs);
        }
    }
}

template <int PART>
__device__ __forceinline__ void even_attn_phase(const Args& a, LAS unsigned char* lds, int vwg, int G) {
    const int tid = otid(), lane = tid & 63, wave = __builtin_amdgcn_readfirstlane(tid >> 6), n = lane & 31, hh = lane >> 5;
    const bf16_t* qkv = (const bf16_t*)(a.ws + WS_QKV); bf16_t* att = (bf16_t*)(a.ws + WS_ATT);
    bf16_t* part = (bf16_t*)a.out;
    float* plse = (float*)(a.ws + WS_LSE);
    LAS unsigned char* vlds = lds + wave * VTILE;
    const LAS float* nof = (const LAS float*)lds;
    for (int j = vwg; j < 256; j += G) {
        const int bh = j >> 2, b = bh >> 3, hl = bh & 7, c = j & 3;
        if (PART & 1) { const bf16_t* base = qkv + (size_t)(b * SEQ) * QKV_LD + hl * 64;
          for (int ui = 0; ui < 2; ++ui) {
              const int u = ui ? 7 - c : c, qt = 8 * u + wave;
              f32x16 O[2]; float lse;
              attn_task<2>(base, base + 1024, base + 2048, (size_t)QKV_LD, 32 * qt, 0, qt, vlds, nof, O, lse);
              store_o_bf16(O, att + (size_t)(b * SEQ + 32 * qt + n) * DM + hl * 64, hh);
          } }
        if (!(PART & 2)) continue;
        const bf16_t* base = qkv + (size_t)(b * SEQ) * QKV_LD + (8 + hl) * 64;
        for (int p = 0; p < 2; ++p) {
            const int dil = p ? 4 : 1;
            for (int ti = 0; ti < 2; ++ti) {
                const int task = wave + 8 * ti;
                const int res = p ? (task & 3) : 0, tile = p ? (task >> 2) : task;
                const int q0 = (p ? 128 * c : 512 * c) + 32 * tile;
                const int kbh = q0 >> 5, kbl = kbh - 4 < 0 ? 0 : kbh - 4;
                const bf16_t* bp = base + (size_t)res * QKV_LD;
                f32x16 O[2]; float lse;
                attn_task<1>(bp, bp + 1024, bp + 2048, (size_t)dil * QKV_LD, q0, kbl, kbh, vlds, nof, O, lse);
                const int tok = res + dil * (q0 + n);
                if (PART & 4) continue;
                store_o_bf16(O, part + ((size_t)p * MTOK + (size_t)(b * SEQ + tok)) * 512 + hl * 64, hh);
                if (hh == 0) plse[((size_t)p * MTOK + (size_t)(b * SEQ + tok)) * 8 + hl] = lse;
            }
        }
        __syncthreads();
        for (int ti = 0; ti < 2; ++ti) {
            const int res = wave + 8 * ti, q0 = 32 * c;
            const bf16_t* bp = base + (size_t)res * QKV_LD;
            f32x16 O[2]; float lse3;
            attn_task<1>(bp, bp + 1024, bp + 2048, (size_t)16 * QKV_LD, q0, 0, c, vlds, nof, O, lse3);
            const int tok = res + 16 * (q0 + n); const size_t grow = (size_t)(b * SEQ + tok);
            if (PART & 4) { store_o_bf16(O, att + grow * DM + (8 + hl) * 64, hh); continue; }
            const float l1 = plse[grow * 8 + hl], l2 = plse[((size_t)MTOK + grow) * 8 + hl];
            const float mx = fmaxf(lse3, fmaxf(l1, l2));
            float w1 = __builtin_amdgcn_exp2f(l1 - mx), w2 = __builtin_amdgcn_exp2f(l2 - mx), w3 = __builtin_amdgcn_exp2f(lse3 - mx);
            const float inv = 1.0f / (w1 + w2 + w3); w1 *= inv; w2 *= inv; w3 *= inv;
            const bf16_t* p1 = part + grow * 512 + hl * 64; const bf16_t* p2 = part + ((size_t)MTOK + grow) * 512 + hl * 64;
#pragma unroll
            for (int db = 0; db < 2; ++db)
#pragma unroll
                for (int i = 0; i < 4; ++i) {
                    const u32x2 r1 = *(const u32x2*)(p1 + 32 * db + 8 * i + 4 * hh), r2 = *(const u32x2*)(p2 + 32 * db + 8 * i + 4 * hh);
                    const float a1[4] = {__uint_as_float(r1.x << 16), __uint_as_float(r1.x & 0xffff0000u), __uint_as_float(r1.y << 16), __uint_as_float(r1.y & 0xffff0000u)};
                    const float a2[4] = {__uint_as_float(r2.x << 16), __uint_as_float(r2.x & 0xffff0000u), __uint_as_float(r2.y << 16), __uint_as_float(r2.y & 0xffff0000u)};
#pragma unroll
                    for (int e = 0; e < 4; ++e) O[db][4 * i + e] = O[db][4 * i + e] * w3 + a1[e] * w1 + a2[e] * w2;
                }
            store_o_bf16(O, att + grow * DM + (8 + hl) * 64, hh);
        }
        __syncthreads();
    }
}

__device__ __forceinline__ void final_phase(const Args& a, int vwg, int G) {
    const int tid = otid(), lane = tid & 63, wave = tid >> 6;
    const float* xres = (const float*)(a.ws + WS_XRES); const float* rowss = (const float*)(a.ws + WS_ROWSS) + (size_t)8 * MTOK;
    const int gw = vwg * NWAVES + wave, NGW = G * NWAVES;
    f32x4 g[4];
#pragma unroll
    for (int j = 0; j < 4; ++j) g[j] = ((const f32x4*)a.norm_final)[lane + 64 * j];
    for (int m = gw; m < MTOK; m += NGW) {
        const float rs = pg8::rstd_of(rowss, m);
        const f32x4* xr = (const f32x4*)(xres + (size_t)m * DM) + lane; f32x4* o = (f32x4*)(a.out + (size_t)m * DM) + lane;
#pragma unroll
        for (int j = 0; j < 4; ++j) o[64 * j] = xr[64 * j] * rs * g[j];
    }
}

#define XB_TMO      128
#define XB_XCNT(j)  (256  + 64 * (j))
#define XB_XSUB(j)  (1280 + 64 * (j))
#define XB_XGEN(j)  (2304 + 64 * (j))
#define XB_TOP      3328
#define XB_TOPGEN   3392
#define XCD_BAR_WORDS 3456
#define XB_SPIN_CAP (1u << 18)

__device__ __forceinline__ unsigned xb_ld(unsigned* p)              { return __hip_atomic_load(p, __ATOMIC_RELAXED, __HIP_MEMORY_SCOPE_AGENT); }
__device__ __forceinline__ unsigned xb_add(unsigned* p, unsigned v) { return __hip_atomic_fetch_add(p, v, __ATOMIC_RELAXED, __HIP_MEMORY_SCOPE_AGENT); }
__device__ __forceinline__ unsigned xb_xcc_id() { return (unsigned)__builtin_amdgcn_s_getreg((3 << 11) | 20) & 0xFu; }
#define XB_SPIN(cond, bar) do { unsigned _sp = 0; while (cond) { __builtin_amdgcn_s_sleep(1); \
    if ((++_sp & 255u) == 0u) { if (xb_ld(&(bar)[XB_TMO])) break; if (_sp > XB_SPIN_CAP) { atomicAdd(&(bar)[XB_TMO], 1u); break; } } } } while (0)

struct XcdBarrier {
    unsigned* bar; unsigned x;
    volatile LAS unsigned* st;
};

__device__ __forceinline__ XcdBarrier xcd_barrier_post(unsigned* bar, volatile LAS unsigned* st) {
    XcdBarrier b; b.bar = bar; b.x = xb_xcc_id(); b.st = st;
    if (threadIdx.x == 0) (void)xb_add(&bar[XB_XCNT(b.x)], 1u);
    return b;
}
__device__ __forceinline__ void xcd_barrier_complete(unsigned* bar, unsigned x, unsigned& nloc, unsigned& nx) {
    const unsigned G = gridDim.x * gridDim.y * gridDim.z;
    unsigned sum, cnt, mine, sp = 0u;
    for (;;) {
        sum = 0u; cnt = 0u; mine = 0u;
#pragma unroll
        for (unsigned j = 0; j < 16; ++j) { const unsigned c = xb_ld(&bar[XB_XCNT(j)]); sum += c; cnt += (c > 0u) ? 1u : 0u; mine = (j == x) ? c : mine; }
        if (sum == G) break;
        __builtin_amdgcn_s_sleep(1);
        if ((++sp & 255u) == 0u) { if (xb_ld(&bar[XB_TMO])) break; if (sp > XB_SPIN_CAP) { atomicAdd(&bar[XB_TMO], 1u); break; } }
    }
    nloc = mine > 0u ? mine : 1u; nx = cnt > 0u ? cnt : 1u;
}

__device__ __forceinline__ void xcd_barrier(const XcdBarrier& b) {
    asm volatile("s_waitcnt vmcnt(0)" ::: "memory");
    __syncthreads();
    if (threadIdx.x == 0) {
        unsigned* bar = b.bar;
        __builtin_amdgcn_s_waitcnt(0);
        unsigned nloc = b.st[0], nx = b.st[1];
        if (nloc == 0u) { xcd_barrier_complete(bar, b.x, nloc, nx); b.st[0] = nloc; b.st[1] = nx; }
        const unsigned old = xb_add(&bar[XB_XSUB(b.x)], 1u);
        const unsigned gen = old / nloc;
        if (old + 1u == (gen + 1u) * nloc) {
            __builtin_amdgcn_fence(__ATOMIC_RELEASE, "agent");
            asm volatile("s_waitcnt vmcnt(0)" ::: "memory");
            const unsigned og = xb_add(&bar[XB_TOP], 1u);
            const unsigned tg = og / nx;
            if (og + 1u == (tg + 1u) * nx) xb_add(&bar[XB_TOPGEN], 1u);
            else XB_SPIN(xb_ld(&bar[XB_TOPGEN]) == tg, bar);
            __builtin_amdgcn_fence(__ATOMIC_ACQUIRE, "agent");
            xb_add(&bar[XB_XGEN(b.x)], 1u);
            asm volatile("s_waitcnt vmcnt(0)" ::: "memory");
        } else {
            XB_SPIN(xb_ld(&bar[XB_XGEN(b.x)]) == gen, bar);
            __builtin_amdgcn_fence(__ATOMIC_ACQUIRE, "agent");
            asm volatile("s_waitcnt vmcnt(0)" ::: "memory");
        }
    }
    __syncthreads();
}

#ifndef DBG_EVEN
#define DBG_EVEN 0
#endif
#ifndef DBG_FOX
#define DBG_FOX 0
#endif
#ifndef REP_QKV
#define REP_QKV 1
#endif
#ifndef REP_FG
#define REP_FG 1
#endif
#ifndef REP_FFI
#define REP_FFI 1
#endif
#ifndef REP_PRO
#define REP_PRO 1
#endif
#ifndef REP_SYNC
#define REP_SYNC 1
#endif
#ifndef REP_FOX
#define REP_FOX 1
#endif
#ifndef REP_EVEN
#define REP_EVEN 1
#endif
__global__ void __launch_bounds__(NTHR, 2) fwd_kernel(Args a) {
    extern __shared__ __attribute__((aligned(16))) unsigned char lds_raw[];
    LAS unsigned char* lds = (LAS unsigned char*)lds_raw;
    cg::grid_group grid = cg::this_grid();
    const int G = gridDim.x, vwg = blockIdx.x;
    unsigned char* ws = a.ws;
    bf16_t* xb = (bf16_t*)(ws + WS_XB); float* xres = (float*)(ws + WS_XRES); bf16_t* qkv = (bf16_t*)(ws + WS_QKV); bf16_t* hid = (bf16_t*)(ws + WS_QKV);
    bf16_t* att = (bf16_t*)(ws + WS_ATT); float* rowss = (float*)(ws + WS_ROWSS); const float* rot = (const float*)(ws + WS_ROT);
    unsigned* barw = (unsigned*)(ws + WS_BAR);
    volatile LAS unsigned* bst = (volatile LAS unsigned*)(lds + LDS_MISC);
    if (threadIdx.x == 0) { bst[0] = 0u; bst[1] = 0u; }
    if (blockIdx.x == 0) { for (int i = threadIdx.x; i < 8192; i += NTHR) barw[i] = 0u; }
    __syncthreads();
    XcdBarrier bar; bar.bar = barw; bar.x = 0; bar.st = bst;
    const bool multi = (a.ph_hi - a.ph_lo) > 1;
    if (multi) { grid.sync(); bar = xcd_barrier_post(barw, bst); }
    for (int ph = a.ph_lo; ph < a.ph_hi; ++ph) {
        if (ph == 0) { for (int rep = 0; rep < REP_PRO; ++rep) { prologue(a, lds, vwg, G); __syncthreads(); } }
        else if (ph == NPHASE - 1) { if (!(FUSE_FINAL && G == 256)) final_phase(a, vwg, G); }
        else {
            const int l = (ph - 1) / 5, sp = (ph - 1) % 5;
            const bf16_t* wl = (const bf16_t*)(ws + WS_W + (size_t)l * SZ_WLAYER);
            const bf16_t* w_qkv = wl; const bf16_t* w_o = (const bf16_t*)((const unsigned char*)wl + SZ_WQKV);
            const bf16_t* w_in = (const bf16_t*)((const unsigned char*)wl + SZ_WQKV + SZ_WO); const bf16_t* w_out = (const bf16_t*)((const unsigned char*)wl + SZ_WQKV + SZ_WO + SZ_WI);
            if (sp == 0) {
                pg8::Gemm g{xb, w_qkv, MTOK, 3072, 1024}; pg8::StaticOrder S; S.init(MTOK, 3072, G, vwg);
                pg8::EpiQKV E{qkv, rowss + (size_t)(2 * l) * MTOK, rot, (l & 1) ? 0 : 1};
                for (int rep = 0; rep < REP_QKV; ++rep) { pg8::gemm_phase<pg8::EpiQKV, pg8::StaticOrder, true, true>(lds, g, S, E); __syncthreads(); }
                if (l & 1) { for (int rep = 0; rep < REP_FG; ++rep) { __syncthreads(); fgate_phase(a, l >> 1, lds, vwg, G); } }
            } else if (sp == 1) {
                if (l & 1) { fox_phase(a, lds_raw, lds, vwg, G); } else { if (DBG_EVEN) { even_attn_phase<DBG_EVEN>(a, lds, vwg, G); __syncthreads(); } even_attn_phase<3>(a, lds, vwg, G); }
            } else if (sp == 2) {
                pg8::Gemm g{att, w_o, MTOK, 1024, 1024}; pg8::StaticOrder S; S.init(MTOK, 1024, G, vwg);
                pg8::EpiResid E{l == 0 ? a.x : xres, xres, xb, rowss + (size_t)(2 * l + 1) * MTOK};
                pg8::gemm_phase<pg8::EpiResid, pg8::StaticOrder, true, true>(lds, g, S, E);
            } else if (sp == 3) {
                pg8::Gemm g{xb, w_in, MTOK, 5632, 1024}; pg8::StaticOrder S; S.init(MTOK, 5632, G, vwg);
                pg8::EpiSwiGLU E{hid, rowss + (size_t)(2 * l + 1) * MTOK};
                for (int rep = 0; rep < REP_FFI; ++rep) { pg8::gemm_phase<pg8::EpiSwiGLU, pg8::StaticOrder, true, true>(lds, g, S, E); __syncthreads(); }
                if (CONV_SPLIT && G == 256 && vwg >= 128 && l + 1 < NLAYER) { __syncthreads(); convert_weights(a, l + 1, l + 2, lds, (vwg - 128) * NWAVES + __builtin_amdgcn_readfirstlane((int)(threadIdx.x >> 6)), 128 * NWAVES); }
            } else {
                pg8::Gemm g{hid, w_out, MTOK, 1024, 2816}; pg8::StaticOrder S; S.init(MTOK, 1024, G, vwg);
                if (FUSE_FINAL && l == NLAYER - 1 && G == 256) {
                    pg8::EpiFinal E{xres, a.out, rowss + (size_t)8 * MTOK, a.norm_final, (unsigned*)(ws + WS_PCNT)};
                    pg8::gemm_phase<pg8::EpiFinal, pg8::StaticOrder, true, true>(lds, g, S, E);
                } else {
                    pg8::EpiResid E{xres, xres, xb, rowss + (size_t)(2 * l + 2) * MTOK};
                    pg8::gemm_phase<pg8::EpiResid, pg8::StaticOrder, true, true>(lds, g, S, E);
                }
            }
        }
        if (ph + 1 < a.ph_hi && !(FUSE_FINAL && G == 256 && ph == NPHASE - 2)) {
            for (int rep = 0; rep < REP_SYNC; ++rep) xcd_barrier(bar);
        }
    }
}

#ifndef N_LAUNCH_MODE
#define N_LAUNCH_MODE 1
#endif

extern "C" void kernel_launch(void* const* d_in, const int* in_sizes, int n_in, void* d_out, int out_size, void* d_ws, size_t ws_size, hipStream_t stream) {
    static int grid = 0;
    if (grid == 0) {
        if (n_in != 11 || out_size != MTOK * DM || ws_size < WS_END) { fprintf(stderr, "kernel_launch: unexpected sizes n_in %d out %d ws %zu (need %zu)\n", n_in, out_size, ws_size, (size_t)WS_END); grid = -1; return; }
        int dev = 0, cus = 0, per_cu = 0;
        hipGetDevice(&dev); hipDeviceGetAttribute(&cus, hipDeviceAttributeMultiprocessorCount, dev);
        if (hipFuncSetAttribute((const void*)fwd_kernel, hipFuncAttributeMaxDynamicSharedMemorySize, LDS_BYTES) != hipSuccess) { fprintf(stderr, "kernel_launch: hipFuncSetAttribute failed\n"); grid = -1; return; }
        if (hipOccupancyMaxActiveBlocksPerMultiprocessor(&per_cu, (const void*)fwd_kernel, NTHR, LDS_BYTES) != hipSuccess || per_cu < 1) { fprintf(stderr, "kernel_launch: occupancy query says %d\n", per_cu); per_cu = 1; }
        (void)hipGetLastError();
        grid = cus * 1;
        fprintf(stderr, "kernel_launch: grid %d (cus %d, per_cu %d)\n", grid, cus, per_cu);
    }
    if (grid < 0) return;
    Args a{};
    a.x = (const float*)d_in[0]; a.norm_mix = (const float*)d_in[1]; a.w_qkv_even = (const float*)d_in[2]; a.w_o_even = (const float*)d_in[3];
    a.w_qkvf_odd = (const float*)d_in[4]; a.b_forget = (const float*)d_in[5]; a.w_o_odd = (const float*)d_in[6]; a.norm_ffn = (const float*)d_in[7];
    a.w_ffn_in = (const float*)d_in[8]; a.w_ffn_out = (const float*)d_in[9]; a.norm_final = (const float*)d_in[10];
    a.out = (float*)d_out; a.ws = (unsigned char*)d_ws;
#if N_LAUNCH_MODE == 1
    a.ph_lo = 0; a.ph_hi = NPHASE;
    void* args[] = {&a};
    hipError_t e = hipLaunchCooperativeKernel((const void*)fwd_kernel, dim3(grid), dim3(NTHR), args, LDS_BYTES, stream);
    if (e != hipSuccess) fprintf(stderr, "cooperative launch failed: %s (grid %d)\n", hipGetErrorString(e), grid);
#else
    for (int ph = 0; ph < NPHASE; ++ph) {
        a.ph_lo = ph; a.ph_hi = ph + 1;
        hipLaunchKernelGGL(fwd_kernel, dim3(grid), dim3(NTHR), LDS_BYTES, stream, a);
    }
#endif
}
```

```cpp
#include <hip/hip_runtime.h>
#include <hip/hip_cooperative_groups.h>
#include <cstdio>
#include <cstdint>
namespace cg = cooperative_groups;
namespace pg8 {
#define PG8_LAS __attribute__((address_space(3)))
typedef unsigned short bf16_t;
typedef short bf16x8 __attribute__((ext_vector_type(8)));
typedef float f32x4 __attribute__((ext_vector_type(4)));
typedef unsigned u32x4 __attribute__((ext_vector_type(4)));
constexpr int BM = 256, BK = 64, HALF = 128, HTB = HALF * BK * 2  , STAGE_BYTES = 8 * HTB, NXCD = 8, WGM = 8;

__host__ __device__ __forceinline__ int lds_byte(int r, int c) { const int st = (r >> 4) * 2 + (c >> 5), rr = r & 15, cc = c & 31, ob = rr * 64 + cc * 2; return st * 1024 + (ob ^ (((ob >> 9) & 1) << 5)); }
__host__ __device__ __forceinline__ void stage_rc(int b, int& R, int& C) { const int st = b / 1024, sb = b % 1024, swz = sb ^ (((sb >> 9) & 1) << 5); R = (st >> 1) * 16 + swz / 64; C = (st & 1) * 32 + (swz % 64) / 2; }
__host__ __device__ __forceinline__ int perm32(int rho) { const int n = rho >> 4, i = rho & 15; return 8 * (i >> 2) + 4 * n + (i & 3); }

struct Unit { int pm, pn; };
struct Gemm { const bf16_t* A; const bf16_t* Bt; int M, N, K; };

struct StaticOrder {
    int nM, nN, nwg, G, c;
    __host__ __device__ void init(int M, int N, int G_, int c_) { nM = M / BM; nN = N / BM; nwg = nM * nN; G = G_; c = c_; }
    __host__ __device__ bool next(int i, Unit& u) const {
        const long L = (long)i * G + c; if (L >= nwg) return false;
        int wgid = (int)L; { const int q = nwg / NXCD, r = nwg % NXCD, xcd = wgid % NXCD, off = wgid / NXCD; wgid = (xcd < r ? xcd * (q + 1) : r * (q + 1) + (xcd - r) * q) + off; }
        const int nig = WGM * nN, gid = wgid / nig, fm = gid * WGM, gsz = (nM - fm) < WGM ? (nM - fm) : WGM;
        u.pm = fm + ((wgid % nig) % gsz); u.pn = (wgid % nig) / gsz; return true;
    }
    __device__ __forceinline__ void a_ready(const Unit&) const {}
    __device__ __forceinline__ void done(const Unit&) const {}
};

__device__ __forceinline__ unsigned cvt_pk_bf16(float lo, float hi) { unsigned r; asm volatile("v_cvt_pk_bf16_f32 %0, %1, %2" : "=v"(r) : "v"(lo), "v"(hi)); return r; }
constexpr float RMS_EPS_F = 1e-5f;
constexpr int RS_M = 16384;
__device__ __forceinline__ float rstd_of(const float* rowss, int row) {
    float s = 0.f;
#pragma unroll
    for (int k = 0; k < 16; ++k) s += rowss[(size_t)k * RS_M + row];
    return 1.0f / sqrtf(s * (1.0f / 1024.0f) + RMS_EPS_F);
}

__device__ __forceinline__ void rstd_table(PG8_LAS float* rtab, const float* rowss, int pm) {
    const int t = threadIdx.x;
    if (t < 256) rtab[t] = rstd_of(rowss, pm * BM + t);
    asm volatile("s_waitcnt lgkmcnt(0)" ::: "memory"); __builtin_amdgcn_s_barrier(); asm volatile("" ::: "memory");
}

struct EpiQKV {
    static constexpr bool PERM = true, AFTER_DRAIN = false;
    bf16_t* O; const float* rowss; const float* rot; int rope; PG8_LAS float* rtab;
    __device__ __forceinline__ void operator()(const f32x4 (&acc)[2][2][4][2], const Unit& u, int wr, int wc, int fr, int fq) const {
        const int row0 = u.pm * BM + wr * 64 + fr;
        const int col0 = u.pn * BM + wc * 32 + 8 * fq;
        const bool rt = rope && ((u.pn & 2) != 0) && (u.pn < 8) && ((wc & 1) == 0);
        rstd_table(rtab, rowss, u.pm);
#pragma unroll
        for (int ai = 0; ai < 2; ++ai)
#pragma unroll
            for (int m = 0; m < 4; ++m) {
                const int row = row0 + ai * HALF + m * 16;
                const float rs = rtab[wr * 64 + fr + ai * HALF + m * 16];
                bf16_t* rowp = O + (size_t)row * 3072 + col0;
                f32x4 c0 = {1.f, 1.f, 1.f, 1.f}, c1 = c0, s0 = {0.f, 0.f, 0.f, 0.f}, s1 = s0;
                if (rt) { const f32x4* rp = (const f32x4*)(rot + (size_t)(row & 2047) * 16); c0 = rp[0]; c1 = rp[1]; s0 = rp[2]; s1 = rp[3]; }
#pragma unroll
                for (int bj = 0; bj < 2; ++bj) {
                    f32x4 v0 = acc[ai][bj][m][0] * rs, v1 = acc[ai][bj][m][1] * rs;
                    if (rt) {
                        f32x4 p0, p1;
#pragma unroll
                        for (int e = 0; e < 4; ++e) { p0[e] = __shfl_xor(v0[e], 16); p1[e] = __shfl_xor(v1[e], 16); }
                        if (fq == 0) { v0 = v0 * c0 - p0 * s0; v1 = v1 * c1 - p1 * s1; }
                        else if (fq == 1) { v0 = v0 * c0 + p0 * s0; v1 = v1 * c1 + p1 * s1; }
                    }
                    u32x4 w; w.x = cvt_pk_bf16(v0[0], v0[1]); w.y = cvt_pk_bf16(v0[2], v0[3]); w.z = cvt_pk_bf16(v1[0], v1[1]); w.w = cvt_pk_bf16(v1[2], v1[3]);
                    *(u32x4*)(rowp + bj * HALF) = w;
                }
            }
    }
};

__device__ __forceinline__ float bf_lo(unsigned u) { return __builtin_bit_cast(float, u << 16); }
__device__ __forceinline__ float bf_hi(unsigned u) { return __builtin_bit_cast(float, u & 0xffff0000u); }
template <bool XIN_F32> struct EpiResid {
    static constexpr bool PERM = true, AFTER_DRAIN = false;
    const float* xin32; bf16_t* xb; float* rowss_next;
    __device__ __forceinline__ void operator()(const f32x4 (&acc)[2][2][4][2], const Unit& u, int wr, int wc, int fr, int fq) const {
        const int row0 = u.pm * BM + wr * 64 + fr;
        const int col0 = u.pn * BM + wc * 32 + 8 * fq;
#pragma unroll
        for (int ai = 0; ai < 2; ++ai)
#pragma unroll
            for (int m = 0; m < 4; ++m) {
                const int row = row0 + ai * HALF + m * 16;
                float ss = 0.f;
#pragma unroll
                for (int bj = 0; bj < 2; ++bj) {
                    const size_t off = (size_t)row * 1024 + col0 + bj * HALF;
                    f32x4 a0, a1;
                    if (XIN_F32) { const f32x4* xi = (const f32x4*)(xin32 + off); a0 = xi[0]; a1 = xi[1]; }
                    else { const u32x4 xw = *(const u32x4*)(xb + off);
                           a0 = (f32x4){bf_lo(xw.x), bf_hi(xw.x), bf_lo(xw.y), bf_hi(xw.y)}; a1 = (f32x4){bf_lo(xw.z), bf_hi(xw.z), bf_lo(xw.w), bf_hi(xw.w)}; }
                    a0 = a0 + acc[ai][bj][m][0]; a1 = a1 + acc[ai][bj][m][1];
                    u32x4 w; w.x = cvt_pk_bf16(a0[0], a0[1]); w.y = cvt_pk_bf16(a0[2], a0[3]); w.z = cvt_pk_bf16(a1[0], a1[1]); w.w = cvt_pk_bf16(a1[2], a1[3]);
                    *(u32x4*)(xb + off) = w;
                    const float r0 = bf_lo(w.x), r1 = bf_hi(w.x), r2 = bf_lo(w.y), r3 = bf_hi(w.y), r4 = bf_lo(w.z), r5 = bf_hi(w.z), r6 = bf_lo(w.w), r7 = bf_hi(w.w);
                    ss += (r0 * r0 + r1 * r1) + (r2 * r2 + r3 * r3) + (r4 * r4 + r5 * r5) + (r6 * r6 + r7 * r7);
                }
                ss += __shfl_xor(ss, 16); ss += __shfl_xor(ss, 32);
                if (fq == 0) rowss_next[(size_t)(u.pn * 4 + wc) * RS_M + row] = ss;
            }
    }
};

struct EpiSwiGLU {
    static constexpr bool PERM = true, AFTER_DRAIN = false;
    bf16_t* H; const float* rowss; PG8_LAS float* rtab;
    __device__ __forceinline__ void operator()(const f32x4 (&acc)[2][2][4][2], const Unit& u, int wr, int wc, int fr, int fq) const {
        const int row0 = u.pm * BM + wr * 64 + fr;
        const int col0 = u.pn * HALF + wc * 32 + 8 * fq;
        rstd_table(rtab, rowss, u.pm);
#pragma unroll
        for (int ai = 0; ai < 2; ++ai)
#pragma unroll
            for (int m = 0; m < 4; ++m) {
                const int row = row0 + ai * HALF + m * 16;
                const float rs = rtab[wr * 64 + fr + ai * HALF + m * 16];
                float h[8];
#pragma unroll
                for (int n = 0; n < 2; ++n)
#pragma unroll
                    for (int e = 0; e < 4; ++e) {
                        const float g = acc[ai][0][m][n][e] * rs, up = acc[ai][1][m][n][e] * rs;
                        const float sg = g * __builtin_amdgcn_rcpf(1.0f + __builtin_amdgcn_exp2f(-1.4426950408889634f * g));
                        h[n * 4 + e] = sg * up;
                    }
                u32x4 w; w.x = cvt_pk_bf16(h[0], h[1]); w.y = cvt_pk_bf16(h[2], h[3]); w.z = cvt_pk_bf16(h[4], h[5]); w.w = cvt_pk_bf16(h[6], h[7]);
                *(u32x4*)(H + (size_t)row * 2816 + col0) = w;
            }
    }
};

struct EpiFinal {
    static constexpr bool PERM = true, AFTER_DRAIN = false;
    const bf16_t* xin; float* out; float* rowss_next; const float* gfin; unsigned* cnt;
    __device__ __forceinline__ void operator()(f32x4 (&acc)[2][2][4][2], const Unit& u, int wr, int wc, int fr, int fq) const {
        const int row0 = u.pm * BM + wr * 64 + fr;
        const int col0 = u.pn * BM + wc * 32 + 8 * fq;
#pragma unroll
        for (int ai = 0; ai < 2; ++ai)
#pragma unroll
            for (int m = 0; m < 4; ++m) {
                const int row = row0 + ai * HALF + m * 16;
                float ss = 0.f;
#pragma unroll
                for (int bj = 0; bj < 2; ++bj) {
                    const u32x4 xw = *(const u32x4*)(xin + (size_t)row * 1024 + col0 + bj * HALF);
                    const f32x4 a0 = (f32x4){bf_lo(xw.x), bf_hi(xw.x), bf_lo(xw.y), bf_hi(xw.y)} + acc[ai][bj][m][0], a1 = (f32x4){bf_lo(xw.z), bf_hi(xw.z), bf_lo(xw.w), bf_hi(xw.w)} + acc[ai][bj][m][1];
                    acc[ai][bj][m][0] = a0; acc[ai][bj][m][1] = a1;
                    ss += (a0[0] * a0[0] + a0[1] * a0[1]) + (a0[2] * a0[2] + a0[3] * a0[3]) + (a1[0] * a1[0] + a1[1] * a1[1]) + (a1[2] * a1[2] + a1[3] * a1[3]);
                }
                ss += __shfl_xor(ss, 16); ss += __shfl_xor(ss, 32);
                if (fq == 0) __hip_atomic_store(rowss_next + (size_t)(u.pn * 4 + wc) * RS_M + row, ss, __ATOMIC_RELAXED, __HIP_MEMORY_SCOPE_AGENT);
            }
        asm volatile("s_waitcnt vmcnt(0)" ::: "memory");
        unsigned* c = cnt + 64 * u.pm;
        if ((threadIdx.x & 63) == 0) __hip_atomic_fetch_add(c, 1u, __ATOMIC_RELAXED, __HIP_MEMORY_SCOPE_AGENT);
        { unsigned sp = 0;
          while ((unsigned)__builtin_amdgcn_readfirstlane((int)__hip_atomic_load(c, __ATOMIC_RELAXED, __HIP_MEMORY_SCOPE_AGENT)) < 32u) { __builtin_amdgcn_s_sleep(1); if (++sp > (1u << 22)) break; } }
        __builtin_amdgcn_fence(__ATOMIC_ACQUIRE, "agent");
        f32x4 g0[2], g1[2];
#pragma unroll
        for (int bj = 0; bj < 2; ++bj) { const f32x4* gp = (const f32x4*)(gfin + col0 + bj * HALF); g0[bj] = gp[0]; g1[bj] = gp[1]; }
#pragma unroll
        for (int ai = 0; ai < 2; ++ai)
#pragma unroll
            for (int m = 0; m < 4; ++m) {
                const int row = row0 + ai * HALF + m * 16;
                float tot = 0.f;
#pragma unroll
                for (int k = 0; k < 16; ++k) tot += __hip_atomic_load(rowss_next + (size_t)k * RS_M + row, __ATOMIC_RELAXED, __HIP_MEMORY_SCOPE_AGENT);
                const float rs = 1.0f / sqrtf(tot * (1.0f / 1024.0f) + RMS_EPS_F);
#pragma unroll
                for (int bj = 0; bj < 2; ++bj) {
                    f32x4* o = (f32x4*)(out + (size_t)row * 1024 + col0 + bj * HALF);
                    o[0] = acc[ai][bj][m][0] * rs * g0[bj]; o[1] = acc[ai][bj][m][1] * rs * g1[bj];
                }
            }
    }
};

struct EpiNull {
    static constexpr bool PERM = true, AFTER_DRAIN = false;
    float* sink;
    __device__ __forceinline__ void operator()(const f32x4 (&acc)[2][2][4][2], const Unit& u, int wr, int wc, int fr, int fq) const {
        if (u.pm < 0) {
#pragma unroll
            for (int ai = 0; ai < 2; ++ai)
#pragma unroll
                for (int m = 0; m < 4; ++m)
#pragma unroll
                    for (int bj = 0; bj < 2; ++bj) { f32x4* o = (f32x4*)(sink + (size_t)(ai * 8 + m * 2 + bj) * 8 + fr); o[0] = acc[ai][bj][m][0]; o[1] = acc[ai][bj][m][1]; }
        }
    }
};

template <class Epi, class Sched, bool ALIGN_EPI = false, bool SP2 = false>
__device__ __forceinline__ void gemm_phase(PG8_LAS unsigned char* lds, const Gemm g, const Sched& S, const Epi& E) {
    int tid_ = threadIdx.x; asm volatile("" : "+v"(tid_));
    const int tid = tid_, wid = __builtin_amdgcn_readfirstlane(tid >> 6), lane = tid & 63, wr = wid >> 2, wc = wid & 3, fr = lane & 15, fq = lane >> 4;
    const int K = g.K, nt = K / BK;
    unsigned voffA[2], voffB[2];
#pragma unroll
    for (int i = 0; i < 2; ++i) { int R, C; stage_rc(tid * 16 + i * 8192, R, C); const int Rb = Epi::PERM ? ((R & ~31) + perm32(R & 31)) : R;
        voffA[i] = (unsigned)(R * K + C) * 2u; voffB[i] = (unsigned)(Rb * K + C) * 2u; }
    const size_t kstep = (size_t)(BK * 2);
    const size_t hstep = (size_t)HALF * K * 2;
    const size_t tstep = 2 * hstep;
    const unsigned ldsw = (unsigned)wid * 1024u;
    const int aoff = lds_byte(wr * 64 + fr, fq * 8), boff = lds_byte(wc * 32 + fr, fq * 8);
#define PG8_SA(b, h) (((b) * 2 + (h)) * HTB)
#define PG8_SB(b, h) ((4 + (b) * 2 + (h)) * HTB)
#define PG8_STAGE(bufoff, gbase, voff) do { _Pragma("unroll") for (int _i = 0; _i < 2; ++_i) \
        __builtin_amdgcn_global_load_lds((const unsigned*)((const char*)(gbase) + (voff)[_i]), (PG8_LAS unsigned*)(lds + (bufoff) + ldsw + _i * 8192), 16, 0, 0); } while (0)
#define PG8_LDA(dst, b, h) do { _Pragma("unroll") for (int m = 0; m < 4; ++m) _Pragma("unroll") for (int k = 0; k < 2; ++k) dst[m][k] = *(const PG8_LAS bf16x8*)(lds + PG8_SA(b, h) + aoff + m * 2048 + k * 1024); } while (0)
#define PG8_LDB(dst, b, h) do { _Pragma("unroll") for (int n = 0; n < 2; ++n) _Pragma("unroll") for (int k = 0; k < 2; ++k) dst[n][k] = *(const PG8_LAS bf16x8*)(lds + PG8_SB(b, h) + boff + n * 2048 + k * 1024); } while (0)
#define PG8_MMA(ai, bj, At, Bt) do { __builtin_amdgcn_s_setprio(1); _Pragma("unroll") for (int m = 0; m < 4; ++m) _Pragma("unroll") for (int n = 0; n < 2; ++n) _Pragma("unroll") for (int k = 0; k < 2; ++k) \
        acc[ai][bj][m][n] = __builtin_amdgcn_mfma_f32_16x16x32_bf16(Bt[n][k], At[m][k], acc[ai][bj][m][n], 0, 0, 0); __builtin_amdgcn_s_setprio(0); } while (0)
#define PG8_WAIT_V(n) asm volatile("s_waitcnt vmcnt(" #n ")" ::: "memory")
#define PG8_WAIT_L(n) asm volatile("s_waitcnt lgkmcnt(" #n ")" ::: "memory")
#define PG8_BAR __builtin_amdgcn_s_barrier()
#define PG8_SCHED __builtin_amdgcn_sched_barrier(0)
    Unit cur, nxt; int ui = 0;
    if (!S.next(0, cur)) return;
    f32x4 acc[2][2][4][2];
#pragma unroll
    for (int a = 0; a < 2; ++a)
#pragma unroll
        for (int b = 0; b < 2; ++b)
#pragma unroll
            for (int m = 0; m < 4; ++m)
#pragma unroll
                for (int n = 0; n < 2; ++n) acc[a][b][m][n] = (f32x4){0.f, 0.f, 0.f, 0.f};
    bf16x8 At[4][2], B0[2][2], B1[2][2];
    const char* cA = (const char*)g.A + (size_t)cur.pm * tstep; const char* cB = (const char*)g.Bt + (size_t)cur.pn * tstep;
    S.a_ready(cur);
    if constexpr (SP2) {
        PG8_STAGE(PG8_SB(0, 0), cB, voffB); PG8_STAGE(PG8_SB(0, 1), cB + hstep, voffB); PG8_STAGE(PG8_SA(0, 0), cA, voffA); PG8_STAGE(PG8_SA(0, 1), cA + hstep, voffA);
        if (wr == 1) PG8_BAR;
        PG8_WAIT_V(2); PG8_BAR;
        PG8_STAGE(PG8_SB(1, 0), cB + kstep, voffB); PG8_STAGE(PG8_SA(1, 0), cA + kstep, voffA); PG8_STAGE(PG8_SB(1, 1), cB + hstep + kstep, voffB);
        PG8_WAIT_V(6); PG8_BAR;
    } else {
        PG8_STAGE(PG8_SB(0, 0), cB, voffB); PG8_STAGE(PG8_SA(0, 0), cA, voffA); PG8_STAGE(PG8_SB(0, 1), cB + hstep, voffB); PG8_STAGE(PG8_SA(0, 1), cA + hstep, voffA);
        if (wr == 1) PG8_BAR;
        PG8_WAIT_V(4); PG8_BAR;
        PG8_STAGE(PG8_SB(1, 0), cB + kstep, voffB); PG8_STAGE(PG8_SA(1, 0), cA + kstep, voffA); PG8_STAGE(PG8_SB(1, 1), cB + hstep + kstep, voffB);
        PG8_WAIT_V(6); PG8_BAR;
    }
    for (;;) {
        const bool has_next = S.next(ui + 1, nxt);
        const char* nA = has_next ? (const char*)g.A + (size_t)nxt.pm * tstep : cA; const char* nB = has_next ? (const char*)g.Bt + (size_t)nxt.pn * tstep : cB;
        for (int t = 0; t < nt; t += 2) {
            const bool last = (t == nt - 2);
            const char* a1 = cA + (size_t)(t + 1) * kstep;
            const char* a2 = last ? nA : cA + (size_t)(t + 2) * kstep; const char* b2 = last ? nB : cB + (size_t)(t + 2) * kstep;
            const char* a3 = a2 + kstep; const char* b3 = b2 + kstep;
            if (last && has_next) S.a_ready(nxt);
            if constexpr (SP2) {
            PG8_LDB(B0, 0, 0); PG8_LDB(B1, 0, 1); PG8_SCHED; PG8_LDA(At, 0, 0); PG8_STAGE(PG8_SA(1, 1), a1 + hstep, voffA);
            PG8_WAIT_V(8); PG8_WAIT_L(0); PG8_BAR; PG8_MMA(0, 0, At, B0); PG8_MMA(0, 1, At, B1); PG8_BAR; PG8_SCHED;
            PG8_LDA(At, 0, 1); PG8_STAGE(PG8_SB(0, 0), b2, voffB); PG8_STAGE(PG8_SB(0, 1), b2 + hstep, voffB); PG8_STAGE(PG8_SA(0, 0), a2, voffA);
            PG8_WAIT_V(8); PG8_WAIT_L(0); PG8_BAR; PG8_MMA(1, 0, At, B0); PG8_MMA(1, 1, At, B1); PG8_BAR; PG8_SCHED;
            PG8_LDB(B0, 1, 0); PG8_LDB(B1, 1, 1); PG8_SCHED; PG8_LDA(At, 1, 0); PG8_STAGE(PG8_SA(0, 1), a2 + hstep, voffA);
            PG8_WAIT_V(8); PG8_WAIT_L(0); PG8_BAR; PG8_MMA(0, 0, At, B0); PG8_MMA(0, 1, At, B1); PG8_BAR; PG8_SCHED;
            PG8_LDA(At, 1, 1); PG8_STAGE(PG8_SB(1, 0), b3, voffB); PG8_STAGE(PG8_SB(1, 1), b3 + hstep, voffB); PG8_STAGE(PG8_SA(1, 0), a3, voffA);
            PG8_WAIT_V(8); PG8_WAIT_L(0); PG8_BAR; PG8_MMA(1, 0, At, B0); PG8_MMA(1, 1, At, B1); PG8_BAR; PG8_SCHED;
            } else {
            PG8_LDB(B0, 0, 0); PG8_SCHED; PG8_LDA(At, 0, 0); PG8_STAGE(PG8_SA(1, 1), a1 + hstep, voffA);
            PG8_WAIT_L(8); PG8_BAR; PG8_WAIT_L(0); PG8_MMA(0, 0, At, B0); PG8_BAR; PG8_SCHED;
            PG8_LDB(B1, 0, 1); PG8_STAGE(PG8_SB(0, 0), b2, voffB);
            PG8_BAR; PG8_WAIT_L(0); PG8_MMA(0, 1, At, B1); PG8_BAR;
            PG8_LDA(At, 0, 1); PG8_STAGE(PG8_SA(0, 0), a2, voffA);
            PG8_BAR; PG8_WAIT_L(0); PG8_MMA(1, 0, At, B0); PG8_BAR; PG8_SCHED;
            PG8_STAGE(PG8_SB(0, 1), b2 + hstep, voffB);
            PG8_WAIT_V(6); PG8_BAR; PG8_MMA(1, 1, At, B1); PG8_BAR;
            PG8_LDB(B0, 1, 0); PG8_SCHED; PG8_LDA(At, 1, 0); PG8_STAGE(PG8_SA(0, 1), a2 + hstep, voffA);
            PG8_WAIT_L(8); PG8_BAR; PG8_WAIT_L(0); PG8_MMA(0, 0, At, B0); PG8_BAR; PG8_SCHED;
            PG8_LDB(B1, 1, 1); PG8_STAGE(PG8_SB(1, 0), b3, voffB);
            PG8_BAR; PG8_WAIT_L(0); PG8_MMA(0, 1, At, B1); PG8_BAR;
            PG8_LDA(At, 1, 1); PG8_STAGE(PG8_SA(1, 0), a3, voffA);
            PG8_BAR; PG8_WAIT_L(0); PG8_MMA(1, 0, At, B0); PG8_BAR; PG8_SCHED;
            PG8_STAGE(PG8_SB(1, 1), b3 + hstep, voffB);
            PG8_WAIT_V(6); PG8_BAR; PG8_MMA(1, 1, At, B1); PG8_BAR;
            }
        }
        if constexpr (ALIGN_EPI) { if (wr == 0) PG8_BAR; }
        if constexpr (!Epi::AFTER_DRAIN) { E(acc, cur, wr, wc, fr, fq); S.done(cur); }
        if (!has_next) break;
#pragma unroll
        for (int a = 0; a < 2; ++a)
#pragma unroll
            for (int b = 0; b < 2; ++b)
#pragma unroll
                for (int m = 0; m < 4; ++m)
#pragma unroll
                    for (int n = 0; n < 2; ++n) acc[a][b][m][n] = (f32x4){0.f, 0.f, 0.f, 0.f};
        cur = nxt; cA = nA; cB = nB; ++ui;
        if constexpr (ALIGN_EPI) { if (wr == 1) PG8_BAR; }
    }
    PG8_WAIT_V(0);
    if constexpr (!ALIGN_EPI) { if (wr == 0) PG8_BAR; }
    PG8_BAR;
    if constexpr (Epi::AFTER_DRAIN) { E.fused(acc, cur, wr, wc, fr, fq, lds, wid, lane); S.done(cur); }
#undef PG8_SA
#undef PG8_SB
#undef PG8_STAGE
#undef PG8_LDA
#undef PG8_LDB
#undef PG8_MMA
#undef PG8_WAIT_V
#undef PG8_WAIT_L
#undef PG8_BAR
#undef PG8_SCHED
}
}
#include <hip/hip_bf16.h>
#include <cmath>
namespace attn_body {
using bf16=__hip_bfloat16;
using bf16x8=__attribute__((ext_vector_type(8)))short;
using s16x4=__attribute__((ext_vector_type(4)))short;
using f32x16=__attribute__((ext_vector_type(16)))float;
using u32x4=__attribute__((ext_vector_type(4)))unsigned;
using f32x4_t=__attribute__((ext_vector_type(4)))float;
constexpr int BATCH=8,NHEAD=16,SEQ=2048,D=64,DM=3072,DMO=1024;
constexpr int NW=8,QBLK=32,QB=QBLK*NW,KVBLK=64,NQB=SEQ/QB;
constexpr int ATTN_PITCH=DM, ATTN_UNIT_ROWS=QB;
__device__ __forceinline__ int crow(int r,int hi){return (r&3)+8*(r>>2)+4*hi;}
#define SBAR() __builtin_amdgcn_sched_barrier(0)
__device__ __forceinline__ void cmask(f32x16&p0,f32x16&p1,int jb,int qrel,int hi){
  const float NEG=-INFINITY; int kb=64*jb+4*hi;
  #pragma unroll
  for(int r=0;r<16;++r){int kv=kb+(r&3)+8*(r>>2); if(kv>qrel)p0[r]=NEG; if(kv+32>qrel)p1[r]=NEG;}
}

constexpr int NSLOT=3, SLOTB=8192;
constexpr int LDS_K=0, LDS_V=NSLOT*SLOTB, LDS_WS=2*NSLOT*SLOTB, LDS_OST=LDS_WS+NW*64*4, LDS_BYTES=LDS_OST+NW*4096;
constexpr float C2=0.125f*1.4426950408889634f;
__device__ __forceinline__ void glds16(const void*gsrc,unsigned lds_dst){unsigned keep;
  asm volatile("s_mov_b32 %0, m0\n\ts_mov_b32 m0, %2\n\ts_nop 0\n\tglobal_load_lds_dwordx4 %1, off\n\ts_mov_b32 m0, %0":"=&s"(keep):"v"(gsrc),"s"(lds_dst):"memory");}
__device__ __forceinline__ float max3f(float a,float b,float c){float r;asm("v_max3_f32 %0, %1, %2, %3":"=v"(r):"v"(a),"v"(b),"v"(c));return r;}
__device__ __forceinline__ float max2f(float a,float b){float r;asm("v_max_f32_e32 %0, %1, %2":"=v"(r):"v"(a),"v"(b));return r;}
__device__ __forceinline__ float fadd_s(float a,float b){float r;asm("v_add_f32_e32 %0, %1, %2":"=v"(r):"v"(a),"v"(b));return r;}
__device__ __forceinline__ float fsub_s(float a,float b){float r;asm("v_sub_f32_e32 %0, %1, %2":"=v"(r):"v"(a),"v"(b));return r;}
typedef float f32x2_t __attribute__((ext_vector_type(2))); typedef __bf16 bf16x2_t __attribute__((ext_vector_type(2)));
__device__ __forceinline__ unsigned cvtpk_s(float lo,float hi){f32x2_t v={lo,hi};bf16x2_t b=__builtin_convertvector(v,bf16x2_t);return __builtin_bit_cast(unsigned,b);}
#define WAIT_BAR(N) asm volatile("s_waitcnt vmcnt(" #N ") lgkmcnt(0)\n\ts_barrier":::"memory")

__device__ __forceinline__ void qkt(f32x16&p0,f32x16&p1,const char*Kslot,const bf16x8*qr,int r32,int hi){
  const char*kb=Kslot+hi*1024+r32*16;
  #pragma unroll
  for(int d0=0;d0<4;++d0){
    const bf16x8 b0=*reinterpret_cast<const bf16x8*>(kb+d0*2048);
    const bf16x8 b1=*reinterpret_cast<const bf16x8*>(kb+d0*2048+512);
    p0=__builtin_amdgcn_mfma_f32_32x32x16_bf16(b0,qr[d0],p0,0,0,0);p1=__builtin_amdgcn_mfma_f32_32x32x16_bf16(b1,qr[d0],p1,0,0,0);}
}
typedef __attribute__((address_space(3))) const char* lds_cptr;
typedef short v4i16_t __attribute__((ext_vector_type(4)));
__device__ __forceinline__ void kload8(bf16x8*kf,lds_cptr kp){
  kf[0]=*(const __attribute__((address_space(3))) bf16x8*)(kp);      kf[1]=*(const __attribute__((address_space(3))) bf16x8*)(kp+512);
  kf[2]=*(const __attribute__((address_space(3))) bf16x8*)(kp+2048); kf[3]=*(const __attribute__((address_space(3))) bf16x8*)(kp+2560);
  kf[4]=*(const __attribute__((address_space(3))) bf16x8*)(kp+4096); kf[5]=*(const __attribute__((address_space(3))) bf16x8*)(kp+4608);
  kf[6]=*(const __attribute__((address_space(3))) bf16x8*)(kp+6144); kf[7]=*(const __attribute__((address_space(3))) bf16x8*)(kp+6656);
}
__device__ __forceinline__ void kload2(bf16x8*kf,lds_cptr kp,int j){ kf[2*j]=*(const __attribute__((address_space(3))) bf16x8*)(kp+j*2048); kf[2*j+1]=*(const __attribute__((address_space(3))) bf16x8*)(kp+j*2048+512); }
__device__ __forceinline__ s16x4 vtr(lds_cptr p){ return __builtin_bit_cast(s16x4,__builtin_amdgcn_ds_read_tr16_b64_v4i16((__attribute__((address_space(3))) v4i16_t*)p)); }
__device__ __forceinline__ float rowmax(const f32x16&p0,const f32x16&p1){
  float a=max3f(p0[0],p0[1],p1[0]),b=max3f(p0[2],p0[3],p1[1]);a=max3f(a,p1[2],p1[3]);
  #pragma unroll
  for(int r=4;r<16;r+=4){a=max3f(a,p0[r],p0[r+1]);b=max3f(b,p0[r+2],p0[r+3]);a=max3f(a,p1[r],p1[r+1]);b=max3f(b,p1[r+2],p1[r+3]);}
  const float m=max2f(a,b);
  auto rr=__builtin_amdgcn_permlane32_swap(__float_as_uint(m),__float_as_uint(m),false,false);
  return max2f(__uint_as_float(rr[0]),__uint_as_float(rr[1]));
}
__device__ __forceinline__ void pv(f32x16*o,int vb,bf16x8 pa0,bf16x8 pa1,bf16x8 pa2,bf16x8 pa3){
  #pragma unroll
  for(int d0=0;d0<2;++d0){s16x4 lo[4],hi[4];
    #pragma unroll
    for(int ks=0;ks<4;++ks){
      asm volatile("ds_read_b64_tr_b16 %0,%1 offset:%c2":"=&v"(lo[ks]):"v"(vb),"i"(d0*4096+ks*1024):"memory");
      asm volatile("ds_read_b64_tr_b16 %0,%1 offset:%c2":"=&v"(hi[ks]):"v"(vb),"i"(d0*4096+ks*1024+512):"memory");}
    asm volatile("s_waitcnt lgkmcnt(0)":::"memory");SBAR();
    #define PK(k) (bf16x8){lo[k][0],lo[k][1],lo[k][2],lo[k][3],hi[k][0],hi[k][1],hi[k][2],hi[k][3]}
    o[d0]=__builtin_amdgcn_mfma_f32_32x32x16_bf16(pa0,PK(0),o[d0],0,0,0);
    o[d0]=__builtin_amdgcn_mfma_f32_32x32x16_bf16(pa1,PK(1),o[d0],0,0,0);
    o[d0]=__builtin_amdgcn_mfma_f32_32x32x16_bf16(pa2,PK(2),o[d0],0,0,0);
    o[d0]=__builtin_amdgcn_mfma_f32_32x32x16_bf16(pa3,PK(3),o[d0],0,0,0);
    #undef PK
  }
}

#ifndef ATTN_STORE16
#define ATTN_STORE16(p,v) (*(u32x4*)(p)=(v))
#endif
template<int THRL> __device__ __forceinline__ void attn_unit(int b,int h,int qb,const bf16*Q,const bf16*__restrict__ K,const bf16*__restrict__ V,bf16*O,char*shm,const __attribute__((address_space(3))) float*Fs){
  int tid_=threadIdx.x; asm volatile("":"+v"(tid_)); const int tid=tid_,lane=tid&63,r32=lane&31,hi=lane>>5;   const int wid=__builtin_amdgcn_readfirstlane(tid>>6);
  const long rowbase=(long)b*SEQ; const int q0=qb*QB;
  const bf16*Qw=Q+(rowbase+q0+wid*QBLK)*DM+h*D;
  const bf16*Kh=K+rowbase*DM+h*D,*Vh=V+rowbase*DM+h*D;
  const unsigned lds0=(unsigned)(uintptr_t)shm;
  float*wsf=(float*)(shm+LDS_WS)+wid*64;
  const bf16*ksrc=Kh+(long)lane*DM+wid*8;
  const bf16*vsrc=Vh+(long)(16*(wid&3)+(lane>>2))*DM+(wid>>2)*32+(lane&3)*8;
  const unsigned kdst=lds0+LDS_K+wid*1024, vdst=lds0+LDS_V+wid*1024;
  #define DMA_K(t,slot) glds16(ksrc+(long)(t)*KVBLK*DM,(unsigned)__builtin_amdgcn_readfirstlane(kdst+(slot)))
  #define DMA_V(t,slot) glds16(vsrc+(long)(t)*KVBLK*DM,(unsigned)__builtin_amdgcn_readfirstlane(vdst+(slot)))
  const int vb0=(int)(lds0+LDS_V)+((lane>>4)&1)*32+(lane&3)*8+(4*hi+((lane&15)>>2))*64;
  const char*Kbase=shm+LDS_K; bf16x8 kf[8];
  const lds_cptr shm3=(lds_cptr)shm; const lds_cptr kp0=shm3+LDS_K+hi*1024+r32*16; const lds_cptr vp0=shm3+LDS_V+((lane>>4)&1)*32+(lane&3)*8+(4*hi+((lane&15)>>2))*64;
  const int NT=(q0+QB)/KVBLK;
  DMA_K(0,0);DMA_V(0,0);DMA_K(1,SLOTB);
  bf16x8 qr[4];
  #pragma unroll
  for(int d0=0;d0<4;++d0)qr[d0]=*reinterpret_cast<const bf16x8*>(&Qw[(long)r32*DM+d0*16+hi*8]);
  float mhat=0.f,l_reg=0.f;f32x16 o[2];o[0]=f32x16{};o[1]=f32x16{};
  const int qrel=wid*QBLK+r32;
  const float Fq=Fs[q0+qrel];
  #define BIAS(C0,C1,t) do{ const __attribute__((address_space(3))) f32x4_t*fk_=(const __attribute__((address_space(3))) f32x4_t*)(Fs+64*(t)+4*hi); const float fb_=Fq-mhat; \
    _Pragma("unroll") for(int g_=0;g_<4;++g_){ const f32x4_t a_=fk_[2*g_], b_=fk_[8+2*g_]; \
      _Pragma("unroll") for(int e_=0;e_<4;++e_){ C0[4*g_+e_]=fb_-a_[e_]; C1[4*g_+e_]=fb_-b_[e_]; } } }while(0)
  #define CMASK(P0,P1,t) do{int jb_=(t)-(NT-4); if(jb_>=0)cmask(P0,P1,jb_,qrel,hi);}while(0)
  bool resc=false;
  #define START(P0,P1) do{ const float rm=rowmax(P0,P1); resc=false; \
    { const float dl=rm; mhat=fadd_s(mhat,dl); \
      _Pragma("unroll") for(int r=0;r<16;++r){P0[r]=fsub_s(P0[r],dl);P1[r]=fsub_s(P1[r],dl);} \
      } \
    _Pragma("unroll") for(int r=0;r<16;++r)P0[r]=__builtin_amdgcn_exp2f(P0[r]); }while(0)
  #define RESC() do{ if(resc){ asm volatile("s_waitcnt lgkmcnt(0)":::"memory"); \
      _Pragma("unroll") for(int d_=0;d_<2;++d_) _Pragma("unroll") for(int r=0;r<16;++r)o[d_][r]*=wsf[crow(r,hi)]; } }while(0)
  f32x16 pA0,pA1,pB0,pB1;
  int sl_prev=0,sl_cur=0,sl_next=SLOTB;
  #define ROT() do{sl_prev=sl_cur;sl_cur=sl_next;sl_next=(sl_next==(NSLOT-1)*SLOTB)?0:sl_next+SLOTB;}while(0)
  DMA_K(2,2*SLOTB);
  WAIT_BAR(3);
  BIAS(pA0,pA1,0); qkt(pA0,pA1,Kbase,qr,r32,hi);asm volatile("s_nop 15\n\ts_nop 7":"+v"(pA0),"+v"(pA1));CMASK(pA0,pA1,0);
  START(pA0,pA1);
  _Pragma("unroll") for(int r=0;r<16;++r)pA1[r]=__builtin_amdgcn_exp2f(pA1[r]);
  WAIT_BAR(0);
  DMA_K(3,0);DMA_V(1,SLOTB);
  ROT();
  kload8(kf,kp0+sl_cur);
  WAIT_BAR(2);
  s16x4 vlo[8],vhi[8]; u32x4 pw0,pw1,pw2,pw3;
  #define PKW(P,B) cvtpk_s(P[B],P[B+1])
  #define PAF(k) __builtin_bit_cast(bf16x8,pw##k)
  #define VFR(i) (bf16x8){vlo[i][0],vlo[i][1],vlo[i][2],vlo[i][3],vhi[i][0],vhi[i][1],vhi[i][2],vhi[i][3]}
  #define PIN(x) asm volatile("":"+v"(x))
  #define MX3(a,b,c) __builtin_fmaxf(__builtin_fmaxf((a),(b)),(c))
  #define GAPA(MF,A0,A1,A2,A3,W0,W1,PW) do{ MF; sacc+=A0; sacc+=A1; sacc+=A2; sacc+=A3; PIN(sacc); W0; W1; PIN(PW); SBAR(); }while(0)
  #define EX(v) __builtin_amdgcn_exp2f(v)
  #define GAPB(MF,X,B) do{ MF; X[B]=EX(X[B]); X[B+1]=EX(X[B+1]); X[B+2]=EX(X[B+2]); X[B+3]=EX(X[B+3]); PIN(X); SBAR(); }while(0)
  #define VRD(i) do{ vlo[i]=vtr(vp_+(((i)>>2)*4096+((i)&3)*1024)); vhi[i]=vtr(vp_+(((i)>>2)*4096+((i)&3)*1024+512)); }while(0)
  #define KRD(G,j) do{ if(G){ kload2(kf,kp0+sl_next,j); SBAR(); } }while(0)
  #define STEP(C0,C1,P0,P1,t,GK,GV,GL) do{ SBAR(); BIAS(C0,C1,t); \
    const lds_cptr vp_=vp0+sl_prev; \
    VRD(0); SBAR(); float sacc=(P0[0]+P0[1]); \
    GAPA(C0=__builtin_amdgcn_mfma_f32_32x32x16_bf16(kf[0],qr[0],C0,0,0,0), P0[2],P0[3],P0[4],P0[5],     pw0[0]=PKW(P0,0), pw0[1]=PKW(P0,2), pw0); \
    VRD(4); SBAR(); GAPA(C1=__builtin_amdgcn_mfma_f32_32x32x16_bf16(kf[1],qr[0],C1,0,0,0), P0[6],P0[7],P0[8],P0[9],     pw0[2]=PKW(P0,4), pw0[3]=PKW(P0,6), pw0); \
    VRD(1); SBAR(); GAPA(C0=__builtin_amdgcn_mfma_f32_32x32x16_bf16(kf[2],qr[1],C0,0,0,0),   P0[10],P0[11],P0[12],P0[13], pw1[0]=PKW(P0,8), pw1[1]=PKW(P0,10), pw1); \
    VRD(5); SBAR(); GAPA(C1=__builtin_amdgcn_mfma_f32_32x32x16_bf16(kf[3],qr[1],C1,0,0,0),   P0[14],P0[15],P1[0],P1[1],   pw1[2]=PKW(P0,12),pw1[3]=PKW(P0,14), pw1); \
    VRD(2); SBAR(); GAPA(C0=__builtin_amdgcn_mfma_f32_32x32x16_bf16(kf[4],qr[2],C0,0,0,0),   P1[2],P1[3],P1[4],P1[5],     pw2[0]=PKW(P1,0), pw2[1]=PKW(P1,2), pw2); \
    VRD(6); SBAR(); GAPA(C1=__builtin_amdgcn_mfma_f32_32x32x16_bf16(kf[5],qr[2],C1,0,0,0),   P1[6],P1[7],P1[8],P1[9],     pw2[2]=PKW(P1,4), pw2[3]=PKW(P1,6), pw2); \
    VRD(3); SBAR(); GAPA(C0=__builtin_amdgcn_mfma_f32_32x32x16_bf16(kf[6],qr[3],C0,0,0,0),   P1[10],P1[11],P1[12],P1[13], pw3[0]=PKW(P1,8), pw3[1]=PKW(P1,10), pw3); \
    VRD(7); SBAR(); GAPA(C1=__builtin_amdgcn_mfma_f32_32x32x16_bf16(kf[7],qr[3],C1,0,0,0),   P1[14],P1[15],0.f,0.f,       pw3[2]=PKW(P1,12),pw3[3]=PKW(P1,14), pw3); \
    l_reg+=sacc; \
    if(GK){DMA_K((t)+3,sl_cur);} if(GV){DMA_V((t)+1,sl_next);} \
    CMASK(C0,C1,t); \
    { float a=MX3(C0[0],C0[1],C1[0]),b=MX3(C0[2],C0[3],C1[1]); a=MX3(a,C1[2],C1[3]); \
      _Pragma("unroll") for(int r=4;r<16;r+=4){a=MX3(a,C0[r],C0[r+1]);b=MX3(b,C0[r+2],C0[r+3]);a=MX3(a,C1[r],C1[r+1]);b=MX3(b,C1[r+2],C1[r+3]);} \
      float rm=__builtin_fmaxf(a,b); { auto rr=__builtin_amdgcn_permlane32_swap(__float_as_uint(rm),__float_as_uint(rm),false,false); rm=__builtin_fmaxf(__uint_as_float(rr[0]),__uint_as_float(rr[1])); } \
      resc=false; \
      if(__builtin_expect(__any(rm>(float)THRL),0)){ const float dl=__builtin_fmaxf(rm,0.f); mhat+=dl; \
        _Pragma("unroll") for(int r=0;r<16;++r){C0[r]-=dl;C1[r]-=dl;} \
        const float f=__builtin_amdgcn_exp2f(-dl); l_reg*=f; if(hi==0)wsf[r32]=f; resc=true; } } \
    SBAR(); \
    GAPB(o[0]=__builtin_amdgcn_mfma_f32_32x32x16_bf16(PAF(0),VFR(0),o[0],0,0,0), C0,0); \
    GAPB(o[1]=__builtin_amdgcn_mfma_f32_32x32x16_bf16(PAF(0),VFR(4),o[1],0,0,0), C0,4); \
    KRD(GL,0); GAPB(o[0]=__builtin_amdgcn_mfma_f32_32x32x16_bf16(PAF(1),VFR(1),o[0],0,0,0), C0,8); \
    KRD(GL,1); GAPB(o[1]=__builtin_amdgcn_mfma_f32_32x32x16_bf16(PAF(1),VFR(5),o[1],0,0,0), C0,12); \
    KRD(GL,2); GAPB(o[0]=__builtin_amdgcn_mfma_f32_32x32x16_bf16(PAF(2),VFR(2),o[0],0,0,0), C1,0); \
    KRD(GL,3); GAPB(o[1]=__builtin_amdgcn_mfma_f32_32x32x16_bf16(PAF(2),VFR(6),o[1],0,0,0), C1,4); \
    GAPB(o[0]=__builtin_amdgcn_mfma_f32_32x32x16_bf16(PAF(3),VFR(3),o[0],0,0,0), C1,8); \
    GAPB(o[1]=__builtin_amdgcn_mfma_f32_32x32x16_bf16(PAF(3),VFR(7),o[1],0,0,0), C1,12); \
    }while(0)
  int t=1;
  #undef CMASK
  #define CMASK(P0,P1,t) do{}while(0)
  for(;t+5<NT;t+=2){
    STEP(pB0,pB1,pA0,pA1,t,true,true,true);     WAIT_BAR(2); RESC(); ROT();
    STEP(pA0,pA1,pB0,pB1,t+1,true,true,true);   WAIT_BAR(2); RESC(); ROT();
  }
  #undef CMASK
  #define CMASK(P0,P1,t) do{int jb_=(t)-(NT-4); if(jb_>=0)cmask(P0,P1,jb_,qrel,hi);}while(0)
  #define ENDW(tt) do{ if((tt)+3<NT){WAIT_BAR(2);} else if((tt)+2<NT){WAIT_BAR(1);} else {WAIT_BAR(0);} }while(0)
  for(;t+1<NT;t+=2){
    STEP(pB0,pB1,pA0,pA1,t,(t+3<NT),(t+1<NT),(t+1<NT));       ENDW(t);   RESC(); ROT();
    STEP(pA0,pA1,pB0,pB1,t+1,(t+4<NT),(t+2<NT),(t+2<NT));     ENDW(t+1); RESC(); ROT();
  }
  STEP(pB0,pB1,pA0,pA1,NT-1,false,false,false); RESC();
  { float sacc=pB0[0]+pB0[1]; _Pragma("unroll") for(int r=2;r<16;++r)sacc+=pB0[r]; _Pragma("unroll") for(int r=0;r<16;++r)sacc+=pB1[r]; l_reg+=sacc;
    pw0=(u32x4){PKW(pB0,0),PKW(pB0,2),PKW(pB0,4),PKW(pB0,6)};pw1=(u32x4){PKW(pB0,8),PKW(pB0,10),PKW(pB0,12),PKW(pB0,14)};pw2=(u32x4){PKW(pB1,0),PKW(pB1,2),PKW(pB1,4),PKW(pB1,6)};pw3=(u32x4){PKW(pB1,8),PKW(pB1,10),PKW(pB1,12),PKW(pB1,14)};
    SBAR(); pv(o,vb0+sl_cur,PAF(0),PAF(1),PAF(2),PAF(3)); }
  #undef PKW
  #undef PAF
  #undef VFR
  #undef PIN
  #undef MX3
  #undef GAPA
  #undef GAPB
  #undef EX
  #undef VRD
  #undef KRD
  #undef STEP
  #undef ENDW
  {auto rr=__builtin_amdgcn_permlane32_swap(__float_as_uint(l_reg),__float_as_uint(l_reg),false,false);l_reg=__uint_as_float(rr[0])+__uint_as_float(rr[1]);}
  if(hi==0)wsf[32+r32]=l_reg;asm volatile("s_waitcnt lgkmcnt(0)":::"memory");
  float rli[16];
  #pragma unroll
  for(int r=0;r<16;++r)rli[r]=__builtin_amdgcn_rcpf(wsf[32+crow(r,hi)]);
  bf16*Ow=O+(rowbase+q0+wid*QBLK)*DMO+h*D;
  { bf16*stg=(bf16*)(shm+LDS_OST)+wid*2048;
    #pragma unroll
    for(int r=0;r<16;++r){const int orow=crow(r,hi);
      #pragma unroll
      for(int d0=0;d0<2;++d0)stg[orow*64+d0*32+r32]=__float2bfloat16(o[d0][r]*rli[r]);}
    asm volatile("s_waitcnt lgkmcnt(0)":::"memory");
    #pragma unroll
    for(int i=0;i<4;++i){const int row=i*8+(lane>>3),ch=lane&7; const u32x4 v=*(const u32x4*)(stg+row*64+ch*8); ATTN_STORE16(Ow+(long)row*DMO+ch*8,v);} }
  asm volatile("s_waitcnt lgkmcnt(0)\n\ts_barrier":::"memory");
  #undef DMA_K
  #undef DMA_V
  #undef CMASK
  #undef START
  #undef RESC
  #undef ROT
  #undef BIAS
}
constexpr int ATTN_LDS_BYTES=LDS_BYTES;
#undef SBAR
#undef WAIT_BAR
}

#define LAS __attribute__((address_space(3)))
typedef unsigned short bf16_t;
typedef short bf16x8 __attribute__((ext_vector_type(8)));
typedef short s16x4 __attribute__((ext_vector_type(4)));
typedef float f32x4 __attribute__((ext_vector_type(4)));
typedef float f32x16 __attribute__((ext_vector_type(16)));
typedef unsigned u32x4 __attribute__((ext_vector_type(4)));
typedef unsigned u32x2 __attribute__((ext_vector_type(2)));

constexpr int NB = 8, SEQ = 2048, DM = 1024, MTOK = NB * SEQ, DFF = 2816, NLAYER = 4, QKV_LD = 3072;
constexpr int NWAVES = 8, NTHR = 512;
constexpr float LOG2E = 1.4426950408889634f;
constexpr int LDS_BYTES = 147456;
constexpr int VROW = 192;
constexpr int VTILE = 32 * VROW;
constexpr int LDS_F = 49152;
constexpr int NPHASE = 2 + 5 * NLAYER;
constexpr int LDS_MISC = 131072;

constexpr size_t MiB = 1u << 20;
constexpr size_t SZ_WQKV = (size_t)3072 * 1024 * 2, SZ_WO = (size_t)1024 * 1024 * 2, SZ_WI = (size_t)5632 * 1024 * 2, SZ_WOUT = (size_t)1024 * 2816 * 2;
constexpr size_t SZ_WLAYER = SZ_WQKV + SZ_WO + SZ_WI + SZ_WOUT;
constexpr size_t WS_W = 0;
constexpr size_t WS_XB = 104 * MiB;
constexpr size_t WS_XRES = WS_XB + 32 * MiB;
constexpr size_t WS_QKV = WS_XRES + 64 * MiB;
constexpr size_t WS_ATT = WS_QKV + 96 * MiB;
constexpr size_t WS_SMALL = WS_ATT + 32 * MiB;
constexpr size_t WS_ROWSS = WS_SMALL;
constexpr size_t WS_ROT = WS_ROWSS + (size_t)9 * 16 * MTOK * 4;
constexpr size_t WS_WF = WS_ROT + (size_t)2048 * 16 * 4;
constexpr size_t WS_LOCF = WS_WF + (size_t)2 * 16 * 1024 * 4;
constexpr size_t WS_TOTF = WS_LOCF + (size_t)128 * 2048 * 4;
constexpr size_t WS_LSE = WS_TOTF + (size_t)128 * 32 * 4;
constexpr size_t WS_BAR = WS_LSE + (size_t)2 * MTOK * 8 * 4;
constexpr size_t WS_PCNT = WS_BAR + 16384;
constexpr size_t WS_END = WS_PCNT + 16384;
static_assert(SZ_WLAYER * 4 <= 104 * MiB, "weights fit");

struct Args {
    const float* x; const float* norm_mix; const float* w_qkv_even; const float* w_o_even; const float* w_qkvf_odd; const float* b_forget; const float* w_o_odd;
    const float* norm_ffn; const float* w_ffn_in; const float* w_ffn_out; const float* norm_final;
    float* out; unsigned char* ws; int ph_lo, ph_hi;
};

__device__ __forceinline__ unsigned f2bf(float f) { unsigned u = __builtin_bit_cast(unsigned, f); return (u + 0x7fffu + ((u >> 16) & 1u)) >> 16; }
__device__ __forceinline__ unsigned pk2(float lo, float hi) { return f2bf(lo) | (f2bf(hi) << 16); }
__device__ __forceinline__ unsigned cvtpk(float lo, float hi) { unsigned r; asm volatile("v_cvt_pk_bf16_f32 %0, %1, %2" : "=v"(r) : "v"(lo), "v"(hi)); return r; }
__device__ __forceinline__ float wave_sum(float v) {
#pragma unroll
    for (int o = 1; o < 64; o <<= 1) v += __shfl_xor(v, o);
    return v;
}
#define LDS_WAIT() asm volatile("s_waitcnt lgkmcnt(0)" ::: "memory")
__device__ __forceinline__ int otid() { int t = threadIdx.x; asm volatile("" : "+v"(t)); return t; }

#ifndef PROBE_OPROJ
#define PROBE_OPROJ 0
#endif
#ifndef PROBE_FFO
#define PROBE_FFO 0
#endif
#ifndef FUSE_FINAL
#define FUSE_FINAL 1
#endif
#ifndef CONV_SPLIT
#define CONV_SPLIT 1
#endif
__device__ __forceinline__ void transpose_item(const float* W, int ldw, int K, int k0, int src_col, bf16_t* WT, int dst_row, const float* gain, float cscale, LAS float* scr, int lane) {
    const int kr = lane >> 3, c4 = lane & 7;
    f32x4 v[8]; float g[8];
#pragma unroll
    for (int i = 0; i < 8; ++i) { const int kk = 8 * i + kr; v[i] = *(const f32x4*)(W + (size_t)(k0 + kk) * ldw + src_col + 4 * c4); g[i] = gain ? gain[k0 + kk] * cscale : cscale; }
#pragma unroll
    for (int i = 0; i < 8; ++i) { const int kk = 8 * i + kr; LAS float* d = scr + kk * 33 + 4 * c4; d[0] = v[i].x * g[i]; d[1] = v[i].y * g[i]; d[2] = v[i].z * g[i]; d[3] = v[i].w * g[i]; }
    LDS_WAIT(); asm volatile("" ::: "memory");
    const int c = lane & 7;
#pragma unroll
    for (int j = 0; j < 4; ++j) { const int n = (lane >> 3) + 8 * j; const LAS float* s = scr + (8 * c) * 33 + n;
        u32x4 o; o.x = pk2(s[0 * 33], s[1 * 33]); o.y = pk2(s[2 * 33], s[3 * 33]); o.z = pk2(s[4 * 33], s[5 * 33]); o.w = pk2(s[6 * 33], s[7 * 33]);
        *(u32x4*)(WT + (size_t)(dst_row + n) * K + k0 + 8 * c) = o; }
    LDS_WAIT(); asm volatile("" ::: "memory");
}

__device__ __forceinline__ void convert_weights(const Args& a, int l_lo, int l_hi, LAS unsigned char* lds, int gw, int NGW) {
    const int tid = otid(), lane = tid & 63, wave = __builtin_amdgcn_readfirstlane(tid >> 6);
    LAS float* scr = (LAS float*)(lds + wave * 16384);
    constexpr int I_QKV = 16 * 96, I_O = 16 * 32, I_IN = 16 * 176, I_OUT = 44 * 32, I_LAYER = I_QKV + I_O + I_IN + I_OUT;
    for (int it = l_lo * I_LAYER + gw; it < l_hi * I_LAYER; it += NGW) {
        const int l = it / I_LAYER; int r = it % I_LAYER;
        bf16_t* wl = (bf16_t*)(a.ws + WS_W + (size_t)l * SZ_WLAYER);
        if (r < I_QKV) {
            const int kb = r / 96, nb = r % 96, n0 = 32 * nb;
            const float* W = (l & 1) ? a.w_qkvf_odd + (size_t)(l >> 1) * 1024 * 3088 : a.w_qkv_even + (size_t)(l >> 1) * 1024 * 3072;
            transpose_item(W, (l & 1) ? 3088 : 3072, 1024, 64 * kb, n0, wl, n0, a.norm_mix + l * 1024, n0 < 1024 ? 0.125f * LOG2E : 1.0f, scr, lane);
            continue; }
        r -= I_QKV;
        if (r < I_O) {
            const int kb = r / 32, nb = r % 32, n0 = 32 * nb;
            const float* W = (l & 1) ? a.w_o_odd + (size_t)(l >> 1) * 1024 * 1024 : a.w_o_even + (size_t)(l >> 1) * 1024 * 1024;
            transpose_item(W, 1024, 1024, 64 * kb, n0, (bf16_t*)((unsigned char*)wl + SZ_WQKV), n0, nullptr, 1.0f, scr, lane);
            continue; }
        r -= I_O;
        if (r < I_IN) {
            const int kb = r / 176, nb = r % 176, n0 = 32 * nb;
            const int pn = n0 >> 8, bj = (n0 >> 7) & 1, c0 = n0 & 127;
            transpose_item(a.w_ffn_in + (size_t)l * 1024 * 5632, 5632, 1024, 64 * kb, bj * 2816 + 128 * pn + c0, (bf16_t*)((unsigned char*)wl + SZ_WQKV + SZ_WO), n0, a.norm_ffn + l * 1024, 1.0f, scr, lane);
            continue; }
        r -= I_IN;
        {
            const int kb = r / 32, nb = r % 32, n0 = 32 * nb;
            transpose_item(a.w_ffn_out + (size_t)l * 2816 * 1024, 1024, 2816, 64 * kb, n0, (bf16_t*)((unsigned char*)wl + SZ_WQKV + SZ_WO + SZ_WI), n0, nullptr, 1.0f, scr, lane);
        }
    }
}

__device__ __forceinline__ void prologue(const Args& a, LAS unsigned char* lds, int vwg, int G) {
    const int tid = otid(), lane = tid & 63, wave = __builtin_amdgcn_readfirstlane(tid >> 6);
    const int gw = vwg * NWAVES + wave, NGW = G * NWAVES;
    convert_weights(a, 0, (CONV_SPLIT && G == 256) ? 1 : NLAYER, lds, gw, NGW);
    bf16_t* xb = (bf16_t*)(a.ws + WS_XB); float* rowss = (float*)(a.ws + WS_ROWSS);
    for (int m = gw; m < MTOK; m += NGW) {
        const f32x4* xr = (const f32x4*)(a.x + (size_t)m * DM) + lane; float s = 0.f; f32x4 v[4];
#pragma unroll
        for (int j = 0; j < 4; ++j) { v[j] = xr[64 * j]; s += (v[j].x * v[j].x + v[j].y * v[j].y) + (v[j].z * v[j].z + v[j].w * v[j].w); }
        s = wave_sum(s);
        unsigned long long* o8 = (unsigned long long*)(xb + (size_t)m * DM) + lane;
#pragma unroll
        for (int j = 0; j < 4; ++j) o8[64 * j] = (unsigned long long)pk2(v[j].x, v[j].y) | ((unsigned long long)pk2(v[j].z, v[j].w) << 32);
        if (lane < 16) rowss[(size_t)lane * MTOK + m] = (lane == 0) ? s : 0.f;
    }
    const int gt = vwg * NTHR + tid, NGT = G * NTHR;
    float* rot = (float*)(a.ws + WS_ROT);
    for (int i = gt; i < 2048 * 8; i += NGT) {
        const int pos = i >> 3, j = i & 7;
        const float invf[8] = {1.0f, 0.19392274474868576f, 0.03760603093086393f, 0.007292664737217109f, 0.001414213562373095f, 0.0002742481756762073f, 5.318295896944988e-05f, 1.031338537721246e-05f};
        float fq = invf[0];
#pragma unroll
        for (int t = 1; t < 8; ++t) fq = (j == t) ? invf[t] : fq;
        const float ang = (float)pos * fq;
        const double rev = (double)ang * 0.15915494309189535; const float fr = (float)(rev - floor(rev));
        rot[pos * 16 + j] = __builtin_amdgcn_cosf(fr); rot[pos * 16 + 8 + j] = __builtin_amdgcn_sinf(fr);
    }
    float* wf = (float*)(a.ws + WS_WF);
    for (int i = gt; i < 2 * 16 * 1024; i += NGT) {
        const int lo = i >> 14, hd = (i >> 10) & 15, k = i & 1023;
        wf[i] = a.w_qkvf_odd[(size_t)lo * 1024 * 3088 + (size_t)k * 3088 + 3072 + hd] * a.norm_mix[(2 * lo + 1) * 1024 + k];
    }
}

__device__ __forceinline__ void fgate_phase(const Args& a, int lo, LAS unsigned char* lds, int vwg, int G) {
    const int tid = otid(), lane = tid & 63, wave = __builtin_amdgcn_readfirstlane(tid >> 6);
    const bf16_t* xbq = (const bf16_t*)(a.ws + WS_XB); const float* rowss = (const float*)(a.ws + WS_ROWSS) + (size_t)(2 * (2 * lo + 1)) * 16 * MTOK;
    const float* wf = (const float*)(a.ws + WS_WF) + (size_t)lo * 16 * 1024;
    float* locF = (float*)(a.ws + WS_LOCF); float* totF = (float*)(a.ws + WS_TOTF);
    LAS float* lf = (LAS float*)lds;
    const int r16 = lane & 15, g4 = lane >> 4, tile = wave & 3, kh = wave >> 2;
    for (int j = vwg; j < 256; j += G) {
        const u32x2* xr = (const u32x2*)(xbq + (size_t)(64 * j + 16 * tile + r16) * DM + 512 * kh + 4 * g4);
        const f32x4* wr = (const f32x4*)(wf + (size_t)r16 * 1024 + 512 * kh + 4 * g4);
        f32x4 acc = {0.f, 0.f, 0.f, 0.f};
#pragma unroll 8
        for (int s = 0; s < 32; ++s) {
            const u32x2 xw = xr[4 * s]; const f32x4 wv = wr[4 * s];
            const f32x4 xv = {pg8::bf_lo(xw.x), pg8::bf_hi(xw.x), pg8::bf_lo(xw.y), pg8::bf_hi(xw.y)};
            acc = __builtin_amdgcn_mfma_f32_16x16x4f32(xv.x, wv.x, acc, 0, 0, 0);
            acc = __builtin_amdgcn_mfma_f32_16x16x4f32(xv.y, wv.y, acc, 0, 0, 0);
            acc = __builtin_amdgcn_mfma_f32_16x16x4f32(xv.z, wv.z, acc, 0, 0, 0);
            acc = __builtin_amdgcn_mfma_f32_16x16x4f32(xv.w, wv.w, acc, 0, 0, 0);
        }
#pragma unroll
        for (int jj = 0; jj < 4; ++jj) lf[(kh * 64 + 16 * tile + 4 * g4 + jj) * 16 + r16] = acc[jj];
        __syncthreads();
        float l2v[2];
#pragma unroll
        for (int q = 0; q < 2; ++q) {
            const int idx = tid + 512 * q, t = idx >> 4, hd = idx & 15;
            const float fl = (lf[idx] + lf[1024 + idx]) * pg8::rstd_of(rowss, 64 * j + t) + a.b_forget[lo * 16 + hd];
            const float z2 = fl * LOG2E; l2v[q] = -(fmaxf(-z2, 0.f) + __builtin_amdgcn_logf(1.0f + __builtin_amdgcn_exp2f(-fabsf(z2))));
        }
        __syncthreads();
        lf[tid] = l2v[0]; lf[tid + 512] = l2v[1];
        __syncthreads();
        if (tid < 16) {
            const int b = j >> 5, sl = j & 31; float run = 0.f; float* dst = locF + (size_t)(b * 16 + tid) * 2048 + sl * 64;
#pragma unroll 8
            for (int t = 0; t < 64; ++t) { run += lf[t * 16 + tid]; dst[t] = run; }
            totF[(b * 16 + tid) * 32 + sl] = run;
        }
        __syncthreads();
    }
}

__device__ __forceinline__ int phi32(int r) { return ((r >> 4) & 1) * 16 + ((r >> 2) & 1) * 8 + ((r >> 3) & 1) * 4 + (r & 3); }
__device__ __forceinline__ s16x4 vtr(const LAS unsigned char* p) { return __builtin_bit_cast(s16x4, __builtin_amdgcn_ds_read_tr16_b64_v4i16((LAS s16x4*)p)); }

template <int MODE, int DBG = 0>
__device__ __forceinline__ void attn_task(const bf16_t* qp, const bf16_t* kp, const bf16_t* vp, size_t rstride, int q0, int kb_lo, int kb_hi,
                                          LAS unsigned char* vlds, const LAS float* Fs, f32x16 (&O)[2], float& lse2) {
    const int lane = otid() & 63, n = lane & 31, hh = lane >> 5;
    bf16x8 qf[4];
    { const bf16_t* p = qp + (size_t)(q0 + n) * rstride + 8 * hh;
#pragma unroll
      for (int ks = 0; ks < 4; ++ks) qf[ks] = *(const bf16x8*)(p + 16 * ks); }
    const int qi = q0 + n;
    float Fq = 0.f; if (MODE == 0) Fq = Fs[qi];
#pragma unroll
    for (int r = 0; r < 16; ++r) { O[0][r] = 0.f; O[1][r] = 0.f; }
    float m = -1e30f, l = 0.f, R = 0.f;
    const bf16_t* kl = kp + (size_t)phi32(n) * rstride + 8 * hh;
    const bf16_t* vl = vp + (size_t)(lane >> 3) * rstride + 8 * (lane & 7);
    LAS unsigned char* vw = vlds + (lane >> 3) * VROW + (lane & 7) * 16;
    const LAS unsigned char* vr = vlds + (8 * hh + ((lane & 15) >> 2)) * VROW + (16 * ((lane >> 4) & 1) + 4 * (lane & 3)) * 2;
    bf16x8 kn[4]; u32x4 vn[4];
#define AT_ISSUE(kb) do { const bf16_t* kk_ = kl + (size_t)(kb) * 32 * rstride; const bf16_t* vv_ = vl + (size_t)(kb) * 32 * rstride; \
        _Pragma("unroll") for (int ks = 0; ks < 4; ++ks) kn[ks] = *(const bf16x8*)(kk_ + 16 * ks); \
        _Pragma("unroll") for (int ii = 0; ii < 4; ++ii) vn[ii] = *(const u32x4*)(vv_ + (size_t)(8 * ii) * rstride); } while (0)
    const int nblk = kb_hi - kb_lo + 1;
    int kb = (MODE == 2) ? kb_hi : kb_lo;
    AT_ISSUE(kb);
    for (int it = 0; it < nblk; ++it) {
        bf16x8 kc[4];
#pragma unroll
        for (int ks = 0; ks < 4; ++ks) kc[ks] = kn[ks];
        asm volatile("" ::: "memory");
#pragma unroll
        for (int ii = 0; ii < 4; ++ii) *(LAS u32x4*)(vw + ii * 8 * VROW) = vn[ii];
        asm volatile("" ::: "memory");
        const int kbn = (MODE == 2) ? kb - 1 : kb + 1;
        if (it + 1 < nblk && DBG != 1) AT_ISSUE(kbn);
        if (DBG != 2) {
        const int key0 = kb * 32 + 8 * hh;
        f32x16 s;
        if (MODE == 0) {
            const LAS f32x4* fk = (const LAS f32x4*)(Fs + key0);
            const f32x4 f0 = fk[0], f1 = fk[1], f2 = fk[4], f3 = fk[5];
#pragma unroll
            for (int e = 0; e < 4; ++e) { s[e] = Fq - f0[e]; s[4 + e] = Fq - f1[e]; s[8 + e] = Fq - f2[e]; s[12 + e] = Fq - f3[e]; }
        } else {
#pragma unroll
            for (int r = 0; r < 16; ++r) s[r] = 0.f;
        }
#pragma unroll
        for (int ks = 0; ks < 4; ++ks) s = __builtin_amdgcn_mfma_f32_32x32x16_bf16(kc[ks], qf[ks], s, 0, 0, 0);
        bf16x8 pb[2];
        if (MODE != 2) {
            const bool diag = (kb * 32 + 31 > q0);
            if (MODE == 1) {
                if (diag || kb * 32 < q0 - 97) {
#pragma unroll
                    for (int r = 0; r < 16; ++r) { const int ki = key0 + 16 * (r >> 3) + (r & 7); if (ki > qi || ki < qi - 128) s[r] = -1e30f; }
                }
            } else if (diag) {
#pragma unroll
                for (int r = 0; r < 16; ++r) { const int ki = key0 + 16 * (r >> 3) + (r & 7); if (ki > qi) s[r] = -1e30f; }
            }
            float bm = fmaxf(fmaxf(s[0], s[1]), fmaxf(s[2], s[3]));
#pragma unroll
            for (int r = 4; r < 16; r += 4) bm = fmaxf(bm, fmaxf(fmaxf(s[r], s[r + 1]), fmaxf(s[r + 2], s[r + 3])));
            bm = fmaxf(bm, __shfl_xor(bm, 32));
            const float mn = fmaxf(m, bm), alpha = __builtin_amdgcn_exp2f(m - mn); m = mn;
            float ps = 0.f;
#pragma unroll
            for (int r = 0; r < 16; ++r) { s[r] = __builtin_amdgcn_exp2f(s[r] - mn); ps += s[r]; }
            l = l * alpha + ps;
#pragma unroll
            for (int r = 0; r < 16; ++r) { O[0][r] *= alpha; O[1][r] *= alpha; }
        } else {
            const bool diag = (kb * 32 + 31 >= q0);
            float L[16];
#pragma unroll
            for (int r = 0; r < 16; ++r) {
                const float z = s[r], t = __builtin_amdgcn_exp2f(-fabsf(z)), sp = fmaxf(z, 0.f) + __builtin_amdgcn_logf(1.0f + t);
                L[r] = -sp; s[r] = z - sp;
            }
            if (diag) {
#pragma unroll
                for (int r = 0; r < 16; ++r) { const int ki = key0 + 16 * (r >> 3) + (r & 7); if (ki >= qi) { L[r] = 0.f; s[r] = -1e30f; } }
            }
            float sA = ((L[0] + L[1]) + (L[2] + L[3])) + ((L[4] + L[5]) + (L[6] + L[7]));
            float sB = ((L[8] + L[9]) + (L[10] + L[11])) + ((L[12] + L[13]) + (L[14] + L[15]));
            const float pA = __shfl_xor(sA, 32), pB = __shfl_xor(sB, 32);
            const float offA = sB + pB + (hh == 0 ? pA : 0.f), offB = (hh == 0 ? pB : 0.f);
            float run = R + offA;
#pragma unroll
            for (int e = 7; e >= 0; --e) { const float lr = L[e]; s[e] = __builtin_amdgcn_exp2f(s[e] + run); run += lr; }
            run = R + offB;
#pragma unroll
            for (int e = 15; e >= 8; --e) { const float lr = L[e]; s[e] = __builtin_amdgcn_exp2f(s[e] + run); run += lr; }
            R += (sA + sB) + (pA + pB);
        }
        { u32x4 w0, w1;
          w0.x = cvtpk(s[0], s[1]); w0.y = cvtpk(s[2], s[3]); w0.z = cvtpk(s[4], s[5]); w0.w = cvtpk(s[6], s[7]);
          w1.x = cvtpk(s[8], s[9]); w1.y = cvtpk(s[10], s[11]); w1.z = cvtpk(s[12], s[13]); w1.w = cvtpk(s[14], s[15]);
          pb[0] = __builtin_bit_cast(bf16x8, w0); pb[1] = __builtin_bit_cast(bf16x8, w1); }
        asm volatile("" ::: "memory");
#pragma unroll
        for (int db = 0; db < 2; ++db)
#pragma unroll
            for (int kk = 0; kk < 2; ++kk) {
                const s16x4 lo4 = vtr(vr + (16 * kk) * VROW + 64 * db), hi4 = vtr(vr + (16 * kk + 4) * VROW + 64 * db);
                const bf16x8 av = {lo4[0], lo4[1], lo4[2], lo4[3], hi4[0], hi4[1], hi4[2], hi4[3]};
                O[db] = __builtin_amdgcn_mfma_f32_32x32x16_bf16(av, pb[kk], O[db], 0, 0, 0);
            }
        asm volatile("s_waitcnt lgkmcnt(0)" ::: "memory");
        } else { asm volatile("s_waitcnt lgkmcnt(0)" ::: "memory"); O[0][0] += __builtin_bit_cast(float, (int)kc[0][0]) ; }
        if (MODE == 2) { if (__builtin_amdgcn_ballot_w64(R >= -160.f) == 0ull) break; }
        kb = kbn;
    }
#undef AT_ISSUE
    asm volatile("s_waitcnt vmcnt(0)" ::: "memory");
    if (MODE != 2) {
        l += __shfl_xor(l, 32);
        const float inv = 1.0f / l;
#pragma unroll
        for (int r = 0; r < 16; ++r) { O[0][r] *= inv; O[1][r] *= inv; }
        lse2 = m + __builtin_amdgcn_logf(l);
    }
}

__device__ __forceinline__ void store_o_bf16(const f32x16 (&O)[2], bf16_t* att_row  , int hh) {
#pragma unroll
    for (int db = 0; db < 2; ++db)
#pragma unroll
        for (int i = 0; i < 4; ++i) {
            u32x2 w; w.x = cvtpk(O[db][4 * i], O[db][4 * i + 1]); w.y = cvtpk(O[db][4 * i + 2], O[db][4 * i + 3]);
            *(u32x2*)(att_row + 32 * db + 8 * i + 4 * hh) = w;
        }
}

constexpr int LDS_FOXF = 90112;
__device__ __forceinline__ void fox_phase(const Args& a, unsigned char* lds_gen, LAS unsigned char* lds, int vwg, int G) {
    const int tid = otid();
    const bf16_t* qkv = (const bf16_t*)(a.ws + WS_QKV); bf16_t* att = (bf16_t*)(a.ws + WS_ATT);
    const float* locF = (const float*)(a.ws + WS_LOCF); const float* totF = (const float*)(a.ws + WS_TOTF);
    LAS float* Fs = (LAS float*)(lds + LDS_FOXF); LAS float* pre = Fs + 2048;
    for (int j = vwg; j < 256; j += G) {
        const int bh = j >> 1, b = bh >> 4, h = bh & 15;
        __syncthreads();
        if (tid < 64) {
            const float v = (tid < 32) ? totF[bh * 32 + tid] : 0.f; float s = v;
#pragma unroll
            for (int o = 1; o < 32; o <<= 1) { const float t2 = __shfl_up(s, o); if ((tid & 63) >= o) s += t2; }
            if (tid < 32) pre[tid] = s - v;
        }
        __syncthreads();
        for (int t = tid; t < 2048; t += NTHR) Fs[t] = locF[(size_t)bh * 2048 + t] + pre[t >> 6];
        __syncthreads();
        for (int ui = 0; ui < 4; ++ui) {
            const int u = (j & 1) ? ((ui < 2) ? 2 + ui : 7 - ui) : ((ui < 2) ? ui : 9 - ui);
            attn_body::attn_unit<8>(b, h, u, (const attn_body::bf16*)qkv, (const attn_body::bf16*)(qkv + 1024), (const attn_body::bf16*)(qkv + 2048), (attn_body::bf16*)att, (char*)lds_gen, Fs);
        }
    }
}

template <int PART>
__device__ __forceinline__ void even_attn_phase(const Args& a, LAS unsigned char* lds, int vwg, int G) {
    const int tid = otid(), lane = tid & 63, wave = __builtin_amdgcn_readfirstlane(tid >> 6), n = lane & 31, hh = lane >> 5;
    const bf16_t* qkv = (const bf16_t*)(a.ws + WS_QKV); bf16_t* att = (bf16_t*)(a.ws + WS_ATT);
    bf16_t* part = (bf16_t*)a.out;
    float* plse = (float*)(a.ws + WS_LSE);
    LAS unsigned char* vlds = lds + wave * VTILE;
    const LAS float* nof = (const LAS float*)lds;
    for (int j = vwg; j < 256; j += G) {
        const int bh = j >> 2, b = bh >> 3, hl = bh & 7, c = j & 3;
        if (PART & 1) { const bf16_t* base = qkv + (size_t)(b * SEQ) * QKV_LD + hl * 64;
          for (int ui = 0; ui < 2; ++ui) {
              const int u = ui ? 7 - c : c, qt = 8 * u + wave;
              f32x16 O[2]; float lse;
              attn_task<2>(base, base + 1024, base + 2048, (size_t)QKV_LD, 32 * qt, 0, qt, vlds, nof, O, lse);
              store_o_bf16(O, att + (size_t)(b * SEQ + 32 * qt + n) * DM + hl * 64, hh);
          } }
        if (!(PART & 2)) continue;
        const bf16_t* base = qkv + (size_t)(b * SEQ) * QKV_LD + (8 + hl) * 64;
        for (int p = 0; p < 2; ++p) {
            const int dil = p ? 4 : 1;
            for (int ti = 0; ti < 2; ++ti) {
                const int task = wave + 8 * ti;
                const int res = p ? (task & 3) : 0, tile = p ? (task >> 2) : task;
                const int q0 = (p ? 128 * c : 512 * c) + 32 * tile;
                const int kbh = q0 >> 5, kbl = kbh - 4 < 0 ? 0 : kbh - 4;
                const bf16_t* bp = base + (size_t)res * QKV_LD;
                f32x16 O[2]; float lse;
                attn_task<1>(bp, bp + 1024, bp + 2048, (size_t)dil * QKV_LD, q0, kbl, kbh, vlds, nof, O, lse);
                const int tok = res + dil * (q0 + n);
                if (PART & 4) continue;
                store_o_bf16(O, part + ((size_t)p * MTOK + (size_t)(b * SEQ + tok)) * 512 + hl * 64, hh);
                if (hh == 0) plse[((size_t)p * MTOK + (size_t)(b * SEQ + tok)) * 8 + hl] = lse;
            }
        }
        __syncthreads();
        for (int ti = 0; ti < 2; ++ti) {
            const int res = wave + 8 * ti, q0 = 32 * c;
            const bf16_t* bp = base + (size_t)res * QKV_LD;
            f32x16 O[2]; float lse3;
            attn_task<1>(bp, bp + 1024, bp + 2048, (size_t)16 * QKV_LD, q0, 0, c, vlds, nof, O, lse3);
            const int tok = res + 16 * (q0 + n); const size_t grow = (size_t)(b * SEQ + tok);
            if (PART & 4) { store_o_bf16(O, att + grow * DM + (8 + hl) * 64, hh); continue; }
            const float l1 = plse[grow * 8 + hl], l2 = plse[((size_t)MTOK + grow) * 8 + hl];
            const float mx = fmaxf(lse3, fmaxf(l1, l2));
            float w1 = __builtin_amdgcn_exp2f(l1 - mx), w2 = __builtin_amdgcn_exp2f(l2 - mx), w3 = __builtin_amdgcn_exp2f(lse3 - mx);
            const float inv = 1.0f / (w1 + w2 + w3); w1 *= inv; w2 *= inv; w3 *= inv;
            const bf16_t* p1 = part + grow * 512 + hl * 64; const bf16_t* p2 = part + ((size_t)MTOK + grow) * 512 + hl * 64;
#pragma unroll
            for (int db = 0; db < 2; ++db)
#pragma unroll
                for (int i = 0; i < 4; ++i) {
                    const u32x2 r1 = *(const u32x2*)(p1 + 32 * db + 8 * i + 4 * hh), r2 = *(const u32x2*)(p2 + 32 * db + 8 * i + 4 * hh);
                    const float a1[4] = {__uint_as_float(r1.x << 16), __uint_as_float(r1.x & 0xffff0000u), __uint_as_float(r1.y << 16), __uint_as_float(r1.y & 0xffff0000u)};
                    const float a2[4] = {__uint_as_float(r2.x << 16), __uint_as_float(r2.x & 0xffff0000u), __uint_as_float(r2.y << 16), __uint_as_float(r2.y & 0xffff0000u)};
#pragma unroll
                    for (int e = 0; e < 4; ++e) O[db][4 * i + e] = O[db][4 * i + e] * w3 + a1[e] * w1 + a2[e] * w2;
                }
            store_o_bf16(O, att + grow * DM + (8 + hl) * 64, hh);
        }
        __syncthreads();
    }
}

__device__ __forceinline__ void final_phase(const Args& a, int vwg, int G) {
    const int tid = otid(), lane = tid & 63, wave = tid >> 6;
    const bf16_t* xbf = (const bf16_t*)(a.ws + WS_XB); const float* rowss = (const float*)(a.ws + WS_ROWSS) + (size_t)8 * 16 * MTOK;
    const int gw = vwg * NWAVES + wave, NGW = G * NWAVES;
    f32x4 g[4];
#pragma unroll
    for (int j = 0; j < 4; ++j) g[j] = ((const f32x4*)a.norm_final)[lane + 64 * j];
    for (int m = gw; m < MTOK; m += NGW) {
        const float rs = pg8::rstd_of(rowss, m);
        const u32x2* xr = (const u32x2*)(xbf + (size_t)m * DM) + lane; f32x4* o = (f32x4*)(a.out + (size_t)m * DM) + lane;
#pragma unroll
        for (int j = 0; j < 4; ++j) { const u32x2 xw = xr[64 * j]; o[64 * j] = (f32x4){pg8::bf_lo(xw.x), pg8::bf_hi(xw.x), pg8::bf_lo(xw.y), pg8::bf_hi(xw.y)} * rs * g[j]; }
    }
}

#define XB_TMO      128
#define XB_XCNT(j)  (256  + 64 * (j))
#define XB_XSUB(j)  (1280 + 64 * (j))
#define XB_XGEN(j)  (2304 + 64 * (j))
#define XB_TOP      3328
#define XB_TOPGEN   3392
#define XCD_BAR_WORDS 3456
#define XB_SPIN_CAP (1u << 18)

__device__ __forceinline__ unsigned xb_ld(unsigned* p)              { return __hip_atomic_load(p, __ATOMIC_RELAXED, __HIP_MEMORY_SCOPE_AGENT); }
__device__ __forceinline__ unsigned xb_add(unsigned* p, unsigned v) { return __hip_atomic_fetch_add(p, v, __ATOMIC_RELAXED, __HIP_MEMORY_SCOPE_AGENT); }
__device__ __forceinline__ unsigned xb_xcc_id() { return (unsigned)__builtin_amdgcn_s_getreg((3 << 11) | 20) & 0xFu; }
#define XB_SPIN(cond, bar) do { unsigned _sp = 0; while (cond) { __builtin_amdgcn_s_sleep(1); \
    if ((++_sp & 255u) == 0u) { if (xb_ld(&(bar)[XB_TMO])) break; if (_sp > XB_SPIN_CAP) { atomicAdd(&(bar)[XB_TMO], 1u); break; } } } } while (0)

struct XcdBarrier {
    unsigned* bar; unsigned x;
    volatile LAS unsigned* st;
};

__device__ __forceinline__ XcdBarrier xcd_barrier_post(unsigned* bar, volatile LAS unsigned* st) {
    XcdBarrier b; b.bar = bar; b.x = xb_xcc_id(); b.st = st;
    if (threadIdx.x == 0) (void)xb_add(&bar[XB_XCNT(b.x)], 1u);
    return b;
}
__device__ __forceinline__ void xcd_barrier_complete(unsigned* bar, unsigned x, unsigned& nloc, unsigned& nx) {
    const unsigned G = gridDim.x * gridDim.y * gridDim.z;
    unsigned sum, cnt, mine, sp = 0u;
    for (;;) {
        sum = 0u; cnt = 0u; mine = 0u;
#pragma unroll
        for (unsigned j = 0; j < 16; ++j) { const unsigned c = xb_ld(&bar[XB_XCNT(j)]); sum += c; cnt += (c > 0u) ? 1u : 0u; mine = (j == x) ? c : mine; }
        if (sum == G) break;
        __builtin_amdgcn_s_sleep(1);
        if ((++sp & 255u) == 0u) { if (xb_ld(&bar[XB_TMO])) break; if (sp > XB_SPIN_CAP) { atomicAdd(&bar[XB_TMO], 1u); break; } }
    }
    nloc = mine > 0u ? mine : 1u; nx = cnt > 0u ? cnt : 1u;
}

__device__ __forceinline__ void xcd_barrier(const XcdBarrier& b) {
    asm volatile("s_waitcnt vmcnt(0)" ::: "memory");
    __syncthreads();
    if (threadIdx.x == 0) {
        unsigned* bar = b.bar;
        __builtin_amdgcn_s_waitcnt(0);
        unsigned nloc = b.st[0], nx = b.st[1];
        if (nloc == 0u) { xcd_barrier_complete(bar, b.x, nloc, nx); b.st[0] = nloc; b.st[1] = nx; }
        const unsigned old = xb_add(&bar[XB_XSUB(b.x)], 1u);
        const unsigned gen = old / nloc;
        if (old + 1u == (gen + 1u) * nloc) {
            __builtin_amdgcn_fence(__ATOMIC_RELEASE, "agent");
            asm volatile("s_waitcnt vmcnt(0)" ::: "memory");
            const unsigned og = xb_add(&bar[XB_TOP], 1u);
            const unsigned tg = og / nx;
            if (og + 1u == (tg + 1u) * nx) xb_add(&bar[XB_TOPGEN], 1u);
            else XB_SPIN(xb_ld(&bar[XB_TOPGEN]) == tg, bar);
            __builtin_amdgcn_fence(__ATOMIC_ACQUIRE, "agent");
            xb_add(&bar[XB_XGEN(b.x)], 1u);
            asm volatile("s_waitcnt vmcnt(0)" ::: "memory");
        } else {
            XB_SPIN(xb_ld(&bar[XB_XGEN(b.x)]) == gen, bar);
            __builtin_amdgcn_fence(__ATOMIC_ACQUIRE, "agent");
            asm volatile("s_waitcnt vmcnt(0)" ::: "memory");
        }
    }
    __syncthreads();
}

#ifndef DBG_EVEN
#define DBG_EVEN 0
#endif
#ifndef DBG_FOX
#define DBG_FOX 0
#endif
#ifndef REP_QKV
#define REP_QKV 1
#endif
#ifndef REP_FG
#define REP_FG 1
#endif
#ifndef REP_FFI
#define REP_FFI 1
#endif
#ifndef REP_PRO
#define REP_PRO 1
#endif
#ifndef REP_SYNC
#define REP_SYNC 1
#endif
#ifndef REP_FOX
#define REP_FOX 1
#endif
#ifndef REP_EVEN
#define REP_EVEN 1
#endif
__global__ void __launch_bounds__(NTHR, 2) fwd_kernel(Args a) {
    extern __shared__ __attribute__((aligned(16))) unsigned char lds_raw[];
    LAS unsigned char* lds = (LAS unsigned char*)lds_raw;
    cg::grid_group grid = cg::this_grid();
    const int G = gridDim.x, vwg = blockIdx.x;
    unsigned char* ws = a.ws;
    bf16_t* xb = (bf16_t*)(ws + WS_XB); float* xres = (float*)(ws + WS_XRES); bf16_t* qkv = (bf16_t*)(ws + WS_QKV); bf16_t* hid = (bf16_t*)(ws + WS_QKV);
    bf16_t* att = (bf16_t*)(ws + WS_ATT); float* rowss = (float*)(ws + WS_ROWSS); const float* rot = (const float*)(ws + WS_ROT);
    unsigned* barw = (unsigned*)(ws + WS_BAR);
    volatile LAS unsigned* bst = (volatile LAS unsigned*)(lds + LDS_MISC);
    if (threadIdx.x == 0) { bst[0] = 0u; bst[1] = 0u; }
    if (blockIdx.x == 0) { for (int i = threadIdx.x; i < 8192; i += NTHR) barw[i] = 0u; }
    __syncthreads();
    XcdBarrier bar; bar.bar = barw; bar.x = 0; bar.st = bst;
    const bool multi = (a.ph_hi - a.ph_lo) > 1;
    if (multi) { grid.sync(); bar = xcd_barrier_post(barw, bst); }
    for (int ph = a.ph_lo; ph < a.ph_hi; ++ph) {
        if (ph == 0) { for (int rep = 0; rep < REP_PRO; ++rep) { prologue(a, lds, vwg, G); __syncthreads(); } }
        else if (ph == NPHASE - 1) { if (!(FUSE_FINAL && G == 256)) final_phase(a, vwg, G); }
        else {
            const int l = (ph - 1) / 5, sp = (ph - 1) % 5;
            const bf16_t* wl = (const bf16_t*)(ws + WS_W + (size_t)l * SZ_WLAYER);
            const bf16_t* w_qkv = wl; const bf16_t* w_o = (const bf16_t*)((const unsigned char*)wl + SZ_WQKV);
            const bf16_t* w_in = (const bf16_t*)((const unsigned char*)wl + SZ_WQKV + SZ_WO); const bf16_t* w_out = (const bf16_t*)((const unsigned char*)wl + SZ_WQKV + SZ_WO + SZ_WI);
            if (sp == 0) {
                pg8::Gemm g{xb, w_qkv, MTOK, 3072, 1024}; pg8::StaticOrder S; S.init(MTOK, 3072, G, vwg);
                pg8::EpiQKV E{qkv, rowss + (size_t)(2 * l) * 16 * MTOK, rot, (l & 1) ? 0 : 1, (LAS float*)(lds + LDS_MISC + 1024)};
                for (int rep = 0; rep < REP_QKV; ++rep) { pg8::gemm_phase<pg8::EpiQKV, pg8::StaticOrder, true, true>(lds, g, S, E); __syncthreads(); }
                if (l & 1) { for (int rep = 0; rep < REP_FG; ++rep) { __syncthreads(); fgate_phase(a, l >> 1, lds, vwg, G); } }
            } else if (sp == 1) {
                if (l & 1) { fox_phase(a, lds_raw, lds, vwg, G); } else { if (DBG_EVEN) { even_attn_phase<DBG_EVEN>(a, lds, vwg, G); __syncthreads(); } even_attn_phase<3>(a, lds, vwg, G); }
            } else if (sp == 2) {
                pg8::Gemm g{att, w_o, MTOK, 1024, 1024}; pg8::StaticOrder S; S.init(MTOK, 1024, G, vwg);
                for (int rep = 0; rep < PROBE_OPROJ; ++rep) { pg8::EpiNull EN{a.out}; pg8::gemm_phase<pg8::EpiNull, pg8::StaticOrder, true, true>(lds, g, S, EN); __syncthreads(); }
                if (l == 0) { pg8::EpiResid<true> E{a.x, xb, rowss + (size_t)(2 * l + 1) * 16 * MTOK}; pg8::gemm_phase<pg8::EpiResid<true>, pg8::StaticOrder, true, true>(lds, g, S, E); }
                else { pg8::EpiResid<false> E{nullptr, xb, rowss + (size_t)(2 * l + 1) * 16 * MTOK}; pg8::gemm_phase<pg8::EpiResid<false>, pg8::StaticOrder, true, true>(lds, g, S, E); }
            } else if (sp == 3) {
                pg8::Gemm g{xb, w_in, MTOK, 5632, 1024}; pg8::StaticOrder S; S.init(MTOK, 5632, G, vwg);
                pg8::EpiSwiGLU E{hid, rowss + (size_t)(2 * l + 1) * 16 * MTOK, (LAS float*)(lds + LDS_MISC + 1024)};
                for (int rep = 0; rep < REP_FFI; ++rep) { pg8::gemm_phase<pg8::EpiSwiGLU, pg8::StaticOrder, true, true>(lds, g, S, E); __syncthreads(); }
                if (CONV_SPLIT && G == 256 && vwg >= 128 && l + 1 < NLAYER) { __syncthreads(); convert_weights(a, l + 1, l + 2, lds, (vwg - 128) * NWAVES + __builtin_amdgcn_readfirstlane((int)(threadIdx.x >> 6)), 128 * NWAVES); }
            } else {
                pg8::Gemm g{hid, w_out, MTOK, 1024, 2816}; pg8::StaticOrder S; S.init(MTOK, 1024, G, vwg);
                for (int rep = 0; rep < PROBE_FFO; ++rep) { pg8::EpiNull EN{a.out}; pg8::gemm_phase<pg8::EpiNull, pg8::StaticOrder, true, true>(lds, g, S, EN); __syncthreads(); }
                if (FUSE_FINAL && l == NLAYER - 1 && G == 256) {
                    pg8::EpiFinal E{xb, a.out, rowss + (size_t)8 * 16 * MTOK, a.norm_final, (unsigned*)(ws + WS_PCNT)};
                    pg8::gemm_phase<pg8::EpiFinal, pg8::StaticOrder, true, true>(lds, g, S, E);
                } else {
                    pg8::EpiResid<false> E{nullptr, xb, rowss + (size_t)(2 * l + 2) * 16 * MTOK};
                    pg8::gemm_phase<pg8::EpiResid<false>, pg8::StaticOrder, true, true>(lds, g, S, E);
                }
            }
        }
        if (ph + 1 < a.ph_hi && !(FUSE_FINAL && G == 256 && ph == NPHASE - 2)) {
            for (int rep = 0; rep < REP_SYNC; ++rep) xcd_barrier(bar);
        }
    }
}

#ifndef N_LAUNCH_MODE
#define N_LAUNCH_MODE 1
#endif

extern "C" void kernel_launch(void* const* d_in, const int* in_sizes, int n_in, void* d_out, int out_size, void* d_ws, size_t ws_size, hipStream_t stream) {
    static int grid = 0;
    if (grid == 0) {
        if (n_in != 11 || out_size != MTOK * DM || ws_size < WS_END) { fprintf(stderr, "kernel_launch: unexpected sizes n_in %d out %d ws %zu (need %zu)\n", n_in, out_size, ws_size, (size_t)WS_END); grid = -1; return; }
        int dev = 0, cus = 0, per_cu = 0;
        hipGetDevice(&dev); hipDeviceGetAttribute(&cus, hipDeviceAttributeMultiprocessorCount, dev);
        if (hipFuncSetAttribute((const void*)fwd_kernel, hipFuncAttributeMaxDynamicSharedMemorySize, LDS_BYTES) != hipSuccess) { fprintf(stderr, "kernel_launch: hipFuncSetAttribute failed\n"); grid = -1; return; }
        if (hipOccupancyMaxActiveBlocksPerMultiprocessor(&per_cu, (const void*)fwd_kernel, NTHR, LDS_BYTES) != hipSuccess || per_cu < 1) { fprintf(stderr, "kernel_launch: occupancy query says %d\n", per_cu); per_cu = 1; }
        (void)hipGetLastError();
        grid = cus * 1;
        fprintf(stderr, "kernel_launch: grid %d (cus %d, per_cu %d)\n", grid, cus, per_cu);
    }
    if (grid < 0) return;
    Args a{};
    a.x = (const float*)d_in[0]; a.norm_mix = (const float*)d_in[1]; a.w_qkv_even = (const float*)d_in[2]; a.w_o_even = (const float*)d_in[3];
    a.w_qkvf_odd = (const float*)d_in[4]; a.b_forget = (const float*)d_in[5]; a.w_o_odd = (const float*)d_in[6]; a.norm_ffn = (const float*)d_in[7];
    a.w_ffn_in = (const float*)d_in[8]; a.w_ffn_out = (const float*)d_in[9]; a.norm_final = (const float*)d_in[10];
    a.out = (float*)d_out; a.ws = (unsigned char*)d_ws;
#if N_LAUNCH_MODE == 1
    a.ph_lo = 0; a.ph_hi = NPHASE;
    void* args[] = {&a};
    hipError_t e = hipLaunchCooperativeKernel((const void*)fwd_kernel, dim3(grid), dim3(NTHR), args, LDS_BYTES, stream);
    if (e != hipSuccess) fprintf(stderr, "cooperative launch failed: %s (grid %d)\n", hipGetErrorString(e), grid);
#else
    for (int ph = 0; ph < NPHASE; ++ph) {
        a.ph_lo = ph; a.ph_hi = ph + 1;
        hipLaunchKernelGGL(fwd_kernel, dim3(grid), dim3(NTHR), LDS_BYTES, stream, a);
    }
#endif
}
```

```cpp
#include <hip/hip_runtime.h>
#include <hip/hip_cooperative_groups.h>
#include <cstdio>
#include <cstdint>
namespace cg = cooperative_groups;
namespace pg8 {
#define PG8_LAS __attribute__((address_space(3)))
typedef unsigned short bf16_t;
typedef short bf16x8 __attribute__((ext_vector_type(8)));
typedef float f32x4 __attribute__((ext_vector_type(4)));
typedef unsigned u32x4 __attribute__((ext_vector_type(4)));
constexpr int BM = 256, BK = 64, HALF = 128, HTB = HALF * BK * 2  , STAGE_BYTES = 8 * HTB, NXCD = 8, WGM = 8;

__host__ __device__ __forceinline__ int lds_byte(int r, int c) { const int st = (r >> 4) * 2 + (c >> 5), rr = r & 15, cc = c & 31, ob = rr * 64 + cc * 2; return st * 1024 + (ob ^ (((ob >> 9) & 1) << 5)); }
__host__ __device__ __forceinline__ void stage_rc(int b, int& R, int& C) { const int st = b / 1024, sb = b % 1024, swz = sb ^ (((sb >> 9) & 1) << 5); R = (st >> 1) * 16 + swz / 64; C = (st & 1) * 32 + (swz % 64) / 2; }
__host__ __device__ __forceinline__ int perm32(int rho) { const int n = rho >> 4, i = rho & 15; return 8 * (i >> 2) + 4 * n + (i & 3); }

struct Unit { int pm, pn; };
struct Gemm { const bf16_t* A; const bf16_t* Bt; int M, N, K; };

struct StaticOrder {
    int nM, nN, nwg, G, c;
    __host__ __device__ void init(int M, int N, int G_, int c_) { nM = M / BM; nN = N / BM; nwg = nM * nN; G = G_; c = c_; }
    __host__ __device__ bool next(int i, Unit& u) const {
        const long L = (long)i * G + c; if (L >= nwg) return false;
        int wgid = (int)L; { const int q = nwg / NXCD, r = nwg % NXCD, xcd = wgid % NXCD, off = wgid / NXCD; wgid = (xcd < r ? xcd * (q + 1) : r * (q + 1) + (xcd - r) * q) + off; }
        const int nig = WGM * nN, gid = wgid / nig, fm = gid * WGM, gsz = (nM - fm) < WGM ? (nM - fm) : WGM;
        u.pm = fm + ((wgid % nig) % gsz); u.pn = (wgid % nig) / gsz; return true;
    }
    __device__ __forceinline__ void a_ready(const Unit&) const {}
    __device__ __forceinline__ void done(const Unit&) const {}
};

__device__ __forceinline__ unsigned cvt_pk_bf16(float lo, float hi) { unsigned r; asm volatile("v_cvt_pk_bf16_f32 %0, %1, %2" : "=v"(r) : "v"(lo), "v"(hi)); return r; }
constexpr float RMS_EPS_F = 1e-5f;
constexpr int RS_M = 16384;
__device__ __forceinline__ float rstd_of(const float* rowss, int row) {
    float s = 0.f;
#pragma unroll
    for (int k = 0; k < 16; ++k) s += rowss[(size_t)k * RS_M + row];
    return 1.0f / sqrtf(s * (1.0f / 1024.0f) + RMS_EPS_F);
}

__device__ __forceinline__ void rstd_table(PG8_LAS float* rtab, const float* rowss, int pm) {
    const int t = threadIdx.x;
    if (t < 256) rtab[t] = rstd_of(rowss, pm * BM + t);
    asm volatile("s_waitcnt lgkmcnt(0)" ::: "memory"); __builtin_amdgcn_s_barrier(); asm volatile("" ::: "memory");
}

struct EpiQKV {
    static constexpr bool PERM = true, AFTER_DRAIN = false;
    bf16_t* O; const float* rowss; const float* rot; int rope; PG8_LAS float* rtab;
    __device__ __forceinline__ void operator()(const f32x4 (&acc)[2][2][4][2], const Unit& u, int wr, int wc, int fr, int fq) const {
        const int row0 = u.pm * BM + wr * 64 + fr;
        const int col0 = u.pn * BM + wc * 32 + 8 * fq;
        const bool rt = rope && ((u.pn & 2) != 0) && (u.pn < 8) && ((wc & 1) == 0);
        rstd_table(rtab, rowss, u.pm);
#pragma unroll
        for (int ai = 0; ai < 2; ++ai)
#pragma unroll
            for (int m = 0; m < 4; ++m) {
                const int row = row0 + ai * HALF + m * 16;
                const float rs = rtab[wr * 64 + fr + ai * HALF + m * 16];
                bf16_t* rowp = O + (size_t)row * 3072 + col0;
                f32x4 c0 = {1.f, 1.f, 1.f, 1.f}, c1 = c0, s0 = {0.f, 0.f, 0.f, 0.f}, s1 = s0;
                if (rt) { const f32x4* rp = (const f32x4*)(rot + (size_t)(row & 2047) * 16); c0 = rp[0]; c1 = rp[1]; s0 = rp[2]; s1 = rp[3]; }
#pragma unroll
                for (int bj = 0; bj < 2; ++bj) {
                    f32x4 v0 = acc[ai][bj][m][0] * rs, v1 = acc[ai][bj][m][1] * rs;
                    if (rt) {
                        f32x4 p0, p1;
#pragma unroll
                        for (int e = 0; e < 4; ++e) { p0[e] = __shfl_xor(v0[e], 16); p1[e] = __shfl_xor(v1[e], 16); }
                        if (fq == 0) { v0 = v0 * c0 - p0 * s0; v1 = v1 * c1 - p1 * s1; }
                        else if (fq == 1) { v0 = v0 * c0 + p0 * s0; v1 = v1 * c1 + p1 * s1; }
                    }
                    u32x4 w; w.x = cvt_pk_bf16(v0[0], v0[1]); w.y = cvt_pk_bf16(v0[2], v0[3]); w.z = cvt_pk_bf16(v1[0], v1[1]); w.w = cvt_pk_bf16(v1[2], v1[3]);
                    *(u32x4*)(rowp + bj * HALF) = w;
                }
            }
    }
};

__device__ __forceinline__ float bf_lo(unsigned u) { return __builtin_bit_cast(float, u << 16); }
__device__ __forceinline__ float bf_hi(unsigned u) { return __builtin_bit_cast(float, u & 0xffff0000u); }
template <bool XIN_F32> struct EpiResid {
    static constexpr bool PERM = true, AFTER_DRAIN = false;
    const float* xin32; bf16_t* xb; float* rowss_next;
    __device__ __forceinline__ void operator()(const f32x4 (&acc)[2][2][4][2], const Unit& u, int wr, int wc, int fr, int fq) const {
        const int row0 = u.pm * BM + wr * 64 + fr;
        const int col0 = u.pn * BM + wc * 32 + 8 * fq;
#pragma unroll
        for (int ai = 0; ai < 2; ++ai)
#pragma unroll
            for (int m = 0; m < 4; ++m) {
                const int row = row0 + ai * HALF + m * 16;
                float ss = 0.f;
#pragma unroll
                for (int bj = 0; bj < 2; ++bj) {
                    const size_t off = (size_t)row * 1024 + col0 + bj * HALF;
                    f32x4 a0, a1;
                    if (XIN_F32) { const f32x4* xi = (const f32x4*)(xin32 + off); a0 = xi[0]; a1 = xi[1]; }
                    else { const u32x4 xw = *(const u32x4*)(xb + off);
                           a0 = (f32x4){bf_lo(xw.x), bf_hi(xw.x), bf_lo(xw.y), bf_hi(xw.y)}; a1 = (f32x4){bf_lo(xw.z), bf_hi(xw.z), bf_lo(xw.w), bf_hi(xw.w)}; }
                    a0 = a0 + acc[ai][bj][m][0]; a1 = a1 + acc[ai][bj][m][1];
                    u32x4 w; w.x = cvt_pk_bf16(a0[0], a0[1]); w.y = cvt_pk_bf16(a0[2], a0[3]); w.z = cvt_pk_bf16(a1[0], a1[1]); w.w = cvt_pk_bf16(a1[2], a1[3]);
                    *(u32x4*)(xb + off) = w;
                    const float r0 = bf_lo(w.x), r1 = bf_hi(w.x), r2 = bf_lo(w.y), r3 = bf_hi(w.y), r4 = bf_lo(w.z), r5 = bf_hi(w.z), r6 = bf_lo(w.w), r7 = bf_hi(w.w);
                    ss += (r0 * r0 + r1 * r1) + (r2 * r2 + r3 * r3) + (r4 * r4 + r5 * r5) + (r6 * r6 + r7 * r7);
                }
                ss += __shfl_xor(ss, 16); ss += __shfl_xor(ss, 32);
                if (fq == 0) rowss_next[(size_t)(u.pn * 4 + wc) * RS_M + row] = ss;
            }
    }
};

struct EpiSwiGLU {
    static constexpr bool PERM = true, AFTER_DRAIN = false;
    bf16_t* H; const float* rowss; PG8_LAS float* rtab;
    __device__ __forceinline__ void operator()(const f32x4 (&acc)[2][2][4][2], const Unit& u, int wr, int wc, int fr, int fq) const {
        const int row0 = u.pm * BM + wr * 64 + fr;
        const int col0 = u.pn * HALF + wc * 32 + 8 * fq;
        rstd_table(rtab, rowss, u.pm);
#pragma unroll
        for (int ai = 0; ai < 2; ++ai)
#pragma unroll
            for (int m = 0; m < 4; ++m) {
                const int row = row0 + ai * HALF + m * 16;
                const float rs = rtab[wr * 64 + fr + ai * HALF + m * 16];
                float h[8];
#pragma unroll
                for (int n = 0; n < 2; ++n)
#pragma unroll
                    for (int e = 0; e < 4; ++e) {
                        const float g = acc[ai][0][m][n][e] * rs, up = acc[ai][1][m][n][e] * rs;
                        const float sg = g * __builtin_amdgcn_rcpf(1.0f + __builtin_amdgcn_exp2f(-1.4426950408889634f * g));
                        h[n * 4 + e] = sg * up;
                    }
                u32x4 w; w.x = cvt_pk_bf16(h[0], h[1]); w.y = cvt_pk_bf16(h[2], h[3]); w.z = cvt_pk_bf16(h[4], h[5]); w.w = cvt_pk_bf16(h[6], h[7]);
                *(u32x4*)(H + (size_t)row * 2816 + col0) = w;
            }
    }
};

struct EpiFinal {
    static constexpr bool PERM = true, AFTER_DRAIN = false;
    const bf16_t* xin; float* out; float* rowss_next; const float* gfin; unsigned* cnt;
    __device__ __forceinline__ void operator()(f32x4 (&acc)[2][2][4][2], const Unit& u, int wr, int wc, int fr, int fq) const {
        const int row0 = u.pm * BM + wr * 64 + fr;
        const int col0 = u.pn * BM + wc * 32 + 8 * fq;
#pragma unroll
        for (int ai = 0; ai < 2; ++ai)
#pragma unroll
            for (int m = 0; m < 4; ++m) {
                const int row = row0 + ai * HALF + m * 16;
                float ss = 0.f;
#pragma unroll
                for (int bj = 0; bj < 2; ++bj) {
                    const u32x4 xw = *(const u32x4*)(xin + (size_t)row * 1024 + col0 + bj * HALF);
                    const f32x4 a0 = (f32x4){bf_lo(xw.x), bf_hi(xw.x), bf_lo(xw.y), bf_hi(xw.y)} + acc[ai][bj][m][0], a1 = (f32x4){bf_lo(xw.z), bf_hi(xw.z), bf_lo(xw.w), bf_hi(xw.w)} + acc[ai][bj][m][1];
                    acc[ai][bj][m][0] = a0; acc[ai][bj][m][1] = a1;
                    ss += (a0[0] * a0[0] + a0[1] * a0[1]) + (a0[2] * a0[2] + a0[3] * a0[3]) + (a1[0] * a1[0] + a1[1] * a1[1]) + (a1[2] * a1[2] + a1[3] * a1[3]);
                }
                ss += __shfl_xor(ss, 16); ss += __shfl_xor(ss, 32);
                if (fq == 0) __hip_atomic_store(rowss_next + (size_t)(u.pn * 4 + wc) * RS_M + row, ss, __ATOMIC_RELAXED, __HIP_MEMORY_SCOPE_AGENT);
            }
        asm volatile("s_waitcnt vmcnt(0)" ::: "memory");
        unsigned* c = cnt + 64 * u.pm;
        if ((threadIdx.x & 63) == 0) __hip_atomic_fetch_add(c, 1u, __ATOMIC_RELAXED, __HIP_MEMORY_SCOPE_AGENT);
        { unsigned sp = 0;
          while ((unsigned)__builtin_amdgcn_readfirstlane((int)__hip_atomic_load(c, __ATOMIC_RELAXED, __HIP_MEMORY_SCOPE_AGENT)) < 32u) { __builtin_amdgcn_s_sleep(1); if (++sp > (1u << 22)) break; } }
        __builtin_amdgcn_fence(__ATOMIC_ACQUIRE, "agent");
        f32x4 g0[2], g1[2];
#pragma unroll
        for (int bj = 0; bj < 2; ++bj) { const f32x4* gp = (const f32x4*)(gfin + col0 + bj * HALF); g0[bj] = gp[0]; g1[bj] = gp[1]; }
#pragma unroll
        for (int ai = 0; ai < 2; ++ai)
#pragma unroll
            for (int m = 0; m < 4; ++m) {
                const int row = row0 + ai * HALF + m * 16;
                float tot = 0.f;
#pragma unroll
                for (int k = 0; k < 16; ++k) tot += __hip_atomic_load(rowss_next + (size_t)k * RS_M + row, __ATOMIC_RELAXED, __HIP_MEMORY_SCOPE_AGENT);
                const float rs = 1.0f / sqrtf(tot * (1.0f / 1024.0f) + RMS_EPS_F);
#pragma unroll
                for (int bj = 0; bj < 2; ++bj) {
                    f32x4* o = (f32x4*)(out + (size_t)row * 1024 + col0 + bj * HALF);
                    o[0] = acc[ai][bj][m][0] * rs * g0[bj]; o[1] = acc[ai][bj][m][1] * rs * g1[bj];
                }
            }
    }
};

struct EpiNull {
    static constexpr bool PERM = true, AFTER_DRAIN = false;
    float* sink;
    __device__ __forceinline__ void operator()(const f32x4 (&acc)[2][2][4][2], const Unit& u, int wr, int wc, int fr, int fq) const {
        if (u.pm < 0) {
#pragma unroll
            for (int ai = 0; ai < 2; ++ai)
#pragma unroll
                for (int m = 0; m < 4; ++m)
#pragma unroll
                    for (int bj = 0; bj < 2; ++bj) { f32x4* o = (f32x4*)(sink + (size_t)(ai * 8 + m * 2 + bj) * 8 + fr); o[0] = acc[ai][bj][m][0]; o[1] = acc[ai][bj][m][1]; }
        }
    }
};

template <class Epi, class Sched, bool ALIGN_EPI = false, bool SP2 = false>
__device__ __forceinline__ void gemm_phase(PG8_LAS unsigned char* lds, const Gemm g, const Sched& S, const Epi& E) {
    int tid_ = threadIdx.x; asm volatile("" : "+v"(tid_));
    const int tid = tid_, wid = __builtin_amdgcn_readfirstlane(tid >> 6), lane = tid & 63, wr = wid >> 2, wc = wid & 3, fr = lane & 15, fq = lane >> 4;
    const int K = g.K, nt = K / BK;
    unsigned voffA[2], voffB[2];
#pragma unroll
    for (int i = 0; i < 2; ++i) { int R, C; stage_rc(tid * 16 + i * 8192, R, C); const int Rb = Epi::PERM ? ((R & ~31) + perm32(R & 31)) : R;
        voffA[i] = (unsigned)(R * K + C) * 2u; voffB[i] = (unsigned)(Rb * K + C) * 2u; }
    const size_t kstep = (size_t)(BK * 2);
    const size_t hstep = (size_t)HALF * K * 2;
    const size_t tstep = 2 * hstep;
    const unsigned ldsw = (unsigned)wid * 1024u;
    const int aoff = lds_byte(wr * 64 + fr, fq * 8), boff = lds_byte(wc * 32 + fr, fq * 8);
#define PG8_SA(b, h) (((b) * 2 + (h)) * HTB)
#define PG8_SB(b, h) ((4 + (b) * 2 + (h)) * HTB)
#define PG8_STAGE(bufoff, gbase, voff) do { _Pragma("unroll") for (int _i = 0; _i < 2; ++_i) \
        __builtin_amdgcn_global_load_lds((const unsigned*)((const char*)(gbase) + (voff)[_i]), (PG8_LAS unsigned*)(lds + (bufoff) + ldsw + _i * 8192), 16, 0, 0); } while (0)
#define PG8_LDA(dst, b, h) do { _Pragma("unroll") for (int m = 0; m < 4; ++m) _Pragma("unroll") for (int k = 0; k < 2; ++k) dst[m][k] = *(const PG8_LAS bf16x8*)(lds + PG8_SA(b, h) + aoff + m * 2048 + k * 1024); } while (0)
#define PG8_LDB(dst, b, h) do { _Pragma("unroll") for (int n = 0; n < 2; ++n) _Pragma("unroll") for (int k = 0; k < 2; ++k) dst[n][k] = *(const PG8_LAS bf16x8*)(lds + PG8_SB(b, h) + boff + n * 2048 + k * 1024); } while (0)
#define PG8_MMA(ai, bj, At, Bt) do { __builtin_amdgcn_s_setprio(1); _Pragma("unroll") for (int m = 0; m < 4; ++m) _Pragma("unroll") for (int n = 0; n < 2; ++n) _Pragma("unroll") for (int k = 0; k < 2; ++k) \
        acc[ai][bj][m][n] = __builtin_amdgcn_mfma_f32_16x16x32_bf16(Bt[n][k], At[m][k], acc[ai][bj][m][n], 0, 0, 0); __builtin_amdgcn_s_setprio(0); } while (0)
#define PG8_WAIT_V(n) asm volatile("s_waitcnt vmcnt(" #n ")" ::: "memory")
#define PG8_WAIT_L(n) asm volatile("s_waitcnt lgkmcnt(" #n ")" ::: "memory")
#define PG8_BAR __builtin_amdgcn_s_barrier()
#define PG8_SCHED __builtin_amdgcn_sched_barrier(0)
    Unit cur, nxt; int ui = 0;
    if (!S.next(0, cur)) return;
    f32x4 acc[2][2][4][2];
#pragma unroll
    for (int a = 0; a < 2; ++a)
#pragma unroll
        for (int b = 0; b < 2; ++b)
#pragma unroll
            for (int m = 0; m < 4; ++m)
#pragma unroll
                for (int n = 0; n < 2; ++n) acc[a][b][m][n] = (f32x4){0.f, 0.f, 0.f, 0.f};
    bf16x8 At[4][2], B0[2][2], B1[2][2];
    const char* cA = (const char*)g.A + (size_t)cur.pm * tstep; const char* cB = (const char*)g.Bt + (size_t)cur.pn * tstep;
    S.a_ready(cur);
    if constexpr (SP2) {
        PG8_STAGE(PG8_SB(0, 0), cB, voffB); PG8_STAGE(PG8_SB(0, 1), cB + hstep, voffB); PG8_STAGE(PG8_SA(0, 0), cA, voffA); PG8_STAGE(PG8_SA(0, 1), cA + hstep, voffA);
        if (wr == 1) PG8_BAR;
        PG8_WAIT_V(2); PG8_BAR;
        PG8_STAGE(PG8_SB(1, 0), cB + kstep, voffB); PG8_STAGE(PG8_SA(1, 0), cA + kstep, voffA); PG8_STAGE(PG8_SB(1, 1), cB + hstep + kstep, voffB);
        PG8_WAIT_V(6); PG8_BAR;
    } else {
        PG8_STAGE(PG8_SB(0, 0), cB, voffB); PG8_STAGE(PG8_SA(0, 0), cA, voffA); PG8_STAGE(PG8_SB(0, 1), cB + hstep, voffB); PG8_STAGE(PG8_SA(0, 1), cA + hstep, voffA);
        if (wr == 1) PG8_BAR;
        PG8_WAIT_V(4); PG8_BAR;
        PG8_STAGE(PG8_SB(1, 0), cB + kstep, voffB); PG8_STAGE(PG8_SA(1, 0), cA + kstep, voffA); PG8_STAGE(PG8_SB(1, 1), cB + hstep + kstep, voffB);
        PG8_WAIT_V(6); PG8_BAR;
    }
    for (;;) {
        const bool has_next = S.next(ui + 1, nxt);
        const char* nA = has_next ? (const char*)g.A + (size_t)nxt.pm * tstep : cA; const char* nB = has_next ? (const char*)g.Bt + (size_t)nxt.pn * tstep : cB;
        for (int t = 0; t < nt; t += 2) {
            const bool last = (t == nt - 2);
            const char* a1 = cA + (size_t)(t + 1) * kstep;
            const char* a2 = last ? nA : cA + (size_t)(t + 2) * kstep; const char* b2 = last ? nB : cB + (size_t)(t + 2) * kstep;
            const char* a3 = a2 + kstep; const char* b3 = b2 + kstep;
            if (last && has_next) S.a_ready(nxt);
            if constexpr (SP2) {
            PG8_LDB(B0, 0, 0); PG8_LDB(B1, 0, 1); PG8_SCHED; PG8_LDA(At, 0, 0); PG8_STAGE(PG8_SA(1, 1), a1 + hstep, voffA);
            PG8_WAIT_V(8); PG8_WAIT_L(0); PG8_BAR; PG8_MMA(0, 0, At, B0); PG8_MMA(0, 1, At, B1); PG8_BAR; PG8_SCHED;
            PG8_LDA(At, 0, 1); PG8_STAGE(PG8_SB(0, 0), b2, voffB); PG8_STAGE(PG8_SB(0, 1), b2 + hstep, voffB); PG8_STAGE(PG8_SA(0, 0), a2, voffA);
            PG8_WAIT_V(8); PG8_WAIT_L(0); PG8_BAR; PG8_MMA(1, 0, At, B0); PG8_MMA(1, 1, At, B1); PG8_BAR; PG8_SCHED;
            PG8_LDB(B0, 1, 0); PG8_LDB(B1, 1, 1); PG8_SCHED; PG8_LDA(At, 1, 0); PG8_STAGE(PG8_SA(0, 1), a2 + hstep, voffA);
            PG8_WAIT_V(8); PG8_WAIT_L(0); PG8_BAR; PG8_MMA(0, 0, At, B0); PG8_MMA(0, 1, At, B1); PG8_BAR; PG8_SCHED;
            PG8_LDA(At, 1, 1); PG8_STAGE(PG8_SB(1, 0), b3, voffB); PG8_STAGE(PG8_SB(1, 1), b3 + hstep, voffB); PG8_STAGE(PG8_SA(1, 0), a3, voffA);
            PG8_WAIT_V(8); PG8_WAIT_L(0); PG8_BAR; PG8_MMA(1, 0, At, B0); PG8_MMA(1, 1, At, B1); PG8_BAR; PG8_SCHED;
            } else {
            PG8_LDB(B0, 0, 0); PG8_SCHED; PG8_LDA(At, 0, 0); PG8_STAGE(PG8_SA(1, 1), a1 + hstep, voffA);
            PG8_WAIT_L(8); PG8_BAR; PG8_WAIT_L(0); PG8_MMA(0, 0, At, B0); PG8_BAR; PG8_SCHED;
            PG8_LDB(B1, 0, 1); PG8_STAGE(PG8_SB(0, 0), b2, voffB);
            PG8_BAR; PG8_WAIT_L(0); PG8_MMA(0, 1, At, B1); PG8_BAR;
            PG8_LDA(At, 0, 1); PG8_STAGE(PG8_SA(0, 0), a2, voffA);
            PG8_BAR; PG8_WAIT_L(0); PG8_MMA(1, 0, At, B0); PG8_BAR; PG8_SCHED;
            PG8_STAGE(PG8_SB(0, 1), b2 + hstep, voffB);
            PG8_WAIT_V(6); PG8_BAR; PG8_MMA(1, 1, At, B1); PG8_BAR;
            PG8_LDB(B0, 1, 0); PG8_SCHED; PG8_LDA(At, 1, 0); PG8_STAGE(PG8_SA(0, 1), a2 + hstep, voffA);
            PG8_WAIT_L(8); PG8_BAR; PG8_WAIT_L(0); PG8_MMA(0, 0, At, B0); PG8_BAR; PG8_SCHED;
            PG8_LDB(B1, 1, 1); PG8_STAGE(PG8_SB(1, 0), b3, voffB);
            PG8_BAR; PG8_WAIT_L(0); PG8_MMA(0, 1, At, B1); PG8_BAR;
            PG8_LDA(At, 1, 1); PG8_STAGE(PG8_SA(1, 0), a3, voffA);
            PG8_BAR; PG8_WAIT_L(0); PG8_MMA(1, 0, At, B0); PG8_BAR; PG8_SCHED;
            PG8_STAGE(PG8_SB(1, 1), b3 + hstep, voffB);
            PG8_WAIT_V(6); PG8_BAR; PG8_MMA(1, 1, At, B1); PG8_BAR;
            }
        }
        if constexpr (ALIGN_EPI) { if (wr == 0) PG8_BAR; }
        if constexpr (!Epi::AFTER_DRAIN) { E(acc, cur, wr, wc, fr, fq); S.done(cur); }
        if (!has_next) break;
#pragma unroll
        for (int a = 0; a < 2; ++a)
#pragma unroll
            for (int b = 0; b < 2; ++b)
#pragma unroll
                for (int m = 0; m < 4; ++m)
#pragma unroll
                    for (int n = 0; n < 2; ++n) acc[a][b][m][n] = (f32x4){0.f, 0.f, 0.f, 0.f};
        cur = nxt; cA = nA; cB = nB; ++ui;
        if constexpr (ALIGN_EPI) { if (wr == 1) PG8_BAR; }
    }
    PG8_WAIT_V(0);
    if constexpr (!ALIGN_EPI) { if (wr == 0) PG8_BAR; }
    PG8_BAR;
    if constexpr (Epi::AFTER_DRAIN) { E.fused(acc, cur, wr, wc, fr, fq, lds, wid, lane); S.done(cur); }
#undef PG8_SA
#undef PG8_SB
#undef PG8_STAGE
#undef PG8_LDA
#undef PG8_LDB
#undef PG8_MMA
#undef PG8_WAIT_V
#undef PG8_WAIT_L
#undef PG8_BAR
#undef PG8_SCHED
}
}
#include <hip/hip_bf16.h>
#include <cmath>
namespace attn_body {
using bf16=__hip_bfloat16;
using bf16x8=__attribute__((ext_vector_type(8)))short;
using s16x4=__attribute__((ext_vector_type(4)))short;
using f32x16=__attribute__((ext_vector_type(16)))float;
using u32x4=__attribute__((ext_vector_type(4)))unsigned;
using f32x4_t=__attribute__((ext_vector_type(4)))float;
constexpr int BATCH=8,NHEAD=16,SEQ=2048,D=64,DM=3072,DMO=1024;
constexpr int NW=8,QBLK=32,QB=QBLK*NW,KVBLK=64,NQB=SEQ/QB;
constexpr int ATTN_PITCH=DM, ATTN_UNIT_ROWS=QB;
__device__ __forceinline__ int crow(int r,int hi){return (r&3)+8*(r>>2)+4*hi;}
#define SBAR() __builtin_amdgcn_sched_barrier(0)
__device__ __forceinline__ void cmask(f32x16&p0,f32x16&p1,int jb,int qrel,int hi){
  const float NEG=-INFINITY; int kb=64*jb+4*hi;
  #pragma unroll
  for(int r=0;r<16;++r){int kv=kb+(r&3)+8*(r>>2); if(kv>qrel)p0[r]=NEG; if(kv+32>qrel)p1[r]=NEG;}
}

constexpr int NSLOT=3, SLOTB=8192;
constexpr int LDS_K=0, LDS_V=NSLOT*SLOTB, LDS_WS=2*NSLOT*SLOTB, LDS_OST=LDS_WS+NW*64*4, LDS_BYTES=LDS_OST+NW*4096;
constexpr float C2=0.125f*1.4426950408889634f;
__device__ __forceinline__ void glds16(const void*gsrc,unsigned lds_dst){unsigned keep;
  asm volatile("s_mov_b32 %0, m0\n\ts_mov_b32 m0, %2\n\ts_nop 0\n\tglobal_load_lds_dwordx4 %1, off\n\ts_mov_b32 m0, %0":"=&s"(keep):"v"(gsrc),"s"(lds_dst):"memory");}
__device__ __forceinline__ float max3f(float a,float b,float c){float r;asm("v_max3_f32 %0, %1, %2, %3":"=v"(r):"v"(a),"v"(b),"v"(c));return r;}
__device__ __forceinline__ float max2f(float a,float b){float r;asm("v_max_f32_e32 %0, %1, %2":"=v"(r):"v"(a),"v"(b));return r;}
__device__ __forceinline__ float fadd_s(float a,float b){float r;asm("v_add_f32_e32 %0, %1, %2":"=v"(r):"v"(a),"v"(b));return r;}
__device__ __forceinline__ float fsub_s(float a,float b){float r;asm("v_sub_f32_e32 %0, %1, %2":"=v"(r):"v"(a),"v"(b));return r;}
typedef float f32x2_t __attribute__((ext_vector_type(2))); typedef __bf16 bf16x2_t __attribute__((ext_vector_type(2)));
__device__ __forceinline__ unsigned cvtpk_s(float lo,float hi){f32x2_t v={lo,hi};bf16x2_t b=__builtin_convertvector(v,bf16x2_t);return __builtin_bit_cast(unsigned,b);}
#define WAIT_BAR(N) asm volatile("s_waitcnt vmcnt(" #N ") lgkmcnt(0)\n\ts_barrier":::"memory")

__device__ __forceinline__ void qkt(f32x16&p0,f32x16&p1,const char*Kslot,const bf16x8*qr,int r32,int hi){
  const char*kb=Kslot+hi*1024+r32*16;
  #pragma unroll
  for(int d0=0;d0<4;++d0){
    const bf16x8 b0=*reinterpret_cast<const bf16x8*>(kb+d0*2048);
    const bf16x8 b1=*reinterpret_cast<const bf16x8*>(kb+d0*2048+512);
    p0=__builtin_amdgcn_mfma_f32_32x32x16_bf16(b0,qr[d0],p0,0,0,0);p1=__builtin_amdgcn_mfma_f32_32x32x16_bf16(b1,qr[d0],p1,0,0,0);}
}
typedef __attribute__((address_space(3))) const char* lds_cptr;
typedef short v4i16_t __attribute__((ext_vector_type(4)));
__device__ __forceinline__ void kload8(bf16x8*kf,lds_cptr kp){
  kf[0]=*(const __attribute__((address_space(3))) bf16x8*)(kp);      kf[1]=*(const __attribute__((address_space(3))) bf16x8*)(kp+512);
  kf[2]=*(const __attribute__((address_space(3))) bf16x8*)(kp+2048); kf[3]=*(const __attribute__((address_space(3))) bf16x8*)(kp+2560);
  kf[4]=*(const __attribute__((address_space(3))) bf16x8*)(kp+4096); kf[5]=*(const __attribute__((address_space(3))) bf16x8*)(kp+4608);
  kf[6]=*(const __attribute__((address_space(3))) bf16x8*)(kp+6144); kf[7]=*(const __attribute__((address_space(3))) bf16x8*)(kp+6656);
}
__device__ __forceinline__ void kload2(bf16x8*kf,lds_cptr kp,int j){ kf[2*j]=*(const __attribute__((address_space(3))) bf16x8*)(kp+j*2048); kf[2*j+1]=*(const __attribute__((address_space(3))) bf16x8*)(kp+j*2048+512); }
__device__ __forceinline__ s16x4 vtr(lds_cptr p){ return __builtin_bit_cast(s16x4,__builtin_amdgcn_ds_read_tr16_b64_v4i16((__attribute__((address_space(3))) v4i16_t*)p)); }
__device__ __forceinline__ float rowmax(const f32x16&p0,const f32x16&p1){
  float a=max3f(p0[0],p0[1],p1[0]),b=max3f(p0[2],p0[3],p1[1]);a=max3f(a,p1[2],p1[3]);
  #pragma unroll
  for(int r=4;r<16;r+=4){a=max3f(a,p0[r],p0[r+1]);b=max3f(b,p0[r+2],p0[r+3]);a=max3f(a,p1[r],p1[r+1]);b=max3f(b,p1[r+2],p1[r+3]);}
  const float m=max2f(a,b);
  auto rr=__builtin_amdgcn_permlane32_swap(__float_as_uint(m),__float_as_uint(m),false,false);
  return max2f(__uint_as_float(rr[0]),__uint_as_float(rr[1]));
}
__device__ __forceinline__ void pv(f32x16*o,int vb,bf16x8 pa0,bf16x8 pa1,bf16x8 pa2,bf16x8 pa3){
  #pragma unroll
  for(int d0=0;d0<2;++d0){s16x4 lo[4],hi[4];
    #pragma unroll
    for(int ks=0;ks<4;++ks){
      asm volatile("ds_read_b64_tr_b16 %0,%1 offset:%c2":"=&v"(lo[ks]):"v"(vb),"i"(d0*4096+ks*1024):"memory");
      asm volatile("ds_read_b64_tr_b16 %0,%1 offset:%c2":"=&v"(hi[ks]):"v"(vb),"i"(d0*4096+ks*1024+512):"memory");}
    asm volatile("s_waitcnt lgkmcnt(0)":::"memory");SBAR();
    #define PK(k) (bf16x8){lo[k][0],lo[k][1],lo[k][2],lo[k][3],hi[k][0],hi[k][1],hi[k][2],hi[k][3]}
    o[d0]=__builtin_amdgcn_mfma_f32_32x32x16_bf16(pa0,PK(0),o[d0],0,0,0);
    o[d0]=__builtin_amdgcn_mfma_f32_32x32x16_bf16(pa1,PK(1),o[d0],0,0,0);
    o[d0]=__builtin_amdgcn_mfma_f32_32x32x16_bf16(pa2,PK(2),o[d0],0,0,0);
    o[d0]=__builtin_amdgcn_mfma_f32_32x32x16_bf16(pa3,PK(3),o[d0],0,0,0);
    #undef PK
  }
}

#ifndef ATTN_STORE16
#define ATTN_STORE16(p,v) (*(u32x4*)(p)=(v))
#endif
template<int THRL> __device__ __forceinline__ void attn_unit(int b,int h,int qb,const bf16*Q,const bf16*__restrict__ K,const bf16*__restrict__ V,bf16*O,char*shm,const __attribute__((address_space(3))) float*Fs){
  int tid_=threadIdx.x; asm volatile("":"+v"(tid_)); const int tid=tid_,lane=tid&63,r32=lane&31,hi=lane>>5;   const int wid=__builtin_amdgcn_readfirstlane(tid>>6);
  const long rowbase=(long)b*SEQ; const int q0=qb*QB;
  const bf16*Qw=Q+(rowbase+q0+wid*QBLK)*DM+h*D;
  const bf16*Kh=K+rowbase*DM+h*D,*Vh=V+rowbase*DM+h*D;
  const unsigned lds0=(unsigned)(uintptr_t)shm;
  float*wsf=(float*)(shm+LDS_WS)+wid*64;
  const bf16*ksrc=Kh+(long)lane*DM+wid*8;
  const bf16*vsrc=Vh+(long)(16*(wid&3)+(lane>>2))*DM+(wid>>2)*32+(lane&3)*8;
  const unsigned kdst=lds0+LDS_K+wid*1024, vdst=lds0+LDS_V+wid*1024;
  #define DMA_K(t,slot) glds16(ksrc+(long)(t)*KVBLK*DM,(unsigned)__builtin_amdgcn_readfirstlane(kdst+(slot)))
  #define DMA_V(t,slot) glds16(vsrc+(long)(t)*KVBLK*DM,(unsigned)__builtin_amdgcn_readfirstlane(vdst+(slot)))
  const int vb0=(int)(lds0+LDS_V)+((lane>>4)&1)*32+(lane&3)*8+(4*hi+((lane&15)>>2))*64;
  const char*Kbase=shm+LDS_K; bf16x8 kf[8];
  const lds_cptr shm3=(lds_cptr)shm; const lds_cptr kp0=shm3+LDS_K+hi*1024+r32*16; const lds_cptr vp0=shm3+LDS_V+((lane>>4)&1)*32+(lane&3)*8+(4*hi+((lane&15)>>2))*64;
  const int NT=(q0+QB)/KVBLK;
  DMA_K(0,0);DMA_V(0,0);DMA_K(1,SLOTB);
  bf16x8 qr[4];
  #pragma unroll
  for(int d0=0;d0<4;++d0)qr[d0]=*reinterpret_cast<const bf16x8*>(&Qw[(long)r32*DM+d0*16+hi*8]);
  float mhat=0.f,l_reg=0.f;f32x16 o[2];o[0]=f32x16{};o[1]=f32x16{};
  const int qrel=wid*QBLK+r32;
  const float Fq=Fs[q0+qrel];
  #define BIAS(C0,C1,t) do{ const __attribute__((address_space(3))) f32x4_t*fk_=(const __attribute__((address_space(3))) f32x4_t*)(Fs+64*(t)+4*hi); const float fb_=Fq-mhat; \
    _Pragma("unroll") for(int g_=0;g_<4;++g_){ const f32x4_t a_=fk_[2*g_], b_=fk_[8+2*g_]; \
      _Pragma("unroll") for(int e_=0;e_<4;++e_){ C0[4*g_+e_]=fb_-a_[e_]; C1[4*g_+e_]=fb_-b_[e_]; } } }while(0)
  #define CMASK(P0,P1,t) do{int jb_=(t)-(NT-4); if(jb_>=0)cmask(P0,P1,jb_,qrel,hi);}while(0)
  bool resc=false;
  #define START(P0,P1) do{ const float rm=rowmax(P0,P1); resc=false; \
    { const float dl=rm; mhat=fadd_s(mhat,dl); \
      _Pragma("unroll") for(int r=0;r<16;++r){P0[r]=fsub_s(P0[r],dl);P1[r]=fsub_s(P1[r],dl);} \
      } \
    _Pragma("unroll") for(int r=0;r<16;++r)P0[r]=__builtin_amdgcn_exp2f(P0[r]); }while(0)
  #define RESC() do{ if(resc){ asm volatile("s_waitcnt lgkmcnt(0)":::"memory"); \
      _Pragma("unroll") for(int d_=0;d_<2;++d_) _Pragma("unroll") for(int r=0;r<16;++r)o[d_][r]*=wsf[crow(r,hi)]; } }while(0)
  f32x16 pA0,pA1,pB0,pB1;
  int sl_prev=0,sl_cur=0,sl_next=SLOTB;
  #define ROT() do{sl_prev=sl_cur;sl_cur=sl_next;sl_next=(sl_next==(NSLOT-1)*SLOTB)?0:sl_next+SLOTB;}while(0)
  DMA_K(2,2*SLOTB);
  WAIT_BAR(3);
  BIAS(pA0,pA1,0); qkt(pA0,pA1,Kbase,qr,r32,hi);asm volatile("s_nop 15\n\ts_nop 7":"+v"(pA0),"+v"(pA1));CMASK(pA0,pA1,0);
  START(pA0,pA1);
  _Pragma("unroll") for(int r=0;r<16;++r)pA1[r]=__builtin_amdgcn_exp2f(pA1[r]);
  WAIT_BAR(0);
  DMA_K(3,0);DMA_V(1,SLOTB);
  ROT();
  kload8(kf,kp0+sl_cur);
  WAIT_BAR(2);
  s16x4 vlo[8],vhi[8]; u32x4 pw0,pw1,pw2,pw3;
  #define PKW(P,B) cvtpk_s(P[B],P[B+1])
  #define PAF(k) __builtin_bit_cast(bf16x8,pw##k)
  #define VFR(i) (bf16x8){vlo[i][0],vlo[i][1],vlo[i][2],vlo[i][3],vhi[i][0],vhi[i][1],vhi[i][2],vhi[i][3]}
  #define PIN(x) asm volatile("":"+v"(x))
  #define MX3(a,b,c) __builtin_fmaxf(__builtin_fmaxf((a),(b)),(c))
  #define GAPA(MF,A0,A1,A2,A3,W0,W1,PW) do{ MF; sacc+=A0; sacc+=A1; sacc+=A2; sacc+=A3; PIN(sacc); W0; W1; PIN(PW); SBAR(); }while(0)
  #define EX(v) __builtin_amdgcn_exp2f(v)
  #define GAPB(MF,X,B,FS) do{ MF; X[B]=EX(X[B]); X[B+1]=EX(X[B+1]); X[B+2]=EX(X[B+2]); X[B+3]=EX(X[B+3]); PIN(X); FS; SBAR(); }while(0)
  #define FKLOAD(P0,P1,t) do{ const __attribute__((address_space(3))) f32x4_t*fk_=(const __attribute__((address_space(3))) f32x4_t*)(Fs+64*(t)+4*hi); \
    _Pragma("unroll") for(int g_=0;g_<4;++g_){ const f32x4_t a_=fk_[2*g_], b_=fk_[8+2*g_]; \
      _Pragma("unroll") for(int e_=0;e_<4;++e_){ P0[4*g_+e_]=a_[e_]; P1[4*g_+e_]=b_[e_]; } } }while(0)
  #define FSUB(G,P,B) do{ if(G){ P[B]=fb_-P[B]; P[B+1]=fb_-P[B+1]; P[B+2]=fb_-P[B+2]; P[B+3]=fb_-P[B+3]; PIN(P); } }while(0)
  #define VRD(i) do{ vlo[i]=vtr(vp_+(((i)>>2)*4096+((i)&3)*1024)); vhi[i]=vtr(vp_+(((i)>>2)*4096+((i)&3)*1024+512)); }while(0)
  #define KRD(G,j) do{ if(G){ kload2(kf,kp0+sl_next,j); SBAR(); } }while(0)
  #define STEP(C0,C1,P0,P1,t,GK,GV,GL) do{ SBAR(); \
    const lds_cptr vp_=vp0+sl_prev; \
    VRD(0); SBAR(); float sacc=(P0[0]+P0[1]); \
    GAPA(C0=__builtin_amdgcn_mfma_f32_32x32x16_bf16(kf[0],qr[0],C0,0,0,0), P0[2],P0[3],P0[4],P0[5],     pw0[0]=PKW(P0,0), pw0[1]=PKW(P0,2), pw0); \
    VRD(4); SBAR(); GAPA(C1=__builtin_amdgcn_mfma_f32_32x32x16_bf16(kf[1],qr[0],C1,0,0,0), P0[6],P0[7],P0[8],P0[9],     pw0[2]=PKW(P0,4), pw0[3]=PKW(P0,6), pw0); \
    VRD(1); SBAR(); GAPA(C0=__builtin_amdgcn_mfma_f32_32x32x16_bf16(kf[2],qr[1],C0,0,0,0),   P0[10],P0[11],P0[12],P0[13], pw1[0]=PKW(P0,8), pw1[1]=PKW(P0,10), pw1); \
    VRD(5); SBAR(); GAPA(C1=__builtin_amdgcn_mfma_f32_32x32x16_bf16(kf[3],qr[1],C1,0,0,0),   P0[14],P0[15],P1[0],P1[1],   pw1[2]=PKW(P0,12),pw1[3]=PKW(P0,14), pw1); \
    VRD(2); SBAR(); GAPA(C0=__builtin_amdgcn_mfma_f32_32x32x16_bf16(kf[4],qr[2],C0,0,0,0),   P1[2],P1[3],P1[4],P1[5],     pw2[0]=PKW(P1,0), pw2[1]=PKW(P1,2), pw2); \
    VRD(6); SBAR(); GAPA(C1=__builtin_amdgcn_mfma_f32_32x32x16_bf16(kf[5],qr[2],C1,0,0,0),   P1[6],P1[7],P1[8],P1[9],     pw2[2]=PKW(P1,4), pw2[3]=PKW(P1,6), pw2); \
    VRD(3); SBAR(); GAPA(C0=__builtin_amdgcn_mfma_f32_32x32x16_bf16(kf[6],qr[3],C0,0,0,0),   P1[10],P1[11],P1[12],P1[13], pw3[0]=PKW(P1,8), pw3[1]=PKW(P1,10), pw3); \
    VRD(7); SBAR(); GAPA(C1=__builtin_amdgcn_mfma_f32_32x32x16_bf16(kf[7],qr[3],C1,0,0,0),   P1[14],P1[15],0.f,0.f,       pw3[2]=PKW(P1,12),pw3[3]=PKW(P1,14), pw3); \
    l_reg+=sacc; \
    if(GK){DMA_K((t)+3,sl_cur);} if(GV){DMA_V((t)+1,sl_next);} \
    CMASK(C0,C1,t); \
    { float a=MX3(C0[0],C0[1],C1[0]),b=MX3(C0[2],C0[3],C1[1]); a=MX3(a,C1[2],C1[3]); \
      _Pragma("unroll") for(int r=4;r<16;r+=4){a=MX3(a,C0[r],C0[r+1]);b=MX3(b,C0[r+2],C0[r+3]);a=MX3(a,C1[r],C1[r+1]);b=MX3(b,C1[r+2],C1[r+3]);} \
      float rm=__builtin_fmaxf(a,b); { auto rr=__builtin_amdgcn_permlane32_swap(__float_as_uint(rm),__float_as_uint(rm),false,false); rm=__builtin_fmaxf(__uint_as_float(rr[0]),__uint_as_float(rr[1])); } \
      resc=false; \
      if(__builtin_expect(__any(rm>(float)THRL),0)){ const float dl=__builtin_fmaxf(rm,0.f); mhat+=dl; \
        _Pragma("unroll") for(int r=0;r<16;++r){C0[r]-=dl;C1[r]-=dl;} \
        const float f=__builtin_amdgcn_exp2f(-dl); l_reg*=f; if(hi==0)wsf[r32]=f; resc=true; } } \
    const float fb_=Fq-mhat; if(GL){ FKLOAD(P0,P1,(t)+1); } \
    SBAR(); \
    GAPB(o[0]=__builtin_amdgcn_mfma_f32_32x32x16_bf16(PAF(0),VFR(0),o[0],0,0,0), C0,0, FSUB(GL,P0,0)); \
    GAPB(o[1]=__builtin_amdgcn_mfma_f32_32x32x16_bf16(PAF(0),VFR(4),o[1],0,0,0), C0,4, FSUB(GL,P0,4)); \
    KRD(GL,0); GAPB(o[0]=__builtin_amdgcn_mfma_f32_32x32x16_bf16(PAF(1),VFR(1),o[0],0,0,0), C0,8, FSUB(GL,P0,8)); \
    KRD(GL,1); GAPB(o[1]=__builtin_amdgcn_mfma_f32_32x32x16_bf16(PAF(1),VFR(5),o[1],0,0,0), C0,12, FSUB(GL,P0,12)); \
    KRD(GL,2); GAPB(o[0]=__builtin_amdgcn_mfma_f32_32x32x16_bf16(PAF(2),VFR(2),o[0],0,0,0), C1,0, FSUB(GL,P1,0)); \
    KRD(GL,3); GAPB(o[1]=__builtin_amdgcn_mfma_f32_32x32x16_bf16(PAF(2),VFR(6),o[1],0,0,0), C1,4, FSUB(GL,P1,4)); \
    GAPB(o[0]=__builtin_amdgcn_mfma_f32_32x32x16_bf16(PAF(3),VFR(3),o[0],0,0,0), C1,8, FSUB(GL,P1,8)); \
    GAPB(o[1]=__builtin_amdgcn_mfma_f32_32x32x16_bf16(PAF(3),VFR(7),o[1],0,0,0), C1,12, FSUB(GL,P1,12)); \
    }while(0)
  BIAS(pB0,pB1,1);
  int t=1;
  #undef CMASK
  #define CMASK(P0,P1,t) do{}while(0)
  for(;t+5<NT;t+=2){
    STEP(pB0,pB1,pA0,pA1,t,true,true,true);     WAIT_BAR(2); RESC(); ROT();
    STEP(pA0,pA1,pB0,pB1,t+1,true,true,true);   WAIT_BAR(2); RESC(); ROT();
  }
  #undef CMASK
  #define CMASK(P0,P1,t) do{int jb_=(t)-(NT-4); if(jb_>=0)cmask(P0,P1,jb_,qrel,hi);}while(0)
  #define ENDW(tt) do{ if((tt)+3<NT){WAIT_BAR(2);} else if((tt)+2<NT){WAIT_BAR(1);} else {WAIT_BAR(0);} }while(0)
  for(;t+1<NT;t+=2){
    STEP(pB0,pB1,pA0,pA1,t,(t+3<NT),(t+1<NT),(t+1<NT));       ENDW(t);   RESC(); ROT();
    STEP(pA0,pA1,pB0,pB1,t+1,(t+4<NT),(t+2<NT),(t+2<NT));     ENDW(t+1); RESC(); ROT();
  }
  STEP(pB0,pB1,pA0,pA1,NT-1,false,false,false); RESC();
  { float sacc=pB0[0]+pB0[1]; _Pragma("unroll") for(int r=2;r<16;++r)sacc+=pB0[r]; _Pragma("unroll") for(int r=0;r<16;++r)sacc+=pB1[r]; l_reg+=sacc;
    pw0=(u32x4){PKW(pB0,0),PKW(pB0,2),PKW(pB0,4),PKW(pB0,6)};pw1=(u32x4){PKW(pB0,8),PKW(pB0,10),PKW(pB0,12),PKW(pB0,14)};pw2=(u32x4){PKW(pB1,0),PKW(pB1,2),PKW(pB1,4),PKW(pB1,6)};pw3=(u32x4){PKW(pB1,8),PKW(pB1,10),PKW(pB1,12),PKW(pB1,14)};
    SBAR(); pv(o,vb0+sl_cur,PAF(0),PAF(1),PAF(2),PAF(3)); }
  #undef PKW
  #undef PAF
  #undef VFR
  #undef PIN
  #undef MX3
  #undef GAPA
  #undef GAPB
  #undef EX
  #undef VRD
  #undef KRD
  #undef STEP
  #undef FKLOAD
  #undef FSUB
  #undef ENDW
  {auto rr=__builtin_amdgcn_permlane32_swap(__float_as_uint(l_reg),__float_as_uint(l_reg),false,false);l_reg=__uint_as_float(rr[0])+__uint_as_float(rr[1]);}
  if(hi==0)wsf[32+r32]=l_reg;asm volatile("s_waitcnt lgkmcnt(0)":::"memory");
  float rli[16];
  #pragma unroll
  for(int r=0;r<16;++r)rli[r]=__builtin_amdgcn_rcpf(wsf[32+crow(r,hi)]);
  bf16*Ow=O+(rowbase+q0+wid*QBLK)*DMO+h*D;
  { bf16*stg=(bf16*)(shm+LDS_OST)+wid*2048;
    #pragma unroll
    for(int r=0;r<16;++r){const int orow=crow(r,hi);
      #pragma unroll
      for(int d0=0;d0<2;++d0)stg[orow*64+d0*32+r32]=__float2bfloat16(o[d0][r]*rli[r]);}
    asm volatile("s_waitcnt lgkmcnt(0)":::"memory");
    #pragma unroll
    for(int i=0;i<4;++i){const int row=i*8+(lane>>3),ch=lane&7; const u32x4 v=*(const u32x4*)(stg+row*64+ch*8); ATTN_STORE16(Ow+(long)row*DMO+ch*8,v);} }
  asm volatile("s_waitcnt lgkmcnt(0)\n\ts_barrier":::"memory");
  #undef DMA_K
  #undef DMA_V
  #undef CMASK
  #undef START
  #undef RESC
  #undef ROT
  #undef BIAS
}
constexpr int ATTN_LDS_BYTES=LDS_BYTES;
#undef SBAR
#undef WAIT_BAR
}

#define LAS __attribute__((address_space(3)))
typedef unsigned short bf16_t;
typedef short bf16x8 __attribute__((ext_vector_type(8)));
typedef short s16x4 __attribute__((ext_vector_type(4)));
typedef float f32x4 __attribute__((ext_vector_type(4)));
typedef float f32x16 __attribute__((ext_vector_type(16)));
typedef unsigned u32x4 __attribute__((ext_vector_type(4)));
typedef unsigned u32x2 __attribute__((ext_vector_type(2)));

constexpr int NB = 8, SEQ = 2048, DM = 1024, MTOK = NB * SEQ, DFF = 2816, NLAYER = 4, QKV_LD = 3072;
constexpr int NWAVES = 8, NTHR = 512;
constexpr float LOG2E = 1.4426950408889634f;
constexpr int LDS_BYTES = 147456;
constexpr int VROW = 192;
constexpr int VTILE = 32 * VROW;
constexpr int LDS_F = 49152;
constexpr int NPHASE = 2 + 5 * NLAYER;
constexpr int LDS_MISC = 131072;

constexpr size_t MiB = 1u << 20;
constexpr size_t SZ_WQKV = (size_t)3072 * 1024 * 2, SZ_WO = (size_t)1024 * 1024 * 2, SZ_WI = (size_t)5632 * 1024 * 2, SZ_WOUT = (size_t)1024 * 2816 * 2;
constexpr size_t SZ_WLAYER = SZ_WQKV + SZ_WO + SZ_WI + SZ_WOUT;
constexpr size_t WS_W = 0;
constexpr size_t WS_XB = 104 * MiB;
constexpr size_t WS_XRES = WS_XB + 32 * MiB;
constexpr size_t WS_QKV = WS_XRES + 64 * MiB;
constexpr size_t WS_ATT = WS_QKV + 96 * MiB;
constexpr size_t WS_SMALL = WS_ATT + 32 * MiB;
constexpr size_t WS_ROWSS = WS_SMALL;
constexpr size_t WS_ROT = WS_ROWSS + (size_t)9 * 16 * MTOK * 4;
constexpr size_t WS_WF = WS_ROT + (size_t)2048 * 16 * 4;
constexpr size_t WS_LOCF = WS_WF + (size_t)2 * 16 * 1024 * 4;
constexpr size_t WS_TOTF = WS_LOCF + (size_t)128 * 2048 * 4;
constexpr size_t WS_LSE = WS_TOTF + (size_t)128 * 32 * 4;
constexpr size_t WS_BAR = WS_LSE + (size_t)2 * MTOK * 8 * 4;
constexpr size_t WS_PCNT = WS_BAR + 16384;
constexpr size_t WS_END = WS_PCNT + 16384;
static_assert(SZ_WLAYER * 4 <= 104 * MiB, "weights fit");

struct Args {
    const float* x; const float* norm_mix; const float* w_qkv_even; const float* w_o_even; const float* w_qkvf_odd; const float* b_forget; const float* w_o_odd;
    const float* norm_ffn; const float* w_ffn_in; const float* w_ffn_out; const float* norm_final;
    float* out; unsigned char* ws; int ph_lo, ph_hi;
};

__device__ __forceinline__ unsigned f2bf(float f) { unsigned u = __builtin_bit_cast(unsigned, f); return (u + 0x7fffu + ((u >> 16) & 1u)) >> 16; }
__device__ __forceinline__ unsigned pk2(float lo, float hi) { return f2bf(lo) | (f2bf(hi) << 16); }
__device__ __forceinline__ unsigned cvtpk(float lo, float hi) { unsigned r; asm volatile("v_cvt_pk_bf16_f32 %0, %1, %2" : "=v"(r) : "v"(lo), "v"(hi)); return r; }
__device__ __forceinline__ float wave_sum(float v) {
#pragma unroll
    for (int o = 1; o < 64; o <<= 1) v += __shfl_xor(v, o);
    return v;
}
#define LDS_WAIT() asm volatile("s_waitcnt lgkmcnt(0)" ::: "memory")
__device__ __forceinline__ int otid() { int t = threadIdx.x; asm volatile("" : "+v"(t)); return t; }

#ifndef PROBE_OPROJ
#define PROBE_OPROJ 0
#endif
#ifndef PROBE_FFO
#define PROBE_FFO 0
#endif
#ifndef FUSE_FINAL
#define FUSE_FINAL 1
#endif
#ifndef CONV_SPLIT
#define CONV_SPLIT 1
#endif
__device__ __forceinline__ void transpose_item(const float* W, int ldw, int K, int k0, int src_col, bf16_t* WT, int dst_row, const float* gain, float cscale, LAS float* scr, int lane) {
    const int kr = lane >> 3, c4 = lane & 7;
    f32x4 v[8]; float g[8];
#pragma unroll
    for (int i = 0; i < 8; ++i) { const int kk = 8 * i + kr; v[i] = *(const f32x4*)(W + (size_t)(k0 + kk) * ldw + src_col + 4 * c4); g[i] = gain ? gain[k0 + kk] * cscale : cscale; }
#pragma unroll
    for (int i = 0; i < 8; ++i) { const int kk = 8 * i + kr; LAS float* d = scr + kk * 33 + 4 * c4; d[0] = v[i].x * g[i]; d[1] = v[i].y * g[i]; d[2] = v[i].z * g[i]; d[3] = v[i].w * g[i]; }
    LDS_WAIT(); asm volatile("" ::: "memory");
    const int c = lane & 7;
#pragma unroll
    for (int j = 0; j < 4; ++j) { const int n = (lane >> 3) + 8 * j; const LAS float* s = scr + (8 * c) * 33 + n;
        u32x4 o; o.x = pk2(s[0 * 33], s[1 * 33]); o.y = pk2(s[2 * 33], s[3 * 33]); o.z = pk2(s[4 * 33], s[5 * 33]); o.w = pk2(s[6 * 33], s[7 * 33]);
        *(u32x4*)(WT + (size_t)(dst_row + n) * K + k0 + 8 * c) = o; }
    LDS_WAIT(); asm volatile("" ::: "memory");
}

__device__ __forceinline__ void convert_weights(const Args& a, int l_lo, int l_hi, LAS unsigned char* lds, int gw, int NGW) {
    const int tid = otid(), lane = tid & 63, wave = __builtin_amdgcn_readfirstlane(tid >> 6);
    LAS float* scr = (LAS float*)(lds + wave * 16384);
    constexpr int I_QKV = 16 * 96, I_O = 16 * 32, I_IN = 16 * 176, I_OUT = 44 * 32, I_LAYER = I_QKV + I_O + I_IN + I_OUT;
    for (int it = l_lo * I_LAYER + gw; it < l_hi * I_LAYER; it += NGW) {
        const int l = it / I_LAYER; int r = it % I_LAYER;
        bf16_t* wl = (bf16_t*)(a.ws + WS_W + (size_t)l * SZ_WLAYER);
        if (r < I_QKV) {
            const int kb = r / 96, nb = r % 96, n0 = 32 * nb;
            const float* W = (l & 1) ? a.w_qkvf_odd + (size_t)(l >> 1) * 1024 * 3088 : a.w_qkv_even + (size_t)(l >> 1) * 1024 * 3072;
            transpose_item(W, (l & 1) ? 3088 : 3072, 1024, 64 * kb, n0, wl, n0, a.norm_mix + l * 1024, n0 < 1024 ? 0.125f * LOG2E : 1.0f, scr, lane);
            continue; }
        r -= I_QKV;
        if (r < I_O) {
            const int kb = r / 32, nb = r % 32, n0 = 32 * nb;
            const float* W = (l & 1) ? a.w_o_odd + (size_t)(l >> 1) * 1024 * 1024 : a.w_o_even + (size_t)(l >> 1) * 1024 * 1024;
            transpose_item(W, 1024, 1024, 64 * kb, n0, (bf16_t*)((unsigned char*)wl + SZ_WQKV), n0, nullptr, 1.0f, scr, lane);
            continue; }
        r -= I_O;
        if (r < I_IN) {
            const int kb = r / 176, nb = r % 176, n0 = 32 * nb;
            const int pn = n0 >> 8, bj = (n0 >> 7) & 1, c0 = n0 & 127;
            transpose_item(a.w_ffn_in + (size_t)l * 1024 * 5632, 5632, 1024, 64 * kb, bj * 2816 + 128 * pn + c0, (bf16_t*)((unsigned char*)wl + SZ_WQKV + SZ_WO), n0, a.norm_ffn + l * 1024, 1.0f, scr, lane);
            continue; }
        r -= I_IN;
        {
            const int kb = r / 32, nb = r % 32, n0 = 32 * nb;
            transpose_item(a.w_ffn_out + (size_t)l * 2816 * 1024, 1024, 2816, 64 * kb, n0, (bf16_t*)((unsigned char*)wl + SZ_WQKV + SZ_WO + SZ_WI), n0, nullptr, 1.0f, scr, lane);
        }
    }
}

__device__ __forceinline__ void prologue(const Args& a, LAS unsigned char* lds, int vwg, int G) {
    const int tid = otid(), lane = tid & 63, wave = __builtin_amdgcn_readfirstlane(tid >> 6);
    const int gw = vwg * NWAVES + wave, NGW = G * NWAVES;
    convert_weights(a, 0, (CONV_SPLIT && G == 256) ? 1 : NLAYER, lds, gw, NGW);
    bf16_t* xb = (bf16_t*)(a.ws + WS_XB); float* rowss = (float*)(a.ws + WS_ROWSS);
    for (int m = gw; m < MTOK; m += NGW) {
        const f32x4* xr = (const f32x4*)(a.x + (size_t)m * DM) + lane; float s = 0.f; f32x4 v[4];
#pragma unroll
        for (int j = 0; j < 4; ++j) { v[j] = xr[64 * j]; s += (v[j].x * v[j].x + v[j].y * v[j].y) + (v[j].z * v[j].z + v[j].w * v[j].w); }
        s = wave_sum(s);
        unsigned long long* o8 = (unsigned long long*)(xb + (size_t)m * DM) + lane;
#pragma unroll
        for (int j = 0; j < 4; ++j) o8[64 * j] = (unsigned long long)pk2(v[j].x, v[j].y) | ((unsigned long long)pk2(v[j].z, v[j].w) << 32);
        if (lane < 16) rowss[(size_t)lane * MTOK + m] = (lane == 0) ? s : 0.f;
    }
    const int gt = vwg * NTHR + tid, NGT = G * NTHR;
    float* rot = (float*)(a.ws + WS_ROT);
    for (int i = gt; i < 2048 * 8; i += NGT) {
        const int pos = i >> 3, j = i & 7;
        const float invf[8] = {1.0f, 0.19392274474868576f, 0.03760603093086393f, 0.007292664737217109f, 0.001414213562373095f, 0.0002742481756762073f, 5.318295896944988e-05f, 1.031338537721246e-05f};
        float fq = invf[0];
#pragma unroll
        for (int t = 1; t < 8; ++t) fq = (j == t) ? invf[t] : fq;
        const float ang = (float)pos * fq;
        const double rev = (double)ang * 0.15915494309189535; const float fr = (float)(rev - floor(rev));
        rot[pos * 16 + j] = __builtin_amdgcn_cosf(fr); rot[pos * 16 + 8 + j] = __builtin_amdgcn_sinf(fr);
    }
    float* wf = (float*)(a.ws + WS_WF);
    for (int i = gt; i < 2 * 16 * 1024; i += NGT) {
        const int lo = i >> 14, hd = (i >> 10) & 15, k = i & 1023;
        wf[i] = a.w_qkvf_odd[(size_t)lo * 1024 * 3088 + (size_t)k * 3088 + 3072 + hd] * a.norm_mix[(2 * lo + 1) * 1024 + k];
    }
}

__device__ __forceinline__ void fgate_phase(const Args& a, int lo, LAS unsigned char* lds, int vwg, int G) {
    const int tid = otid(), lane = tid & 63, wave = __builtin_amdgcn_readfirstlane(tid >> 6);
    const bf16_t* xbq = (const bf16_t*)(a.ws + WS_XB); const float* rowss = (const float*)(a.ws + WS_ROWSS) + (size_t)(2 * (2 * lo + 1)) * 16 * MTOK;
    const float* wf = (const float*)(a.ws + WS_WF) + (size_t)lo * 16 * 1024;
    float* locF = (float*)(a.ws + WS_LOCF); float* totF = (float*)(a.ws + WS_TOTF);
    LAS float* lf = (LAS float*)lds;
    const int r16 = lane & 15, g4 = lane >> 4, tile = wave & 3, kh = wave >> 2;
    for (int j = vwg; j < 256; j += G) {
        const u32x2* xr = (const u32x2*)(xbq + (size_t)(64 * j + 16 * tile + r16) * DM + 512 * kh + 4 * g4);
        const f32x4* wr = (const f32x4*)(wf + (size_t)r16 * 1024 + 512 * kh + 4 * g4);
        f32x4 acc = {0.f, 0.f, 0.f, 0.f};
#pragma unroll 8
        for (int s = 0; s < 32; ++s) {
            const u32x2 xw = xr[4 * s]; const f32x4 wv = wr[4 * s];
            const f32x4 xv = {pg8::bf_lo(xw.x), pg8::bf_hi(xw.x), pg8::bf_lo(xw.y), pg8::bf_hi(xw.y)};
            acc = __builtin_amdgcn_mfma_f32_16x16x4f32(xv.x, wv.x, acc, 0, 0, 0);
            acc = __builtin_amdgcn_mfma_f32_16x16x4f32(xv.y, wv.y, acc, 0, 0, 0);
            acc = __builtin_amdgcn_mfma_f32_16x16x4f32(xv.z, wv.z, acc, 0, 0, 0);
            acc = __builtin_amdgcn_mfma_f32_16x16x4f32(xv.w, wv.w, acc, 0, 0, 0);
        }
#pragma unroll
        for (int jj = 0; jj < 4; ++jj) lf[(kh * 64 + 16 * tile + 4 * g4 + jj) * 16 + r16] = acc[jj];
        __syncthreads();
        float l2v[2];
#pragma unroll
        for (int q = 0; q < 2; ++q) {
            const int idx = tid + 512 * q, t = idx >> 4, hd = idx & 15;
            const float fl = (lf[idx] + lf[1024 + idx]) * pg8::rstd_of(rowss, 64 * j + t) + a.b_forget[lo * 16 + hd];
            const float z2 = fl * LOG2E; l2v[q] = -(fmaxf(-z2, 0.f) + __builtin_amdgcn_logf(1.0f + __builtin_amdgcn_exp2f(-fabsf(z2))));
        }
        __syncthreads();
        lf[tid] = l2v[0]; lf[tid + 512] = l2v[1];
        __syncthreads();
        if (tid < 16) {
            const int b = j >> 5, sl = j & 31; float run = 0.f; float* dst = locF + (size_t)(b * 16 + tid) * 2048 + sl * 64;
#pragma unroll 8
            for (int t = 0; t < 64; ++t) { run += lf[t * 16 + tid]; dst[t] = run; }
            totF[(b * 16 + tid) * 32 + sl] = run;
        }
        __syncthreads();
    }
}

__device__ __forceinline__ int phi32(int r) { return ((r >> 4) & 1) * 16 + ((r >> 2) & 1) * 8 + ((r >> 3) & 1) * 4 + (r & 3); }
__device__ __forceinline__ s16x4 vtr(const LAS unsigned char* p) { return __builtin_bit_cast(s16x4, __builtin_amdgcn_ds_read_tr16_b64_v4i16((LAS s16x4*)p)); }

template <int MODE, int DBG = 0>
__device__ __forceinline__ void attn_task(const bf16_t* qp, const bf16_t* kp, const bf16_t* vp, size_t rstride, int q0, int kb_lo, int kb_hi,
                                          LAS unsigned char* vlds, const LAS float* Fs, f32x16 (&O)[2], float& lse2) {
    const int lane = otid() & 63, n = lane & 31, hh = lane >> 5;
    bf16x8 qf[4];
    { const bf16_t* p = qp + (size_t)(q0 + n) * rstride + 8 * hh;
#pragma unroll
      for (int ks = 0; ks < 4; ++ks) qf[ks] = *(const bf16x8*)(p + 16 * ks); }
    const int qi = q0 + n;
    float Fq = 0.f; if (MODE == 0) Fq = Fs[qi];
#pragma unroll
    for (int r = 0; r < 16; ++r) { O[0][r] = 0.f; O[1][r] = 0.f; }
    float m = -1e30f, l = 0.f, R = 0.f;
    const bf16_t* kl = kp + (size_t)phi32(n) * rstride + 8 * hh;
    const bf16_t* vl = vp + (size_t)(lane >> 3) * rstride + 8 * (lane & 7);
    LAS unsigned char* vw = vlds + (lane >> 3) * VROW + (lane & 7) * 16;
    const LAS unsigned char* vr = vlds + (8 * hh + ((lane & 15) >> 2)) * VROW + (16 * ((lane >> 4) & 1) + 4 * (lane & 3)) * 2;
    bf16x8 kn[4]; u32x4 vn[4];
#define AT_ISSUE(kb) do { const bf16_t* kk_ = kl + (size_t)(kb) * 32 * rstride; const bf16_t* vv_ = vl + (size_t)(kb) * 32 * rstride; \
        _Pragma("unroll") for (int ks = 0; ks < 4; ++ks) kn[ks] = *(const bf16x8*)(kk_ + 16 * ks); \
        _Pragma("unroll") for (int ii = 0; ii < 4; ++ii) vn[ii] = *(const u32x4*)(vv_ + (size_t)(8 * ii) * rstride); } while (0)
    const int nblk = kb_hi - kb_lo + 1;
    int kb = (MODE == 2) ? kb_hi : kb_lo;
    AT_ISSUE(kb);
    for (int it = 0; it < nblk; ++it) {
        bf16x8 kc[4];
#pragma unroll
        for (int ks = 0; ks < 4; ++ks) kc[ks] = kn[ks];
        asm volatile("" ::: "memory");
#pragma unroll
        for (int ii = 0; ii < 4; ++ii) *(LAS u32x4*)(vw + ii * 8 * VROW) = vn[ii];
        asm volatile("" ::: "memory");
        const int kbn = (MODE == 2) ? kb - 1 : kb + 1;
        if (it + 1 < nblk && DBG != 1) AT_ISSUE(kbn);
        if (DBG != 2) {
        const int key0 = kb * 32 + 8 * hh;
        f32x16 s;
        if (MODE == 0) {
            const LAS f32x4* fk = (const LAS f32x4*)(Fs + key0);
            const f32x4 f0 = fk[0], f1 = fk[1], f2 = fk[4], f3 = fk[5];
#pragma unroll
            for (int e = 0; e < 4; ++e) { s[e] = Fq - f0[e]; s[4 + e] = Fq - f1[e]; s[8 + e] = Fq - f2[e]; s[12 + e] = Fq - f3[e]; }
        } else {
#pragma unroll
            for (int r = 0; r < 16; ++r) s[r] = 0.f;
        }
#pragma unroll
        for (int ks = 0; ks < 4; ++ks) s = __builtin_amdgcn_mfma_f32_32x32x16_bf16(kc[ks], qf[ks], s, 0, 0, 0);
        bf16x8 pb[2];
        if (MODE != 2) {
            const bool diag = (kb * 32 + 31 > q0);
            if (MODE == 1) {
                if (diag || kb * 32 < q0 - 97) {
#pragma unroll
                    for (int r = 0; r < 16; ++r) { const int ki = key0 + 16 * (r >> 3) + (r & 7); if (ki > qi || ki < qi - 128) s[r] = -1e30f; }
                }
            } else if (diag) {
#pragma unroll
                for (int r = 0; r < 16; ++r) { const int ki = key0 + 16 * (r >> 3) + (r & 7); if (ki > qi) s[r] = -1e30f; }
            }
            float bm = fmaxf(fmaxf(s[0], s[1]), fmaxf(s[2], s[3]));
#pragma unroll
            for (int r = 4; r < 16; r += 4) bm = fmaxf(bm, fmaxf(fmaxf(s[r], s[r + 1]), fmaxf(s[r + 2], s[r + 3])));
            bm = fmaxf(bm, __shfl_xor(bm, 32));
            const float mn = fmaxf(m, bm), alpha = __builtin_amdgcn_exp2f(m - mn); m = mn;
            float ps = 0.f;
#pragma unroll
            for (int r = 0; r < 16; ++r) { s[r] = __builtin_amdgcn_exp2f(s[r] - mn); ps += s[r]; }
            l = l * alpha + ps;
#pragma unroll
            for (int r = 0; r < 16; ++r) { O[0][r] *= alpha; O[1][r] *= alpha; }
        } else {
            const bool diag = (kb * 32 + 31 >= q0);
            float L[16];
#pragma unroll
            for (int r = 0; r < 16; ++r) {
                const float z = s[r], t = __builtin_amdgcn_exp2f(-fabsf(z)), sp = fmaxf(z, 0.f) + __builtin_amdgcn_logf(1.0f + t);
                L[r] = -sp; s[r] = z - sp;
            }
            if (diag) {
#pragma unroll
                for (int r = 0; r < 16; ++r) { const int ki = key0 + 16 * (r >> 3) + (r & 7); if (ki >= qi) { L[r] = 0.f; s[r] = -1e30f; } }
            }
            float sA = ((L[0] + L[1]) + (L[2] + L[3])) + ((L[4] + L[5]) + (L[6] + L[7]));
            float sB = ((L[8] + L[9]) + (L[10] + L[11])) + ((L[12] + L[13]) + (L[14] + L[15]));
            const float pA = __shfl_xor(sA, 32), pB = __shfl_xor(sB, 32);
            const float offA = sB + pB + (hh == 0 ? pA : 0.f), offB = (hh == 0 ? pB : 0.f);
            float run = R + offA;
#pragma unroll
            for (int e = 7; e >= 0; --e) { const float lr = L[e]; s[e] = __builtin_amdgcn_exp2f(s[e] + run); run += lr; }
            run = R + offB;
#pragma unroll
            for (int e = 15; e >= 8; --e) { const float lr = L[e]; s[e] = __builtin_amdgcn_exp2f(s[e] + run); run += lr; }
            R += (sA + sB) + (pA + pB);
        }
        { u32x4 w0, w1;
          w0.x = cvtpk(s[0], s[1]); w0.y = cvtpk(s[2], s[3]); w0.z = cvtpk(s[4], s[5]); w0.w = cvtpk(s[6], s[7]);
          w1.x = cvtpk(s[8], s[9]); w1.y = cvtpk(s[10], s[11]); w1.z = cvtpk(s[12], s[13]); w1.w = cvtpk(s[14], s[15]);
          pb[0] = __builtin_bit_cast(bf16x8, w0); pb[1] = __builtin_bit_cast(bf16x8, w1); }
        asm volatile("" ::: "memory");
#pragma unroll
        for (int db = 0; db < 2; ++db)
#pragma unroll
            for (int kk = 0; kk < 2; ++kk) {
                const s16x4 lo4 = vtr(vr + (16 * kk) * VROW + 64 * db), hi4 = vtr(vr + (16 * kk + 4) * VROW + 64 * db);
                const bf16x8 av = {lo4[0], lo4[1], lo4[2], lo4[3], hi4[0], hi4[1], hi4[2], hi4[3]};
                O[db] = __builtin_amdgcn_mfma_f32_32x32x16_bf16(av, pb[kk], O[db], 0, 0, 0);
            }
        asm volatile("s_waitcnt lgkmcnt(0)" ::: "memory");
        } else { asm volatile("s_waitcnt lgkmcnt(0)" ::: "memory"); O[0][0] += __builtin_bit_cast(float, (int)kc[0][0]) ; }
        if (MODE == 2) { if (__builtin_amdgcn_ballot_w64(R >= -160.f) == 0ull) break; }
        kb = kbn;
    }
#undef AT_ISSUE
    asm volatile("s_waitcnt vmcnt(0)" ::: "memory");
    if (MODE != 2) {
        l += __shfl_xor(l, 32);
        const float inv = 1.0f / l;
#pragma unroll
        for (int r = 0; r < 16; ++r) { O[0][r] *= inv; O[1][r] *= inv; }
        lse2 = m + __builtin_amdgcn_logf(l);
    }
}

__device__ __forceinline__ void store_o_bf16(const f32x16 (&O)[2], bf16_t* att_row  , int hh) {
#pragma unroll
    for (int db = 0; db < 2; ++db)
#pragma unroll
        for (int i = 0; i < 4; ++i) {
            u32x2 w; w.x = cvtpk(O[db][4 * i], O[db][4 * i + 1]); w.y = cvtpk(O[db][4 * i + 2], O[db][4 * i + 3]);
            *(u32x2*)(att_row + 32 * db + 8 * i + 4 * hh) = w;
        }
}

constexpr int LDS_FOXF = 90112;
__device__ __forceinline__ void fox_phase(const Args& a, unsigned char* lds_gen, LAS unsigned char* lds, int vwg, int G) {
    const int tid = otid();
    const bf16_t* qkv = (const bf16_t*)(a.ws + WS_QKV); bf16_t* att = (bf16_t*)(a.ws + WS_ATT);
    const float* locF = (const float*)(a.ws + WS_LOCF); const float* totF = (const float*)(a.ws + WS_TOTF);
    LAS float* Fs = (LAS float*)(lds + LDS_FOXF); LAS float* pre = Fs + 2048;
    for (int j = vwg; j < 256; j += G) {
        const int bh = j >> 1, b = bh >> 4, h = bh & 15;
        __syncthreads();
        if (tid < 64) {
            const float v = (tid < 32) ? totF[bh * 32 + tid] : 0.f; float s = v;
#pragma unroll
            for (int o = 1; o < 32; o <<= 1) { const float t2 = __shfl_up(s, o); if ((tid & 63) >= o) s += t2; }
            if (tid < 32) pre[tid] = s - v;
        }
        __syncthreads();
        for (int t = tid; t < 2048; t += NTHR) Fs[t] = locF[(size_t)bh * 2048 + t] + pre[t >> 6];
        __syncthreads();
        for (int ui = 0; ui < 4; ++ui) {
            const int u = (j & 1) ? ((ui < 2) ? 2 + ui : 7 - ui) : ((ui < 2) ? ui : 9 - ui);
            attn_body::attn_unit<8>(b, h, u, (const attn_body::bf16*)qkv, (const attn_body::bf16*)(qkv + 1024), (const attn_body::bf16*)(qkv + 2048), (attn_body::bf16*)att, (char*)lds_gen, Fs);
        }
    }
}

template <int PART>
__device__ __forceinline__ void even_attn_phase(const Args& a, LAS unsigned char* lds, int vwg, int G) {
    const int tid = otid(), lane = tid & 63, wave = __builtin_amdgcn_readfirstlane(tid >> 6), n = lane & 31, hh = lane >> 5;
    const bf16_t* qkv = (const bf16_t*)(a.ws + WS_QKV); bf16_t* att = (bf16_t*)(a.ws + WS_ATT);
    bf16_t* part = (bf16_t*)a.out;
    float* plse = (float*)(a.ws + WS_LSE);
    LAS unsigned char* vlds = lds + wave * VTILE;
    const LAS float* nof = (const LAS float*)lds;
    for (int j = vwg; j < 256; j += G) {
        const int bh = j >> 2, b = bh >> 3, hl = bh & 7, c = j & 3;
        if (PART & 1) { const bf16_t* base = qkv + (size_t)(b * SEQ) * QKV_LD + hl * 64;
          for (int ui = 0; ui < 2; ++ui) {
              const int u = ui ? 7 - c : c, qt = 8 * u + wave;
              f32x16 O[2]; float lse;
              attn_task<2>(base, base + 1024, base + 2048, (size_t)QKV_LD, 32 * qt, 0, qt, vlds, nof, O, lse);
              store_o_bf16(O, att + (size_t)(b * SEQ + 32 * qt + n) * DM + hl * 64, hh);
          } }
        if (!(PART & 2)) continue;
        const bf16_t* base = qkv + (size_t)(b * SEQ) * QKV_LD + (8 + hl) * 64;
        for (int p = 0; p < 2; ++p) {
            const int dil = p ? 4 : 1;
            for (int ti = 0; ti < 2; ++ti) {
                const int task = wave + 8 * ti;
                const int res = p ? (task & 3) : 0, tile = p ? (task >> 2) : task;
                const int q0 = (p ? 128 * c : 512 * c) + 32 * tile;
                const int kbh = q0 >> 5, kbl = kbh - 4 < 0 ? 0 : kbh - 4;
                const bf16_t* bp = base + (size_t)res * QKV_LD;
                f32x16 O[2]; float lse;
                attn_task<1>(bp, bp + 1024, bp + 2048, (size_t)dil * QKV_LD, q0, kbl, kbh, vlds, nof, O, lse);
                const int tok = res + dil * (q0 + n);
                if (PART & 4) continue;
                store_o_bf16(O, part + ((size_t)p * MTOK + (size_t)(b * SEQ + tok)) * 512 + hl * 64, hh);
                if (hh == 0) plse[((size_t)p * MTOK + (size_t)(b * SEQ + tok)) * 8 + hl] = lse;
            }
        }
        __syncthreads();
        for (int ti = 0; ti < 2; ++ti) {
            const int res = wave + 8 * ti, q0 = 32 * c;
            const bf16_t* bp = base + (size_t)res * QKV_LD;
            f32x16 O[2]; float lse3;
            attn_task<1>(bp, bp + 1024, bp + 2048, (size_t)16 * QKV_LD, q0, 0, c, vlds, nof, O, lse3);
            const int tok = res + 16 * (q0 + n); const size_t grow = (size_t)(b * SEQ + tok);
            if (PART & 4) { store_o_bf16(O, att + grow * DM + (8 + hl) * 64, hh); continue; }
            const float l1 = plse[grow * 8 + hl], l2 = plse[((size_t)MTOK + grow) * 8 + hl];
            const float mx = fmaxf(lse3, fmaxf(l1, l2));
            float w1 = __builtin_amdgcn_exp2f(l1 - mx), w2 = __builtin_amdgcn_exp2f(l2 - mx), w3 = __builtin_amdgcn_exp2f(lse3 - mx);
            const float inv = 1.0f / (w1 + w2 + w3); w1 *= inv; w2 *= inv; w3 *= inv;
            const bf16_t* p1 = part + grow * 512 + hl * 64; const bf16_t* p2 = part + ((size_t)MTOK + grow) * 512 + hl * 64;
#pragma unroll
            for (int db = 0; db < 2; ++db)
#pragma unroll
                for (int i = 0; i < 4; ++i) {
                    const u32x2 r1 = *(const u32x2*)(p1 + 32 * db + 8 * i + 4 * hh), r2 = *(const u32x2*)(p2 + 32 * db + 8 * i + 4 * hh);
                    const float a1[4] = {__uint_as_float(r1.x << 16), __uint_as_float(r1.x & 0xffff0000u), __uint_as_float(r1.y << 16), __uint_as_float(r1.y & 0xffff0000u)};
                    const float a2[4] = {__uint_as_float(r2.x << 16), __uint_as_float(r2.x & 0xffff0000u), __uint_as_float(r2.y << 16), __uint_as_float(r2.y & 0xffff0000u)};
#pragma unroll
                    for (int e = 0; e < 4; ++e) O[db][4 * i + e] = O[db][4 * i + e] * w3 + a1[e] * w1 + a2[e] * w2;
                }
            store_o_bf16(O, att + grow * DM + (8 + hl) * 64, hh);
        }
        __syncthreads();
    }
}

__device__ __forceinline__ void final_phase(const Args& a, int vwg, int G) {
    const int tid = otid(), lane = tid & 63, wave = tid >> 6;
    const bf16_t* xbf = (const bf16_t*)(a.ws + WS_XB); const float* rowss = (const float*)(a.ws + WS_ROWSS) + (size_t)8 * 16 * MTOK;
    const int gw = vwg * NWAVES + wave, NGW = G * NWAVES;
    f32x4 g[4];
#pragma unroll
    for (int j = 0; j < 4; ++j) g[j] = ((const f32x4*)a.norm_final)[lane + 64 * j];
    for (int m = gw; m < MTOK; m += NGW) {
        const float rs = pg8::rstd_of(rowss, m);
        const u32x2* xr = (const u32x2*)(xbf + (size_t)m * DM) + lane; f32x4* o = (f32x4*)(a.out + (size_t)m * DM) + lane;
#pragma unroll
        for (int j = 0; j < 4; ++j) { const u32x2 xw = xr[64 * j]; o[64 * j] = (f32x4){pg8::bf_lo(xw.x), pg8::bf_hi(xw.x), pg8::bf_lo(xw.y), pg8::bf_hi(xw.y)} * rs * g[j]; }
    }
}

#define XB_TMO      128
#define XB_XCNT(j)  (256  + 64 * (j))
#define XB_XSUB(j)  (1280 + 64 * (j))
#define XB_XGEN(j)  (2304 + 64 * (j))
#define XB_TOP      3328
#define XB_TOPGEN   3392
#define XCD_BAR_WORDS 3456
#define XB_SPIN_CAP (1u << 18)

__device__ __forceinline__ unsigned xb_ld(unsigned* p)              { return __hip_atomic_load(p, __ATOMIC_RELAXED, __HIP_MEMORY_SCOPE_AGENT); }
__device__ __forceinline__ unsigned xb_add(unsigned* p, unsigned v) { return __hip_atomic_fetch_add(p, v, __ATOMIC_RELAXED, __HIP_MEMORY_SCOPE_AGENT); }
__device__ __forceinline__ unsigned xb_xcc_id() { return (unsigned)__builtin_amdgcn_s_getreg((3 << 11) | 20) & 0xFu; }
#define XB_SPIN(cond, bar) do { unsigned _sp = 0; while (cond) { __builtin_amdgcn_s_sleep(1); \
    if ((++_sp & 255u) == 0u) { if (xb_ld(&(bar)[XB_TMO])) break; if (_sp > XB_SPIN_CAP) { atomicAdd(&(bar)[XB_TMO], 1u); break; } } } } while (0)

struct XcdBarrier {
    unsigned* bar; unsigned x;
    volatile LAS unsigned* st;
};

__device__ __forceinline__ XcdBarrier xcd_barrier_post(unsigned* bar, volatile LAS unsigned* st) {
    XcdBarrier b; b.bar = bar; b.x = xb_xcc_id(); b.st = st;
    if (threadIdx.x == 0) (void)xb_add(&bar[XB_XCNT(b.x)], 1u);
    return b;
}
__device__ __forceinline__ void xcd_barrier_complete(unsigned* bar, unsigned x, unsigned& nloc, unsigned& nx) {
    const unsigned G = gridDim.x * gridDim.y * gridDim.z;
    unsigned sum, cnt, mine, sp = 0u;
    for (;;) {
        sum = 0u; cnt = 0u; mine = 0u;
#pragma unroll
        for (unsigned j = 0; j < 16; ++j) { const unsigned c = xb_ld(&bar[XB_XCNT(j)]); sum += c; cnt += (c > 0u) ? 1u : 0u; mine = (j == x) ? c : mine; }
        if (sum == G) break;
        __builtin_amdgcn_s_sleep(1);
        if ((++sp & 255u) == 0u) { if (xb_ld(&bar[XB_TMO])) break; if (sp > XB_SPIN_CAP) { atomicAdd(&bar[XB_TMO], 1u); break; } }
    }
    nloc = mine > 0u ? mine : 1u; nx = cnt > 0u ? cnt : 1u;
}

__device__ __forceinline__ void xcd_barrier(const XcdBarrier& b) {
    asm volatile("s_waitcnt vmcnt(0)" ::: "memory");
    __syncthreads();
    if (threadIdx.x == 0) {
        unsigned* bar = b.bar;
        __builtin_amdgcn_s_waitcnt(0);
        unsigned nloc = b.st[0], nx = b.st[1];
        if (nloc == 0u) { xcd_barrier_complete(bar, b.x, nloc, nx); b.st[0] = nloc; b.st[1] = nx; }
        const unsigned old = xb_add(&bar[XB_XSUB(b.x)], 1u);
        const unsigned gen = old / nloc;
        if (old + 1u == (gen + 1u) * nloc) {
            __builtin_amdgcn_fence(__ATOMIC_RELEASE, "agent");
            asm volatile("s_waitcnt vmcnt(0)" ::: "memory");
            const unsigned og = xb_add(&bar[XB_TOP], 1u);
            const unsigned tg = og / nx;
            if (og + 1u == (tg + 1u) * nx) xb_add(&bar[XB_TOPGEN], 1u);
            else XB_SPIN(xb_ld(&bar[XB_TOPGEN]) == tg, bar);
            __builtin_amdgcn_fence(__ATOMIC_ACQUIRE, "agent");
            xb_add(&bar[XB_XGEN(b.x)], 1u);
            asm volatile("s_waitcnt vmcnt(0)" ::: "memory");
        } else {
            XB_SPIN(xb_ld(&bar[XB_XGEN(b.x)]) == gen, bar);
            __builtin_amdgcn_fence(__ATOMIC_ACQUIRE, "agent");
            asm volatile("s_waitcnt vmcnt(0)" ::: "memory");
        }
    }
    __syncthreads();
}

#ifndef DBG_EVEN
#define DBG_EVEN 0
#endif
#ifndef DBG_FOX
#define DBG_FOX 0
#endif
#ifndef REP_QKV
#define REP_QKV 1
#endif
#ifndef REP_FG
#define REP_FG 1
#endif
#ifndef REP_FFI
#define REP_FFI 1
#endif
#ifndef REP_PRO
#define REP_PRO 1
#endif
#ifndef REP_SYNC
#define REP_SYNC 1
#endif
#ifndef REP_FOX
#define REP_FOX 1
#endif
#ifndef REP_EVEN
#define REP_EVEN 1
#endif
__global__ void __launch_bounds__(NTHR, 2) fwd_kernel(Args a) {
    extern __shared__ __attribute__((aligned(16))) unsigned char lds_raw[];
    LAS unsigned char* lds = (LAS unsigned char*)lds_raw;
    cg::grid_group grid = cg::this_grid();
    const int G = gridDim.x, vwg = blockIdx.x;
    unsigned char* ws = a.ws;
    bf16_t* xb = (bf16_t*)(ws + WS_XB); float* xres = (float*)(ws + WS_XRES); bf16_t* qkv = (bf16_t*)(ws + WS_QKV); bf16_t* hid = (bf16_t*)(ws + WS_QKV);
    bf16_t* att = (bf16_t*)(ws + WS_ATT); float* rowss = (float*)(ws + WS_ROWSS); const float* rot = (const float*)(ws + WS_ROT);
    unsigned* barw = (unsigned*)(ws + WS_BAR);
    volatile LAS unsigned* bst = (volatile LAS unsigned*)(lds + LDS_MISC);
    if (threadIdx.x == 0) { bst[0] = 0u; bst[1] = 0u; }
    if (blockIdx.x == 0) { for (int i = threadIdx.x; i < 8192; i += NTHR) barw[i] = 0u; }
    __syncthreads();
    XcdBarrier bar; bar.bar = barw; bar.x = 0; bar.st = bst;
    const bool multi = (a.ph_hi - a.ph_lo) > 1;
    if (multi) { grid.sync(); bar = xcd_barrier_post(barw, bst); }
    for (int ph = a.ph_lo; ph < a.ph_hi; ++ph) {
        if (ph == 0) { for (int rep = 0; rep < REP_PRO; ++rep) { prologue(a, lds, vwg, G); __syncthreads(); } }
        else if (ph == NPHASE - 1) { if (!(FUSE_FINAL && G == 256)) final_phase(a, vwg, G); }
        else {
            const int l = (ph - 1) / 5, sp = (ph - 1) % 5;
            const bf16_t* wl = (const bf16_t*)(ws + WS_W + (size_t)l * SZ_WLAYER);
            const bf16_t* w_qkv = wl; const bf16_t* w_o = (const bf16_t*)((const unsigned char*)wl + SZ_WQKV);
            const bf16_t* w_in = (const bf16_t*)((const unsigned char*)wl + SZ_WQKV + SZ_WO); const bf16_t* w_out = (const bf16_t*)((const unsigned char*)wl + SZ_WQKV + SZ_WO + SZ_WI);
            if (sp == 0) {
                pg8::Gemm g{xb, w_qkv, MTOK, 3072, 1024}; pg8::StaticOrder S; S.init(MTOK, 3072, G, vwg);
                pg8::EpiQKV E{qkv, rowss + (size_t)(2 * l) * 16 * MTOK, rot, (l & 1) ? 0 : 1, (LAS float*)(lds + LDS_MISC + 1024)};
                for (int rep = 0; rep < REP_QKV; ++rep) { pg8::gemm_phase<pg8::EpiQKV, pg8::StaticOrder, true, true>(lds, g, S, E); __syncthreads(); }
                if (l & 1) { for (int rep = 0; rep < REP_FG; ++rep) { __syncthreads(); fgate_phase(a, l >> 1, lds, vwg, G); } }
            } else if (sp == 1) {
                if (l & 1) { fox_phase(a, lds_raw, lds, vwg, G); } else { if (DBG_EVEN) { even_attn_phase<DBG_EVEN>(a, lds, vwg, G); __syncthreads(); } even_attn_phase<3>(a, lds, vwg, G); }
            } else if (sp == 2) {
                pg8::Gemm g{att, w_o, MTOK, 1024, 1024}; pg8::StaticOrder S; S.init(MTOK, 1024, G, vwg);
                for (int rep = 0; rep < PROBE_OPROJ; ++rep) { pg8::EpiNull EN{a.out}; pg8::gemm_phase<pg8::EpiNull, pg8::StaticOrder, true, true>(lds, g, S, EN); __syncthreads(); }
                if (l == 0) { pg8::EpiResid<true> E{a.x, xb, rowss + (size_t)(2 * l + 1) * 16 * MTOK}; pg8::gemm_phase<pg8::EpiResid<true>, pg8::StaticOrder, true, true>(lds, g, S, E); }
                else { pg8::EpiResid<false> E{nullptr, xb, rowss + (size_t)(2 * l + 1) * 16 * MTOK}; pg8::gemm_phase<pg8::EpiResid<false>, pg8::StaticOrder, true, true>(lds, g, S, E); }
            } else if (sp == 3) {
                pg8::Gemm g{xb, w_in, MTOK, 5632, 1024}; pg8::StaticOrder S; S.init(MTOK, 5632, G, vwg);
                pg8::EpiSwiGLU E{hid, rowss + (size_t)(2 * l + 1) * 16 * MTOK, (LAS float*)(lds + LDS_MISC + 1024)};
                for (int rep = 0; rep < REP_FFI; ++rep) { pg8::gemm_phase<pg8::EpiSwiGLU, pg8::StaticOrder, true, true>(lds, g, S, E); __syncthreads(); }
                if (CONV_SPLIT && G == 256 && vwg >= 128 && l + 1 < NLAYER) { __syncthreads(); convert_weights(a, l + 1, l + 2, lds, (vwg - 128) * NWAVES + __builtin_amdgcn_readfirstlane((int)(threadIdx.x >> 6)), 128 * NWAVES); }
            } else {
                pg8::Gemm g{hid, w_out, MTOK, 1024, 2816}; pg8::StaticOrder S; S.init(MTOK, 1024, G, vwg);
                for (int rep = 0; rep < PROBE_FFO; ++rep) { pg8::EpiNull EN{a.out}; pg8::gemm_phase<pg8::EpiNull, pg8::StaticOrder, true, true>(lds, g, S, EN); __syncthreads(); }
                if (FUSE_FINAL && l == NLAYER - 1 && G == 256) {
                    pg8::EpiFinal E{xb, a.out, rowss + (size_t)8 * 16 * MTOK, a.norm_final, (unsigned*)(ws + WS_PCNT)};
                    pg8::gemm_phase<pg8::EpiFinal, pg8::StaticOrder, true, true>(lds, g, S, E);
                } else {
                    pg8::EpiResid<false> E{nullptr, xb, rowss + (size_t)(2 * l + 2) * 16 * MTOK};
                    pg8::gemm_phase<pg8::EpiResid<false>, pg8::StaticOrder, true, true>(lds, g, S, E);
                }
            }
        }
        if (ph + 1 < a.ph_hi && !(FUSE_FINAL && G == 256 && ph == NPHASE - 2)) {
            for (int rep = 0; rep < REP_SYNC; ++rep) xcd_barrier(bar);
        }
    }
}

#ifndef N_LAUNCH_MODE
#define N_LAUNCH_MODE 1
#endif

extern "C" void kernel_launch(void* const* d_in, const int* in_sizes, int n_in, void* d_out, int out_size, void* d_ws, size_t ws_size, hipStream_t stream) {
    static int grid = 0;
    if (grid == 0) {
        if (n_in != 11 || out_size != MTOK * DM || ws_size < WS_END) { fprintf(stderr, "kernel_launch: unexpected sizes n_in %d out %d ws %zu (need %zu)\n", n_in, out_size, ws_size, (size_t)WS_END); grid = -1; return; }
        int dev = 0, cus = 0, per_cu = 0;
        hipGetDevice(&dev); hipDeviceGetAttribute(&cus, hipDeviceAttributeMultiprocessorCount, dev);
        if (hipFuncSetAttribute((const void*)fwd_kernel, hipFuncAttributeMaxDynamicSharedMemorySize, LDS_BYTES) != hipSuccess) { fprintf(stderr, "kernel_launch: hipFuncSetAttribute failed\n"); grid = -1; return; }
        if (hipOccupancyMaxActiveBlocksPerMultiprocessor(&per_cu, (const void*)fwd_kernel, NTHR, LDS_BYTES) != hipSuccess || per_cu < 1) { fprintf(stderr, "kernel_launch: occupancy query says %d\n", per_cu); per_cu = 1; }
        (void)hipGetLastError();
        grid = cus * 1;
        fprintf(stderr, "kernel_launch: grid %d (cus %d, per_cu %d)\n", grid, cus, per_cu);
    }
    if (grid < 0) return;
    Args a{};
    a.x = (const float*)d_in[0]; a.norm_mix = (const float*)d_in[1]; a.w_qkv_even = (const float*)d_in[2]; a.w_o_even = (const float*)d_in[3];
    a.w_qkvf_odd = (const float*)d_in[4]; a.b_forget = (const float*)d_in[5]; a.w_o_odd = (const float*)d_in[6]; a.norm_ffn = (const float*)d_in[7];
    a.w_ffn_in = (const float*)d_in[8]; a.w_ffn_out = (const float*)d_in[9]; a.norm_final = (const float*)d_in[10];
    a.out = (float*)d_out; a.ws = (unsigned char*)d_ws;
#if N_LAUNCH_MODE == 1
    a.ph_lo = 0; a.ph_hi = NPHASE;
    void* args[] = {&a};
    hipError_t e = hipLaunchCooperativeKernel((const void*)fwd_kernel, dim3(grid), dim3(NTHR), args, LDS_BYTES, stream);
    if (e != hipSuccess) fprintf(stderr, "cooperative launch failed: %s (grid %d)\n", hipGetErrorString(e), grid);
#else
    for (int ph = 0; ph < NPHASE; ++ph) {
        a.ph_lo = ph; a.ph_hi = ph + 1;
        hipLaunchKernelGGL(fwd_kernel, dim3(grid), dim3(NTHR), LDS_BYTES, stream, a);
    }
#endif
}
```

```cpp
#include <hip/hip_runtime.h>
#include <hip/hip_cooperative_groups.h>
#include <cstdio>
#include <cstdint>
namespace cg = cooperative_groups;
namespace pg8 {
#define PG8_LAS __attribute__((address_space(3)))
typedef unsigned short bf16_t;
typedef short bf16x8 __attribute__((ext_vector_type(8)));
typedef float f32x4 __attribute__((ext_vector_type(4)));
typedef unsigned u32x4 __attribute__((ext_vector_type(4)));
constexpr int BM = 256, BK = 64, HALF = 128, HTB = HALF * BK * 2  , STAGE_BYTES = 8 * HTB, NXCD = 8, WGM = 8;

__host__ __device__ __forceinline__ int lds_byte(int r, int c) { const int st = (r >> 4) * 2 + (c >> 5), rr = r & 15, cc = c & 31, ob = rr * 64 + cc * 2; return st * 1024 + (ob ^ (((ob >> 9) & 1) << 5)); }
__host__ __device__ __forceinline__ void stage_rc(int b, int& R, int& C) { const int st = b / 1024, sb = b % 1024, swz = sb ^ (((sb >> 9) & 1) << 5); R = (st >> 1) * 16 + swz / 64; C = (st & 1) * 32 + (swz % 64) / 2; }
__host__ __device__ __forceinline__ int perm32(int rho) { const int n = rho >> 4, i = rho & 15; return 8 * (i >> 2) + 4 * n + (i & 3); }

struct Unit { int pm, pn; };
struct Gemm { const bf16_t* A; const bf16_t* Bt; int M, N, K; };

struct StaticOrder {
    int nM, nN, nwg, G, c;
    __host__ __device__ void init(int M, int N, int G_, int c_) { nM = M / BM; nN = N / BM; nwg = nM * nN; G = G_; c = c_; }
    __host__ __device__ bool next(int i, Unit& u) const {
        const long L = (long)i * G + c; if (L >= nwg) return false;
        int wgid = (int)L; { const int q = nwg / NXCD, r = nwg % NXCD, xcd = wgid % NXCD, off = wgid / NXCD; wgid = (xcd < r ? xcd * (q + 1) : r * (q + 1) + (xcd - r) * q) + off; }
        const int nig = WGM * nN, gid = wgid / nig, fm = gid * WGM, gsz = (nM - fm) < WGM ? (nM - fm) : WGM;
        u.pm = fm + ((wgid % nig) % gsz); u.pn = (wgid % nig) / gsz; return true;
    }
    __device__ __forceinline__ void a_ready(const Unit&) const {}
    __device__ __forceinline__ void done(const Unit&) const {}
};

__device__ __forceinline__ unsigned cvt_pk_bf16(float lo, float hi) { unsigned r; asm volatile("v_cvt_pk_bf16_f32 %0, %1, %2" : "=v"(r) : "v"(lo), "v"(hi)); return r; }
constexpr float RMS_EPS_F = 1e-5f;
constexpr int RS_M = 16384;
__device__ __forceinline__ float rstd_of(const float* rowss, int row) {
    float s = 0.f;
#pragma unroll
    for (int k = 0; k < 16; ++k) s += rowss[(size_t)k * RS_M + row];
    return 1.0f / sqrtf(s * (1.0f / 1024.0f) + RMS_EPS_F);
}

__device__ __forceinline__ void rstd_tables(PG8_LAS float* rtab, const float* rowss, int fm) {
    const int t = threadIdx.x;
#pragma unroll
    for (int q = 0; q < 4; ++q) { const int r = t + 512 * q; rtab[r] = rstd_of(rowss, fm * BM + r); }
}

struct EpiQKV {
    static constexpr bool PERM = true, AFTER_DRAIN = false;
    bf16_t* O; const float* rowss; const float* rot; int rope; PG8_LAS float* rtab; int fm;
    __device__ __forceinline__ void operator()(const f32x4 (&acc)[2][2][4][2], const Unit& u, int wr, int wc, int fr, int fq) const {
        const int row0 = u.pm * BM + wr * 64 + fr;
        const int col0 = u.pn * BM + wc * 32 + 8 * fq;
        const bool rt = rope && ((u.pn & 2) != 0) && (u.pn < 8) && ((wc & 1) == 0);
#pragma unroll
        for (int ai = 0; ai < 2; ++ai)
#pragma unroll
            for (int m = 0; m < 4; ++m) {
                const int row = row0 + ai * HALF + m * 16;
                const float rs = ((u.pm & ~7) == fm) ? rtab[(u.pm & 7) * BM + wr * 64 + fr + ai * HALF + m * 16] : rstd_of(rowss, row);
                bf16_t* rowp = O + (size_t)row * 3072 + col0;
                f32x4 c0 = {1.f, 1.f, 1.f, 1.f}, c1 = c0, s0 = {0.f, 0.f, 0.f, 0.f}, s1 = s0;
                if (rt) { const f32x4* rp = (const f32x4*)(rot + (size_t)(row & 2047) * 16); c0 = rp[0]; c1 = rp[1]; s0 = rp[2]; s1 = rp[3]; }
#pragma unroll
                for (int bj = 0; bj < 2; ++bj) {
                    f32x4 v0 = acc[ai][bj][m][0] * rs, v1 = acc[ai][bj][m][1] * rs;
                    if (rt) {
                        f32x4 p0, p1;
#pragma unroll
                        for (int e = 0; e < 4; ++e) { p0[e] = __shfl_xor(v0[e], 16); p1[e] = __shfl_xor(v1[e], 16); }
                        if (fq == 0) { v0 = v0 * c0 - p0 * s0; v1 = v1 * c1 - p1 * s1; }
                        else if (fq == 1) { v0 = v0 * c0 + p0 * s0; v1 = v1 * c1 + p1 * s1; }
                    }
                    u32x4 w; w.x = cvt_pk_bf16(v0[0], v0[1]); w.y = cvt_pk_bf16(v0[2], v0[3]); w.z = cvt_pk_bf16(v1[0], v1[1]); w.w = cvt_pk_bf16(v1[2], v1[3]);
                    *(u32x4*)(rowp + bj * HALF) = w;
                }
            }
    }
};

__device__ __forceinline__ float bf_lo(unsigned u) { return __builtin_bit_cast(float, u << 16); }
__device__ __forceinline__ float bf_hi(unsigned u) { return __builtin_bit_cast(float, u & 0xffff0000u); }
#ifndef RES_F32
#define RES_F32 0
#endif
template <bool XIN_F32> struct EpiResid {
    static constexpr bool PERM = true, AFTER_DRAIN = false;
    const float* xin32; bf16_t* xb; float* rowss_next; float* xres;
    __device__ __forceinline__ void operator()(const f32x4 (&acc)[2][2][4][2], const Unit& u, int wr, int wc, int fr, int fq) const {
        const int row0 = u.pm * BM + wr * 64 + fr;
        const int col0 = u.pn * BM + wc * 32 + 8 * fq;
#pragma unroll
        for (int ai = 0; ai < 2; ++ai)
#pragma unroll
            for (int m = 0; m < 4; ++m) {
                const int row = row0 + ai * HALF + m * 16;
                float ss = 0.f;
#pragma unroll
                for (int bj = 0; bj < 2; ++bj) {
                    const size_t off = (size_t)row * 1024 + col0 + bj * HALF;
                    f32x4 a0, a1;
                    if (XIN_F32 || RES_F32) { const f32x4* xi = (const f32x4*)((XIN_F32 ? xin32 : (const float*)xres) + off); a0 = xi[0]; a1 = xi[1]; }
                    else { const u32x4 xw = *(const u32x4*)(xb + off);
                           a0 = (f32x4){bf_lo(xw.x), bf_hi(xw.x), bf_lo(xw.y), bf_hi(xw.y)}; a1 = (f32x4){bf_lo(xw.z), bf_hi(xw.z), bf_lo(xw.w), bf_hi(xw.w)}; }
                    a0 = a0 + acc[ai][bj][m][0]; a1 = a1 + acc[ai][bj][m][1];
                    if (RES_F32) { f32x4* xo = (f32x4*)(xres + off); xo[0] = a0; xo[1] = a1; }
                    u32x4 w; w.x = cvt_pk_bf16(a0[0], a0[1]); w.y = cvt_pk_bf16(a0[2], a0[3]); w.z = cvt_pk_bf16(a1[0], a1[1]); w.w = cvt_pk_bf16(a1[2], a1[3]);
                    *(u32x4*)(xb + off) = w;
                    const float r0 = RES_F32 ? a0[0] : bf_lo(w.x), r1 = RES_F32 ? a0[1] : bf_hi(w.x), r2 = RES_F32 ? a0[2] : bf_lo(w.y), r3 = RES_F32 ? a0[3] : bf_hi(w.y), r4 = RES_F32 ? a1[0] : bf_lo(w.z), r5 = RES_F32 ? a1[1] : bf_hi(w.z), r6 = RES_F32 ? a1[2] : bf_lo(w.w), r7 = RES_F32 ? a1[3] : bf_hi(w.w);
                    ss += (r0 * r0 + r1 * r1) + (r2 * r2 + r3 * r3) + (r4 * r4 + r5 * r5) + (r6 * r6 + r7 * r7);
                }
                ss += __shfl_xor(ss, 16); ss += __shfl_xor(ss, 32);
                if (fq == 0) rowss_next[(size_t)(u.pn * 4 + wc) * RS_M + row] = ss;
            }
    }
};

struct EpiSwiGLU {
    static constexpr bool PERM = true, AFTER_DRAIN = false;
    bf16_t* H; const float* rowss; PG8_LAS float* rtab; int fm;
    __device__ __forceinline__ void operator()(const f32x4 (&acc)[2][2][4][2], const Unit& u, int wr, int wc, int fr, int fq) const {
        const int row0 = u.pm * BM + wr * 64 + fr;
        const int col0 = u.pn * HALF + wc * 32 + 8 * fq;
#pragma unroll
        for (int ai = 0; ai < 2; ++ai)
#pragma unroll
            for (int m = 0; m < 4; ++m) {
                const int row = row0 + ai * HALF + m * 16;
                const float rs = ((u.pm & ~7) == fm) ? rtab[(u.pm & 7) * BM + wr * 64 + fr + ai * HALF + m * 16] : rstd_of(rowss, row);
                float h[8];
#pragma unroll
                for (int n = 0; n < 2; ++n)
#pragma unroll
                    for (int e = 0; e < 4; ++e) {
                        const float g = acc[ai][0][m][n][e] * rs, up = acc[ai][1][m][n][e] * rs;
                        const float sg = g * __builtin_amdgcn_rcpf(1.0f + __builtin_amdgcn_exp2f(-1.4426950408889634f * g));
                        h[n * 4 + e] = sg * up;
                    }
                u32x4 w; w.x = cvt_pk_bf16(h[0], h[1]); w.y = cvt_pk_bf16(h[2], h[3]); w.z = cvt_pk_bf16(h[4], h[5]); w.w = cvt_pk_bf16(h[6], h[7]);
                *(u32x4*)(H + (size_t)row * 2816 + col0) = w;
            }
    }
};

struct EpiFinal {
    static constexpr bool PERM = true, AFTER_DRAIN = false;
    const bf16_t* xin; float* out; float* rowss_next; const float* gfin; unsigned* cnt; const float* xres;
    __device__ __forceinline__ void operator()(f32x4 (&acc)[2][2][4][2], const Unit& u, int wr, int wc, int fr, int fq) const {
        const int row0 = u.pm * BM + wr * 64 + fr;
        const int col0 = u.pn * BM + wc * 32 + 8 * fq;
#pragma unroll
        for (int ai = 0; ai < 2; ++ai)
#pragma unroll
            for (int m = 0; m < 4; ++m) {
                const int row = row0 + ai * HALF + m * 16;
                float ss = 0.f;
#pragma unroll
                for (int bj = 0; bj < 2; ++bj) {
                    f32x4 a0, a1;
                    if (RES_F32) { const f32x4* xi = (const f32x4*)(xres + (size_t)row * 1024 + col0 + bj * HALF); a0 = xi[0] + acc[ai][bj][m][0]; a1 = xi[1] + acc[ai][bj][m][1]; }
                    else { const u32x4 xw = *(const u32x4*)(xin + (size_t)row * 1024 + col0 + bj * HALF);
                           a0 = (f32x4){bf_lo(xw.x), bf_hi(xw.x), bf_lo(xw.y), bf_hi(xw.y)} + acc[ai][bj][m][0]; a1 = (f32x4){bf_lo(xw.z), bf_hi(xw.z), bf_lo(xw.w), bf_hi(xw.w)} + acc[ai][bj][m][1]; }
                    acc[ai][bj][m][0] = a0; acc[ai][bj][m][1] = a1;
                    ss += (a0[0] * a0[0] + a0[1] * a0[1]) + (a0[2] * a0[2] + a0[3] * a0[3]) + (a1[0] * a1[0] + a1[1] * a1[1]) + (a1[2] * a1[2] + a1[3] * a1[3]);
                }
                ss += __shfl_xor(ss, 16); ss += __shfl_xor(ss, 32);
                if (fq == 0) __hip_atomic_store(rowss_next + (size_t)(u.pn * 4 + wc) * RS_M + row, ss, __ATOMIC_RELAXED, __HIP_MEMORY_SCOPE_AGENT);
            }
        asm volatile("s_waitcnt vmcnt(0)" ::: "memory");
        unsigned* c = cnt + 64 * u.pm;
        if ((threadIdx.x & 63) == 0) __hip_atomic_fetch_add(c, 1u, __ATOMIC_RELAXED, __HIP_MEMORY_SCOPE_AGENT);
        { unsigned sp = 0;
          while ((unsigned)__builtin_amdgcn_readfirstlane((int)__hip_atomic_load(c, __ATOMIC_RELAXED, __HIP_MEMORY_SCOPE_AGENT)) < 32u) { __builtin_amdgcn_s_sleep(1); if (++sp > (1u << 22)) break; } }
        __builtin_amdgcn_fence(__ATOMIC_ACQUIRE, "agent");
        f32x4 g0[2], g1[2];
#pragma unroll
        for (int bj = 0; bj < 2; ++bj) { const f32x4* gp = (const f32x4*)(gfin + col0 + bj * HALF); g0[bj] = gp[0]; g1[bj] = gp[1]; }
#pragma unroll
        for (int ai = 0; ai < 2; ++ai)
#pragma unroll
            for (int m = 0; m < 4; ++m) {
                const int row = row0 + ai * HALF + m * 16;
                float tot = 0.f;
#pragma unroll
                for (int k = 0; k < 16; ++k) tot += __hip_atomic_load(rowss_next + (size_t)k * RS_M + row, __ATOMIC_RELAXED, __HIP_MEMORY_SCOPE_AGENT);
                const float rs = 1.0f / sqrtf(tot * (1.0f / 1024.0f) + RMS_EPS_F);
#pragma unroll
                for (int bj = 0; bj < 2; ++bj) {
                    f32x4* o = (f32x4*)(out + (size_t)row * 1024 + col0 + bj * HALF);
                    o[0] = acc[ai][bj][m][0] * rs * g0[bj]; o[1] = acc[ai][bj][m][1] * rs * g1[bj];
                }
            }
    }
};

struct EpiNull {
    static constexpr bool PERM = true, AFTER_DRAIN = false;
    float* sink;
    __device__ __forceinline__ void operator()(const f32x4 (&acc)[2][2][4][2], const Unit& u, int wr, int wc, int fr, int fq) const {
        if (u.pm < 0) {
#pragma unroll
            for (int ai = 0; ai < 2; ++ai)
#pragma unroll
                for (int m = 0; m < 4; ++m)
#pragma unroll
                    for (int bj = 0; bj < 2; ++bj) { f32x4* o = (f32x4*)(sink + (size_t)(ai * 8 + m * 2 + bj) * 8 + fr); o[0] = acc[ai][bj][m][0]; o[1] = acc[ai][bj][m][1]; }
        }
    }
};

template <class Epi, class Sched, bool ALIGN_EPI = false, bool SP2 = false>
__device__ __forceinline__ void gemm_phase(PG8_LAS unsigned char* lds, const Gemm g, const Sched& S, const Epi& E) {
    int tid_ = threadIdx.x; asm volatile("" : "+v"(tid_));
    const int tid = tid_, wid = __builtin_amdgcn_readfirstlane(tid >> 6), lane = tid & 63, wr = wid >> 2, wc = wid & 3, fr = lane & 15, fq = lane >> 4;
    const int K = g.K, nt = K / BK;
    unsigned voffA[2], voffB[2];
#pragma unroll
    for (int i = 0; i < 2; ++i) { int R, C; stage_rc(tid * 16 + i * 8192, R, C); const int Rb = Epi::PERM ? ((R & ~31) + perm32(R & 31)) : R;
        voffA[i] = (unsigned)(R * K + C) * 2u; voffB[i] = (unsigned)(Rb * K + C) * 2u; }
    const size_t kstep = (size_t)(BK * 2);
    const size_t hstep = (size_t)HALF * K * 2;
    const size_t tstep = 2 * hstep;
    const unsigned ldsw = (unsigned)wid * 1024u;
    const int aoff = lds_byte(wr * 64 + fr, fq * 8), boff = lds_byte(wc * 32 + fr, fq * 8);
#define PG8_SA(b, h) (((b) * 2 + (h)) * HTB)
#define PG8_SB(b, h) ((4 + (b) * 2 + (h)) * HTB)
#define PG8_STAGE(bufoff, gbase, voff) do { _Pragma("unroll") for (int _i = 0; _i < 2; ++_i) \
        __builtin_amdgcn_global_load_lds((const unsigned*)((const char*)(gbase) + (voff)[_i]), (PG8_LAS unsigned*)(lds + (bufoff) + ldsw + _i * 8192), 16, 0, 0); } while (0)
#define PG8_LDA(dst, b, h) do { _Pragma("unroll") for (int m = 0; m < 4; ++m) _Pragma("unroll") for (int k = 0; k < 2; ++k) dst[m][k] = *(const PG8_LAS bf16x8*)(lds + PG8_SA(b, h) + aoff + m * 2048 + k * 1024); } while (0)
#define PG8_LDB(dst, b, h) do { _Pragma("unroll") for (int n = 0; n < 2; ++n) _Pragma("unroll") for (int k = 0; k < 2; ++k) dst[n][k] = *(const PG8_LAS bf16x8*)(lds + PG8_SB(b, h) + boff + n * 2048 + k * 1024); } while (0)
#define PG8_MMA(ai, bj, At, Bt) do { __builtin_amdgcn_s_setprio(1); _Pragma("unroll") for (int m = 0; m < 4; ++m) _Pragma("unroll") for (int n = 0; n < 2; ++n) _Pragma("unroll") for (int k = 0; k < 2; ++k) \
        acc[ai][bj][m][n] = __builtin_amdgcn_mfma_f32_16x16x32_bf16(Bt[n][k], At[m][k], acc[ai][bj][m][n], 0, 0, 0); __builtin_amdgcn_s_setprio(0); } while (0)
#define PG8_WAIT_V(n) asm volatile("s_waitcnt vmcnt(" #n ")" ::: "memory")
#define PG8_WAIT_L(n) asm volatile("s_waitcnt lgkmcnt(" #n ")" ::: "memory")
#define PG8_BAR __builtin_amdgcn_s_barrier()
#define PG8_SCHED __builtin_amdgcn_sched_barrier(0)
    Unit cur, nxt; int ui = 0;
    if (!S.next(0, cur)) return;
    f32x4 acc[2][2][4][2];
#pragma unroll
    for (int a = 0; a < 2; ++a)
#pragma unroll
        for (int b = 0; b < 2; ++b)
#pragma unroll
            for (int m = 0; m < 4; ++m)
#pragma unroll
                for (int n = 0; n < 2; ++n) acc[a][b][m][n] = (f32x4){0.f, 0.f, 0.f, 0.f};
    bf16x8 At[4][2], B0[2][2], B1[2][2];
    const char* cA = (const char*)g.A + (size_t)cur.pm * tstep; const char* cB = (const char*)g.Bt + (size_t)cur.pn * tstep;
    S.a_ready(cur);
    if constexpr (SP2) {
        PG8_STAGE(PG8_SB(0, 0), cB, voffB); PG8_STAGE(PG8_SB(0, 1), cB + hstep, voffB); PG8_STAGE(PG8_SA(0, 0), cA, voffA); PG8_STAGE(PG8_SA(0, 1), cA + hstep, voffA);
        if (wr == 1) PG8_BAR;
        PG8_WAIT_V(2); PG8_BAR;
        PG8_STAGE(PG8_SB(1, 0), cB + kstep, voffB); PG8_STAGE(PG8_SA(1, 0), cA + kstep, voffA); PG8_STAGE(PG8_SB(1, 1), cB + hstep + kstep, voffB);
        PG8_WAIT_V(6); PG8_BAR;
    } else {
        PG8_STAGE(PG8_SB(0, 0), cB, voffB); PG8_STAGE(PG8_SA(0, 0), cA, voffA); PG8_STAGE(PG8_SB(0, 1), cB + hstep, voffB); PG8_STAGE(PG8_SA(0, 1), cA + hstep, voffA);
        if (wr == 1) PG8_BAR;
        PG8_WAIT_V(4); PG8_BAR;
        PG8_STAGE(PG8_SB(1, 0), cB + kstep, voffB); PG8_STAGE(PG8_SA(1, 0), cA + kstep, voffA); PG8_STAGE(PG8_SB(1, 1), cB + hstep + kstep, voffB);
        PG8_WAIT_V(6); PG8_BAR;
    }
    for (;;) {
        const bool has_next = S.next(ui + 1, nxt);
        const char* nA = has_next ? (const char*)g.A + (size_t)nxt.pm * tstep : cA; const char* nB = has_next ? (const char*)g.Bt + (size_t)nxt.pn * tstep : cB;
        for (int t = 0; t < nt; t += 2) {
            const bool last = (t == nt - 2);
            const char* a1 = cA + (size_t)(t + 1) * kstep;
            const char* a2 = last ? nA : cA + (size_t)(t + 2) * kstep; const char* b2 = last ? nB : cB + (size_t)(t + 2) * kstep;
            const char* a3 = a2 + kstep; const char* b3 = b2 + kstep;
            if (last && has_next) S.a_ready(nxt);
            if constexpr (SP2) {
            PG8_LDB(B0, 0, 0); PG8_LDB(B1, 0, 1); PG8_SCHED; PG8_LDA(At, 0, 0); PG8_STAGE(PG8_SA(1, 1), a1 + hstep, voffA);
            PG8_WAIT_V(8); PG8_WAIT_L(0); PG8_BAR; PG8_MMA(0, 0, At, B0); PG8_MMA(0, 1, At, B1); PG8_BAR; PG8_SCHED;
            PG8_LDA(At, 0, 1); PG8_STAGE(PG8_SB(0, 0), b2, voffB); PG8_STAGE(PG8_SB(0, 1), b2 + hstep, voffB); PG8_STAGE(PG8_SA(0, 0), a2, voffA);
            PG8_WAIT_V(8); PG8_WAIT_L(0); PG8_BAR; PG8_MMA(1, 0, At, B0); PG8_MMA(1, 1, At, B1); PG8_BAR; PG8_SCHED;
            PG8_LDB(B0, 1, 0); PG8_LDB(B1, 1, 1); PG8_SCHED; PG8_LDA(At, 1, 0); PG8_STAGE(PG8_SA(0, 1), a2 + hstep, voffA);
            PG8_WAIT_V(8); PG8_WAIT_L(0); PG8_BAR; PG8_MMA(0, 0, At, B0); PG8_MMA(0, 1, At, B1); PG8_BAR; PG8_SCHED;
            PG8_LDA(At, 1, 1); PG8_STAGE(PG8_SB(1, 0), b3, voffB); PG8_STAGE(PG8_SB(1, 1), b3 + hstep, voffB); PG8_STAGE(PG8_SA(1, 0), a3, voffA);
            PG8_WAIT_V(8); PG8_WAIT_L(0); PG8_BAR; PG8_MMA(1, 0, At, B0); PG8_MMA(1, 1, At, B1); PG8_BAR; PG8_SCHED;
            } else {
            PG8_LDB(B0, 0, 0); PG8_SCHED; PG8_LDA(At, 0, 0); PG8_STAGE(PG8_SA(1, 1), a1 + hstep, voffA);
            PG8_WAIT_L(8); PG8_BAR; PG8_WAIT_L(0); PG8_MMA(0, 0, At, B0); PG8_BAR; PG8_SCHED;
            PG8_LDB(B1, 0, 1); PG8_STAGE(PG8_SB(0, 0), b2, voffB);
            PG8_BAR; PG8_WAIT_L(0); PG8_MMA(0, 1, At, B1); PG8_BAR;
            PG8_LDA(At, 0, 1); PG8_STAGE(PG8_SA(0, 0), a2, voffA);
            PG8_BAR; PG8_WAIT_L(0); PG8_MMA(1, 0, At, B0); PG8_BAR; PG8_SCHED;
            PG8_STAGE(PG8_SB(0, 1), b2 + hstep, voffB);
            PG8_WAIT_V(6); PG8_BAR; PG8_MMA(1, 1, At, B1); PG8_BAR;
            PG8_LDB(B0, 1, 0); PG8_SCHED; PG8_LDA(At, 1, 0); PG8_STAGE(PG8_SA(0, 1), a2 + hstep, voffA);
            PG8_WAIT_L(8); PG8_BAR; PG8_WAIT_L(0); PG8_MMA(0, 0, At, B0); PG8_BAR; PG8_SCHED;
            PG8_LDB(B1, 1, 1); PG8_STAGE(PG8_SB(1, 0), b3, voffB);
            PG8_BAR; PG8_WAIT_L(0); PG8_MMA(0, 1, At, B1); PG8_BAR;
            PG8_LDA(At, 1, 1); PG8_STAGE(PG8_SA(1, 0), a3, voffA);
            PG8_BAR; PG8_WAIT_L(0); PG8_MMA(1, 0, At, B0); PG8_BAR; PG8_SCHED;
            PG8_STAGE(PG8_SB(1, 1), b3 + hstep, voffB);
            PG8_WAIT_V(6); PG8_BAR; PG8_MMA(1, 1, At, B1); PG8_BAR;
            }
        }
        if constexpr (ALIGN_EPI) { if (wr == 0) PG8_BAR; }
        if constexpr (!Epi::AFTER_DRAIN) { E(acc, cur, wr, wc, fr, fq); S.done(cur); }
        if (!has_next) break;
#pragma unroll
        for (int a = 0; a < 2; ++a)
#pragma unroll
            for (int b = 0; b < 2; ++b)
#pragma unroll
                for (int m = 0; m < 4; ++m)
#pragma unroll
                    for (int n = 0; n < 2; ++n) acc[a][b][m][n] = (f32x4){0.f, 0.f, 0.f, 0.f};
        cur = nxt; cA = nA; cB = nB; ++ui;
        if constexpr (ALIGN_EPI) { if (wr == 1) PG8_BAR; }
    }
    PG8_WAIT_V(0);
    if constexpr (!ALIGN_EPI) { if (wr == 0) PG8_BAR; }
    PG8_BAR;
    if constexpr (Epi::AFTER_DRAIN) { E.fused(acc, cur, wr, wc, fr, fq, lds, wid, lane); S.done(cur); }
#undef PG8_SA
#undef PG8_SB
#undef PG8_STAGE
#undef PG8_LDA
#undef PG8_LDB
#undef PG8_MMA
#undef PG8_WAIT_V
#undef PG8_WAIT_L
#undef PG8_BAR
#undef PG8_SCHED
}
}
#include <hip/hip_bf16.h>
#include <cmath>
namespace attn_body {
using bf16=__hip_bfloat16;
using bf16x8=__attribute__((ext_vector_type(8)))short;
using s16x4=__attribute__((ext_vector_type(4)))short;
using f32x16=__attribute__((ext_vector_type(16)))float;
using u32x4=__attribute__((ext_vector_type(4)))unsigned;
using f32x4_t=__attribute__((ext_vector_type(4)))float;
constexpr int BATCH=8,NHEAD=16,SEQ=2048,D=64,DM=3072,DMO=1024;
constexpr int NW=8,QBLK=32,QB=QBLK*NW,KVBLK=64,NQB=SEQ/QB;
constexpr int ATTN_PITCH=DM, ATTN_UNIT_ROWS=QB;
__device__ __forceinline__ int crow(int r,int hi){return (r&3)+8*(r>>2)+4*hi;}
#define SBAR() __builtin_amdgcn_sched_barrier(0)
__device__ __forceinline__ void cmask(f32x16&p0,f32x16&p1,int jb,int qrel,int hi){
  const float NEG=-INFINITY; int kb=64*jb+4*hi;
  #pragma unroll
  for(int r=0;r<16;++r){int kv=kb+(r&3)+8*(r>>2); if(kv>qrel)p0[r]=NEG; if(kv+32>qrel)p1[r]=NEG;}
}

constexpr int NSLOT=3, SLOTB=8192;
constexpr int LDS_K=0, LDS_V=NSLOT*SLOTB, LDS_WS=2*NSLOT*SLOTB, LDS_OST=LDS_WS+NW*64*4, LDS_BYTES=LDS_OST+NW*4096;
constexpr float C2=0.125f*1.4426950408889634f;
__device__ __forceinline__ void glds16(const void*gsrc,unsigned lds_dst){unsigned keep;
  asm volatile("s_mov_b32 %0, m0\n\ts_mov_b32 m0, %2\n\ts_nop 0\n\tglobal_load_lds_dwordx4 %1, off\n\ts_mov_b32 m0, %0":"=&s"(keep):"v"(gsrc),"s"(lds_dst):"memory");}
__device__ __forceinline__ float max3f(float a,float b,float c){float r;asm("v_max3_f32 %0, %1, %2, %3":"=v"(r):"v"(a),"v"(b),"v"(c));return r;}
__device__ __forceinline__ float max2f(float a,float b){float r;asm("v_max_f32_e32 %0, %1, %2":"=v"(r):"v"(a),"v"(b));return r;}
__device__ __forceinline__ float fadd_s(float a,float b){float r;asm("v_add_f32_e32 %0, %1, %2":"=v"(r):"v"(a),"v"(b));return r;}
__device__ __forceinline__ float fsub_s(float a,float b){float r;asm("v_sub_f32_e32 %0, %1, %2":"=v"(r):"v"(a),"v"(b));return r;}
typedef float f32x2_t __attribute__((ext_vector_type(2))); typedef __bf16 bf16x2_t __attribute__((ext_vector_type(2)));
__device__ __forceinline__ unsigned cvtpk_s(float lo,float hi){f32x2_t v={lo,hi};bf16x2_t b=__builtin_convertvector(v,bf16x2_t);return __builtin_bit_cast(unsigned,b);}
#define WAIT_BAR(N) asm volatile("s_waitcnt vmcnt(" #N ") lgkmcnt(0)\n\ts_barrier":::"memory")

__device__ __forceinline__ void qkt(f32x16&p0,f32x16&p1,const char*Kslot,const bf16x8*qr,int r32,int hi){
  const char*kb=Kslot+hi*1024+r32*16;
  #pragma unroll
  for(int d0=0;d0<4;++d0){
    const bf16x8 b0=*reinterpret_cast<const bf16x8*>(kb+d0*2048);
    const bf16x8 b1=*reinterpret_cast<const bf16x8*>(kb+d0*2048+512);
    p0=__builtin_amdgcn_mfma_f32_32x32x16_bf16(b0,qr[d0],p0,0,0,0);p1=__builtin_amdgcn_mfma_f32_32x32x16_bf16(b1,qr[d0],p1,0,0,0);}
}
typedef __attribute__((address_space(3))) const char* lds_cptr;
typedef short v4i16_t __attribute__((ext_vector_type(4)));
__device__ __forceinline__ void kload8(bf16x8*kf,lds_cptr kp){
  kf[0]=*(const __attribute__((address_space(3))) bf16x8*)(kp);      kf[1]=*(const __attribute__((address_space(3))) bf16x8*)(kp+512);
  kf[2]=*(const __attribute__((address_space(3))) bf16x8*)(kp+2048); kf[3]=*(const __attribute__((address_space(3))) bf16x8*)(kp+2560);
  kf[4]=*(const __attribute__((address_space(3))) bf16x8*)(kp+4096); kf[5]=*(const __attribute__((address_space(3))) bf16x8*)(kp+4608);
  kf[6]=*(const __attribute__((address_space(3))) bf16x8*)(kp+6144); kf[7]=*(const __attribute__((address_space(3))) bf16x8*)(kp+6656);
}
__device__ __forceinline__ void kload2(bf16x8*kf,lds_cptr kp,int j){ kf[2*j]=*(const __attribute__((address_space(3))) bf16x8*)(kp+j*2048); kf[2*j+1]=*(const __attribute__((address_space(3))) bf16x8*)(kp+j*2048+512); }
__device__ __forceinline__ s16x4 vtr(lds_cptr p){ return __builtin_bit_cast(s16x4,__builtin_amdgcn_ds_read_tr16_b64_v4i16((__attribute__((address_space(3))) v4i16_t*)p)); }
__device__ __forceinline__ float rowmax(const f32x16&p0,const f32x16&p1){
  float a=max3f(p0[0],p0[1],p1[0]),b=max3f(p0[2],p0[3],p1[1]);a=max3f(a,p1[2],p1[3]);
  #pragma unroll
  for(int r=4;r<16;r+=4){a=max3f(a,p0[r],p0[r+1]);b=max3f(b,p0[r+2],p0[r+3]);a=max3f(a,p1[r],p1[r+1]);b=max3f(b,p1[r+2],p1[r+3]);}
  const float m=max2f(a,b);
  auto rr=__builtin_amdgcn_permlane32_swap(__float_as_uint(m),__float_as_uint(m),false,false);
  return max2f(__uint_as_float(rr[0]),__uint_as_float(rr[1]));
}
__device__ __forceinline__ void pv(f32x16*o,int vb,bf16x8 pa0,bf16x8 pa1,bf16x8 pa2,bf16x8 pa3){
  #pragma unroll
  for(int d0=0;d0<2;++d0){s16x4 lo[4],hi[4];
    #pragma unroll
    for(int ks=0;ks<4;++ks){
      asm volatile("ds_read_b64_tr_b16 %0,%1 offset:%c2":"=&v"(lo[ks]):"v"(vb),"i"(d0*4096+ks*1024):"memory");
      asm volatile("ds_read_b64_tr_b16 %0,%1 offset:%c2":"=&v"(hi[ks]):"v"(vb),"i"(d0*4096+ks*1024+512):"memory");}
    asm volatile("s_waitcnt lgkmcnt(0)":::"memory");SBAR();
    #define PK(k) (bf16x8){lo[k][0],lo[k][1],lo[k][2],lo[k][3],hi[k][0],hi[k][1],hi[k][2],hi[k][3]}
    o[d0]=__builtin_amdgcn_mfma_f32_32x32x16_bf16(pa0,PK(0),o[d0],0,0,0);
    o[d0]=__builtin_amdgcn_mfma_f32_32x32x16_bf16(pa1,PK(1),o[d0],0,0,0);
    o[d0]=__builtin_amdgcn_mfma_f32_32x32x16_bf16(pa2,PK(2),o[d0],0,0,0);
    o[d0]=__builtin_amdgcn_mfma_f32_32x32x16_bf16(pa3,PK(3),o[d0],0,0,0);
    #undef PK
  }
}

#ifndef ATTN_STORE16
#define ATTN_STORE16(p,v) (*(u32x4*)(p)=(v))
#endif
template<int THRL> __device__ __forceinline__ void attn_unit(int b,int h,int qb,const bf16*Q,const bf16*__restrict__ K,const bf16*__restrict__ V,bf16*O,char*shm,const __attribute__((address_space(3))) float*Fs){
  int tid_=threadIdx.x; asm volatile("":"+v"(tid_)); const int tid=tid_,lane=tid&63,r32=lane&31,hi=lane>>5;   const int wid=__builtin_amdgcn_readfirstlane(tid>>6);
  const long rowbase=(long)b*SEQ; const int q0=qb*QB;
  const bf16*Qw=Q+(rowbase+q0+wid*QBLK)*DM+h*D;
  const bf16*Kh=K+rowbase*DM+h*D,*Vh=V+rowbase*DM+h*D;
  const unsigned lds0=(unsigned)(uintptr_t)shm;
  float*wsf=(float*)(shm+LDS_WS)+wid*64;
  const bf16*ksrc=Kh+(long)lane*DM+wid*8;
  const bf16*vsrc=Vh+(long)(16*(wid&3)+(lane>>2))*DM+(wid>>2)*32+(lane&3)*8;
  const unsigned kdst=lds0+LDS_K+wid*1024, vdst=lds0+LDS_V+wid*1024;
  #define DMA_K(t,slot) glds16(ksrc+(long)(t)*KVBLK*DM,(unsigned)__builtin_amdgcn_readfirstlane(kdst+(slot)))
  #define DMA_V(t,slot) glds16(vsrc+(long)(t)*KVBLK*DM,(unsigned)__builtin_amdgcn_readfirstlane(vdst+(slot)))
  const int vb0=(int)(lds0+LDS_V)+((lane>>4)&1)*32+(lane&3)*8+(4*hi+((lane&15)>>2))*64;
  const char*Kbase=shm+LDS_K; bf16x8 kf[8];
  const lds_cptr shm3=(lds_cptr)shm; const lds_cptr kp0=shm3+LDS_K+hi*1024+r32*16; const lds_cptr vp0=shm3+LDS_V+((lane>>4)&1)*32+(lane&3)*8+(4*hi+((lane&15)>>2))*64;
  const int NT=(q0+QB)/KVBLK;
  DMA_K(0,0);DMA_V(0,0);DMA_K(1,SLOTB);
  bf16x8 qr[4];
  #pragma unroll
  for(int d0=0;d0<4;++d0)qr[d0]=*reinterpret_cast<const bf16x8*>(&Qw[(long)r32*DM+d0*16+hi*8]);
  float mhat=0.f,l_reg=0.f;f32x16 o[2];o[0]=f32x16{};o[1]=f32x16{};
  const int qrel=wid*QBLK+r32;
  const float Fq=Fs[q0+qrel];
  #define BIAS(C0,C1,t) do{ const __attribute__((address_space(3))) f32x4_t*fk_=(const __attribute__((address_space(3))) f32x4_t*)(Fs+64*(t)+4*hi); const float fb_=Fq-mhat; \
    _Pragma("unroll") for(int g_=0;g_<4;++g_){ const f32x4_t a_=fk_[2*g_], b_=fk_[8+2*g_]; \
      _Pragma("unroll") for(int e_=0;e_<4;++e_){ C0[4*g_+e_]=fb_-a_[e_]; C1[4*g_+e_]=fb_-b_[e_]; } } }while(0)
  #define CMASK(P0,P1,t) do{int jb_=(t)-(NT-4); if(jb_>=0)cmask(P0,P1,jb_,qrel,hi);}while(0)
  bool resc=false;
  #define START(P0,P1) do{ const float rm=rowmax(P0,P1); resc=false; \
    { const float dl=rm; mhat=fadd_s(mhat,dl); \
      _Pragma("unroll") for(int r=0;r<16;++r){P0[r]=fsub_s(P0[r],dl);P1[r]=fsub_s(P1[r],dl);} \
      } \
    _Pragma("unroll") for(int r=0;r<16;++r)P0[r]=__builtin_amdgcn_exp2f(P0[r]); }while(0)
  #define RESC() do{ if(resc){ asm volatile("s_waitcnt lgkmcnt(0)":::"memory"); \
      _Pragma("unroll") for(int d_=0;d_<2;++d_) _Pragma("unroll") for(int r=0;r<16;++r)o[d_][r]*=wsf[crow(r,hi)]; } }while(0)
  f32x16 pA0,pA1,pB0,pB1;
  int sl_prev=0,sl_cur=0,sl_next=SLOTB;
  #define ROT() do{sl_prev=sl_cur;sl_cur=sl_next;sl_next=(sl_next==(NSLOT-1)*SLOTB)?0:sl_next+SLOTB;}while(0)
  DMA_K(2,2*SLOTB);
  WAIT_BAR(3);
  BIAS(pA0,pA1,0); qkt(pA0,pA1,Kbase,qr,r32,hi);asm volatile("s_nop 15\n\ts_nop 7":"+v"(pA0),"+v"(pA1));CMASK(pA0,pA1,0);
  START(pA0,pA1);
  _Pragma("unroll") for(int r=0;r<16;++r)pA1[r]=__builtin_amdgcn_exp2f(pA1[r]);
  WAIT_BAR(0);
  DMA_K(3,0);DMA_V(1,SLOTB);
  ROT();
  kload8(kf,kp0+sl_cur);
  WAIT_BAR(2);
  s16x4 vlo[8],vhi[8]; u32x4 pw0,pw1,pw2,pw3;
  #define PKW(P,B) cvtpk_s(P[B],P[B+1])
  #define PAF(k) __builtin_bit_cast(bf16x8,pw##k)
  #define VFR(i) (bf16x8){vlo[i][0],vlo[i][1],vlo[i][2],vlo[i][3],vhi[i][0],vhi[i][1],vhi[i][2],vhi[i][3]}
  #define PIN(x) asm volatile("":"+v"(x))
  #define MX3(a,b,c) __builtin_fmaxf(__builtin_fmaxf((a),(b)),(c))
  #define GAPA(MF,A0,A1,A2,A3,W0,W1,PW) do{ MF; sacc+=A0; sacc+=A1; sacc+=A2; sacc+=A3; PIN(sacc); W0; W1; PIN(PW); SBAR(); }while(0)
  #define EX(v) __builtin_amdgcn_exp2f(v)
  #define GAPB(MF,X,B,FS) do{ MF; X[B]=EX(X[B]); X[B+1]=EX(X[B+1]); X[B+2]=EX(X[B+2]); X[B+3]=EX(X[B+3]); PIN(X); FS; SBAR(); }while(0)
  #define FKLOAD(P0,P1,t) do{ const __attribute__((address_space(3))) f32x4_t*fk_=(const __attribute__((address_space(3))) f32x4_t*)(Fs+64*(t)+4*hi); \
    _Pragma("unroll") for(int g_=0;g_<4;++g_){ const f32x4_t a_=fk_[2*g_], b_=fk_[8+2*g_]; \
      _Pragma("unroll") for(int e_=0;e_<4;++e_){ P0[4*g_+e_]=a_[e_]; P1[4*g_+e_]=b_[e_]; } } }while(0)
  #define FSUB(G,P,B) do{ if(G){ P[B]=fb_-P[B]; P[B+1]=fb_-P[B+1]; P[B+2]=fb_-P[B+2]; P[B+3]=fb_-P[B+3]; PIN(P); } }while(0)
  #define VRD(i) do{ vlo[i]=vtr(vp_+(((i)>>2)*4096+((i)&3)*1024)); vhi[i]=vtr(vp_+(((i)>>2)*4096+((i)&3)*1024+512)); }while(0)
  #define KRD(G,j) do{ if(G){ kload2(kf,kp0+sl_next,j); SBAR(); } }while(0)
  #define STEP(C0,C1,P0,P1,t,GK,GV,GL) do{ SBAR(); \
    const lds_cptr vp_=vp0+sl_prev; \
    VRD(0); SBAR(); float sacc=(P0[0]+P0[1]); \
    GAPA(C0=__builtin_amdgcn_mfma_f32_32x32x16_bf16(kf[0],qr[0],C0,0,0,0), P0[2],P0[3],P0[4],P0[5],     pw0[0]=PKW(P0,0), pw0[1]=PKW(P0,2), pw0); \
    VRD(4); SBAR(); GAPA(C1=__builtin_amdgcn_mfma_f32_32x32x16_bf16(kf[1],qr[0],C1,0,0,0), P0[6],P0[7],P0[8],P0[9],     pw0[2]=PKW(P0,4), pw0[3]=PKW(P0,6), pw0); \
    VRD(1); SBAR(); GAPA(C0=__builtin_amdgcn_mfma_f32_32x32x16_bf16(kf[2],qr[1],C0,0,0,0),   P0[10],P0[11],P0[12],P0[13], pw1[0]=PKW(P0,8), pw1[1]=PKW(P0,10), pw1); \
    VRD(5); SBAR(); GAPA(C1=__builtin_amdgcn_mfma_f32_32x32x16_bf16(kf[3],qr[1],C1,0,0,0),   P0[14],P0[15],P1[0],P1[1],   pw1[2]=PKW(P0,12),pw1[3]=PKW(P0,14), pw1); \
    VRD(2); SBAR(); GAPA(C0=__builtin_amdgcn_mfma_f32_32x32x16_bf16(kf[4],qr[2],C0,0,0,0),   P1[2],P1[3],P1[4],P1[5],     pw2[0]=PKW(P1,0), pw2[1]=PKW(P1,2), pw2); \
    VRD(6); SBAR(); GAPA(C1=__builtin_amdgcn_mfma_f32_32x32x16_bf16(kf[5],qr[2],C1,0,0,0),   P1[6],P1[7],P1[8],P1[9],     pw2[2]=PKW(P1,4), pw2[3]=PKW(P1,6), pw2); \
    VRD(3); SBAR(); GAPA(C0=__builtin_amdgcn_mfma_f32_32x32x16_bf16(kf[6],qr[3],C0,0,0,0),   P1[10],P1[11],P1[12],P1[13], pw3[0]=PKW(P1,8), pw3[1]=PKW(P1,10), pw3); \
    VRD(7); SBAR(); GAPA(C1=__builtin_amdgcn_mfma_f32_32x32x16_bf16(kf[7],qr[3],C1,0,0,0),   P1[14],P1[15],0.f,0.f,       pw3[2]=PKW(P1,12),pw3[3]=PKW(P1,14), pw3); \
    l_reg+=sacc; \
    if(GK){DMA_K((t)+3,sl_cur);} if(GV){DMA_V((t)+1,sl_next);} \
    CMASK(C0,C1,t); \
    { float a=MX3(C0[0],C0[1],C1[0]),b=MX3(C0[2],C0[3],C1[1]); a=MX3(a,C1[2],C1[3]); \
      _Pragma("unroll") for(int r=4;r<16;r+=4){a=MX3(a,C0[r],C0[r+1]);b=MX3(b,C0[r+2],C0[r+3]);a=MX3(a,C1[r],C1[r+1]);b=MX3(b,C1[r+2],C1[r+3]);} \
      float rm=__builtin_fmaxf(a,b); { auto rr=__builtin_amdgcn_permlane32_swap(__float_as_uint(rm),__float_as_uint(rm),false,false); rm=__builtin_fmaxf(__uint_as_float(rr[0]),__uint_as_float(rr[1])); } \
      resc=false; \
      if(__builtin_expect(__any(rm>(float)THRL),0)){ const float dl=__builtin_fmaxf(rm,0.f); mhat+=dl; \
        _Pragma("unroll") for(int r=0;r<16;++r){C0[r]-=dl;C1[r]-=dl;} \
        const float f=__builtin_amdgcn_exp2f(-dl); l_reg*=f; if(hi==0)wsf[r32]=f; resc=true; } } \
    const float fb_=Fq-mhat; if(GL){ FKLOAD(P0,P1,(t)+1); } \
    SBAR(); \
    GAPB(o[0]=__builtin_amdgcn_mfma_f32_32x32x16_bf16(PAF(0),VFR(0),o[0],0,0,0), C0,0, FSUB(GL,P0,0)); \
    GAPB(o[1]=__builtin_amdgcn_mfma_f32_32x32x16_bf16(PAF(0),VFR(4),o[1],0,0,0), C0,4, FSUB(GL,P0,4)); \
    KRD(GL,0); GAPB(o[0]=__builtin_amdgcn_mfma_f32_32x32x16_bf16(PAF(1),VFR(1),o[0],0,0,0), C0,8, FSUB(GL,P0,8)); \
    KRD(GL,1); GAPB(o[1]=__builtin_amdgcn_mfma_f32_32x32x16_bf16(PAF(1),VFR(5),o[1],0,0,0), C0,12, FSUB(GL,P0,12)); \
    KRD(GL,2); GAPB(o[0]=__builtin_amdgcn_mfma_f32_32x32x16_bf16(PAF(2),VFR(2),o[0],0,0,0), C1,0, FSUB(GL,P1,0)); \
    KRD(GL,3); GAPB(o[1]=__builtin_amdgcn_mfma_f32_32x32x16_bf16(PAF(2),VFR(6),o[1],0,0,0), C1,4, FSUB(GL,P1,4)); \
    GAPB(o[0]=__builtin_amdgcn_mfma_f32_32x32x16_bf16(PAF(3),VFR(3),o[0],0,0,0), C1,8, FSUB(GL,P1,8)); \
    GAPB(o[1]=__builtin_amdgcn_mfma_f32_32x32x16_bf16(PAF(3),VFR(7),o[1],0,0,0), C1,12, FSUB(GL,P1,12)); \
    }while(0)
  BIAS(pB0,pB1,1);
  int t=1;
  #undef CMASK
  #define CMASK(P0,P1,t) do{}while(0)
  for(;t+5<NT;t+=2){
    STEP(pB0,pB1,pA0,pA1,t,true,true,true);     WAIT_BAR(2); RESC(); ROT();
    STEP(pA0,pA1,pB0,pB1,t+1,true,true,true);   WAIT_BAR(2); RESC(); ROT();
  }
  #undef CMASK
  #define CMASK(P0,P1,t) do{int jb_=(t)-(NT-4); if(jb_>=0)cmask(P0,P1,jb_,qrel,hi);}while(0)
  #define ENDW(tt) do{ if((tt)+3<NT){WAIT_BAR(2);} else if((tt)+2<NT){WAIT_BAR(1);} else {WAIT_BAR(0);} }while(0)
  for(;t+1<NT;t+=2){
    STEP(pB0,pB1,pA0,pA1,t,(t+3<NT),(t+1<NT),(t+1<NT));       ENDW(t);   RESC(); ROT();
    STEP(pA0,pA1,pB0,pB1,t+1,(t+4<NT),(t+2<NT),(t+2<NT));     ENDW(t+1); RESC(); ROT();
  }
  STEP(pB0,pB1,pA0,pA1,NT-1,false,false,false); RESC();
  { float sacc=pB0[0]+pB0[1]; _Pragma("unroll") for(int r=2;r<16;++r)sacc+=pB0[r]; _Pragma("unroll") for(int r=0;r<16;++r)sacc+=pB1[r]; l_reg+=sacc;
    pw0=(u32x4){PKW(pB0,0),PKW(pB0,2),PKW(pB0,4),PKW(pB0,6)};pw1=(u32x4){PKW(pB0,8),PKW(pB0,10),PKW(pB0,12),PKW(pB0,14)};pw2=(u32x4){PKW(pB1,0),PKW(pB1,2),PKW(pB1,4),PKW(pB1,6)};pw3=(u32x4){PKW(pB1,8),PKW(pB1,10),PKW(pB1,12),PKW(pB1,14)};
    SBAR(); pv(o,vb0+sl_cur,PAF(0),PAF(1),PAF(2),PAF(3)); }
  #undef PKW
  #undef PAF
  #undef VFR
  #undef PIN
  #undef MX3
  #undef GAPA
  #undef GAPB
  #undef EX
  #undef VRD
  #undef KRD
  #undef STEP
  #undef FKLOAD
  #undef FSUB
  #undef ENDW
  {auto rr=__builtin_amdgcn_permlane32_swap(__float_as_uint(l_reg),__float_as_uint(l_reg),false,false);l_reg=__uint_as_float(rr[0])+__uint_as_float(rr[1]);}
  if(hi==0)wsf[32+r32]=l_reg;asm volatile("s_waitcnt lgkmcnt(0)":::"memory");
  float rli[16];
  #pragma unroll
  for(int r=0;r<16;++r)rli[r]=__builtin_amdgcn_rcpf(wsf[32+crow(r,hi)]);
  bf16*Ow=O+(rowbase+q0+wid*QBLK)*DMO+h*D;
  { bf16*stg=(bf16*)(shm+LDS_OST)+wid*2048;
    #pragma unroll
    for(int r=0;r<16;++r){const int orow=crow(r,hi);
      #pragma unroll
      for(int d0=0;d0<2;++d0)stg[orow*64+d0*32+r32]=__float2bfloat16(o[d0][r]*rli[r]);}
    asm volatile("s_waitcnt lgkmcnt(0)":::"memory");
    #pragma unroll
    for(int i=0;i<4;++i){const int row=i*8+(lane>>3),ch=lane&7; const u32x4 v=*(const u32x4*)(stg+row*64+ch*8); ATTN_STORE16(Ow+(long)row*DMO+ch*8,v);} }
  asm volatile("s_waitcnt lgkmcnt(0)\n\ts_barrier":::"memory");
  #undef DMA_K
  #undef DMA_V
  #undef CMASK
  #undef START
  #undef RESC
  #undef ROT
  #undef BIAS
}
constexpr int ATTN_LDS_BYTES=LDS_BYTES;
#undef SBAR
#undef WAIT_BAR
}

#define LAS __attribute__((address_space(3)))
typedef unsigned short bf16_t;
typedef short bf16x8 __attribute__((ext_vector_type(8)));
typedef short s16x4 __attribute__((ext_vector_type(4)));
typedef float f32x4 __attribute__((ext_vector_type(4)));
typedef float f32x16 __attribute__((ext_vector_type(16)));
typedef unsigned u32x4 __attribute__((ext_vector_type(4)));
typedef unsigned u32x2 __attribute__((ext_vector_type(2)));

constexpr int NB = 8, SEQ = 2048, DM = 1024, MTOK = NB * SEQ, DFF = 2816, NLAYER = 4, QKV_LD = 3072;
constexpr int NWAVES = 8, NTHR = 512;
constexpr float LOG2E = 1.4426950408889634f;
constexpr int LDS_BYTES = 147456;
constexpr int VROW = 192;
constexpr int VTILE = 32 * VROW;
constexpr int LDS_F = 49152;
constexpr int NPHASE = 2 + 5 * NLAYER;
constexpr int LDS_MISC = 131072;

constexpr size_t MiB = 1u << 20;
constexpr size_t SZ_WQKV = (size_t)3072 * 1024 * 2, SZ_WO = (size_t)1024 * 1024 * 2, SZ_WI = (size_t)5632 * 1024 * 2, SZ_WOUT = (size_t)1024 * 2816 * 2;
constexpr size_t SZ_WLAYER = SZ_WQKV + SZ_WO + SZ_WI + SZ_WOUT;
constexpr size_t WS_W = 0;
constexpr size_t WS_XB = 104 * MiB;
constexpr size_t WS_XRES = WS_XB + 32 * MiB;
constexpr size_t WS_QKV = WS_XRES + 64 * MiB;
constexpr size_t WS_ATT = WS_QKV + 96 * MiB;
constexpr size_t WS_SMALL = WS_ATT + 32 * MiB;
constexpr size_t WS_ROWSS = WS_SMALL;
constexpr size_t WS_ROT = WS_ROWSS + (size_t)9 * 16 * MTOK * 4;
constexpr size_t WS_WF = WS_ROT + (size_t)2048 * 16 * 4;
constexpr size_t WS_LOCF = WS_WF + (size_t)2 * 16 * 1024 * 4;
constexpr size_t WS_TOTF = WS_LOCF + (size_t)128 * 2048 * 4;
constexpr size_t WS_LSE = WS_TOTF + (size_t)128 * 32 * 4;
constexpr size_t WS_BAR = WS_LSE + (size_t)2 * MTOK * 8 * 4;
constexpr size_t WS_PCNT = WS_BAR + 16384;
constexpr size_t WS_END = WS_PCNT + 16384;
static_assert(SZ_WLAYER * 4 <= 104 * MiB, "weights fit");

struct Args {
    const float* x; const float* norm_mix; const float* w_qkv_even; const float* w_o_even; const float* w_qkvf_odd; const float* b_forget; const float* w_o_odd;
    const float* norm_ffn; const float* w_ffn_in; const float* w_ffn_out; const float* norm_final;
    float* out; unsigned char* ws; int ph_lo, ph_hi;
};

__device__ __forceinline__ unsigned f2bf(float f) { unsigned u = __builtin_bit_cast(unsigned, f); return (u + 0x7fffu + ((u >> 16) & 1u)) >> 16; }
__device__ __forceinline__ unsigned pk2(float lo, float hi) { return f2bf(lo) | (f2bf(hi) << 16); }
__device__ __forceinline__ unsigned cvtpk(float lo, float hi) { unsigned r; asm volatile("v_cvt_pk_bf16_f32 %0, %1, %2" : "=v"(r) : "v"(lo), "v"(hi)); return r; }
__device__ __forceinline__ float wave_sum(float v) {
#pragma unroll
    for (int o = 1; o < 64; o <<= 1) v += __shfl_xor(v, o);
    return v;
}
#define LDS_WAIT() asm volatile("s_waitcnt lgkmcnt(0)" ::: "memory")
__device__ __forceinline__ int otid() { int t = threadIdx.x; asm volatile("" : "+v"(t)); return t; }

#ifndef PROBE_OPROJ
#define PROBE_OPROJ 0
#endif
#ifndef PROBE_FFO
#define PROBE_FFO 0
#endif
#ifndef FUSE_FINAL
#define FUSE_FINAL 1
#endif
#ifndef CONV_SPLIT
#define CONV_SPLIT 1
#endif
__device__ __forceinline__ void transpose_item(const float* W, int ldw, int K, int k0, int src_col, bf16_t* WT, int dst_row, const float* gain, float cscale, LAS float* scr, int lane) {
    const int kr = lane >> 3, c4 = lane & 7;
    f32x4 v[8]; float g[8];
#pragma unroll
    for (int i = 0; i < 8; ++i) { const int kk = 8 * i + kr; v[i] = *(const f32x4*)(W + (size_t)(k0 + kk) * ldw + src_col + 4 * c4); g[i] = gain ? gain[k0 + kk] * cscale : cscale; }
#pragma unroll
    for (int i = 0; i < 8; ++i) { const int kk = 8 * i + kr; LAS float* d = scr + kk * 33 + 4 * c4; d[0] = v[i].x * g[i]; d[1] = v[i].y * g[i]; d[2] = v[i].z * g[i]; d[3] = v[i].w * g[i]; }
    LDS_WAIT(); asm volatile("" ::: "memory");
    const int c = lane & 7;
#pragma unroll
    for (int j = 0; j < 4; ++j) { const int n = (lane >> 3) + 8 * j; const LAS float* s = scr + (8 * c) * 33 + n;
        u32x4 o; o.x = pk2(s[0 * 33], s[1 * 33]); o.y = pk2(s[2 * 33], s[3 * 33]); o.z = pk2(s[4 * 33], s[5 * 33]); o.w = pk2(s[6 * 33], s[7 * 33]);
        *(u32x4*)(WT + (size_t)(dst_row + n) * K + k0 + 8 * c) = o; }
    LDS_WAIT(); asm volatile("" ::: "memory");
}

__device__ __forceinline__ void convert_weights(const Args& a, int l_lo, int l_hi, LAS unsigned char* lds, int gw, int NGW) {
    const int tid = otid(), lane = tid & 63, wave = __builtin_amdgcn_readfirstlane(tid >> 6);
    LAS float* scr = (LAS float*)(lds + wave * 16384);
    constexpr int I_QKV = 16 * 96, I_O = 16 * 32, I_IN = 16 * 176, I_OUT = 44 * 32, I_LAYER = I_QKV + I_O + I_IN + I_OUT;
    for (int it = l_lo * I_LAYER + gw; it < l_hi * I_LAYER; it += NGW) {
        const int l = it / I_LAYER; int r = it % I_LAYER;
        bf16_t* wl = (bf16_t*)(a.ws + WS_W + (size_t)l * SZ_WLAYER);
        if (r < I_QKV) {
            const int kb = r / 96, nb = r % 96, n0 = 32 * nb;
            const float* W = (l & 1) ? a.w_qkvf_odd + (size_t)(l >> 1) * 1024 * 3088 : a.w_qkv_even + (size_t)(l >> 1) * 1024 * 3072;
            transpose_item(W, (l & 1) ? 3088 : 3072, 1024, 64 * kb, n0, wl, n0, a.norm_mix + l * 1024, n0 < 1024 ? 0.125f * LOG2E : 1.0f, scr, lane);
            continue; }
        r -= I_QKV;
        if (r < I_O) {
            const int kb = r / 32, nb = r % 32, n0 = 32 * nb;
            const float* W = (l & 1) ? a.w_o_odd + (size_t)(l >> 1) * 1024 * 1024 : a.w_o_even + (size_t)(l >> 1) * 1024 * 1024;
            transpose_item(W, 1024, 1024, 64 * kb, n0, (bf16_t*)((unsigned char*)wl + SZ_WQKV), n0, nullptr, 1.0f, scr, lane);
            continue; }
        r -= I_O;
        if (r < I_IN) {
            const int kb = r / 176, nb = r % 176, n0 = 32 * nb;
            const int pn = n0 >> 8, bj = (n0 >> 7) & 1, c0 = n0 & 127;
            transpose_item(a.w_ffn_in + (size_t)l * 1024 * 5632, 5632, 1024, 64 * kb, bj * 2816 + 128 * pn + c0, (bf16_t*)((unsigned char*)wl + SZ_WQKV + SZ_WO), n0, a.norm_ffn + l * 1024, 1.0f, scr, lane);
            continue; }
        r -= I_IN;
        {
            const int kb = r / 32, nb = r % 32, n0 = 32 * nb;
            transpose_item(a.w_ffn_out + (size_t)l * 2816 * 1024, 1024, 2816, 64 * kb, n0, (bf16_t*)((unsigned char*)wl + SZ_WQKV + SZ_WO + SZ_WI), n0, nullptr, 1.0f, scr, lane);
        }
    }
}

__device__ __forceinline__ void prologue(const Args& a, LAS unsigned char* lds, int vwg, int G) {
    const int tid = otid(), lane = tid & 63, wave = __builtin_amdgcn_readfirstlane(tid >> 6);
    const int gw = vwg * NWAVES + wave, NGW = G * NWAVES;
    convert_weights(a, 0, (CONV_SPLIT && G == 256) ? 1 : NLAYER, lds, gw, NGW);
    bf16_t* xb = (bf16_t*)(a.ws + WS_XB); float* rowss = (float*)(a.ws + WS_ROWSS);
    for (int m = gw; m < MTOK; m += NGW) {
        const f32x4* xr = (const f32x4*)(a.x + (size_t)m * DM) + lane; float s = 0.f; f32x4 v[4];
#pragma unroll
        for (int j = 0; j < 4; ++j) { v[j] = xr[64 * j]; s += (v[j].x * v[j].x + v[j].y * v[j].y) + (v[j].z * v[j].z + v[j].w * v[j].w); }
        s = wave_sum(s);
        unsigned long long* o8 = (unsigned long long*)(xb + (size_t)m * DM) + lane;
#pragma unroll
        for (int j = 0; j < 4; ++j) o8[64 * j] = (unsigned long long)pk2(v[j].x, v[j].y) | ((unsigned long long)pk2(v[j].z, v[j].w) << 32);
        if (lane < 16) rowss[(size_t)lane * MTOK + m] = (lane == 0) ? s : 0.f;
    }
    const int gt = vwg * NTHR + tid, NGT = G * NTHR;
    float* rot = (float*)(a.ws + WS_ROT);
    for (int i = gt; i < 2048 * 8; i += NGT) {
        const int pos = i >> 3, j = i & 7;
        const float invf[8] = {1.0f, 0.19392274474868576f, 0.03760603093086393f, 0.007292664737217109f, 0.001414213562373095f, 0.0002742481756762073f, 5.318295896944988e-05f, 1.031338537721246e-05f};
        float fq = invf[0];
#pragma unroll
        for (int t = 1; t < 8; ++t) fq = (j == t) ? invf[t] : fq;
        const float ang = (float)pos * fq;
        const double rev = (double)ang * 0.15915494309189535; const float fr = (float)(rev - floor(rev));
        rot[pos * 16 + j] = __builtin_amdgcn_cosf(fr); rot[pos * 16 + 8 + j] = __builtin_amdgcn_sinf(fr);
    }
    float* wf = (float*)(a.ws + WS_WF);
    for (int i = gt; i < 2 * 16 * 1024; i += NGT) {
        const int lo = i >> 14, hd = (i >> 10) & 15, k = i & 1023;
        wf[i] = a.w_qkvf_odd[(size_t)lo * 1024 * 3088 + (size_t)k * 3088 + 3072 + hd] * a.norm_mix[(2 * lo + 1) * 1024 + k];
    }
}

__device__ __forceinline__ void fgate_phase(const Args& a, int lo, LAS unsigned char* lds, int vwg, int G) {
    const int tid = otid(), lane = tid & 63, wave = __builtin_amdgcn_readfirstlane(tid >> 6);
    const bf16_t* xbq = (const bf16_t*)(a.ws + WS_XB); const float* rowss = (const float*)(a.ws + WS_ROWSS) + (size_t)(2 * (2 * lo + 1)) * 16 * MTOK;
    const float* wf = (const float*)(a.ws + WS_WF) + (size_t)lo * 16 * 1024;
    float* locF = (float*)(a.ws + WS_LOCF); float* totF = (float*)(a.ws + WS_TOTF);
    LAS float* lf = (LAS float*)lds;
    const int r16 = lane & 15, g4 = lane >> 4, tile = wave & 3, kh = wave >> 2;
    for (int j = vwg; j < 256; j += G) {
        const u32x2* xr = (const u32x2*)(xbq + (size_t)(64 * j + 16 * tile + r16) * DM + 512 * kh + 4 * g4);
        const f32x4* wr = (const f32x4*)(wf + (size_t)r16 * 1024 + 512 * kh + 4 * g4);
        f32x4 acc = {0.f, 0.f, 0.f, 0.f};
#pragma unroll 8
        for (int s = 0; s < 32; ++s) {
            const u32x2 xw = xr[4 * s]; const f32x4 wv = wr[4 * s];
            const f32x4 xv = {pg8::bf_lo(xw.x), pg8::bf_hi(xw.x), pg8::bf_lo(xw.y), pg8::bf_hi(xw.y)};
            acc = __builtin_amdgcn_mfma_f32_16x16x4f32(xv.x, wv.x, acc, 0, 0, 0);
            acc = __builtin_amdgcn_mfma_f32_16x16x4f32(xv.y, wv.y, acc, 0, 0, 0);
            acc = __builtin_amdgcn_mfma_f32_16x16x4f32(xv.z, wv.z, acc, 0, 0, 0);
            acc = __builtin_amdgcn_mfma_f32_16x16x4f32(xv.w, wv.w, acc, 0, 0, 0);
        }
#pragma unroll
        for (int jj = 0; jj < 4; ++jj) lf[(kh * 64 + 16 * tile + 4 * g4 + jj) * 16 + r16] = acc[jj];
        __syncthreads();
        float l2v[2];
#pragma unroll
        for (int q = 0; q < 2; ++q) {
            const int idx = tid + 512 * q, t = idx >> 4, hd = idx & 15;
            const float fl = (lf[idx] + lf[1024 + idx]) * pg8::rstd_of(rowss, 64 * j + t) + a.b_forget[lo * 16 + hd];
            const float z2 = fl * LOG2E; l2v[q] = -(fmaxf(-z2, 0.f) + __builtin_amdgcn_logf(1.0f + __builtin_amdgcn_exp2f(-fabsf(z2))));
        }
        __syncthreads();
        lf[tid] = l2v[0]; lf[tid + 512] = l2v[1];
        __syncthreads();
        if (tid < 16) {
            const int b = j >> 5, sl = j & 31; float run = 0.f; float* dst = locF + (size_t)(b * 16 + tid) * 2048 + sl * 64;
#pragma unroll 8
            for (int t = 0; t < 64; ++t) { run += lf[t * 16 + tid]; dst[t] = run; }
            totF[(b * 16 + tid) * 32 + sl] = run;
        }
        __syncthreads();
    }
}

__device__ __forceinline__ int phi32(int r) { return ((r >> 4) & 1) * 16 + ((r >> 2) & 1) * 8 + ((r >> 3) & 1) * 4 + (r & 3); }
__device__ __forceinline__ s16x4 vtr(const LAS unsigned char* p) { return __builtin_bit_cast(s16x4, __builtin_amdgcn_ds_read_tr16_b64_v4i16((LAS s16x4*)p)); }

template <int MODE, int DBG = 0>
__device__ __forceinline__ void attn_task(const bf16_t* qp, const bf16_t* kp, const bf16_t* vp, size_t rstride, int q0, int kb_lo, int kb_hi,
                                          LAS unsigned char* vlds, const LAS float* Fs, f32x16 (&O)[2], float& lse2) {
    const int lane = otid() & 63, n = lane & 31, hh = lane >> 5;
    bf16x8 qf[4];
    { const bf16_t* p = qp + (size_t)(q0 + n) * rstride + 8 * hh;
#pragma unroll
      for (int ks = 0; ks < 4; ++ks) qf[ks] = *(const bf16x8*)(p + 16 * ks); }
    const int qi = q0 + n;
    float Fq = 0.f; if (MODE == 0) Fq = Fs[qi];
#pragma unroll
    for (int r = 0; r < 16; ++r) { O[0][r] = 0.f; O[1][r] = 0.f; }
    float m = -1e30f, l = 0.f, R = 0.f;
    const bf16_t* kl = kp + (size_t)phi32(n) * rstride + 8 * hh;
    const bf16_t* vl = vp + (size_t)(lane >> 3) * rstride + 8 * (lane & 7);
    LAS unsigned char* vw = vlds + (lane >> 3) * VROW + (lane & 7) * 16;
    const LAS unsigned char* vr = vlds + (8 * hh + ((lane & 15) >> 2)) * VROW + (16 * ((lane >> 4) & 1) + 4 * (lane & 3)) * 2;
    bf16x8 kn[4]; u32x4 vn[4];
#define AT_ISSUE(kb) do { const bf16_t* kk_ = kl + (size_t)(kb) * 32 * rstride; const bf16_t* vv_ = vl + (size_t)(kb) * 32 * rstride; \
        _Pragma("unroll") for (int ks = 0; ks < 4; ++ks) kn[ks] = *(const bf16x8*)(kk_ + 16 * ks); \
        _Pragma("unroll") for (int ii = 0; ii < 4; ++ii) vn[ii] = *(const u32x4*)(vv_ + (size_t)(8 * ii) * rstride); } while (0)
    const int nblk = kb_hi - kb_lo + 1;
    int kb = (MODE == 2) ? kb_hi : kb_lo;
    AT_ISSUE(kb);
    for (int it = 0; it < nblk; ++it) {
        bf16x8 kc[4];
#pragma unroll
        for (int ks = 0; ks < 4; ++ks) kc[ks] = kn[ks];
        asm volatile("" ::: "memory");
#pragma unroll
        for (int ii = 0; ii < 4; ++ii) *(LAS u32x4*)(vw + ii * 8 * VROW) = vn[ii];
        asm volatile("" ::: "memory");
        const int kbn = (MODE == 2) ? kb - 1 : kb + 1;
        if (it + 1 < nblk && DBG != 1) AT_ISSUE(kbn);
        if (DBG != 2) {
        const int key0 = kb * 32 + 8 * hh;
        f32x16 s;
        if (MODE == 0) {
            const LAS f32x4* fk = (const LAS f32x4*)(Fs + key0);
            const f32x4 f0 = fk[0], f1 = fk[1], f2 = fk[4], f3 = fk[5];
#pragma unroll
            for (int e = 0; e < 4; ++e) { s[e] = Fq - f0[e]; s[4 + e] = Fq - f1[e]; s[8 + e] = Fq - f2[e]; s[12 + e] = Fq - f3[e]; }
        } else {
#pragma unroll
            for (int r = 0; r < 16; ++r) s[r] = 0.f;
        }
#pragma unroll
        for (int ks = 0; ks < 4; ++ks) s = __builtin_amdgcn_mfma_f32_32x32x16_bf16(kc[ks], qf[ks], s, 0, 0, 0);
        bf16x8 pb[2];
        if (MODE != 2) {
            const bool diag = (kb * 32 + 31 > q0);
            if (MODE == 1) {
                if (diag || kb * 32 < q0 - 97) {
#pragma unroll
                    for (int r = 0; r < 16; ++r) { const int ki = key0 + 16 * (r >> 3) + (r & 7); if (ki > qi || ki < qi - 128) s[r] = -1e30f; }
                }
            } else if (diag) {
#pragma unroll
                for (int r = 0; r < 16; ++r) { const int ki = key0 + 16 * (r >> 3) + (r & 7); if (ki > qi) s[r] = -1e30f; }
            }
            float bm = fmaxf(fmaxf(s[0], s[1]), fmaxf(s[2], s[3]));
#pragma unroll
            for (int r = 4; r < 16; r += 4) bm = fmaxf(bm, fmaxf(fmaxf(s[r], s[r + 1]), fmaxf(s[r + 2], s[r + 3])));
            bm = fmaxf(bm, __shfl_xor(bm, 32));
            const float mn = fmaxf(m, bm), alpha = __builtin_amdgcn_exp2f(m - mn); m = mn;
            float ps = 0.f;
#pragma unroll
            for (int r = 0; r < 16; ++r) { s[r] = __builtin_amdgcn_exp2f(s[r] - mn); ps += s[r]; }
            l = l * alpha + ps;
#pragma unroll
            for (int r = 0; r < 16; ++r) { O[0][r] *= alpha; O[1][r] *= alpha; }
        } else {
            const bool diag = (kb * 32 + 31 >= q0);
            float L[16];
#pragma unroll
            for (int r = 0; r < 16; ++r) {
                const float z = s[r], t = __builtin_amdgcn_exp2f(-fabsf(z)), sp = fmaxf(z, 0.f) + __builtin_amdgcn_logf(1.0f + t);
                L[r] = -sp; s[r] = z - sp;
            }
            if (diag) {
#pragma unroll
                for (int r = 0; r < 16; ++r) { const int ki = key0 + 16 * (r >> 3) + (r & 7); if (ki >= qi) { L[r] = 0.f; s[r] = -1e30f; } }
            }
            float sA = ((L[0] + L[1]) + (L[2] + L[3])) + ((L[4] + L[5]) + (L[6] + L[7]));
            float sB = ((L[8] + L[9]) + (L[10] + L[11])) + ((L[12] + L[13]) + (L[14] + L[15]));
            const float pA = __shfl_xor(sA, 32), pB = __shfl_xor(sB, 32);
            const float offA = sB + pB + (hh == 0 ? pA : 0.f), offB = (hh == 0 ? pB : 0.f);
            float run = R + offA;
#pragma unroll
            for (int e = 7; e >= 0; --e) { const float lr = L[e]; s[e] = __builtin_amdgcn_exp2f(s[e] + run); run += lr; }
            run = R + offB;
#pragma unroll
            for (int e = 15; e >= 8; --e) { const float lr = L[e]; s[e] = __builtin_amdgcn_exp2f(s[e] + run); run += lr; }
            R += (sA + sB) + (pA + pB);
        }
        { u32x4 w0, w1;
          w0.x = cvtpk(s[0], s[1]); w0.y = cvtpk(s[2], s[3]); w0.z = cvtpk(s[4], s[5]); w0.w = cvtpk(s[6], s[7]);
          w1.x = cvtpk(s[8], s[9]); w1.y = cvtpk(s[10], s[11]); w1.z = cvtpk(s[12], s[13]); w1.w = cvtpk(s[14], s[15]);
          pb[0] = __builtin_bit_cast(bf16x8, w0); pb[1] = __builtin_bit_cast(bf16x8, w1); }
        asm volatile("" ::: "memory");
#pragma unroll
        for (int db = 0; db < 2; ++db)
#pragma unroll
            for (int kk = 0; kk < 2; ++kk) {
                const s16x4 lo4 = vtr(vr + (16 * kk) * VROW + 64 * db), hi4 = vtr(vr + (16 * kk + 4) * VROW + 64 * db);
                const bf16x8 av = {lo4[0], lo4[1], lo4[2], lo4[3], hi4[0], hi4[1], hi4[2], hi4[3]};
                O[db] = __builtin_amdgcn_mfma_f32_32x32x16_bf16(av, pb[kk], O[db], 0, 0, 0);
            }
        asm volatile("s_waitcnt lgkmcnt(0)" ::: "memory");
        } else { asm volatile("s_waitcnt lgkmcnt(0)" ::: "memory"); O[0][0] += __builtin_bit_cast(float, (int)kc[0][0]) ; }
        if (MODE == 2) { if (__builtin_amdgcn_ballot_w64(R >= -160.f) == 0ull) break; }
        kb = kbn;
    }
#undef AT_ISSUE
    asm volatile("s_waitcnt vmcnt(0)" ::: "memory");
    if (MODE != 2) {
        l += __shfl_xor(l, 32);
        const float inv = 1.0f / l;
#pragma unroll
        for (int r = 0; r < 16; ++r) { O[0][r] *= inv; O[1][r] *= inv; }
        lse2 = m + __builtin_amdgcn_logf(l);
    }
}

__device__ __forceinline__ void store_o_bf16(const f32x16 (&O)[2], bf16_t* att_row  , int hh) {
#pragma unroll
    for (int db = 0; db < 2; ++db)
#pragma unroll
        for (int i = 0; i < 4; ++i) {
            u32x2 w; w.x = cvtpk(O[db][4 * i], O[db][4 * i + 1]); w.y = cvtpk(O[db][4 * i + 2], O[db][4 * i + 3]);
            *(u32x2*)(att_row + 32 * db + 8 * i + 4 * hh) = w;
        }
}

constexpr int LDS_FOXF = 90112;
__device__ __forceinline__ void fox_phase(const Args& a, unsigned char* lds_gen, LAS unsigned char* lds, int vwg, int G) {
    const int tid = otid();
    const bf16_t* qkv = (const bf16_t*)(a.ws + WS_QKV); bf16_t* att = (bf16_t*)(a.ws + WS_ATT);
    const float* locF = (const float*)(a.ws + WS_LOCF); const float* totF = (const float*)(a.ws + WS_TOTF);
    LAS float* Fs = (LAS float*)(lds + LDS_FOXF); LAS float* pre = Fs + 2048;
    for (int j = vwg; j < 256; j += G) {
        const int bh = j >> 1, b = bh >> 4, h = bh & 15;
        __syncthreads();
        if (tid < 64) {
            const float v = (tid < 32) ? totF[bh * 32 + tid] : 0.f; float s = v;
#pragma unroll
            for (int o = 1; o < 32; o <<= 1) { const float t2 = __shfl_up(s, o); if ((tid & 63) >= o) s += t2; }
            if (tid < 32) pre[tid] = s - v;
        }
        __syncthreads();
        for (int t = tid; t < 2048; t += NTHR) Fs[t] = locF[(size_t)bh * 2048 + t] + pre[t >> 6];
        __syncthreads();
        for (int ui = 0; ui < 4; ++ui) {
            const int u = (j & 1) ? ((ui < 2) ? 2 + ui : 7 - ui) : ((ui < 2) ? ui : 9 - ui);
            attn_body::attn_unit<8>(b, h, u, (const attn_body::bf16*)qkv, (const attn_body::bf16*)(qkv + 1024), (const attn_body::bf16*)(qkv + 2048), (attn_body::bf16*)att, (char*)lds_gen, Fs);
        }
    }
}

template <int PART>
__device__ __forceinline__ void even_attn_phase(const Args& a, LAS unsigned char* lds, int vwg, int G) {
    const int tid = otid(), lane = tid & 63, wave = __builtin_amdgcn_readfirstlane(tid >> 6), n = lane & 31, hh = lane >> 5;
    const bf16_t* qkv = (const bf16_t*)(a.ws + WS_QKV); bf16_t* att = (bf16_t*)(a.ws + WS_ATT);
    bf16_t* part = (bf16_t*)a.out;
    float* plse = (float*)(a.ws + WS_LSE);
    LAS unsigned char* vlds = lds + wave * VTILE;
    const LAS float* nof = (const LAS float*)lds;
    for (int j = vwg; j < 256; j += G) {
        const int bh = j >> 2, b = bh >> 3, hl = bh & 7, c = j & 3;
        if (PART & 1) { const bf16_t* base = qkv + (size_t)(b * SEQ) * QKV_LD + hl * 64;
          for (int ui = 0; ui < 2; ++ui) {
              const int u = ui ? 7 - c : c, qt = 8 * u + wave;
              f32x16 O[2]; float lse;
              attn_task<2>(base, base + 1024, base + 2048, (size_t)QKV_LD, 32 * qt, 0, qt, vlds, nof, O, lse);
              store_o_bf16(O, att + (size_t)(b * SEQ + 32 * qt + n) * DM + hl * 64, hh);
          } }
        if (!(PART & 2)) continue;
        const bf16_t* base = qkv + (size_t)(b * SEQ) * QKV_LD + (8 + hl) * 64;
        for (int p = 0; p < 2; ++p) {
            const int dil = p ? 4 : 1;
            for (int ti = 0; ti < 2; ++ti) {
                const int task = wave + 8 * ti;
                const int res = p ? (task & 3) : 0, tile = p ? (task >> 2) : task;
                const int q0 = (p ? 128 * c : 512 * c) + 32 * tile;
                const int kbh = q0 >> 5, kbl = kbh - 4 < 0 ? 0 : kbh - 4;
                const bf16_t* bp = base + (size_t)res * QKV_LD;
                f32x16 O[2]; float lse;
                attn_task<1>(bp, bp + 1024, bp + 2048, (size_t)dil * QKV_LD, q0, kbl, kbh, vlds, nof, O, lse);
                const int tok = res + dil * (q0 + n);
                if (PART & 4) continue;
                store_o_bf16(O, part + ((size_t)p * MTOK + (size_t)(b * SEQ + tok)) * 512 + hl * 64, hh);
                if (hh == 0) plse[((size_t)p * MTOK + (size_t)(b * SEQ + tok)) * 8 + hl] = lse;
            }
        }
        __syncthreads();
        for (int ti = 0; ti < 2; ++ti) {
            const int res = wave + 8 * ti, q0 = 32 * c;
            const bf16_t* bp = base + (size_t)res * QKV_LD;
            f32x16 O[2]; float lse3;
            attn_task<1>(bp, bp + 1024, bp + 2048, (size_t)16 * QKV_LD, q0, 0, c, vlds, nof, O, lse3);
            const int tok = res + 16 * (q0 + n); const size_t grow = (size_t)(b * SEQ + tok);
            if (PART & 4) { store_o_bf16(O, att + grow * DM + (8 + hl) * 64, hh); continue; }
            const float l1 = plse[grow * 8 + hl], l2 = plse[((size_t)MTOK + grow) * 8 + hl];
            const float mx = fmaxf(lse3, fmaxf(l1, l2));
            float w1 = __builtin_amdgcn_exp2f(l1 - mx), w2 = __builtin_amdgcn_exp2f(l2 - mx), w3 = __builtin_amdgcn_exp2f(lse3 - mx);
            const float inv = 1.0f / (w1 + w2 + w3); w1 *= inv; w2 *= inv; w3 *= inv;
            const bf16_t* p1 = part + grow * 512 + hl * 64; const bf16_t* p2 = part + ((size_t)MTOK + grow) * 512 + hl * 64;
#pragma unroll
            for (int db = 0; db < 2; ++db)
#pragma unroll
                for (int i = 0; i < 4; ++i) {
                    const u32x2 r1 = *(const u32x2*)(p1 + 32 * db + 8 * i + 4 * hh), r2 = *(const u32x2*)(p2 + 32 * db + 8 * i + 4 * hh);
                    const float a1[4] = {__uint_as_float(r1.x << 16), __uint_as_float(r1.x & 0xffff0000u), __uint_as_float(r1.y << 16), __uint_as_float(r1.y & 0xffff0000u)};
                    const float a2[4] = {__uint_as_float(r2.x << 16), __uint_as_float(r2.x & 0xffff0000u), __uint_as_float(r2.y << 16), __uint_as_float(r2.y & 0xffff0000u)};
#pragma unroll
                    for (int e = 0; e < 4; ++e) O[db][4 * i + e] = O[db][4 * i + e] * w3 + a1[e] * w1 + a2[e] * w2;
                }
            store_o_bf16(O, att + grow * DM + (8 + hl) * 64, hh);
        }
        __syncthreads();
    }
}

__device__ __forceinline__ void final_phase(const Args& a, int vwg, int G) {
    const int tid = otid(), lane = tid & 63, wave = tid >> 6;
    const bf16_t* xbf = (const bf16_t*)(a.ws + WS_XB); const float* rowss = (const float*)(a.ws + WS_ROWSS) + (size_t)8 * 16 * MTOK;
    const int gw = vwg * NWAVES + wave, NGW = G * NWAVES;
    f32x4 g[4];
#pragma unroll
    for (int j = 0; j < 4; ++j) g[j] = ((const f32x4*)a.norm_final)[lane + 64 * j];
    for (int m = gw; m < MTOK; m += NGW) {
        const float rs = pg8::rstd_of(rowss, m);
        const u32x2* xr = (const u32x2*)(xbf + (size_t)m * DM) + lane; f32x4* o = (f32x4*)(a.out + (size_t)m * DM) + lane;
#pragma unroll
        for (int j = 0; j < 4; ++j) { const u32x2 xw = xr[64 * j]; o[64 * j] = (f32x4){pg8::bf_lo(xw.x), pg8::bf_hi(xw.x), pg8::bf_lo(xw.y), pg8::bf_hi(xw.y)} * rs * g[j]; }
    }
}

#define XB_TMO      128
#define XB_XCNT(j)  (256  + 64 * (j))
#define XB_XSUB(j)  (1280 + 64 * (j))
#define XB_XGEN(j)  (2304 + 64 * (j))
#define XB_TOP      3328
#define XB_TOPGEN   3392
#define XCD_BAR_WORDS 3456
#define XB_SPIN_CAP (1u << 18)

__device__ __forceinline__ unsigned xb_ld(unsigned* p)              { return __hip_atomic_load(p, __ATOMIC_RELAXED, __HIP_MEMORY_SCOPE_AGENT); }
__device__ __forceinline__ unsigned xb_add(unsigned* p, unsigned v) { return __hip_atomic_fetch_add(p, v, __ATOMIC_RELAXED, __HIP_MEMORY_SCOPE_AGENT); }
__device__ __forceinline__ unsigned xb_xcc_id() { return (unsigned)__builtin_amdgcn_s_getreg((3 << 11) | 20) & 0xFu; }
#define XB_SPIN(cond, bar) do { unsigned _sp = 0; while (cond) { __builtin_amdgcn_s_sleep(1); \
    if ((++_sp & 255u) == 0u) { if (xb_ld(&(bar)[XB_TMO])) break; if (_sp > XB_SPIN_CAP) { atomicAdd(&(bar)[XB_TMO], 1u); break; } } } } while (0)

struct XcdBarrier {
    unsigned* bar; unsigned x;
    volatile LAS unsigned* st;
};

__device__ __forceinline__ XcdBarrier xcd_barrier_post(unsigned* bar, volatile LAS unsigned* st) {
    XcdBarrier b; b.bar = bar; b.x = xb_xcc_id(); b.st = st;
    if (threadIdx.x == 0) (void)xb_add(&bar[XB_XCNT(b.x)], 1u);
    return b;
}
__device__ __forceinline__ void xcd_barrier_complete(unsigned* bar, unsigned x, unsigned& nloc, unsigned& nx) {
    const unsigned G = gridDim.x * gridDim.y * gridDim.z;
    unsigned sum, cnt, mine, sp = 0u;
    for (;;) {
        sum = 0u; cnt = 0u; mine = 0u;
#pragma unroll
        for (unsigned j = 0; j < 16; ++j) { const unsigned c = xb_ld(&bar[XB_XCNT(j)]); sum += c; cnt += (c > 0u) ? 1u : 0u; mine = (j == x) ? c : mine; }
        if (sum == G) break;
        __builtin_amdgcn_s_sleep(1);
        if ((++sp & 255u) == 0u) { if (xb_ld(&bar[XB_TMO])) break; if (sp > XB_SPIN_CAP) { atomicAdd(&bar[XB_TMO], 1u); break; } }
    }
    nloc = mine > 0u ? mine : 1u; nx = cnt > 0u ? cnt : 1u;
}

__device__ __forceinline__ void xcd_barrier(const XcdBarrier& b) {
    asm volatile("s_waitcnt vmcnt(0)" ::: "memory");
    __syncthreads();
    if (threadIdx.x == 0) {
        unsigned* bar = b.bar;
        __builtin_amdgcn_s_waitcnt(0);
        unsigned nloc = b.st[0], nx = b.st[1];
        if (nloc == 0u) { xcd_barrier_complete(bar, b.x, nloc, nx); b.st[0] = nloc; b.st[1] = nx; }
        const unsigned old = xb_add(&bar[XB_XSUB(b.x)], 1u);
        const unsigned gen = old / nloc;
        if (old + 1u == (gen + 1u) * nloc) {
            __builtin_amdgcn_fence(__ATOMIC_RELEASE, "agent");
            asm volatile("s_waitcnt vmcnt(0)" ::: "memory");
            const unsigned og = xb_add(&bar[XB_TOP], 1u);
            const unsigned tg = og / nx;
            if (og + 1u == (tg + 1u) * nx) xb_add(&bar[XB_TOPGEN], 1u);
            else XB_SPIN(xb_ld(&bar[XB_TOPGEN]) == tg, bar);
            __builtin_amdgcn_fence(__ATOMIC_ACQUIRE, "agent");
            xb_add(&bar[XB_XGEN(b.x)], 1u);
            asm volatile("s_waitcnt vmcnt(0)" ::: "memory");
        } else {
            XB_SPIN(xb_ld(&bar[XB_XGEN(b.x)]) == gen, bar);
            __builtin_amdgcn_fence(__ATOMIC_ACQUIRE, "agent");
            asm volatile("s_waitcnt vmcnt(0)" ::: "memory");
        }
    }
    __syncthreads();
}

#ifndef DBG_EVEN
#define DBG_EVEN 0
#endif
#ifndef DBG_FOX
#define DBG_FOX 0
#endif
#ifndef REP_QKV
#define REP_QKV 1
#endif
#ifndef REP_FG
#define REP_FG 1
#endif
#ifndef REP_FFI
#define REP_FFI 1
#endif
#ifndef REP_PRO
#define REP_PRO 1
#endif
#ifndef REP_SYNC
#define REP_SYNC 1
#endif
#ifndef REP_FOX
#define REP_FOX 1
#endif
#ifndef REP_EVEN
#define REP_EVEN 1
#endif
__global__ void __launch_bounds__(NTHR, 2) fwd_kernel(Args a) {
    extern __shared__ __attribute__((aligned(16))) unsigned char lds_raw[];
    LAS unsigned char* lds = (LAS unsigned char*)lds_raw;
    cg::grid_group grid = cg::this_grid();
    const int G = gridDim.x, vwg = blockIdx.x;
    unsigned char* ws = a.ws;
    bf16_t* xb = (bf16_t*)(ws + WS_XB); float* xres = (float*)(ws + WS_XRES); bf16_t* qkv = (bf16_t*)(ws + WS_QKV); bf16_t* hid = (bf16_t*)(ws + WS_QKV);
    bf16_t* att = (bf16_t*)(ws + WS_ATT); float* rowss = (float*)(ws + WS_ROWSS); const float* rot = (const float*)(ws + WS_ROT);
    unsigned* barw = (unsigned*)(ws + WS_BAR);
    volatile LAS unsigned* bst = (volatile LAS unsigned*)(lds + LDS_MISC);
    if (threadIdx.x == 0) { bst[0] = 0u; bst[1] = 0u; }
    if (blockIdx.x == 0) { for (int i = threadIdx.x; i < 8192; i += NTHR) barw[i] = 0u; }
    __syncthreads();
    XcdBarrier bar; bar.bar = barw; bar.x = 0; bar.st = bst;
    const bool multi = (a.ph_hi - a.ph_lo) > 1;
    if (multi) { grid.sync(); bar = xcd_barrier_post(barw, bst); }
    for (int ph = a.ph_lo; ph < a.ph_hi; ++ph) {
        if (ph == 0) { for (int rep = 0; rep < REP_PRO; ++rep) { prologue(a, lds, vwg, G); __syncthreads(); } }
        else if (ph == NPHASE - 1) { if (!(FUSE_FINAL && G == 256)) final_phase(a, vwg, G); }
        else {
            const int l = (ph - 1) / 5, sp = (ph - 1) % 5;
            const bf16_t* wl = (const bf16_t*)(ws + WS_W + (size_t)l * SZ_WLAYER);
            const bf16_t* w_qkv = wl; const bf16_t* w_o = (const bf16_t*)((const unsigned char*)wl + SZ_WQKV);
            const bf16_t* w_in = (const bf16_t*)((const unsigned char*)wl + SZ_WQKV + SZ_WO); const bf16_t* w_out = (const bf16_t*)((const unsigned char*)wl + SZ_WQKV + SZ_WO + SZ_WI);
            if (sp == 0) {
                pg8::Gemm g{xb, w_qkv, MTOK, 3072, 1024}; pg8::StaticOrder S; S.init(MTOK, 3072, G, vwg);
                pg8::EpiQKV E{qkv, rowss + (size_t)(2 * l) * 16 * MTOK, rot, (l & 1) ? 0 : 1, (LAS float*)(lds + LDS_MISC + 1024), -1};
                { pg8::Unit u0; if (S.next(0, u0)) { E.fm = u0.pm & ~7; pg8::rstd_tables(E.rtab, E.rowss, E.fm); } __syncthreads(); }
                for (int rep = 0; rep < REP_QKV; ++rep) { pg8::gemm_phase<pg8::EpiQKV, pg8::StaticOrder, true, true>(lds, g, S, E); __syncthreads(); }
                if (l & 1) { for (int rep = 0; rep < REP_FG; ++rep) { __syncthreads(); fgate_phase(a, l >> 1, lds, vwg, G); } }
            } else if (sp == 1) {
                if (l & 1) { fox_phase(a, lds_raw, lds, vwg, G); } else { if (DBG_EVEN) { even_attn_phase<DBG_EVEN>(a, lds, vwg, G); __syncthreads(); } even_attn_phase<3>(a, lds, vwg, G); }
            } else if (sp == 2) {
                pg8::Gemm g{att, w_o, MTOK, 1024, 1024}; pg8::StaticOrder S; S.init(MTOK, 1024, G, vwg);
                for (int rep = 0; rep < PROBE_OPROJ; ++rep) { pg8::EpiNull EN{a.out}; pg8::gemm_phase<pg8::EpiNull, pg8::StaticOrder, true, true>(lds, g, S, EN); __syncthreads(); }
                if (l == 0) { pg8::EpiResid<true> E{a.x, xb, rowss + (size_t)(2 * l + 1) * 16 * MTOK, xres}; pg8::gemm_phase<pg8::EpiResid<true>, pg8::StaticOrder, true, true>(lds, g, S, E); }
                else { pg8::EpiResid<false> E{nullptr, xb, rowss + (size_t)(2 * l + 1) * 16 * MTOK, xres}; pg8::gemm_phase<pg8::EpiResid<false>, pg8::StaticOrder, true, true>(lds, g, S, E); }
            } else if (sp == 3) {
                pg8::Gemm g{xb, w_in, MTOK, 5632, 1024}; pg8::StaticOrder S; S.init(MTOK, 5632, G, vwg);
                pg8::EpiSwiGLU E{hid, rowss + (size_t)(2 * l + 1) * 16 * MTOK, (LAS float*)(lds + LDS_MISC + 1024), -1};
                { pg8::Unit u0; if (S.next(0, u0)) { E.fm = u0.pm & ~7; pg8::rstd_tables(E.rtab, E.rowss, E.fm); } __syncthreads(); }
                for (int rep = 0; rep < REP_FFI; ++rep) { pg8::gemm_phase<pg8::EpiSwiGLU, pg8::StaticOrder, true, true>(lds, g, S, E); __syncthreads(); }
                if (CONV_SPLIT && G == 256 && vwg >= 128 && l + 1 < NLAYER) { __syncthreads(); convert_weights(a, l + 1, l + 2, lds, (vwg - 128) * NWAVES + __builtin_amdgcn_readfirstlane((int)(threadIdx.x >> 6)), 128 * NWAVES); }
            } else {
                pg8::Gemm g{hid, w_out, MTOK, 1024, 2816}; pg8::StaticOrder S; S.init(MTOK, 1024, G, vwg);
                for (int rep = 0; rep < PROBE_FFO; ++rep) { pg8::EpiNull EN{a.out}; pg8::gemm_phase<pg8::EpiNull, pg8::StaticOrder, true, true>(lds, g, S, EN); __syncthreads(); }
                if (FUSE_FINAL && l == NLAYER - 1 && G == 256) {
                    pg8::EpiFinal E{xb, a.out, rowss + (size_t)8 * 16 * MTOK, a.norm_final, (unsigned*)(ws + WS_PCNT), xres};
                    pg8::gemm_phase<pg8::EpiFinal, pg8::StaticOrder, true, true>(lds, g, S, E);
                } else {
                    pg8::EpiResid<false> E{nullptr, xb, rowss + (size_t)(2 * l + 2) * 16 * MTOK, xres};
                    pg8::gemm_phase<pg8::EpiResid<false>, pg8::StaticOrder, true, true>(lds, g, S, E);
                }
            }
        }
        if (ph + 1 < a.ph_hi && !(FUSE_FINAL && G == 256 && ph == NPHASE - 2)) {
            for (int rep = 0; rep < REP_SYNC; ++rep) xcd_barrier(bar);
        }
    }
}

#ifndef N_LAUNCH_MODE
#define N_LAUNCH_MODE 1
#endif

extern "C" void kernel_launch(void* const* d_in, const int* in_sizes, int n_in, void* d_out, int out_size, void* d_ws, size_t ws_size, hipStream_t stream) {
    static int grid = 0;
    if (grid == 0) {
        if (n_in != 11 || out_size != MTOK * DM || ws_size < WS_END) { fprintf(stderr, "kernel_launch: unexpected sizes n_in %d out %d ws %zu (need %zu)\n", n_in, out_size, ws_size, (size_t)WS_END); grid = -1; return; }
        int dev = 0, cus = 0, per_cu = 0;
        hipGetDevice(&dev); hipDeviceGetAttribute(&cus, hipDeviceAttributeMultiprocessorCount, dev);
        if (hipFuncSetAttribute((const void*)fwd_kernel, hipFuncAttributeMaxDynamicSharedMemorySize, LDS_BYTES) != hipSuccess) { fprintf(stderr, "kernel_launch: hipFuncSetAttribute failed\n"); grid = -1; return; }
        if (hipOccupancyMaxActiveBlocksPerMultiprocessor(&per_cu, (const void*)fwd_kernel, NTHR, LDS_BYTES) != hipSuccess || per_cu < 1) { fprintf(stderr, "kernel_launch: occupancy query says %d\n", per_cu); per_cu = 1; }
        (void)hipGetLastError();
        grid = cus * 1;
        fprintf(stderr, "kernel_launch: grid %d (cus %d, per_cu %d)\n", grid, cus, per_cu);
    }
    if (grid < 0) return;
    Args a{};
    a.x = (const float*)d_in[0]; a.norm_mix = (const float*)d_in[1]; a.w_qkv_even = (const float*)d_in[2]; a.w_o_even = (const float*)d_in[3];
    a.w_qkvf_odd = (const float*)d_in[4]; a.b_forget = (const float*)d_in[5]; a.w_o_odd = (const float*)d_in[6]; a.norm_ffn = (const float*)d_in[7];
    a.w_ffn_in = (const float*)d_in[8]; a.w_ffn_out = (const float*)d_in[9]; a.norm_final = (const float*)d_in[10];
    a.out = (float*)d_out; a.ws = (unsigned char*)d_ws;
#if N_LAUNCH_MODE == 1
    a.ph_lo = 0; a.ph_hi = NPHASE;
    void* args[] = {&a};
    hipError_t e = hipLaunchCooperativeKernel((const void*)fwd_kernel, dim3(grid), dim3(NTHR), args, LDS_BYTES, stream);
    if (e != hipSuccess) fprintf(stderr, "cooperative launch failed: %s (grid %d)\n", hipGetErrorString(e), grid);
#else
    for (int ph = 0; ph < NPHASE; ++ph) {
        a.ph_lo = ph; a.ph_hi = ph + 1;
        hipLaunchKernelGGL(fwd_kernel, dim3(grid), dim3(NTHR), LDS_BYTES, stream, a);
    }
#endif
}
```

```cpp
#include <hip/hip_runtime.h>
#include <hip/hip_cooperative_groups.h>
#include <cstdio>
#include <cstdint>
namespace cg = cooperative_groups;
namespace pg8 {
#define PG8_LAS __attribute__((address_space(3)))
typedef unsigned short bf16_t;
typedef short bf16x8 __attribute__((ext_vector_type(8)));
typedef float f32x4 __attribute__((ext_vector_type(4)));
typedef unsigned u32x4 __attribute__((ext_vector_type(4)));
constexpr int BM = 256, BK = 64, HALF = 128, HTB = HALF * BK * 2  , STAGE_BYTES = 8 * HTB, NXCD = 8, WGM = 8;

__host__ __device__ __forceinline__ int lds_byte(int r, int c) { const int st = (r >> 4) * 2 + (c >> 5), rr = r & 15, cc = c & 31, ob = rr * 64 + cc * 2; return st * 1024 + (ob ^ (((ob >> 9) & 1) << 5)); }
__host__ __device__ __forceinline__ void stage_rc(int b, int& R, int& C) { const int st = b / 1024, sb = b % 1024, swz = sb ^ (((sb >> 9) & 1) << 5); R = (st >> 1) * 16 + swz / 64; C = (st & 1) * 32 + (swz % 64) / 2; }
__host__ __device__ __forceinline__ int perm32(int rho) { const int n = rho >> 4, i = rho & 15; return 8 * (i >> 2) + 4 * n + (i & 3); }

struct Unit { int pm, pn; };
struct Gemm { const bf16_t* A; const bf16_t* Bt; int M, N, K; };

struct StaticOrder {
    int nM, nN, nwg, G, c;
    __host__ __device__ void init(int M, int N, int G_, int c_) { nM = M / BM; nN = N / BM; nwg = nM * nN; G = G_; c = c_; }
    __host__ __device__ bool next(int i, Unit& u) const {
        const long L = (long)i * G + c; if (L >= nwg) return false;
        int wgid = (int)L; { const int q = nwg / NXCD, r = nwg % NXCD, xcd = wgid % NXCD, off = wgid / NXCD; wgid = (xcd < r ? xcd * (q + 1) : r * (q + 1) + (xcd - r) * q) + off; }
        const int nig = WGM * nN, gid = wgid / nig, fm = gid * WGM, gsz = (nM - fm) < WGM ? (nM - fm) : WGM;
        u.pm = fm + ((wgid % nig) % gsz); u.pn = (wgid % nig) / gsz; return true;
    }
    __device__ __forceinline__ void a_ready(const Unit&) const {}
    __device__ __forceinline__ void done(const Unit&) const {}
};

__device__ __forceinline__ unsigned cvt_pk_bf16(float lo, float hi) { unsigned r; asm volatile("v_cvt_pk_bf16_f32 %0, %1, %2" : "=v"(r) : "v"(lo), "v"(hi)); return r; }
constexpr float RMS_EPS_F = 1e-5f;
constexpr int RS_M = 16384;
__device__ __forceinline__ float rstd_of(const float* rowss, int row) {
    float s = 0.f;
#pragma unroll
    for (int k = 0; k < 16; ++k) s += rowss[(size_t)k * RS_M + row];
    return 1.0f / sqrtf(s * (1.0f / 1024.0f) + RMS_EPS_F);
}

__device__ __forceinline__ void rstd_tables(PG8_LAS float* rtab, const float* rowss, int fm) {
    const int t = threadIdx.x;
#pragma unroll
    for (int q = 0; q < 4; ++q) { const int r = t + 512 * q; rtab[r] = rstd_of(rowss, fm * BM + r); }
}

struct EpiQKV {
    static constexpr bool PERM = true, AFTER_DRAIN = false;
    bf16_t* O; const float* rowss; const float* rot; int rope; PG8_LAS float* rtab; int fm;
    __device__ __forceinline__ void operator()(const f32x4 (&acc)[2][2][4][2], const Unit& u, int wr, int wc, int fr, int fq) const {
        const int row0 = u.pm * BM + wr * 64 + fr;
        const int col0 = u.pn * BM + wc * 32 + 8 * fq;
        const bool rt = rope && ((u.pn & 2) != 0) && (u.pn < 8) && ((wc & 1) == 0);
#pragma unroll
        for (int ai = 0; ai < 2; ++ai)
#pragma unroll
            for (int m = 0; m < 4; ++m) {
                const int row = row0 + ai * HALF + m * 16;
                const float rs = ((u.pm & ~7) == fm) ? rtab[(u.pm & 7) * BM + wr * 64 + fr + ai * HALF + m * 16] : rstd_of(rowss, row);
                bf16_t* rowp = O + (size_t)row * 3072 + col0;
                f32x4 c0 = {1.f, 1.f, 1.f, 1.f}, c1 = c0, s0 = {0.f, 0.f, 0.f, 0.f}, s1 = s0;
                if (rt) { const f32x4* rp = (const f32x4*)(rot + (size_t)(row & 2047) * 16); c0 = rp[0]; c1 = rp[1]; s0 = rp[2]; s1 = rp[3]; }
#pragma unroll
                for (int bj = 0; bj < 2; ++bj) {
                    f32x4 v0 = acc[ai][bj][m][0] * rs, v1 = acc[ai][bj][m][1] * rs;
                    if (rt) {
                        f32x4 p0, p1;
#pragma unroll
                        for (int e = 0; e < 4; ++e) { p0[e] = __shfl_xor(v0[e], 16); p1[e] = __shfl_xor(v1[e], 16); }
                        if (fq == 0) { v0 = v0 * c0 - p0 * s0; v1 = v1 * c1 - p1 * s1; }
                        else if (fq == 1) { v0 = v0 * c0 + p0 * s0; v1 = v1 * c1 + p1 * s1; }
                    }
                    u32x4 w; w.x = cvt_pk_bf16(v0[0], v0[1]); w.y = cvt_pk_bf16(v0[2], v0[3]); w.z = cvt_pk_bf16(v1[0], v1[1]); w.w = cvt_pk_bf16(v1[2], v1[3]);
                    *(u32x4*)(rowp + bj * HALF) = w;
                }
            }
    }
};

__device__ __forceinline__ float bf_lo(unsigned u) { return __builtin_bit_cast(float, u << 16); }
__device__ __forceinline__ float bf_hi(unsigned u) { return __builtin_bit_cast(float, u & 0xffff0000u); }
#ifndef RES_F32
#define RES_F32 0
#endif
template <bool XIN_F32> struct EpiResid {
    static constexpr bool PERM = true, AFTER_DRAIN = false;
    const float* xin32; bf16_t* xb; float* rowss_next; float* xres;
    __device__ __forceinline__ void operator()(const f32x4 (&acc)[2][2][4][2], const Unit& u, int wr, int wc, int fr, int fq) const {
        const int row0 = u.pm * BM + wr * 64 + fr;
        const int col0 = u.pn * BM + wc * 32 + 8 * fq;
#pragma unroll
        for (int ai = 0; ai < 2; ++ai)
#pragma unroll
            for (int m = 0; m < 4; ++m) {
                const int row = row0 + ai * HALF + m * 16;
                float ss = 0.f;
#pragma unroll
                for (int bj = 0; bj < 2; ++bj) {
                    const size_t off = (size_t)row * 1024 + col0 + bj * HALF;
                    f32x4 a0, a1;
                    if (XIN_F32 || RES_F32) { const f32x4* xi = (const f32x4*)((XIN_F32 ? xin32 : (const float*)xres) + off); a0 = xi[0]; a1 = xi[1]; }
                    else { const u32x4 xw = *(const u32x4*)(xb + off);
                           a0 = (f32x4){bf_lo(xw.x), bf_hi(xw.x), bf_lo(xw.y), bf_hi(xw.y)}; a1 = (f32x4){bf_lo(xw.z), bf_hi(xw.z), bf_lo(xw.w), bf_hi(xw.w)}; }
                    a0 = a0 + acc[ai][bj][m][0]; a1 = a1 + acc[ai][bj][m][1];
                    if (RES_F32) { f32x4* xo = (f32x4*)(xres + off); xo[0] = a0; xo[1] = a1; }
                    u32x4 w; w.x = cvt_pk_bf16(a0[0], a0[1]); w.y = cvt_pk_bf16(a0[2], a0[3]); w.z = cvt_pk_bf16(a1[0], a1[1]); w.w = cvt_pk_bf16(a1[2], a1[3]);
                    *(u32x4*)(xb + off) = w;
                    const float r0 = RES_F32 ? a0[0] : bf_lo(w.x), r1 = RES_F32 ? a0[1] : bf_hi(w.x), r2 = RES_F32 ? a0[2] : bf_lo(w.y), r3 = RES_F32 ? a0[3] : bf_hi(w.y), r4 = RES_F32 ? a1[0] : bf_lo(w.z), r5 = RES_F32 ? a1[1] : bf_hi(w.z), r6 = RES_F32 ? a1[2] : bf_lo(w.w), r7 = RES_F32 ? a1[3] : bf_hi(w.w);
                    ss += (r0 * r0 + r1 * r1) + (r2 * r2 + r3 * r3) + (r4 * r4 + r5 * r5) + (r6 * r6 + r7 * r7);
                }
                ss += __shfl_xor(ss, 16); ss += __shfl_xor(ss, 32);
                if (fq == 0) rowss_next[(size_t)(u.pn * 4 + wc) * RS_M + row] = ss;
            }
    }
};

struct EpiSwiGLU {
    static constexpr bool PERM = true, AFTER_DRAIN = false;
    bf16_t* H; const float* rowss; PG8_LAS float* rtab; int fm;
    __device__ __forceinline__ void operator()(const f32x4 (&acc)[2][2][4][2], const Unit& u, int wr, int wc, int fr, int fq) const {
        const int row0 = u.pm * BM + wr * 64 + fr;
        const int col0 = u.pn * HALF + wc * 32 + 8 * fq;
#pragma unroll
        for (int ai = 0; ai < 2; ++ai)
#pragma unroll
            for (int m = 0; m < 4; ++m) {
                const int row = row0 + ai * HALF + m * 16;
                const float rs = ((u.pm & ~7) == fm) ? rtab[(u.pm & 7) * BM + wr * 64 + fr + ai * HALF + m * 16] : rstd_of(rowss, row);
                float h[8];
#pragma unroll
                for (int n = 0; n < 2; ++n)
#pragma unroll
                    for (int e = 0; e < 4; ++e) {
                        const float g = acc[ai][0][m][n][e] * rs, up = acc[ai][1][m][n][e] * rs;
                        const float sg = g * __builtin_amdgcn_rcpf(1.0f + __builtin_amdgcn_exp2f(-1.4426950408889634f * g));
                        h[n * 4 + e] = sg * up;
                    }
                u32x4 w; w.x = cvt_pk_bf16(h[0], h[1]); w.y = cvt_pk_bf16(h[2], h[3]); w.z = cvt_pk_bf16(h[4], h[5]); w.w = cvt_pk_bf16(h[6], h[7]);
                *(u32x4*)(H + (size_t)row * 2816 + col0) = w;
            }
    }
};

struct EpiFinal {
    static constexpr bool PERM = true, AFTER_DRAIN = false;
    const bf16_t* xin; float* out; float* rowss_next; const float* gfin; unsigned* cnt; const float* xres;
    __device__ __forceinline__ void operator()(f32x4 (&acc)[2][2][4][2], const Unit& u, int wr, int wc, int fr, int fq) const {
        const int row0 = u.pm * BM + wr * 64 + fr;
        const int col0 = u.pn * BM + wc * 32 + 8 * fq;
#pragma unroll
        for (int ai = 0; ai < 2; ++ai)
#pragma unroll
            for (int m = 0; m < 4; ++m) {
                const int row = row0 + ai * HALF + m * 16;
                float ss = 0.f;
#pragma unroll
                for (int bj = 0; bj < 2; ++bj) {
                    f32x4 a0, a1;
                    if (RES_F32) { const f32x4* xi = (const f32x4*)(xres + (size_t)row * 1024 + col0 + bj * HALF); a0 = xi[0] + acc[ai][bj][m][0]; a1 = xi[1] + acc[ai][bj][m][1]; }
                    else { const u32x4 xw = *(const u32x4*)(xin + (size_t)row * 1024 + col0 + bj * HALF);
                           a0 = (f32x4){bf_lo(xw.x), bf_hi(xw.x), bf_lo(xw.y), bf_hi(xw.y)} + acc[ai][bj][m][0]; a1 = (f32x4){bf_lo(xw.z), bf_hi(xw.z), bf_lo(xw.w), bf_hi(xw.w)} + acc[ai][bj][m][1]; }
                    acc[ai][bj][m][0] = a0; acc[ai][bj][m][1] = a1;
                    ss += (a0[0] * a0[0] + a0[1] * a0[1]) + (a0[2] * a0[2] + a0[3] * a0[3]) + (a1[0] * a1[0] + a1[1] * a1[1]) + (a1[2] * a1[2] + a1[3] * a1[3]);
                }
                ss += __shfl_xor(ss, 16); ss += __shfl_xor(ss, 32);
                if (fq == 0) __hip_atomic_store(rowss_next + (size_t)(u.pn * 4 + wc) * RS_M + row, ss, __ATOMIC_RELAXED, __HIP_MEMORY_SCOPE_AGENT);
            }
        asm volatile("s_waitcnt vmcnt(0)" ::: "memory");
        unsigned* c = cnt + 64 * u.pm;
        if ((threadIdx.x & 63) == 0) __hip_atomic_fetch_add(c, 1u, __ATOMIC_RELAXED, __HIP_MEMORY_SCOPE_AGENT);
        { unsigned sp = 0;
          while ((unsigned)__builtin_amdgcn_readfirstlane((int)__hip_atomic_load(c, __ATOMIC_RELAXED, __HIP_MEMORY_SCOPE_AGENT)) < 32u) { __builtin_amdgcn_s_sleep(1); if (++sp > (1u << 22)) break; } }
        __builtin_amdgcn_fence(__ATOMIC_ACQUIRE, "agent");
        f32x4 g0[2], g1[2];
#pragma unroll
        for (int bj = 0; bj < 2; ++bj) { const f32x4* gp = (const f32x4*)(gfin + col0 + bj * HALF); g0[bj] = gp[0]; g1[bj] = gp[1]; }
#pragma unroll
        for (int ai = 0; ai < 2; ++ai)
#pragma unroll
            for (int m = 0; m < 4; ++m) {
                const int row = row0 + ai * HALF + m * 16;
                float tot = 0.f;
#pragma unroll
                for (int k = 0; k < 16; ++k) tot += __hip_atomic_load(rowss_next + (size_t)k * RS_M + row, __ATOMIC_RELAXED, __HIP_MEMORY_SCOPE_AGENT);
                const float rs = 1.0f / sqrtf(tot * (1.0f / 1024.0f) + RMS_EPS_F);
#pragma unroll
                for (int bj = 0; bj < 2; ++bj) {
                    f32x4* o = (f32x4*)(out + (size_t)row * 1024 + col0 + bj * HALF);
                    o[0] = acc[ai][bj][m][0] * rs * g0[bj]; o[1] = acc[ai][bj][m][1] * rs * g1[bj];
                }
            }
    }
};

struct EpiNull {
    static constexpr bool PERM = true, AFTER_DRAIN = false;
    float* sink;
    __device__ __forceinline__ void operator()(const f32x4 (&acc)[2][2][4][2], const Unit& u, int wr, int wc, int fr, int fq) const {
        if (u.pm < 0) {
#pragma unroll
            for (int ai = 0; ai < 2; ++ai)
#pragma unroll
                for (int m = 0; m < 4; ++m)
#pragma unroll
                    for (int bj = 0; bj < 2; ++bj) { f32x4* o = (f32x4*)(sink + (size_t)(ai * 8 + m * 2 + bj) * 8 + fr); o[0] = acc[ai][bj][m][0]; o[1] = acc[ai][bj][m][1]; }
        }
    }
};

template <class Epi, class Sched, bool ALIGN_EPI = false, bool SP2 = false>
__device__ __forceinline__ void gemm_phase(PG8_LAS unsigned char* lds, const Gemm g, const Sched& S, const Epi& E) {
    int tid_ = threadIdx.x; asm volatile("" : "+v"(tid_));
    const int tid = tid_, wid = __builtin_amdgcn_readfirstlane(tid >> 6), lane = tid & 63, wr = wid >> 2, wc = wid & 3, fr = lane & 15, fq = lane >> 4;
    const int K = g.K, nt = K / BK;
    unsigned voffA[2], voffB[2];
#pragma unroll
    for (int i = 0; i < 2; ++i) { int R, C; stage_rc(tid * 16 + i * 8192, R, C); const int Rb = Epi::PERM ? ((R & ~31) + perm32(R & 31)) : R;
        voffA[i] = (unsigned)(R * K + C) * 2u; voffB[i] = (unsigned)(Rb * K + C) * 2u; }
    const size_t kstep = (size_t)(BK * 2);
    const size_t hstep = (size_t)HALF * K * 2;
    const size_t tstep = 2 * hstep;
    const unsigned ldsw = (unsigned)wid * 1024u;
    const int aoff = lds_byte(wr * 64 + fr, fq * 8), boff = lds_byte(wc * 32 + fr, fq * 8);
#define PG8_SA(b, h) (((b) * 2 + (h)) * HTB)
#define PG8_SB(b, h) ((4 + (b) * 2 + (h)) * HTB)
#define PG8_STAGE(bufoff, gbase, voff) do { _Pragma("unroll") for (int _i = 0; _i < 2; ++_i) \
        __builtin_amdgcn_global_load_lds((const unsigned*)((const char*)(gbase) + (voff)[_i]), (PG8_LAS unsigned*)(lds + (bufoff) + ldsw + _i * 8192), 16, 0, 0); } while (0)
#define PG8_LDA(dst, b, h) do { _Pragma("unroll") for (int m = 0; m < 4; ++m) _Pragma("unroll") for (int k = 0; k < 2; ++k) dst[m][k] = *(const PG8_LAS bf16x8*)(lds + PG8_SA(b, h) + aoff + m * 2048 + k * 1024); } while (0)
#define PG8_LDB(dst, b, h) do { _Pragma("unroll") for (int n = 0; n < 2; ++n) _Pragma("unroll") for (int k = 0; k < 2; ++k) dst[n][k] = *(const PG8_LAS bf16x8*)(lds + PG8_SB(b, h) + boff + n * 2048 + k * 1024); } while (0)
#define PG8_MMA(ai, bj, At, Bt) do { __builtin_amdgcn_s_setprio(1); _Pragma("unroll") for (int m = 0; m < 4; ++m) _Pragma("unroll") for (int n = 0; n < 2; ++n) _Pragma("unroll") for (int k = 0; k < 2; ++k) \
        acc[ai][bj][m][n] = __builtin_amdgcn_mfma_f32_16x16x32_bf16(Bt[n][k], At[m][k], acc[ai][bj][m][n], 0, 0, 0); __builtin_amdgcn_s_setprio(0); } while (0)
#define PG8_WAIT_V(n) asm volatile("s_waitcnt vmcnt(" #n ")" ::: "memory")
#define PG8_WAIT_L(n) asm volatile("s_waitcnt lgkmcnt(" #n ")" ::: "memory")
#define PG8_BAR __builtin_amdgcn_s_barrier()
#define PG8_SCHED __builtin_amdgcn_sched_barrier(0)
    Unit cur, nxt; int ui = 0;
    if (!S.next(0, cur)) return;
    f32x4 acc[2][2][4][2];
#pragma unroll
    for (int a = 0; a < 2; ++a)
#pragma unroll
        for (int b = 0; b < 2; ++b)
#pragma unroll
            for (int m = 0; m < 4; ++m)
#pragma unroll
                for (int n = 0; n < 2; ++n) acc[a][b][m][n] = (f32x4){0.f, 0.f, 0.f, 0.f};
    bf16x8 At[4][2], B0[2][2], B1[2][2];
    const char* cA = (const char*)g.A + (size_t)cur.pm * tstep; const char* cB = (const char*)g.Bt + (size_t)cur.pn * tstep;
    S.a_ready(cur);
    if constexpr (SP2) {
        PG8_STAGE(PG8_SB(0, 0), cB, voffB); PG8_STAGE(PG8_SB(0, 1), cB + hstep, voffB); PG8_STAGE(PG8_SA(0, 0), cA, voffA); PG8_STAGE(PG8_SA(0, 1), cA + hstep, voffA);
        if (wr == 1) PG8_BAR;
        PG8_WAIT_V(2); PG8_BAR;
        PG8_STAGE(PG8_SB(1, 0), cB + kstep, voffB); PG8_STAGE(PG8_SA(1, 0), cA + kstep, voffA); PG8_STAGE(PG8_SB(1, 1), cB + hstep + kstep, voffB);
        PG8_WAIT_V(6); PG8_BAR;
    } else {
        PG8_STAGE(PG8_SB(0, 0), cB, voffB); PG8_STAGE(PG8_SA(0, 0), cA, voffA); PG8_STAGE(PG8_SB(0, 1), cB + hstep, voffB); PG8_STAGE(PG8_SA(0, 1), cA + hstep, voffA);
        if (wr == 1) PG8_BAR;
        PG8_WAIT_V(4); PG8_BAR;
        PG8_STAGE(PG8_SB(1, 0), cB + kstep, voffB); PG8_STAGE(PG8_SA(1, 0), cA + kstep, voffA); PG8_STAGE(PG8_SB(1, 1), cB + hstep + kstep, voffB);
        PG8_WAIT_V(6); PG8_BAR;
    }
    for (;;) {
        const bool has_next = S.next(ui + 1, nxt);
        const char* nA = has_next ? (const char*)g.A + (size_t)nxt.pm * tstep : cA; const char* nB = has_next ? (const char*)g.Bt + (size_t)nxt.pn * tstep : cB;
        for (int t = 0; t < nt; t += 2) {
            const bool last = (t == nt - 2);
            const char* a1 = cA + (size_t)(t + 1) * kstep;
            const char* a2 = last ? nA : cA + (size_t)(t + 2) * kstep; const char* b2 = last ? nB : cB + (size_t)(t + 2) * kstep;
            const char* a3 = a2 + kstep; const char* b3 = b2 + kstep;
            if (last && has_next) S.a_ready(nxt);
            if constexpr (SP2) {
            PG8_LDB(B0, 0, 0); PG8_LDB(B1, 0, 1); PG8_SCHED; PG8_LDA(At, 0, 0); PG8_STAGE(PG8_SA(1, 1), a1 + hstep, voffA);
            PG8_WAIT_V(8); PG8_WAIT_L(0); PG8_BAR; PG8_MMA(0, 0, At, B0); PG8_MMA(0, 1, At, B1); PG8_BAR; PG8_SCHED;
            PG8_LDA(At, 0, 1); PG8_STAGE(PG8_SB(0, 0), b2, voffB); PG8_STAGE(PG8_SB(0, 1), b2 + hstep, voffB); PG8_STAGE(PG8_SA(0, 0), a2, voffA);
            PG8_WAIT_V(8); PG8_WAIT_L(0); PG8_BAR; PG8_MMA(1, 0, At, B0); PG8_MMA(1, 1, At, B1); PG8_BAR; PG8_SCHED;
            PG8_LDB(B0, 1, 0); PG8_LDB(B1, 1, 1); PG8_SCHED; PG8_LDA(At, 1, 0); PG8_STAGE(PG8_SA(0, 1), a2 + hstep, voffA);
            PG8_WAIT_V(8); PG8_WAIT_L(0); PG8_BAR; PG8_MMA(0, 0, At, B0); PG8_MMA(0, 1, At, B1); PG8_BAR; PG8_SCHED;
            PG8_LDA(At, 1, 1); PG8_STAGE(PG8_SB(1, 0), b3, voffB); PG8_STAGE(PG8_SB(1, 1), b3 + hstep, voffB); PG8_STAGE(PG8_SA(1, 0), a3, voffA);
            PG8_WAIT_V(8); PG8_WAIT_L(0); PG8_BAR; PG8_MMA(1, 0, At, B0); PG8_MMA(1, 1, At, B1); PG8_BAR; PG8_SCHED;
            } else {
            PG8_LDB(B0, 0, 0); PG8_SCHED; PG8_LDA(At, 0, 0); PG8_STAGE(PG8_SA(1, 1), a1 + hstep, voffA);
            PG8_WAIT_L(8); PG8_BAR; PG8_WAIT_L(0); PG8_MMA(0, 0, At, B0); PG8_BAR; PG8_SCHED;
            PG8_LDB(B1, 0, 1); PG8_STAGE(PG8_SB(0, 0), b2, voffB);
            PG8_BAR; PG8_WAIT_L(0); PG8_MMA(0, 1, At, B1); PG8_BAR;
            PG8_LDA(At, 0, 1); PG8_STAGE(PG8_SA(0, 0), a2, voffA);
            PG8_BAR; PG8_WAIT_L(0); PG8_MMA(1, 0, At, B0); PG8_BAR; PG8_SCHED;
            PG8_STAGE(PG8_SB(0, 1), b2 + hstep, voffB);
            PG8_WAIT_V(6); PG8_BAR; PG8_MMA(1, 1, At, B1); PG8_BAR;
            PG8_LDB(B0, 1, 0); PG8_SCHED; PG8_LDA(At, 1, 0); PG8_STAGE(PG8_SA(0, 1), a2 + hstep, voffA);
            PG8_WAIT_L(8); PG8_BAR; PG8_WAIT_L(0); PG8_MMA(0, 0, At, B0); PG8_BAR; PG8_SCHED;
            PG8_LDB(B1, 1, 1); PG8_STAGE(PG8_SB(1, 0), b3, voffB);
            PG8_BAR; PG8_WAIT_L(0); PG8_MMA(0, 1, At, B1); PG8_BAR;
            PG8_LDA(At, 1, 1); PG8_STAGE(PG8_SA(1, 0), a3, voffA);
            PG8_BAR; PG8_WAIT_L(0); PG8_MMA(1, 0, At, B0); PG8_BAR; PG8_SCHED;
            PG8_STAGE(PG8_SB(1, 1), b3 + hstep, voffB);
            PG8_WAIT_V(6); PG8_BAR; PG8_MMA(1, 1, At, B1); PG8_BAR;
            }
        }
        if constexpr (ALIGN_EPI) { if (wr == 0) PG8_BAR; }
        if constexpr (!Epi::AFTER_DRAIN) { E(acc, cur, wr, wc, fr, fq); S.done(cur); }
        if (!has_next) break;
#pragma unroll
        for (int a = 0; a < 2; ++a)
#pragma unroll
            for (int b = 0; b < 2; ++b)
#pragma unroll
                for (int m = 0; m < 4; ++m)
#pragma unroll
                    for (int n = 0; n < 2; ++n) acc[a][b][m][n] = (f32x4){0.f, 0.f, 0.f, 0.f};
        cur = nxt; cA = nA; cB = nB; ++ui;
        if constexpr (ALIGN_EPI) { if (wr == 1) PG8_BAR; }
    }
    PG8_WAIT_V(0);
    if constexpr (!ALIGN_EPI) { if (wr == 0) PG8_BAR; }
    PG8_BAR;
    if constexpr (Epi::AFTER_DRAIN) { E.fused(acc, cur, wr, wc, fr, fq, lds, wid, lane); S.done(cur); }
#undef PG8_SA
#undef PG8_SB
#undef PG8_STAGE
#undef PG8_LDA
#undef PG8_LDB
#undef PG8_MMA
#undef PG8_WAIT_V
#undef PG8_WAIT_L
#undef PG8_BAR
#undef PG8_SCHED
}
}
#include <hip/hip_bf16.h>
#include <cmath>
namespace attn_body {
using bf16=__hip_bfloat16;
using bf16x8=__attribute__((ext_vector_type(8)))short;
using s16x4=__attribute__((ext_vector_type(4)))short;
using f32x16=__attribute__((ext_vector_type(16)))float;
using u32x4=__attribute__((ext_vector_type(4)))unsigned;
using f32x4_t=__attribute__((ext_vector_type(4)))float;
constexpr int BATCH=8,NHEAD=16,SEQ=2048,D=64,DM=3072,DMO=1024;
constexpr int NW=8,QBLK=32,QB=QBLK*NW,KVBLK=64,NQB=SEQ/QB;
constexpr int ATTN_PITCH=DM, ATTN_UNIT_ROWS=QB;
__device__ __forceinline__ int crow(int r,int hi){return (r&3)+8*(r>>2)+4*hi;}
#define SBAR() __builtin_amdgcn_sched_barrier(0)
__device__ __forceinline__ void cmask(f32x16&p0,f32x16&p1,int jb,int qrel,int hi){
  const float NEG=-INFINITY; int kb=64*jb+4*hi;
  #pragma unroll
  for(int r=0;r<16;++r){int kv=kb+(r&3)+8*(r>>2); if(kv>qrel)p0[r]=NEG; if(kv+32>qrel)p1[r]=NEG;}
}

constexpr int NSLOT=3, SLOTB=8192;
constexpr int LDS_K=0, LDS_V=NSLOT*SLOTB, LDS_WS=2*NSLOT*SLOTB, LDS_OST=LDS_WS+NW*64*4, LDS_BYTES=LDS_OST+NW*4096;
constexpr float C2=0.125f*1.4426950408889634f;
__device__ __forceinline__ void glds16(const void*gsrc,unsigned lds_dst){unsigned keep;
  asm volatile("s_mov_b32 %0, m0\n\ts_mov_b32 m0, %2\n\ts_nop 0\n\tglobal_load_lds_dwordx4 %1, off\n\ts_mov_b32 m0, %0":"=&s"(keep):"v"(gsrc),"s"(lds_dst):"memory");}
__device__ __forceinline__ float max3f(float a,float b,float c){float r;asm("v_max3_f32 %0, %1, %2, %3":"=v"(r):"v"(a),"v"(b),"v"(c));return r;}
__device__ __forceinline__ float max2f(float a,float b){float r;asm("v_max_f32_e32 %0, %1, %2":"=v"(r):"v"(a),"v"(b));return r;}
__device__ __forceinline__ float fadd_s(float a,float b){float r;asm("v_add_f32_e32 %0, %1, %2":"=v"(r):"v"(a),"v"(b));return r;}
__device__ __forceinline__ float fsub_s(float a,float b){float r;asm("v_sub_f32_e32 %0, %1, %2":"=v"(r):"v"(a),"v"(b));return r;}
typedef float f32x2_t __attribute__((ext_vector_type(2))); typedef __bf16 bf16x2_t __attribute__((ext_vector_type(2)));
__device__ __forceinline__ unsigned cvtpk_s(float lo,float hi){f32x2_t v={lo,hi};bf16x2_t b=__builtin_convertvector(v,bf16x2_t);return __builtin_bit_cast(unsigned,b);}
#define WAIT_BAR(N) asm volatile("s_waitcnt vmcnt(" #N ") lgkmcnt(0)\n\ts_barrier":::"memory")

__device__ __forceinline__ void qkt(f32x16&p0,f32x16&p1,const char*Kslot,const bf16x8*qr,int r32,int hi){
  const char*kb=Kslot+hi*1024+r32*16;
  #pragma unroll
  for(int d0=0;d0<4;++d0){
    const bf16x8 b0=*reinterpret_cast<const bf16x8*>(kb+d0*2048);
    const bf16x8 b1=*reinterpret_cast<const bf16x8*>(kb+d0*2048+512);
    p0=__builtin_amdgcn_mfma_f32_32x32x16_bf16(b0,qr[d0],p0,0,0,0);p1=__builtin_amdgcn_mfma_f32_32x32x16_bf16(b1,qr[d0],p1,0,0,0);}
}
typedef __attribute__((address_space(3))) const char* lds_cptr;
typedef short v4i16_t __attribute__((ext_vector_type(4)));
__device__ __forceinline__ void kload8(bf16x8*kf,lds_cptr kp){
  kf[0]=*(const __attribute__((address_space(3))) bf16x8*)(kp);      kf[1]=*(const __attribute__((address_space(3))) bf16x8*)(kp+512);
  kf[2]=*(const __attribute__((address_space(3))) bf16x8*)(kp+2048); kf[3]=*(const __attribute__((address_space(3))) bf16x8*)(kp+2560);
  kf[4]=*(const __attribute__((address_space(3))) bf16x8*)(kp+4096); kf[5]=*(const __attribute__((address_space(3))) bf16x8*)(kp+4608);
  kf[6]=*(const __attribute__((address_space(3))) bf16x8*)(kp+6144); kf[7]=*(const __attribute__((address_space(3))) bf16x8*)(kp+6656);
}
__device__ __forceinline__ void kload2(bf16x8*kf,lds_cptr kp,int j){ kf[2*j]=*(const __attribute__((address_space(3))) bf16x8*)(kp+j*2048); kf[2*j+1]=*(const __attribute__((address_space(3))) bf16x8*)(kp+j*2048+512); }
__device__ __forceinline__ s16x4 vtr(lds_cptr p){ return __builtin_bit_cast(s16x4,__builtin_amdgcn_ds_read_tr16_b64_v4i16((__attribute__((address_space(3))) v4i16_t*)p)); }
__device__ __forceinline__ float rowmax(const f32x16&p0,const f32x16&p1){
  float a=max3f(p0[0],p0[1],p1[0]),b=max3f(p0[2],p0[3],p1[1]);a=max3f(a,p1[2],p1[3]);
  #pragma unroll
  for(int r=4;r<16;r+=4){a=max3f(a,p0[r],p0[r+1]);b=max3f(b,p0[r+2],p0[r+3]);a=max3f(a,p1[r],p1[r+1]);b=max3f(b,p1[r+2],p1[r+3]);}
  const float m=max2f(a,b);
  auto rr=__builtin_amdgcn_permlane32_swap(__float_as_uint(m),__float_as_uint(m),false,false);
  return max2f(__uint_as_float(rr[0]),__uint_as_float(rr[1]));
}
__device__ __forceinline__ void pv(f32x16*o,int vb,bf16x8 pa0,bf16x8 pa1,bf16x8 pa2,bf16x8 pa3){
  #pragma unroll
  for(int d0=0;d0<2;++d0){s16x4 lo[4],hi[4];
    #pragma unroll
    for(int ks=0;ks<4;++ks){
      asm volatile("ds_read_b64_tr_b16 %0,%1 offset:%c2":"=&v"(lo[ks]):"v"(vb),"i"(d0*4096+ks*1024):"memory");
      asm volatile("ds_read_b64_tr_b16 %0,%1 offset:%c2":"=&v"(hi[ks]):"v"(vb),"i"(d0*4096+ks*1024+512):"memory");}
    asm volatile("s_waitcnt lgkmcnt(0)":::"memory");SBAR();
    #define PK(k) (bf16x8){lo[k][0],lo[k][1],lo[k][2],lo[k][3],hi[k][0],hi[k][1],hi[k][2],hi[k][3]}
    o[d0]=__builtin_amdgcn_mfma_f32_32x32x16_bf16(pa0,PK(0),o[d0],0,0,0);
    o[d0]=__builtin_amdgcn_mfma_f32_32x32x16_bf16(pa1,PK(1),o[d0],0,0,0);
    o[d0]=__builtin_amdgcn_mfma_f32_32x32x16_bf16(pa2,PK(2),o[d0],0,0,0);
    o[d0]=__builtin_amdgcn_mfma_f32_32x32x16_bf16(pa3,PK(3),o[d0],0,0,0);
    #undef PK
  }
}

#ifndef ATTN_STORE16
#define ATTN_STORE16(p,v) (*(u32x4*)(p)=(v))
#endif
template<int THRL> __device__ __forceinline__ void attn_unit(int b,int h,int qb,const bf16*Q,const bf16*__restrict__ K,const bf16*__restrict__ V,bf16*O,char*shm,const __attribute__((address_space(3))) float*Fs){
  int tid_=threadIdx.x; asm volatile("":"+v"(tid_)); const int tid=tid_,lane=tid&63,r32=lane&31,hi=lane>>5;   const int wid=__builtin_amdgcn_readfirstlane(tid>>6);
  const long rowbase=(long)b*SEQ; const int q0=qb*QB;
  const bf16*Qw=Q+(rowbase+q0+wid*QBLK)*DM+h*D;
  const bf16*Kh=K+rowbase*DM+h*D,*Vh=V+rowbase*DM+h*D;
  const unsigned lds0=(unsigned)(uintptr_t)shm;
  float*wsf=(float*)(shm+LDS_WS)+wid*64;
  const bf16*ksrc=Kh+(long)lane*DM+wid*8;
  const bf16*vsrc=Vh+(long)(16*(wid&3)+(lane>>2))*DM+(wid>>2)*32+(lane&3)*8;
  const unsigned kdst=lds0+LDS_K+wid*1024, vdst=lds0+LDS_V+wid*1024;
  #define DMA_K(t,slot) glds16(ksrc+(long)(t)*KVBLK*DM,(unsigned)__builtin_amdgcn_readfirstlane(kdst+(slot)))
  #define DMA_V(t,slot) glds16(vsrc+(long)(t)*KVBLK*DM,(unsigned)__builtin_amdgcn_readfirstlane(vdst+(slot)))
  const int vb0=(int)(lds0+LDS_V)+((lane>>4)&1)*32+(lane&3)*8+(4*hi+((lane&15)>>2))*64;
  const char*Kbase=shm+LDS_K; bf16x8 kf[8];
  const lds_cptr shm3=(lds_cptr)shm; const lds_cptr kp0=shm3+LDS_K+hi*1024+r32*16; const lds_cptr vp0=shm3+LDS_V+((lane>>4)&1)*32+(lane&3)*8+(4*hi+((lane&15)>>2))*64;
  const int NT=(q0+QB)/KVBLK;
  DMA_K(0,0);DMA_V(0,0);DMA_K(1,SLOTB);
  bf16x8 qr[4];
  #pragma unroll
  for(int d0=0;d0<4;++d0)qr[d0]=*reinterpret_cast<const bf16x8*>(&Qw[(long)r32*DM+d0*16+hi*8]);
  float mhat=0.f,l_reg=0.f;f32x16 o[2];o[0]=f32x16{};o[1]=f32x16{};
  const int qrel=wid*QBLK+r32;
  const float Fq=Fs[q0+qrel];
  #define BIAS(C0,C1,t) do{ const __attribute__((address_space(3))) f32x4_t*fk_=(const __attribute__((address_space(3))) f32x4_t*)(Fs+64*(t)+4*hi); const float fb_=Fq-mhat; \
    _Pragma("unroll") for(int g_=0;g_<4;++g_){ const f32x4_t a_=fk_[2*g_], b_=fk_[8+2*g_]; \
      _Pragma("unroll") for(int e_=0;e_<4;++e_){ C0[4*g_+e_]=fb_-a_[e_]; C1[4*g_+e_]=fb_-b_[e_]; } } }while(0)
  #define CMASK(P0,P1,t) do{int jb_=(t)-(NT-4); if(jb_>=0)cmask(P0,P1,jb_,qrel,hi);}while(0)
  bool resc=false;
  #define START(P0,P1) do{ const float rm=rowmax(P0,P1); resc=false; \
    { const float dl=rm; mhat=fadd_s(mhat,dl); \
      _Pragma("unroll") for(int r=0;r<16;++r){P0[r]=fsub_s(P0[r],dl);P1[r]=fsub_s(P1[r],dl);} \
      } \
    _Pragma("unroll") for(int r=0;r<16;++r)P0[r]=__builtin_amdgcn_exp2f(P0[r]); }while(0)
  #define RESC() do{ if(resc){ asm volatile("s_waitcnt lgkmcnt(0)":::"memory"); \
      _Pragma("unroll") for(int d_=0;d_<2;++d_) _Pragma("unroll") for(int r=0;r<16;++r)o[d_][r]*=wsf[crow(r,hi)]; } }while(0)
  f32x16 pA0,pA1,pB0,pB1;
  int sl_prev=0,sl_cur=0,sl_next=SLOTB;
  #define ROT() do{sl_prev=sl_cur;sl_cur=sl_next;sl_next=(sl_next==(NSLOT-1)*SLOTB)?0:sl_next+SLOTB;}while(0)
  DMA_K(2,2*SLOTB);
  WAIT_BAR(3);
  BIAS(pA0,pA1,0); qkt(pA0,pA1,Kbase,qr,r32,hi);asm volatile("s_nop 15\n\ts_nop 7":"+v"(pA0),"+v"(pA1));CMASK(pA0,pA1,0);
  START(pA0,pA1);
  _Pragma("unroll") for(int r=0;r<16;++r)pA1[r]=__builtin_amdgcn_exp2f(pA1[r]);
  WAIT_BAR(0);
  DMA_K(3,0);DMA_V(1,SLOTB);
  ROT();
  kload8(kf,kp0+sl_cur);
  WAIT_BAR(2);
  s16x4 vlo[8],vhi[8]; u32x4 pw0,pw1,pw2,pw3;
  #define PKW(P,B) cvtpk_s(P[B],P[B+1])
  #define PAF(k) __builtin_bit_cast(bf16x8,pw##k)
  #define VFR(i) (bf16x8){vlo[i][0],vlo[i][1],vlo[i][2],vlo[i][3],vhi[i][0],vhi[i][1],vhi[i][2],vhi[i][3]}
  #define PIN(x) asm volatile("":"+v"(x))
  #define MX3(a,b,c) __builtin_fmaxf(__builtin_fmaxf((a),(b)),(c))
  #define GAPA(MF,A0,A1,A2,A3,W0,W1,PW) do{ MF; sacc+=A0; sacc+=A1; sacc+=A2; sacc+=A3; PIN(sacc); W0; W1; PIN(PW); SBAR(); }while(0)
  #define EX(v) __builtin_amdgcn_exp2f(v)
  #define GAPB(MF,X,B,FS) do{ MF; X[B]=EX(X[B]); X[B+1]=EX(X[B+1]); X[B+2]=EX(X[B+2]); X[B+3]=EX(X[B+3]); PIN(X); FS; SBAR(); }while(0)
  #define FKLOAD(P0,P1,t) do{ const __attribute__((address_space(3))) f32x4_t*fk_=(const __attribute__((address_space(3))) f32x4_t*)(Fs+64*(t)+4*hi); \
    _Pragma("unroll") for(int g_=0;g_<4;++g_){ const f32x4_t a_=fk_[2*g_], b_=fk_[8+2*g_]; \
      _Pragma("unroll") for(int e_=0;e_<4;++e_){ P0[4*g_+e_]=a_[e_]; P1[4*g_+e_]=b_[e_]; } } }while(0)
  #define FSUB(G,P,B) do{ if(G){ P[B]=fb_-P[B]; P[B+1]=fb_-P[B+1]; P[B+2]=fb_-P[B+2]; P[B+3]=fb_-P[B+3]; PIN(P); } }while(0)
  #define VRD(i) do{ vlo[i]=vtr(vp_+(((i)>>2)*4096+((i)&3)*1024)); vhi[i]=vtr(vp_+(((i)>>2)*4096+((i)&3)*1024+512)); }while(0)
  #define KRD(G,j) do{ if(G){ kload2(kf,kp0+sl_next,j); SBAR(); } }while(0)
  #define STEP(C0,C1,P0,P1,t,GK,GV,GL) do{ SBAR(); \
    const lds_cptr vp_=vp0+sl_prev; \
    VRD(0); SBAR(); float sacc=(P0[0]+P0[1]); \
    GAPA(C0=__builtin_amdgcn_mfma_f32_32x32x16_bf16(kf[0],qr[0],C0,0,0,0), P0[2],P0[3],P0[4],P0[5],     pw0[0]=PKW(P0,0), pw0[1]=PKW(P0,2), pw0); \
    VRD(4); SBAR(); GAPA(C1=__builtin_amdgcn_mfma_f32_32x32x16_bf16(kf[1],qr[0],C1,0,0,0), P0[6],P0[7],P0[8],P0[9],     pw0[2]=PKW(P0,4), pw0[3]=PKW(P0,6), pw0); \
    VRD(1); SBAR(); GAPA(C0=__builtin_amdgcn_mfma_f32_32x32x16_bf16(kf[2],qr[1],C0,0,0,0),   P0[10],P0[11],P0[12],P0[13], pw1[0]=PKW(P0,8), pw1[1]=PKW(P0,10), pw1); \
    VRD(5); SBAR(); GAPA(C1=__builtin_amdgcn_mfma_f32_32x32x16_bf16(kf[3],qr[1],C1,0,0,0),   P0[14],P0[15],P1[0],P1[1],   pw1[2]=PKW(P0,12),pw1[3]=PKW(P0,14), pw1); \
    VRD(2); SBAR(); GAPA(C0=__builtin_amdgcn_mfma_f32_32x32x16_bf16(kf[4],qr[2],C0,0,0,0),   P1[2],P1[3],P1[4],P1[5],     pw2[0]=PKW(P1,0), pw2[1]=PKW(P1,2), pw2); \
    VRD(6); SBAR(); GAPA(C1=__builtin_amdgcn_mfma_f32_32x32x16_bf16(kf[5],qr[2],C1,0,0,0),   P1[6],P1[7],P1[8],P1[9],     pw2[2]=PKW(P1,4), pw2[3]=PKW(P1,6), pw2); \
    VRD(3); SBAR(); GAPA(C0=__builtin_amdgcn_mfma_f32_32x32x16_bf16(kf[6],qr[3],C0,0,0,0),   P1[10],P1[11],P1[12],P1[13], pw3[0]=PKW(P1,8), pw3[1]=PKW(P1,10), pw3); \
    VRD(7); SBAR(); GAPA(C1=__builtin_amdgcn_mfma_f32_32x32x16_bf16(kf[7],qr[3],C1,0,0,0),   P1[14],P1[15],0.f,0.f,       pw3[2]=PKW(P1,12),pw3[3]=PKW(P1,14), pw3); \
    l_reg+=sacc; \
    if(GK){DMA_K((t)+3,sl_cur);} if(GV){DMA_V((t)+1,sl_next);} \
    CMASK(C0,C1,t); \
    { float a=MX3(C0[0],C0[1],C1[0]),b=MX3(C0[2],C0[3],C1[1]); a=MX3(a,C1[2],C1[3]); \
      _Pragma("unroll") for(int r=4;r<16;r+=4){a=MX3(a,C0[r],C0[r+1]);b=MX3(b,C0[r+2],C0[r+3]);a=MX3(a,C1[r],C1[r+1]);b=MX3(b,C1[r+2],C1[r+3]);} \
      float rm=__builtin_fmaxf(a,b); { auto rr=__builtin_amdgcn_permlane32_swap(__float_as_uint(rm),__float_as_uint(rm),false,false); rm=__builtin_fmaxf(__uint_as_float(rr[0]),__uint_as_float(rr[1])); } \
      resc=false; \
      if(__builtin_expect(__any(rm>(float)THRL),0)){ const float dl=__builtin_fmaxf(rm,0.f); mhat+=dl; \
        _Pragma("unroll") for(int r=0;r<16;++r){C0[r]-=dl;C1[r]-=dl;} \
        const float f=__builtin_amdgcn_exp2f(-dl); l_reg*=f; if(hi==0)wsf[r32]=f; resc=true; } } \
    const float fb_=Fq-mhat; if(GL){ FKLOAD(P0,P1,(t)+1); } \
    SBAR(); \
    GAPB(o[0]=__builtin_amdgcn_mfma_f32_32x32x16_bf16(PAF(0),VFR(0),o[0],0,0,0), C0,0, FSUB(GL,P0,0)); \
    GAPB(o[1]=__builtin_amdgcn_mfma_f32_32x32x16_bf16(PAF(0),VFR(4),o[1],0,0,0), C0,4, FSUB(GL,P0,4)); \
    KRD(GL,0); GAPB(o[0]=__builtin_amdgcn_mfma_f32_32x32x16_bf16(PAF(1),VFR(1),o[0],0,0,0), C0,8, FSUB(GL,P0,8)); \
    KRD(GL,1); GAPB(o[1]=__builtin_amdgcn_mfma_f32_32x32x16_bf16(PAF(1),VFR(5),o[1],0,0,0), C0,12, FSUB(GL,P0,12)); \
    KRD(GL,2); GAPB(o[0]=__builtin_amdgcn_mfma_f32_32x32x16_bf16(PAF(2),VFR(2),o[0],0,0,0), C1,0, FSUB(GL,P1,0)); \
    KRD(GL,3); GAPB(o[1]=__builtin_amdgcn_mfma_f32_32x32x16_bf16(PAF(2),VFR(6),o[1],0,0,0), C1,4, FSUB(GL,P1,4)); \
    GAPB(o[0]=__builtin_amdgcn_mfma_f32_32x32x16_bf16(PAF(3),VFR(3),o[0],0,0,0), C1,8, FSUB(GL,P1,8)); \
    GAPB(o[1]=__builtin_amdgcn_mfma_f32_32x32x16_bf16(PAF(3),VFR(7),o[1],0,0,0), C1,12, FSUB(GL,P1,12)); \
    }while(0)
  BIAS(pB0,pB1,1);
  int t=1;
  #undef CMASK
  #define CMASK(P0,P1,t) do{}while(0)
  for(;t+5<NT;t+=2){
    STEP(pB0,pB1,pA0,pA1,t,true,true,true);     WAIT_BAR(2); RESC(); ROT();
    STEP(pA0,pA1,pB0,pB1,t+1,true,true,true);   WAIT_BAR(2); RESC(); ROT();
  }
  #undef CMASK
  #define CMASK(P0,P1,t) do{int jb_=(t)-(NT-4); if(jb_>=0)cmask(P0,P1,jb_,qrel,hi);}while(0)
  #define ENDW(tt) do{ if((tt)+3<NT){WAIT_BAR(2);} else if((tt)+2<NT){WAIT_BAR(1);} else {WAIT_BAR(0);} }while(0)
  for(;t+1<NT;t+=2){
    STEP(pB0,pB1,pA0,pA1,t,(t+3<NT),(t+1<NT),(t+1<NT));       ENDW(t);   RESC(); ROT();
    STEP(pA0,pA1,pB0,pB1,t+1,(t+4<NT),(t+2<NT),(t+2<NT));     ENDW(t+1); RESC(); ROT();
  }
  STEP(pB0,pB1,pA0,pA1,NT-1,false,false,false); RESC();
  { float sacc=pB0[0]+pB0[1]; _Pragma("unroll") for(int r=2;r<16;++r)sacc+=pB0[r]; _Pragma("unroll") for(int r=0;r<16;++r)sacc+=pB1[r]; l_reg+=sacc;
    pw0=(u32x4){PKW(pB0,0),PKW(pB0,2),PKW(pB0,4),PKW(pB0,6)};pw1=(u32x4){PKW(pB0,8),PKW(pB0,10),PKW(pB0,12),PKW(pB0,14)};pw2=(u32x4){PKW(pB1,0),PKW(pB1,2),PKW(pB1,4),PKW(pB1,6)};pw3=(u32x4){PKW(pB1,8),PKW(pB1,10),PKW(pB1,12),PKW(pB1,14)};
    SBAR(); pv(o,vb0+sl_cur,PAF(0),PAF(1),PAF(2),PAF(3)); }
  #undef PKW
  #undef PAF
  #undef VFR
  #undef PIN
  #undef MX3
  #undef GAPA
  #undef GAPB
  #undef EX
  #undef VRD
  #undef KRD
  #undef STEP
  #undef FKLOAD
  #undef FSUB
  #undef ENDW
  {auto rr=__builtin_amdgcn_permlane32_swap(__float_as_uint(l_reg),__float_as_uint(l_reg),false,false);l_reg=__uint_as_float(rr[0])+__uint_as_float(rr[1]);}
  if(hi==0)wsf[32+r32]=l_reg;asm volatile("s_waitcnt lgkmcnt(0)":::"memory");
  float rli[16];
  #pragma unroll
  for(int r=0;r<16;++r)rli[r]=__builtin_amdgcn_rcpf(wsf[32+crow(r,hi)]);
  bf16*Ow=O+(rowbase+q0+wid*QBLK)*DMO+h*D;
  { bf16*stg=(bf16*)(shm+LDS_OST)+wid*2048;
    #pragma unroll
    for(int r=0;r<16;++r){const int orow=crow(r,hi);
      #pragma unroll
      for(int d0=0;d0<2;++d0)stg[orow*64+d0*32+r32]=__float2bfloat16(o[d0][r]*rli[r]);}
    asm volatile("s_waitcnt lgkmcnt(0)":::"memory");
    #pragma unroll
    for(int i=0;i<4;++i){const int row=i*8+(lane>>3),ch=lane&7; const u32x4 v=*(const u32x4*)(stg+row*64+ch*8); ATTN_STORE16(Ow+(long)row*DMO+ch*8,v);} }
  asm volatile("s_waitcnt lgkmcnt(0)\n\ts_barrier":::"memory");
  #undef DMA_K
  #undef DMA_V
  #undef CMASK
  #undef START
  #undef RESC
  #undef ROT
  #undef BIAS
}
constexpr int ATTN_LDS_BYTES=LDS_BYTES;
#undef SBAR
#undef WAIT_BAR
}

#define LAS __attribute__((address_space(3)))
typedef unsigned short bf16_t;
typedef short bf16x8 __attribute__((ext_vector_type(8)));
typedef short s16x4 __attribute__((ext_vector_type(4)));
typedef float f32x4 __attribute__((ext_vector_type(4)));
typedef float f32x16 __attribute__((ext_vector_type(16)));
typedef unsigned u32x4 __attribute__((ext_vector_type(4)));
typedef unsigned u32x2 __attribute__((ext_vector_type(2)));

constexpr int NB = 8, SEQ = 2048, DM = 1024, MTOK = NB * SEQ, DFF = 2816, NLAYER = 4, QKV_LD = 3072;
constexpr int NWAVES = 8, NTHR = 512;
constexpr float LOG2E = 1.4426950408889634f;
constexpr int LDS_BYTES = 147456;
constexpr int VROW = 192;
constexpr int VTILE = 32 * VROW;
constexpr int LDS_F = 49152;
constexpr int NPHASE = 2 + 5 * NLAYER;
constexpr int LDS_MISC = 131072;

constexpr size_t MiB = 1u << 20;
constexpr size_t SZ_WQKV = (size_t)3072 * 1024 * 2, SZ_WO = (size_t)1024 * 1024 * 2, SZ_WI = (size_t)5632 * 1024 * 2, SZ_WOUT = (size_t)1024 * 2816 * 2;
constexpr size_t SZ_WLAYER = SZ_WQKV + SZ_WO + SZ_WI + SZ_WOUT;
constexpr size_t WS_W = 0;
constexpr size_t WS_XB = 104 * MiB;
constexpr size_t WS_XRES = WS_XB + 32 * MiB;
constexpr size_t WS_QKV = WS_XRES + 64 * MiB;
constexpr size_t WS_ATT = WS_QKV + 96 * MiB;
constexpr size_t WS_SMALL = WS_ATT + 32 * MiB;
constexpr size_t WS_ROWSS = WS_SMALL;
constexpr size_t WS_ROT = WS_ROWSS + (size_t)9 * 16 * MTOK * 4;
constexpr size_t WS_WF = WS_ROT + (size_t)2048 * 16 * 4;
constexpr size_t WS_LOCF = WS_WF + (size_t)2 * 16 * 1024 * 4;
constexpr size_t WS_TOTF = WS_LOCF + (size_t)128 * 2048 * 4;
constexpr size_t WS_LSE = WS_TOTF + (size_t)128 * 32 * 4;
constexpr size_t WS_BAR = WS_LSE + (size_t)2 * MTOK * 8 * 4;
constexpr size_t WS_PCNT = WS_BAR + 16384;
constexpr size_t WS_END = WS_PCNT + 16384;
static_assert(SZ_WLAYER * 4 <= 104 * MiB, "weights fit");

struct Args {
    const float* x; const float* norm_mix; const float* w_qkv_even; const float* w_o_even; const float* w_qkvf_odd; const float* b_forget; const float* w_o_odd;
    const float* norm_ffn; const float* w_ffn_in; const float* w_ffn_out; const float* norm_final;
    float* out; unsigned char* ws; int ph_lo, ph_hi;
};

__device__ __forceinline__ unsigned f2bf(float f) { unsigned u = __builtin_bit_cast(unsigned, f); return (u + 0x7fffu + ((u >> 16) & 1u)) >> 16; }
__device__ __forceinline__ unsigned pk2(float lo, float hi) { return f2bf(lo) | (f2bf(hi) << 16); }
__device__ __forceinline__ unsigned cvtpk(float lo, float hi) { unsigned r; asm volatile("v_cvt_pk_bf16_f32 %0, %1, %2" : "=v"(r) : "v"(lo), "v"(hi)); return r; }
__device__ __forceinline__ float wave_sum(float v) {
#pragma unroll
    for (int o = 1; o < 64; o <<= 1) v += __shfl_xor(v, o);
    return v;
}
#define LDS_WAIT() asm volatile("s_waitcnt lgkmcnt(0)" ::: "memory")
__device__ __forceinline__ int otid() { int t = threadIdx.x; asm volatile("" : "+v"(t)); return t; }

#ifndef PROBE_OPROJ
#define PROBE_OPROJ 0
#endif
#ifndef PROBE_FFO
#define PROBE_FFO 0
#endif
#ifndef FUSE_FINAL
#define FUSE_FINAL 1
#endif
#ifndef CONV_SPLIT
#define CONV_SPLIT 1
#endif
__device__ __forceinline__ void transpose_item(const float* W, int ldw, int K, int k0, int src_col, bf16_t* WT, int dst_row, const float* gain, float cscale, LAS float* scr, int lane) {
    const int kr = lane >> 3, c4 = lane & 7;
    f32x4 v[8]; float g[8];
#pragma unroll
    for (int i = 0; i < 8; ++i) { const int kk = 8 * i + kr; v[i] = *(const f32x4*)(W + (size_t)(k0 + kk) * ldw + src_col + 4 * c4); g[i] = gain ? gain[k0 + kk] * cscale : cscale; }
#pragma unroll
    for (int i = 0; i < 8; ++i) { const int kk = 8 * i + kr; LAS float* d = scr + kk * 33 + 4 * c4; d[0] = v[i].x * g[i]; d[1] = v[i].y * g[i]; d[2] = v[i].z * g[i]; d[3] = v[i].w * g[i]; }
    LDS_WAIT(); asm volatile("" ::: "memory");
    const int c = lane & 7;
#pragma unroll
    for (int j = 0; j < 4; ++j) { const int n = (lane >> 3) + 8 * j; const LAS float* s = scr + (8 * c) * 33 + n;
        u32x4 o; o.x = pk2(s[0 * 33], s[1 * 33]); o.y = pk2(s[2 * 33], s[3 * 33]); o.z = pk2(s[4 * 33], s[5 * 33]); o.w = pk2(s[6 * 33], s[7 * 33]);
        *(u32x4*)(WT + (size_t)(dst_row + n) * K + k0 + 8 * c) = o; }
    LDS_WAIT(); asm volatile("" ::: "memory");
}

__device__ __forceinline__ void convert_weights(const Args& a, int l_lo, int l_hi, LAS unsigned char* lds, int gw, int NGW) {
    const int tid = otid(), lane = tid & 63, wave = __builtin_amdgcn_readfirstlane(tid >> 6);
    LAS float* scr = (LAS float*)(lds + wave * 16384);
    constexpr int I_QKV = 16 * 96, I_O = 16 * 32, I_IN = 16 * 176, I_OUT = 44 * 32, I_LAYER = I_QKV + I_O + I_IN + I_OUT;
    for (int it = l_lo * I_LAYER + gw; it < l_hi * I_LAYER; it += NGW) {
        const int l = it / I_LAYER; int r = it % I_LAYER;
        bf16_t* wl = (bf16_t*)(a.ws + WS_W + (size_t)l * SZ_WLAYER);
        if (r < I_QKV) {
            const int kb = r / 96, nb = r % 96, n0 = 32 * nb;
            const float* W = (l & 1) ? a.w_qkvf_odd + (size_t)(l >> 1) * 1024 * 3088 : a.w_qkv_even + (size_t)(l >> 1) * 1024 * 3072;
            transpose_item(W, (l & 1) ? 3088 : 3072, 1024, 64 * kb, n0, wl, n0, a.norm_mix + l * 1024, n0 < 1024 ? 0.125f * LOG2E : 1.0f, scr, lane);
            continue; }
        r -= I_QKV;
        if (r < I_O) {
            const int kb = r / 32, nb = r % 32, n0 = 32 * nb;
            const float* W = (l & 1) ? a.w_o_odd + (size_t)(l >> 1) * 1024 * 1024 : a.w_o_even + (size_t)(l >> 1) * 1024 * 1024;
            transpose_item(W, 1024, 1024, 64 * kb, n0, (bf16_t*)((unsigned char*)wl + SZ_WQKV), n0, nullptr, 1.0f, scr, lane);
            continue; }
        r -= I_O;
        if (r < I_IN) {
            const int kb = r / 176, nb = r % 176, n0 = 32 * nb;
            const int pn = n0 >> 8, bj = (n0 >> 7) & 1, c0 = n0 & 127;
            transpose_item(a.w_ffn_in + (size_t)l * 1024 * 5632, 5632, 1024, 64 * kb, bj * 2816 + 128 * pn + c0, (bf16_t*)((unsigned char*)wl + SZ_WQKV + SZ_WO), n0, a.norm_ffn + l * 1024, 1.0f, scr, lane);
            continue; }
        r -= I_IN;
        {
            const int kb = r / 32, nb = r % 32, n0 = 32 * nb;
            transpose_item(a.w_ffn_out + (size_t)l * 2816 * 1024, 1024, 2816, 64 * kb, n0, (bf16_t*)((unsigned char*)wl + SZ_WQKV + SZ_WO + SZ_WI), n0, nullptr, 1.0f, scr, lane);
        }
    }
}

__device__ __forceinline__ void prologue(const Args& a, LAS unsigned char* lds, int vwg, int G) {
    const int tid = otid(), lane = tid & 63, wave = __builtin_amdgcn_readfirstlane(tid >> 6);
    const int gw = vwg * NWAVES + wave, NGW = G * NWAVES;
    convert_weights(a, 0, (CONV_SPLIT && G == 256) ? 1 : NLAYER, lds, gw, NGW);
    bf16_t* xb = (bf16_t*)(a.ws + WS_XB); float* rowss = (float*)(a.ws + WS_ROWSS);
    for (int m = gw; m < MTOK; m += NGW) {
        const f32x4* xr = (const f32x4*)(a.x + (size_t)m * DM) + lane; float s = 0.f; f32x4 v[4];
#pragma unroll
        for (int j = 0; j < 4; ++j) { v[j] = xr[64 * j]; s += (v[j].x * v[j].x + v[j].y * v[j].y) + (v[j].z * v[j].z + v[j].w * v[j].w); }
        s = wave_sum(s);
        unsigned long long* o8 = (unsigned long long*)(xb + (size_t)m * DM) + lane;
#pragma unroll
        for (int j = 0; j < 4; ++j) o8[64 * j] = (unsigned long long)pk2(v[j].x, v[j].y) | ((unsigned long long)pk2(v[j].z, v[j].w) << 32);
        if (lane < 16) rowss[(size_t)lane * MTOK + m] = (lane == 0) ? s : 0.f;
    }
    const int gt = vwg * NTHR + tid, NGT = G * NTHR;
    float* rot = (float*)(a.ws + WS_ROT);
    for (int i = gt; i < 2048 * 8; i += NGT) {
        const int pos = i >> 3, j = i & 7;
        const float invf[8] = {1.0f, 0.19392274474868576f, 0.03760603093086393f, 0.007292664737217109f, 0.001414213562373095f, 0.0002742481756762073f, 5.318295896944988e-05f, 1.031338537721246e-05f};
        float fq = invf[0];
#pragma unroll
        for (int t = 1; t < 8; ++t) fq = (j == t) ? invf[t] : fq;
        const float ang = (float)pos * fq;
        const double rev = (double)ang * 0.15915494309189535; const float fr = (float)(rev - floor(rev));
        rot[pos * 16 + j] = __builtin_amdgcn_cosf(fr); rot[pos * 16 + 8 + j] = __builtin_amdgcn_sinf(fr);
    }
    float* wf = (float*)(a.ws + WS_WF);
    for (int i = gt; i < 2 * 16 * 1024; i += NGT) {
        const int lo = i >> 14, hd = (i >> 10) & 15, k = i & 1023;
        wf[i] = a.w_qkvf_odd[(size_t)lo * 1024 * 3088 + (size_t)k * 3088 + 3072 + hd] * a.norm_mix[(2 * lo + 1) * 1024 + k];
    }
}

__device__ __forceinline__ void fgate_phase(const Args& a, int lo, LAS unsigned char* lds, int vwg, int G) {
    const int tid = otid(), lane = tid & 63, wave = __builtin_amdgcn_readfirstlane(tid >> 6);
    const bf16_t* xbq = (const bf16_t*)(a.ws + WS_XB); const float* rowss = (const float*)(a.ws + WS_ROWSS) + (size_t)(2 * (2 * lo + 1)) * 16 * MTOK;
    const float* wf = (const float*)(a.ws + WS_WF) + (size_t)lo * 16 * 1024;
    float* locF = (float*)(a.ws + WS_LOCF); float* totF = (float*)(a.ws + WS_TOTF);
    LAS float* lf = (LAS float*)lds;
    const int r16 = lane & 15, g4 = lane >> 4, tile = wave & 3, kh = wave >> 2;
    for (int j = vwg; j < 256; j += G) {
        const u32x2* xr = (const u32x2*)(xbq + (size_t)(64 * j + 16 * tile + r16) * DM + 512 * kh + 4 * g4);
        const f32x4* wr = (const f32x4*)(wf + (size_t)r16 * 1024 + 512 * kh + 4 * g4);
        f32x4 acc = {0.f, 0.f, 0.f, 0.f};
#pragma unroll 8
        for (int s = 0; s < 32; ++s) {
            const u32x2 xw = xr[4 * s]; const f32x4 wv = wr[4 * s];
            const f32x4 xv = {pg8::bf_lo(xw.x), pg8::bf_hi(xw.x), pg8::bf_lo(xw.y), pg8::bf_hi(xw.y)};
            acc = __builtin_amdgcn_mfma_f32_16x16x4f32(xv.x, wv.x, acc, 0, 0, 0);
            acc = __builtin_amdgcn_mfma_f32_16x16x4f32(xv.y, wv.y, acc, 0, 0, 0);
            acc = __builtin_amdgcn_mfma_f32_16x16x4f32(xv.z, wv.z, acc, 0, 0, 0);
            acc = __builtin_amdgcn_mfma_f32_16x16x4f32(xv.w, wv.w, acc, 0, 0, 0);
        }
#pragma unroll
        for (int jj = 0; jj < 4; ++jj) lf[(kh * 64 + 16 * tile + 4 * g4 + jj) * 16 + r16] = acc[jj];
        __syncthreads();
        float l2v[2];
#pragma unroll
        for (int q = 0; q < 2; ++q) {
            const int idx = tid + 512 * q, t = idx >> 4, hd = idx & 15;
            const float fl = (lf[idx] + lf[1024 + idx]) * pg8::rstd_of(rowss, 64 * j + t) + a.b_forget[lo * 16 + hd];
            const float z2 = fl * LOG2E; l2v[q] = -(fmaxf(-z2, 0.f) + __builtin_amdgcn_logf(1.0f + __builtin_amdgcn_exp2f(-fabsf(z2))));
        }
        __syncthreads();
        lf[tid] = l2v[0]; lf[tid + 512] = l2v[1];
        __syncthreads();
        if (tid < 16) {
            const int b = j >> 5, sl = j & 31; float run = 0.f; float* dst = locF + (size_t)(b * 16 + tid) * 2048 + sl * 64;
#pragma unroll 8
            for (int t = 0; t < 64; ++t) { run += lf[t * 16 + tid]; dst[t] = run; }
            totF[(b * 16 + tid) * 32 + sl] = run;
        }
        __syncthreads();
    }
}

__device__ __forceinline__ int phi32(int r) { return ((r >> 4) & 1) * 16 + ((r >> 2) & 1) * 8 + ((r >> 3) & 1) * 4 + (r & 3); }
__device__ __forceinline__ s16x4 vtr(const LAS unsigned char* p) { return __builtin_bit_cast(s16x4, __builtin_amdgcn_ds_read_tr16_b64_v4i16((LAS s16x4*)p)); }

template <int MODE, int DBG = 0>
__device__ __forceinline__ void attn_task(const bf16_t* qp, const bf16_t* kp, const bf16_t* vp, size_t rstride, int q0, int kb_lo, int kb_hi,
                                          LAS unsigned char* vlds, const LAS float* Fs, f32x16 (&O)[2], float& lse2) {
    const int lane = otid() & 63, n = lane & 31, hh = lane >> 5;
    bf16x8 qf[4];
    { const bf16_t* p = qp + (size_t)(q0 + n) * rstride + 8 * hh;
#pragma unroll
      for (int ks = 0; ks < 4; ++ks) qf[ks] = *(const bf16x8*)(p + 16 * ks); }
    const int qi = q0 + n;
    float Fq = 0.f; if (MODE == 0) Fq = Fs[qi];
#pragma unroll
    for (int r = 0; r < 16; ++r) { O[0][r] = 0.f; O[1][r] = 0.f; }
    float m = -1e30f, l = 0.f, R = 0.f;
    const bf16_t* kl = kp + (size_t)phi32(n) * rstride + 8 * hh;
    const bf16_t* vl = vp + (size_t)(lane >> 3) * rstride + 8 * (lane & 7);
    LAS unsigned char* vw = vlds + (lane >> 3) * VROW + (lane & 7) * 16;
    const LAS unsigned char* vr = vlds + (8 * hh + ((lane & 15) >> 2)) * VROW + (16 * ((lane >> 4) & 1) + 4 * (lane & 3)) * 2;
    bf16x8 kn[4]; u32x4 vn[4];
#define AT_ISSUE(kb) do { const bf16_t* kk_ = kl + (size_t)(kb) * 32 * rstride; const bf16_t* vv_ = vl + (size_t)(kb) * 32 * rstride; \
        _Pragma("unroll") for (int ks = 0; ks < 4; ++ks) kn[ks] = *(const bf16x8*)(kk_ + 16 * ks); \
        _Pragma("unroll") for (int ii = 0; ii < 4; ++ii) vn[ii] = *(const u32x4*)(vv_ + (size_t)(8 * ii) * rstride); } while (0)
    const int nblk = kb_hi - kb_lo + 1;
    int kb = (MODE == 2) ? kb_hi : kb_lo;
    AT_ISSUE(kb);
    for (int it = 0; it < nblk; ++it) {
        bf16x8 kc[4];
#pragma unroll
        for (int ks = 0; ks < 4; ++ks) kc[ks] = kn[ks];
        asm volatile("" ::: "memory");
#pragma unroll
        for (int ii = 0; ii < 4; ++ii) *(LAS u32x4*)(vw + ii * 8 * VROW) = vn[ii];
        asm volatile("" ::: "memory");
        const int kbn = (MODE == 2) ? kb - 1 : kb + 1;
        if (it + 1 < nblk && DBG != 1) AT_ISSUE(kbn);
        if (DBG != 2) {
        const int key0 = kb * 32 + 8 * hh;
        f32x16 s;
        if (MODE == 0) {
            const LAS f32x4* fk = (const LAS f32x4*)(Fs + key0);
            const f32x4 f0 = fk[0], f1 = fk[1], f2 = fk[4], f3 = fk[5];
#pragma unroll
            for (int e = 0; e < 4; ++e) { s[e] = Fq - f0[e]; s[4 + e] = Fq - f1[e]; s[8 + e] = Fq - f2[e]; s[12 + e] = Fq - f3[e]; }
        } else {
#pragma unroll
            for (int r = 0; r < 16; ++r) s[r] = 0.f;
        }
#pragma unroll
        for (int ks = 0; ks < 4; ++ks) s = __builtin_amdgcn_mfma_f32_32x32x16_bf16(kc[ks], qf[ks], s, 0, 0, 0);
        bf16x8 pb[2];
        if (MODE != 2) {
            const bool diag = (kb * 32 + 31 > q0);
            if (MODE == 1) {
                if (diag || kb * 32 < q0 - 97) {
#pragma unroll
                    for (int r = 0; r < 16; ++r) { const int ki = key0 + 16 * (r >> 3) + (r & 7); if (ki > qi || ki < qi - 128) s[r] = -1e30f; }
                }
            } else if (diag) {
#pragma unroll
                for (int r = 0; r < 16; ++r) { const int ki = key0 + 16 * (r >> 3) + (r & 7); if (ki > qi) s[r] = -1e30f; }
            }
            float bm = fmaxf(fmaxf(s[0], s[1]), fmaxf(s[2], s[3]));
#pragma unroll
            for (int r = 4; r < 16; r += 4) bm = fmaxf(bm, fmaxf(fmaxf(s[r], s[r + 1]), fmaxf(s[r + 2], s[r + 3])));
            bm = fmaxf(bm, __shfl_xor(bm, 32));
            const float mn = fmaxf(m, bm), alpha = __builtin_amdgcn_exp2f(m - mn); m = mn;
            float ps = 0.f;
#pragma unroll
            for (int r = 0; r < 16; ++r) { s[r] = __builtin_amdgcn_exp2f(s[r] - mn); ps += s[r]; }
            l = l * alpha + ps;
#pragma unroll
            for (int r = 0; r < 16; ++r) { O[0][r] *= alpha; O[1][r] *= alpha; }
        } else {
            const bool diag = (kb * 32 + 31 >= q0);
            float L[16];
#pragma unroll
            for (int r = 0; r < 16; ++r) {
                const float z = s[r], t = __builtin_amdgcn_exp2f(-fabsf(z)), sp = fmaxf(z, 0.f) + __builtin_amdgcn_logf(1.0f + t);
                L[r] = -sp; s[r] = z - sp;
            }
            if (diag) {
#pragma unroll
                for (int r = 0; r < 16; ++r) { const int ki = key0 + 16 * (r >> 3) + (r & 7); if (ki >= qi) { L[r] = 0.f; s[r] = -1e30f; } }
            }
            float sA = ((L[0] + L[1]) + (L[2] + L[3])) + ((L[4] + L[5]) + (L[6] + L[7]));
            float sB = ((L[8] + L[9]) + (L[10] + L[11])) + ((L[12] + L[13]) + (L[14] + L[15]));
            const float pA = __shfl_xor(sA, 32), pB = __shfl_xor(sB, 32);
            const float offA = sB + pB + (hh == 0 ? pA : 0.f), offB = (hh == 0 ? pB : 0.f);
            float run = R + offA;
#pragma unroll
            for (int e = 7; e >= 0; --e) { const float lr = L[e]; s[e] = __builtin_amdgcn_exp2f(s[e] + run); run += lr; }
            run = R + offB;
#pragma unroll
            for (int e = 15; e >= 8; --e) { const float lr = L[e]; s[e] = __builtin_amdgcn_exp2f(s[e] + run); run += lr; }
            R += (sA + sB) + (pA + pB);
        }
        { u32x4 w0, w1;
          w0.x = cvtpk(s[0], s[1]); w0.y = cvtpk(s[2], s[3]); w0.z = cvtpk(s[4], s[5]); w0.w = cvtpk(s[6], s[7]);
          w1.x = cvtpk(s[8], s[9]); w1.y = cvtpk(s[10], s[11]); w1.z = cvtpk(s[12], s[13]); w1.w = cvtpk(s[14], s[15]);
          pb[0] = __builtin_bit_cast(bf16x8, w0); pb[1] = __builtin_bit_cast(bf16x8, w1); }
        asm volatile("" ::: "memory");
#pragma unroll
        for (int db = 0; db < 2; ++db)
#pragma unroll
            for (int kk = 0; kk < 2; ++kk) {
                const s16x4 lo4 = vtr(vr + (16 * kk) * VROW + 64 * db), hi4 = vtr(vr + (16 * kk + 4) * VROW + 64 * db);
                const bf16x8 av = {lo4[0], lo4[1], lo4[2], lo4[3], hi4[0], hi4[1], hi4[2], hi4[3]};
                O[db] = __builtin_amdgcn_mfma_f32_32x32x16_bf16(av, pb[kk], O[db], 0, 0, 0);
            }
        asm volatile("s_waitcnt lgkmcnt(0)" ::: "memory");
        } else { asm volatile("s_waitcnt lgkmcnt(0)" ::: "memory"); O[0][0] += __builtin_bit_cast(float, (int)kc[0][0]) ; }
        if (MODE == 2) { if (__builtin_amdgcn_ballot_w64(R >= -160.f) == 0ull) break; }
        kb = kbn;
    }
#undef AT_ISSUE
    asm volatile("s_waitcnt vmcnt(0)" ::: "memory");
    if (MODE != 2) {
        l += __shfl_xor(l, 32);
        const float inv = 1.0f / l;
#pragma unroll
        for (int r = 0; r < 16; ++r) { O[0][r] *= inv; O[1][r] *= inv; }
        lse2 = m + __builtin_amdgcn_logf(l);
    }
}

__device__ __forceinline__ void store_o_bf16(const f32x16 (&O)[2], bf16_t* att_row  , int hh) {
#pragma unroll
    for (int db = 0; db < 2; ++db)
#pragma unroll
        for (int i = 0; i < 4; ++i) {
            u32x2 w; w.x = cvtpk(O[db][4 * i], O[db][4 * i + 1]); w.y = cvtpk(O[db][4 * i + 2], O[db][4 * i + 3]);
            *(u32x2*)(att_row + 32 * db + 8 * i + 4 * hh) = w;
        }
}

constexpr int LDS_FOXF = 90112;
__device__ __forceinline__ void fox_phase(const Args& a, unsigned char* lds_gen, LAS unsigned char* lds, int vwg, int G) {
    const int tid = otid();
    const bf16_t* qkv = (const bf16_t*)(a.ws + WS_QKV); bf16_t* att = (bf16_t*)(a.ws + WS_ATT);
    const float* locF = (const float*)(a.ws + WS_LOCF); const float* totF = (const float*)(a.ws + WS_TOTF);
    LAS float* Fs = (LAS float*)(lds + LDS_FOXF); LAS float* pre = Fs + 2048;
    const int nun = (G == 256) ? 4 : (1024 + G - 1) / G;
    int cur_bh = -1;
    for (int ui = 0; ui < nun; ++ui) {
        int bh, qb;
        if (G == 256) { const int x = vwg & 7, vi = vwg >> 3, g = vi >> 3, s = vi & 7; bh = 16 * x + 4 * ui + g; qb = (ui & 1) ? 7 - s : s; }
        else { const int un = ui * G + vwg; if (un >= 1024) break; bh = un >> 3; qb = un & 7; }
        const int b = bh >> 4, h = bh & 15;
        if (bh != cur_bh) {
            cur_bh = bh;
            __syncthreads();
            if (tid < 64) {
                const float v = (tid < 32) ? totF[bh * 32 + tid] : 0.f; float s2 = v;
#pragma unroll
                for (int o = 1; o < 32; o <<= 1) { const float t2 = __shfl_up(s2, o); if ((tid & 63) >= o) s2 += t2; }
                if (tid < 32) pre[tid] = s2 - v;
            }
            __syncthreads();
            for (int t = tid; t < 2048; t += NTHR) Fs[t] = locF[(size_t)bh * 2048 + t] + pre[t >> 6];
            __syncthreads();
        }
        attn_body::attn_unit<8>(b, h, qb, (const attn_body::bf16*)qkv, (const attn_body::bf16*)(qkv + 1024), (const attn_body::bf16*)(qkv + 2048), (attn_body::bf16*)att, (char*)lds_gen, Fs);
    }
}

template <int PART>
__device__ __forceinline__ void even_attn_phase(const Args& a, LAS unsigned char* lds, int vwg, int G) {
    const int tid = otid(), lane = tid & 63, wave = __builtin_amdgcn_readfirstlane(tid >> 6), n = lane & 31, hh = lane >> 5;
    const bf16_t* qkv = (const bf16_t*)(a.ws + WS_QKV); bf16_t* att = (bf16_t*)(a.ws + WS_ATT);
    bf16_t* part = (bf16_t*)a.out;
    float* plse = (float*)(a.ws + WS_LSE);
    LAS unsigned char* vlds = lds + wave * VTILE;
    const LAS float* nof = (const LAS float*)lds;
    for (int j0 = vwg; j0 < 256; j0 += G) {
        const int j = (G == 256) ? ((j0 & 7) * 32 + (j0 >> 3)) : j0;
        const int bh = j >> 2, b = bh >> 3, hl = bh & 7, c = j & 3;
        if (PART & 1) { const bf16_t* base = qkv + (size_t)(b * SEQ) * QKV_LD + hl * 64;
          for (int ui = 0; ui < 2; ++ui) {
              const int u = ui ? 7 - c : c, qt = 8 * u + wave;
              f32x16 O[2]; float lse;
              attn_task<2>(base, base + 1024, base + 2048, (size_t)QKV_LD, 32 * qt, 0, qt, vlds, nof, O, lse);
              store_o_bf16(O, att + (size_t)(b * SEQ + 32 * qt + n) * DM + hl * 64, hh);
          } }
        if (!(PART & 2)) continue;
        const bf16_t* base = qkv + (size_t)(b * SEQ) * QKV_LD + (8 + hl) * 64;
        for (int p = 0; p < 2; ++p) {
            const int dil = p ? 4 : 1;
            for (int ti = 0; ti < 2; ++ti) {
                const int task = wave + 8 * ti;
                const int res = p ? (task & 3) : 0, tile = p ? (task >> 2) : task;
                const int q0 = (p ? 128 * c : 512 * c) + 32 * tile;
                const int kbh = q0 >> 5, kbl = kbh - 4 < 0 ? 0 : kbh - 4;
                const bf16_t* bp = base + (size_t)res * QKV_LD;
                f32x16 O[2]; float lse;
                attn_task<1>(bp, bp + 1024, bp + 2048, (size_t)dil * QKV_LD, q0, kbl, kbh, vlds, nof, O, lse);
                const int tok = res + dil * (q0 + n);
                if (PART & 4) continue;
                store_o_bf16(O, part + ((size_t)p * MTOK + (size_t)(b * SEQ + tok)) * 512 + hl * 64, hh);
                if (hh == 0) plse[((size_t)p * MTOK + (size_t)(b * SEQ + tok)) * 8 + hl] = lse;
            }
        }
        __syncthreads();
        for (int ti = 0; ti < 2; ++ti) {
            const int res = wave + 8 * ti, q0 = 32 * c;
            const bf16_t* bp = base + (size_t)res * QKV_LD;
            f32x16 O[2]; float lse3;
            attn_task<1>(bp, bp + 1024, bp + 2048, (size_t)16 * QKV_LD, q0, 0, c, vlds, nof, O, lse3);
            const int tok = res + 16 * (q0 + n); const size_t grow = (size_t)(b * SEQ + tok);
            if (PART & 4) { store_o_bf16(O, att + grow * DM + (8 + hl) * 64, hh); continue; }
            const float l1 = plse[grow * 8 + hl], l2 = plse[((size_t)MTOK + grow) * 8 + hl];
            const float mx = fmaxf(lse3, fmaxf(l1, l2));
            float w1 = __builtin_amdgcn_exp2f(l1 - mx), w2 = __builtin_amdgcn_exp2f(l2 - mx), w3 = __builtin_amdgcn_exp2f(lse3 - mx);
            const float inv = 1.0f / (w1 + w2 + w3); w1 *= inv; w2 *= inv; w3 *= inv;
            const bf16_t* p1 = part + grow * 512 + hl * 64; const bf16_t* p2 = part + ((size_t)MTOK + grow) * 512 + hl * 64;
#pragma unroll
            for (int db = 0; db < 2; ++db)
#pragma unroll
                for (int i = 0; i < 4; ++i) {
                    const u32x2 r1 = *(const u32x2*)(p1 + 32 * db + 8 * i + 4 * hh), r2 = *(const u32x2*)(p2 + 32 * db + 8 * i + 4 * hh);
                    const float a1[4] = {__uint_as_float(r1.x << 16), __uint_as_float(r1.x & 0xffff0000u), __uint_as_float(r1.y << 16), __uint_as_float(r1.y & 0xffff0000u)};
                    const float a2[4] = {__uint_as_float(r2.x << 16), __uint_as_float(r2.x & 0xffff0000u), __uint_as_float(r2.y << 16), __uint_as_float(r2.y & 0xffff0000u)};
#pragma unroll
                    for (int e = 0; e < 4; ++e) O[db][4 * i + e] = O[db][4 * i + e] * w3 + a1[e] * w1 + a2[e] * w2;
                }
            store_o_bf16(O, att + grow * DM + (8 + hl) * 64, hh);
        }
        __syncthreads();
    }
}

__device__ __forceinline__ void final_phase(const Args& a, int vwg, int G) {
    const int tid = otid(), lane = tid & 63, wave = tid >> 6;
    const bf16_t* xbf = (const bf16_t*)(a.ws + WS_XB); const float* rowss = (const float*)(a.ws + WS_ROWSS) + (size_t)8 * 16 * MTOK;
    const int gw = vwg * NWAVES + wave, NGW = G * NWAVES;
    f32x4 g[4];
#pragma unroll
    for (int j = 0; j < 4; ++j) g[j] = ((const f32x4*)a.norm_final)[lane + 64 * j];
    for (int m = gw; m < MTOK; m += NGW) {
        const float rs = pg8::rstd_of(rowss, m);
        const u32x2* xr = (const u32x2*)(xbf + (size_t)m * DM) + lane; f32x4* o = (f32x4*)(a.out + (size_t)m * DM) + lane;
#pragma unroll
        for (int j = 0; j < 4; ++j) { const u32x2 xw = xr[64 * j]; o[64 * j] = (f32x4){pg8::bf_lo(xw.x), pg8::bf_hi(xw.x), pg8::bf_lo(xw.y), pg8::bf_hi(xw.y)} * rs * g[j]; }
    }
}

#define XB_TMO      128
#define XB_XCNT(j)  (256  + 64 * (j))
#define XB_XSUB(j)  (1280 + 64 * (j))
#define XB_XGEN(j)  (2304 + 64 * (j))
#define XB_TOP      3328
#define XB_TOPGEN   3392
#define XCD_BAR_WORDS 3456
#define XB_SPIN_CAP (1u << 18)

__device__ __forceinline__ unsigned xb_ld(unsigned* p)              { return __hip_atomic_load(p, __ATOMIC_RELAXED, __HIP_MEMORY_SCOPE_AGENT); }
__device__ __forceinline__ unsigned xb_add(unsigned* p, unsigned v) { return __hip_atomic_fetch_add(p, v, __ATOMIC_RELAXED, __HIP_MEMORY_SCOPE_AGENT); }
__device__ __forceinline__ unsigned xb_xcc_id() { return (unsigned)__builtin_amdgcn_s_getreg((3 << 11) | 20) & 0xFu; }
#define XB_SPIN(cond, bar) do { unsigned _sp = 0; while (cond) { __builtin_amdgcn_s_sleep(1); \
    if ((++_sp & 255u) == 0u) { if (xb_ld(&(bar)[XB_TMO])) break; if (_sp > XB_SPIN_CAP) { atomicAdd(&(bar)[XB_TMO], 1u); break; } } } } while (0)

struct XcdBarrier {
    unsigned* bar; unsigned x;
    volatile LAS unsigned* st;
};

__device__ __forceinline__ XcdBarrier xcd_barrier_post(unsigned* bar, volatile LAS unsigned* st) {
    XcdBarrier b; b.bar = bar; b.x = xb_xcc_id(); b.st = st;
    if (threadIdx.x == 0) (void)xb_add(&bar[XB_XCNT(b.x)], 1u);
    return b;
}
__device__ __forceinline__ void xcd_barrier_complete(unsigned* bar, unsigned x, unsigned& nloc, unsigned& nx) {
    const unsigned G = gridDim.x * gridDim.y * gridDim.z;
    unsigned sum, cnt, mine, sp = 0u;
    for (;;) {
        sum = 0u; cnt = 0u; mine = 0u;
#pragma unroll
        for (unsigned j = 0; j < 16; ++j) { const unsigned c = xb_ld(&bar[XB_XCNT(j)]); sum += c; cnt += (c > 0u) ? 1u : 0u; mine = (j == x) ? c : mine; }
        if (sum == G) break;
        __builtin_amdgcn_s_sleep(1);
        if ((++sp & 255u) == 0u) { if (xb_ld(&bar[XB_TMO])) break; if (sp > XB_SPIN_CAP) { atomicAdd(&bar[XB_TMO], 1u); break; } }
    }
    nloc = mine > 0u ? mine : 1u; nx = cnt > 0u ? cnt : 1u;
}

__device__ __forceinline__ void xcd_barrier(const XcdBarrier& b) {
    asm volatile("s_waitcnt vmcnt(0)" ::: "memory");
    __syncthreads();
    if (threadIdx.x == 0) {
        unsigned* bar = b.bar;
        __builtin_amdgcn_s_waitcnt(0);
        unsigned nloc = b.st[0], nx = b.st[1];
        if (nloc == 0u) { xcd_barrier_complete(bar, b.x, nloc, nx); b.st[0] = nloc; b.st[1] = nx; }
        const unsigned old = xb_add(&bar[XB_XSUB(b.x)], 1u);
        const unsigned gen = old / nloc;
        if (old + 1u == (gen + 1u) * nloc) {
            __builtin_amdgcn_fence(__ATOMIC_RELEASE, "agent");
            asm volatile("s_waitcnt vmcnt(0)" ::: "memory");
            const unsigned og = xb_add(&bar[XB_TOP], 1u);
            const unsigned tg = og / nx;
            if (og + 1u == (tg + 1u) * nx) xb_add(&bar[XB_TOPGEN], 1u);
            else XB_SPIN(xb_ld(&bar[XB_TOPGEN]) == tg, bar);
            __builtin_amdgcn_fence(__ATOMIC_ACQUIRE, "agent");
            xb_add(&bar[XB_XGEN(b.x)], 1u);
            asm volatile("s_waitcnt vmcnt(0)" ::: "memory");
        } else {
            XB_SPIN(xb_ld(&bar[XB_XGEN(b.x)]) == gen, bar);
            __builtin_amdgcn_fence(__ATOMIC_ACQUIRE, "agent");
            asm volatile("s_waitcnt vmcnt(0)" ::: "memory");
        }
    }
    __syncthreads();
}

#ifndef DBG_EVEN
#define DBG_EVEN 0
#endif
#ifndef DBG_FOX
#define DBG_FOX 0
#endif
#ifndef REP_QKV
#define REP_QKV 1
#endif
#ifndef REP_FG
#define REP_FG 1
#endif
#ifndef REP_FFI
#define REP_FFI 1
#endif
#ifndef REP_PRO
#define REP_PRO 1
#endif
#ifndef REP_SYNC
#define REP_SYNC 1
#endif
#ifndef REP_FOX
#define REP_FOX 1
#endif
#ifndef REP_EVEN
#define REP_EVEN 1
#endif
__global__ void __launch_bounds__(NTHR, 2) fwd_kernel(Args a) {
    extern __shared__ __attribute__((aligned(16))) unsigned char lds_raw[];
    LAS unsigned char* lds = (LAS unsigned char*)lds_raw;
    cg::grid_group grid = cg::this_grid();
    const int G = gridDim.x, vwg = blockIdx.x;
    unsigned char* ws = a.ws;
    bf16_t* xb = (bf16_t*)(ws + WS_XB); float* xres = (float*)(ws + WS_XRES); bf16_t* qkv = (bf16_t*)(ws + WS_QKV); bf16_t* hid = (bf16_t*)(ws + WS_QKV);
    bf16_t* att = (bf16_t*)(ws + WS_ATT); float* rowss = (float*)(ws + WS_ROWSS); const float* rot = (const float*)(ws + WS_ROT);
    unsigned* barw = (unsigned*)(ws + WS_BAR);
    volatile LAS unsigned* bst = (volatile LAS unsigned*)(lds + LDS_MISC);
    if (threadIdx.x == 0) { bst[0] = 0u; bst[1] = 0u; }
    if (blockIdx.x == 0) { for (int i = threadIdx.x; i < 8192; i += NTHR) barw[i] = 0u; }
    __syncthreads();
    XcdBarrier bar; bar.bar = barw; bar.x = 0; bar.st = bst;
    const bool multi = (a.ph_hi - a.ph_lo) > 1;
    if (multi) { grid.sync(); bar = xcd_barrier_post(barw, bst); }
    for (int ph = a.ph_lo; ph < a.ph_hi; ++ph) {
        if (ph == 0) { for (int rep = 0; rep < REP_PRO; ++rep) { prologue(a, lds, vwg, G); __syncthreads(); } }
        else if (ph == NPHASE - 1) { if (!(FUSE_FINAL && G == 256)) final_phase(a, vwg, G); }
        else {
            const int l = (ph - 1) / 5, sp = (ph - 1) % 5;
            const bf16_t* wl = (const bf16_t*)(ws + WS_W + (size_t)l * SZ_WLAYER);
            const bf16_t* w_qkv = wl; const bf16_t* w_o = (const bf16_t*)((const unsigned char*)wl + SZ_WQKV);
            const bf16_t* w_in = (const bf16_t*)((const unsigned char*)wl + SZ_WQKV + SZ_WO); const bf16_t* w_out = (const bf16_t*)((const unsigned char*)wl + SZ_WQKV + SZ_WO + SZ_WI);
            if (sp == 0) {
                pg8::Gemm g{xb, w_qkv, MTOK, 3072, 1024}; pg8::StaticOrder S; S.init(MTOK, 3072, G, vwg);
                pg8::EpiQKV E{qkv, rowss + (size_t)(2 * l) * 16 * MTOK, rot, (l & 1) ? 0 : 1, (LAS float*)(lds + LDS_MISC + 1024), -1};
                { pg8::Unit u0; if (S.next(0, u0)) { E.fm = u0.pm & ~7; pg8::rstd_tables(E.rtab, E.rowss, E.fm); } __syncthreads(); }
                for (int rep = 0; rep < REP_QKV; ++rep) { pg8::gemm_phase<pg8::EpiQKV, pg8::StaticOrder, true, true>(lds, g, S, E); __syncthreads(); }
                if (l & 1) { for (int rep = 0; rep < REP_FG; ++rep) { __syncthreads(); fgate_phase(a, l >> 1, lds, vwg, G); } }
            } else if (sp == 1) {
                if (l & 1) { for (int rep = 0; rep < REP_FOX; ++rep) { fox_phase(a, lds_raw, lds, vwg, G); __syncthreads(); } } else { if (DBG_EVEN) { even_attn_phase<DBG_EVEN>(a, lds, vwg, G); __syncthreads(); } even_attn_phase<3>(a, lds, vwg, G); }
            } else if (sp == 2) {
                pg8::Gemm g{att, w_o, MTOK, 1024, 1024}; pg8::StaticOrder S; S.init(MTOK, 1024, G, vwg);
                for (int rep = 0; rep < PROBE_OPROJ; ++rep) { pg8::EpiNull EN{a.out}; pg8::gemm_phase<pg8::EpiNull, pg8::StaticOrder, true, true>(lds, g, S, EN); __syncthreads(); }
                if (l == 0) { pg8::EpiResid<true> E{a.x, xb, rowss + (size_t)(2 * l + 1) * 16 * MTOK, xres}; pg8::gemm_phase<pg8::EpiResid<true>, pg8::StaticOrder, true, true>(lds, g, S, E); }
                else { pg8::EpiResid<false> E{nullptr, xb, rowss + (size_t)(2 * l + 1) * 16 * MTOK, xres}; pg8::gemm_phase<pg8::EpiResid<false>, pg8::StaticOrder, true, true>(lds, g, S, E); }
            } else if (sp == 3) {
                pg8::Gemm g{xb, w_in, MTOK, 5632, 1024}; pg8::StaticOrder S; S.init(MTOK, 5632, G, vwg);
                pg8::EpiSwiGLU E{hid, rowss + (size_t)(2 * l + 1) * 16 * MTOK, (LAS float*)(lds + LDS_MISC + 1024), -1};
                { pg8::Unit u0; if (S.next(0, u0)) { E.fm = u0.pm & ~7; pg8::rstd_tables(E.rtab, E.rowss, E.fm); } __syncthreads(); }
                for (int rep = 0; rep < REP_FFI; ++rep) { pg8::gemm_phase<pg8::EpiSwiGLU, pg8::StaticOrder, true, true>(lds, g, S, E); __syncthreads(); }
                if (CONV_SPLIT && G == 256 && vwg >= 128 && l + 1 < NLAYER) { __syncthreads(); convert_weights(a, l + 1, l + 2, lds, (vwg - 128) * NWAVES + __builtin_amdgcn_readfirstlane((int)(threadIdx.x >> 6)), 128 * NWAVES); }
            } else {
                pg8::Gemm g{hid, w_out, MTOK, 1024, 2816}; pg8::StaticOrder S; S.init(MTOK, 1024, G, vwg);
                for (int rep = 0; rep < PROBE_FFO; ++rep) { pg8::EpiNull EN{a.out}; pg8::gemm_phase<pg8::EpiNull, pg8::StaticOrder, true, true>(lds, g, S, EN); __syncthreads(); }
                if (FUSE_FINAL && l == NLAYER - 1 && G == 256) {
                    pg8::EpiFinal E{xb, a.out, rowss + (size_t)8 * 16 * MTOK, a.norm_final, (unsigned*)(ws + WS_PCNT), xres};
                    pg8::gemm_phase<pg8::EpiFinal, pg8::StaticOrder, true, true>(lds, g, S, E);
                } else {
                    pg8::EpiResid<false> E{nullptr, xb, rowss + (size_t)(2 * l + 2) * 16 * MTOK, xres};
                    pg8::gemm_phase<pg8::EpiResid<false>, pg8::StaticOrder, true, true>(lds, g, S, E);
                }
            }
        }
        if (ph + 1 < a.ph_hi && !(FUSE_FINAL && G == 256 && ph == NPHASE - 2)) {
            for (int rep = 0; rep < REP_SYNC; ++rep) xcd_barrier(bar);
        }
    }
}

#ifndef N_LAUNCH_MODE
#define N_LAUNCH_MODE 1
#endif

extern "C" void kernel_launch(void* const* d_in, const int* in_sizes, int n_in, void* d_out, int out_size, void* d_ws, size_t ws_size, hipStream_t stream) {
    static int grid = 0;
    if (grid == 0) {
        if (n_in != 11 || out_size != MTOK * DM || ws_size < WS_END) { fprintf(stderr, "kernel_launch: unexpected sizes n_in %d out %d ws %zu (need %zu)\n", n_in, out_size, ws_size, (size_t)WS_END); grid = -1; return; }
        int dev = 0, cus = 0, per_cu = 0;
        hipGetDevice(&dev); hipDeviceGetAttribute(&cus, hipDeviceAttributeMultiprocessorCount, dev);
        if (hipFuncSetAttribute((const void*)fwd_kernel, hipFuncAttributeMaxDynamicSharedMemorySize, LDS_BYTES) != hipSuccess) { fprintf(stderr, "kernel_launch: hipFuncSetAttribute failed\n"); grid = -1; return; }
        if (hipOccupancyMaxActiveBlocksPerMultiprocessor(&per_cu, (const void*)fwd_kernel, NTHR, LDS_BYTES) != hipSuccess || per_cu < 1) { fprintf(stderr, "kernel_launch: occupancy query says %d\n", per_cu); per_cu = 1; }
        (void)hipGetLastError();
        grid = cus * 1;
        fprintf(stderr, "kernel_launch: grid %d (cus %d, per_cu %d)\n", grid, cus, per_cu);
    }
    if (grid < 0) return;
    Args a{};
    a.x = (const float*)d_in[0]; a.norm_mix = (const float*)d_in[1]; a.w_qkv_even = (const float*)d_in[2]; a.w_o_even = (const float*)d_in[3];
    a.w_qkvf_odd = (const float*)d_in[4]; a.b_forget = (const float*)d_in[5]; a.w_o_odd = (const float*)d_in[6]; a.norm_ffn = (const float*)d_in[7];
    a.w_ffn_in = (const float*)d_in[8]; a.w_ffn_out = (const float*)d_in[9]; a.norm_final = (const float*)d_in[10];
    a.out = (float*)d_out; a.ws = (unsigned char*)d_ws;
#if N_LAUNCH_MODE == 1
    a.ph_lo = 0; a.ph_hi = NPHASE;
    void* args[] = {&a};
    hipError_t e = hipLaunchCooperativeKernel((const void*)fwd_kernel, dim3(grid), dim3(NTHR), args, LDS_BYTES, stream);
    if (e != hipSuccess) fprintf(stderr, "cooperative launch failed: %s (grid %d)\n", hipGetErrorString(e), grid);
#else
    for (int ph = 0; ph < NPHASE; ++ph) {
        a.ph_lo = ph; a.ph_hi = ph + 1;
        hipLaunchKernelGGL(fwd_kernel, dim3(grid), dim3(NTHR), LDS_BYTES, stream, a);
    }
#endif
}
```
